# Optimizing an MI355X kernel written in HIP

```python
import math
import jax, jax.numpy as jnp
from jax import lax
import numpy as np

D_MODEL = 1024
BATCH = 16
SEQ = 2048
DEPTH = 4

HEAD_DIM = 64
SB_HEADS = 8
SB_WIDTH = SB_HEADS * HEAD_DIM
NSA_HEADS = 8
NSA_KV_HEADS = 2
NSA_GROUP = NSA_HEADS // NSA_KV_HEADS
NSA_WIDTH = NSA_HEADS * HEAD_DIM
NSA_KV_WIDTH = NSA_KV_HEADS * HEAD_DIM
NSA_BRANCHES = 3
CMP_LEN = 32
CMP_STRIDE = 16
CMP_HIDDEN = 256
SEL_BLOCK = 64
SEL_TOP_N = 8
WINDOW = 512
Q_BLOCK = 128
ROPE_THETA = 10000.0
NORM_EPS = 1e-6
FORCED_BONUS = 1e4
NEG_INF = -1e30

IN_SPLITS = (SB_WIDTH, SB_WIDTH, SB_WIDTH, SB_WIDTH,
             NSA_WIDTH,
             NSA_KV_WIDTH, NSA_KV_WIDTH,
             NSA_KV_WIDTH, NSA_KV_WIDTH,
             NSA_KV_WIDTH, NSA_KV_WIDTH,
             NSA_BRANCHES * NSA_HEADS,
             NSA_WIDTH,
             D_MODEL, D_MODEL)
N_IN = 4 * SB_WIDTH + NSA_WIDTH + 6 * NSA_KV_WIDTH + NSA_BRANCHES * NSA_HEADS + NSA_WIDTH + 2 * D_MODEL

kernel_name = 'hybrid_stickbreak_nsa_block'


def rms_norm(x, g):
    xf = x.astype(jnp.float32)
    y = xf * lax.rsqrt(jnp.mean(xf * xf, axis=-1, keepdims=True) + NORM_EPS)
    return (y * g.astype(jnp.float32)).astype(x.dtype)


def rope(x, pos):
    half = HEAD_DIM // 2
    inv_freq = ROPE_THETA ** (-jnp.arange(half, dtype=jnp.float32) / half)
    ang = pos.astype(jnp.float32)[:, None, :, None] * inv_freq
    cos, sin = jnp.cos(ang), jnp.sin(ang)
    xf = x.astype(jnp.float32)
    x1, x2 = xf[..., :half], xf[..., half:]
    return jnp.concatenate([x1 * cos - x2 * sin, x2 * cos + x1 * sin], axis=-1).astype(x.dtype)


def split_heads(t, n):
    b, l, _ = t.shape
    return t.reshape(b, l, n, HEAD_DIM).transpose(0, 2, 1, 3)


def merge_heads(t):
    b, n, l, d = t.shape
    return t.transpose(0, 2, 1, 3).reshape(b, l, n * d)


def masked_softmax(s, mask):
    return jax.nn.softmax(jnp.where(mask, s.astype(jnp.float32), NEG_INF), axis=-1)


def stick_breaking_attention(q, k, v):
    s_len = q.shape[2]
    scale = HEAD_DIM ** -0.5
    outs = []
    for i in range(s_len // Q_BLOCK):
        end = (i + 1) * Q_BLOCK
        qb = q[:, :, i * Q_BLOCK:end]
        kb, vb = k[:, :, :end], v[:, :, :end]
        z = jnp.einsum('bhqd,bhkd->bhqk', qb, kb).astype(jnp.float32) * scale
        t = i * Q_BLOCK + jnp.arange(Q_BLOCK)
        s = jnp.arange(end)
        mask = s[None, :] < t[:, None]
        log_1m = jnp.where(mask, jax.nn.log_sigmoid(-z), 0.0)
        between = lax.cumsum(log_1m, axis=3, reverse=True) - log_1m
        w = jnp.where(mask, jnp.exp(jax.nn.log_sigmoid(z) + between), 0.0)
        outs.append(jnp.einsum('bhqk,bhkd->bhqd', w.astype(vb.dtype), vb))
    return jnp.concatenate(outs, axis=2)


def compress_blocks(x, idx, pe, w1, b1, w2):
    blocks = x[:, :, idx] + pe
    flat = blocks.reshape(blocks.shape[:3] + (CMP_LEN * HEAD_DIM,))
    return jax.nn.silu(flat @ w1 + b1) @ w2


def nsa_attention(q, k_cmp, v_cmp, k_slc, v_slc, k_win, v_win, branch_gate, pos,
                  k_cmp_norm_g, cmp_pe, cmp_w1, cmp_b1, cmp_w2):
    b, _, s_len, _ = q.shape
    g_n, r_n = NSA_KV_HEADS, NSA_GROUP
    scale = HEAD_DIM ** -0.5
    t = jnp.arange(s_len)
    qg = q.reshape(b, g_n, r_n, s_len, HEAD_DIM)

    n_cmp = (s_len - CMP_LEN) // CMP_STRIDE + 1
    cmp_start = jnp.arange(n_cmp) * CMP_STRIDE
    idx = cmp_start[:, None] + jnp.arange(CMP_LEN)[None, :]
    kc = compress_blocks(k_cmp, idx, cmp_pe[0], cmp_w1[0], cmp_b1[0], cmp_w2[0])
    vc = compress_blocks(v_cmp, idx, cmp_pe[1], cmp_w1[1], cmp_b1[1], cmp_w2[1])
    kc = rope(rms_norm(kc, k_cmp_norm_g), jnp.mean(pos[:, idx].astype(jnp.float32), axis=-1))
    s_cmp = jnp.einsum('bgrqd,bgcd->bgrqc', qg, kc) * scale
    mask_c = (cmp_start + CMP_LEN - 1)[None, :] <= t[:, None]
    p_cmp = masked_softmax(s_cmp, mask_c) * jnp.any(mask_c, axis=-1)[:, None]
    o_cmp = jnp.einsum('bgrqc,bgcd->bgrqd', p_cmp.astype(vc.dtype), vc)

    n_sel = s_len // SEL_BLOCK
    top_n = min(SEL_TOP_N, n_sel)
    sel_start = jnp.arange(n_sel) * SEL_BLOCK
    overlap = ((cmp_start[:, None] < sel_start[None, :] + SEL_BLOCK)
               & (cmp_start[:, None] + CMP_LEN > sel_start[None, :])).astype(jnp.float32)
    imp = jnp.einsum('bgrqc,cj->bgqj', p_cmp, overlap)
    cur = t // SEL_BLOCK
    j = jnp.arange(n_sel)
    forced = (j[None, :] == 0) | (j[None, :] == cur[:, None]) | (j[None, :] == cur[:, None] - 1)
    imp = jnp.where(sel_start[None, :] <= t[:, None],
                    imp + jnp.where(forced, FORCED_BONUS, 0.0), NEG_INF)
    _, sel_idx = lax.top_k(imp, top_n)

    nb = s_len // Q_BLOCK
    q_blocks = qg.reshape(b, g_n, r_n, nb, Q_BLOCK, HEAD_DIM).transpose(3, 0, 1, 2, 4, 5)
    idx_blocks = sel_idx.reshape(b, g_n, nb, Q_BLOCK, top_n).transpose(2, 0, 1, 3, 4)
    pad = ((0, 0), (0, 0), (WINDOW, 0), (0, 0))
    kw_pad, vw_pad = jnp.pad(k_win, pad), jnp.pad(v_win, pad)
    gather = jax.vmap(jax.vmap(lambda arr, ii: arr[ii]))
    n_keys = top_n * SEL_BLOCK

    def block_step(args):
        qb, ib, i = args
        tq = i * Q_BLOCK + jnp.arange(Q_BLOCK)
        tok = (ib[..., None] * SEL_BLOCK + jnp.arange(SEL_BLOCK)).reshape(b, g_n, Q_BLOCK * n_keys)
        ks = gather(k_slc, tok).reshape(b, g_n, Q_BLOCK, n_keys, HEAD_DIM)
        vs = gather(v_slc, tok).reshape(b, g_n, Q_BLOCK, n_keys, HEAD_DIM)
        tok = tok.reshape(b, g_n, Q_BLOCK, n_keys)
        ss = jnp.einsum('bgrqd,bgqkd->bgrqk', qb, ks) * scale
        ps = masked_softmax(ss, (tok <= tq[:, None])[:, :, None])
        o_s = jnp.einsum('bgrqk,bgqkd->bgrqd', ps.astype(vs.dtype), vs)
        kw = lax.dynamic_slice_in_dim(kw_pad, i * Q_BLOCK, WINDOW + Q_BLOCK, axis=2)
        vw = lax.dynamic_slice_in_dim(vw_pad, i * Q_BLOCK, WINDOW + Q_BLOCK, axis=2)
        p = i * Q_BLOCK - WINDOW + jnp.arange(WINDOW + Q_BLOCK)
        mw = (p[None, :] <= tq[:, None]) & (p[None, :] > tq[:, None] - WINDOW) & (p[None, :] >= 0)
        sw = jnp.einsum('bgrqd,bgkd->bgrqk', qb, kw) * scale
        pw = masked_softmax(sw, mw)
        o_w = jnp.einsum('bgrqk,bgkd->bgrqd', pw.astype(vw.dtype), vw)
        return o_s, o_w

    o_slc, o_win = lax.map(block_step, (q_blocks, idx_blocks, jnp.arange(nb)))
    o_slc = o_slc.transpose(1, 2, 3, 0, 4, 5).reshape(b, g_n, r_n, s_len, HEAD_DIM)
    o_win = o_win.transpose(1, 2, 3, 0, 4, 5).reshape(b, g_n, r_n, s_len, HEAD_DIM)

    gates = jax.nn.sigmoid(branch_gate.astype(jnp.float32)).reshape(b, s_len, NSA_BRANCHES, g_n, r_n)
    gates = gates.transpose(2, 0, 3, 4, 1)[..., None]
    o = gates[0] * o_cmp + gates[1] * o_slc + gates[2] * o_win
    return o.transpose(0, 3, 1, 2, 4).reshape(b, s_len, NSA_WIDTH)


def hybrid_layer(x, pos, norm_g, w_in, q_norm_g, k_norm_g, cmp_pe, cmp_w1, cmp_b1, cmp_w2,
                 w_up_a, w_up_b, w_out):
    h = rms_norm(x, norm_g)
    proj = h @ w_in
    (sb_q, sb_k, sb_v, sb_z, n_q, n_kc, n_vc, n_ks, n_vs, n_kw, n_vw,
     n_gate, n_z, gate_a, gate_b) = jnp.split(proj, list(np.cumsum(IN_SPLITS)[:-1]), axis=-1)

    o_a = stick_breaking_attention(split_heads(sb_q, SB_HEADS), split_heads(sb_k, SB_HEADS),
                                   split_heads(sb_v, SB_HEADS))
    y_a = merge_heads(o_a) * jax.nn.silu(sb_z)

    q = rope(rms_norm(split_heads(n_q, NSA_HEADS), q_norm_g), pos)
    k_slc = rope(rms_norm(split_heads(n_ks, NSA_KV_HEADS), k_norm_g[1]), pos)
    k_win = rope(rms_norm(split_heads(n_kw, NSA_KV_HEADS), k_norm_g[2]), pos)
    o_b = nsa_attention(q, split_heads(n_kc, NSA_KV_HEADS), split_heads(n_vc, NSA_KV_HEADS),
                        k_slc, split_heads(n_vs, NSA_KV_HEADS),
                        k_win, split_heads(n_vw, NSA_KV_HEADS),
                        n_gate, pos, k_norm_g[0], cmp_pe, cmp_w1, cmp_b1, cmp_w2)
    y_b = o_b * jax.nn.silu(n_z)

    merged = jax.nn.sigmoid(gate_a) * (y_a @ w_up_a) + jax.nn.sigmoid(gate_b) * (y_b @ w_up_b)
    return (x + merged @ w_out).astype(x.dtype)


def setup_inputs(seed: int = 0) -> dict:
    key = jax.random.key(seed)
    ks = jax.random.split(key, 14)
    f32 = jnp.float32
    x = jax.random.normal(ks[0], (BATCH, SEQ, D_MODEL), f32)
    offsets = jax.random.randint(ks[1], (BATCH, 1), 0, SEQ, dtype=jnp.int32)
    positions = (jnp.arange(SEQ, dtype=jnp.int32)[None, :] + offsets).astype(jnp.int32)
    norm_g = 1.0 + 0.02 * jax.random.normal(ks[2], (DEPTH, D_MODEL), f32)
    w_in = jax.random.normal(ks[3], (DEPTH, D_MODEL, N_IN), f32) * D_MODEL ** -0.5
    q_norm_g = 1.0 + 0.02 * jax.random.normal(ks[4], (DEPTH, HEAD_DIM), f32)
    k_norm_g = 1.0 + 0.02 * jax.random.normal(ks[5], (DEPTH, NSA_BRANCHES, HEAD_DIM), f32)
    cmp_pe = 0.1 * jax.random.normal(ks[6], (DEPTH, 2, CMP_LEN, HEAD_DIM), f32)
    cmp_w1 = jax.random.normal(ks[7], (DEPTH, 2, CMP_LEN * HEAD_DIM, CMP_HIDDEN), f32) * (CMP_LEN * HEAD_DIM) ** -0.5
    cmp_b1 = 0.01 * jax.random.normal(ks[8], (DEPTH, 2, CMP_HIDDEN), f32)
    cmp_w2 = jax.random.normal(ks[9], (DEPTH, 2, CMP_HIDDEN, HEAD_DIM), f32) * CMP_HIDDEN ** -0.5
    w_up_a = jax.random.normal(ks[10], (DEPTH, SB_WIDTH, D_MODEL), f32) * SB_WIDTH ** -0.5
    w_up_b = jax.random.normal(ks[11], (DEPTH, NSA_WIDTH, D_MODEL), f32) * NSA_WIDTH ** -0.5
    w_out = jax.random.normal(ks[12], (DEPTH, D_MODEL, D_MODEL), f32) * D_MODEL ** -0.5
    return {'x': x, 'positions': positions, 'norm_g': norm_g, 'w_in': w_in,
            'q_norm_g': q_norm_g, 'k_norm_g': k_norm_g, 'cmp_pe': cmp_pe,
            'cmp_w1': cmp_w1, 'cmp_b1': cmp_b1, 'cmp_w2': cmp_w2,
            'w_up_a': w_up_a, 'w_up_b': w_up_b, 'w_out': w_out}


def reference(x, positions, norm_g, w_in, q_norm_g, k_norm_g, cmp_pe, cmp_w1, cmp_b1, cmp_w2,
              w_up_a, w_up_b, w_out):
    for layer in range(DEPTH):
        x = hybrid_layer(x, positions, norm_g[layer], w_in[layer], q_norm_g[layer], k_norm_g[layer],
                         cmp_pe[layer], cmp_w1[layer], cmp_b1[layer], cmp_w2[layer],
                         w_up_a[layer], w_up_b[layer], w_out[layer])
    return x
```

```cpp
#include <hip/hip_runtime.h>
#include <hip/hip_cooperative_groups.h>
#include <cstdio>
#include <cstdint>
namespace cg = cooperative_groups;

typedef unsigned short bf16_t;
typedef short bf16x8 __attribute__((ext_vector_type(8)));
typedef float f32x4 __attribute__((ext_vector_type(4)));
typedef float f32x2 __attribute__((ext_vector_type(2)));
typedef unsigned u32x4 __attribute__((ext_vector_type(4)));
typedef unsigned u32x2 __attribute__((ext_vector_type(2)));
typedef __bf16 bf16x2_t __attribute__((ext_vector_type(2)));

#define DI __device__ __forceinline__
#define MFMA16(a, b, c) __builtin_amdgcn_mfma_f32_16x16x32_bf16((a), (b), (c), 0, 0, 0)

constexpr int D_MODEL = 1024, BATCH = 16, SEQ = 2048, DEPTH = 4, NTOK = BATCH * SEQ;
constexpr int N_IN = 5912, NP = 6016, NT_IN = 47;
constexpr int NCMP = 127;
constexpr float NORM_EPS = 1e-6f;

DI unsigned pk2(float lo, float hi) { f32x2 v = {lo, hi}; bf16x2_t b = __builtin_convertvector(v, bf16x2_t); return __builtin_bit_cast(unsigned, b); }
DI float bflo(unsigned u) { return __uint_as_float(u << 16); }
DI float bfhi(unsigned u) { return __uint_as_float(u & 0xffff0000u); }
DI float sigmoidf_(float x) { return 1.f / (1.f + __expf(-x)); }
DI float siluf_(float x) { return x / (1.f + __expf(-x)); }
DI bf16x8 mk8(u32x4 v) { return __builtin_bit_cast(bf16x8, v); }
DI bf16x8 ld8(const bf16_t* p) { return __builtin_bit_cast(bf16x8, *(const u32x4*)p); }


DI void sincos_acc(float angf, float& sn, float& cs) {
  const double a = (double)angf;
  const double k = rint(a * 0.63661977236758134308);
  const double y = (a - k * 1.57079632679489655800) - k * 6.12323399573676603587e-17;
  const double y2 = y * y;
  const double sp = y * (1.0 + y2 * (-1.0 / 6 + y2 * (1.0 / 120 + y2 * (-1.0 / 5040 + y2 * (1.0 / 362880 + y2 * (-1.0 / 39916800 + y2 * (1.0 / 6227020800.0)))))));
  const double cp = 1.0 + y2 * (-0.5 + y2 * (1.0 / 24 + y2 * (-1.0 / 720 + y2 * (1.0 / 40320 + y2 * (-1.0 / 3628800 + y2 * (1.0 / 479001600.0))))));
  const int q = ((int)k) & 3;
  const double s_ = (q & 1) ? cp : sp, c_ = (q & 1) ? sp : cp;
  sn = (float)((q & 2) ? -s_ : s_);
  cs = (float)(((q + 1) & 2) ? -c_ : c_);
}
DI float inv_freq(int f) { return (float)exp(-(double)f * (9.21034037197618273607 / 32.0)); }

constexpr size_t al256(size_t x) { return (x + 255) & ~(size_t)255; }
constexpr size_t OFF_WT_IN = 0;
constexpr size_t OFF_W1T = OFF_WT_IN + al256((size_t)NP * 1024 * 2);
constexpr size_t OFF_W2T = OFF_W1T + al256((size_t)2 * 256 * 2048 * 2);
constexpr size_t OFF_WUPA = OFF_W2T + al256((size_t)2 * 64 * 256 * 2);
constexpr size_t OFF_WUPB = OFF_WUPA + al256((size_t)1024 * 512 * 2);
constexpr size_t OFF_WOUT = OFF_WUPB + al256((size_t)1024 * 512 * 2);
constexpr size_t OFF_B1EFF = OFF_WOUT + al256((size_t)1024 * 1024 * 2);
constexpr size_t OFF_COST = OFF_B1EFF + al256((size_t)DEPTH * 2 * 256 * 4);
constexpr size_t OFF_SINT = OFF_COST + al256((size_t)NTOK * 32 * 4);
constexpr size_t OFF_COSC = OFF_SINT + al256((size_t)NTOK * 32 * 4);
constexpr size_t OFF_SINC = OFF_COSC + al256((size_t)BATCH * 128 * 32 * 4);
constexpr size_t OFF_XB = OFF_SINC + al256((size_t)BATCH * 128 * 32 * 4);
constexpr size_t OFF_PART = OFF_XB + al256((size_t)NTOK * 1024 * 2);
constexpr size_t OFF_SBQ = OFF_PART + al256((size_t)NTOK * 16 * 4);
constexpr size_t OFF_SBK = OFF_SBQ + al256((size_t)NTOK * 512 * 2);
constexpr size_t OFF_SBVT = OFF_SBK + al256((size_t)NTOK * 512 * 2);
constexpr size_t OFF_SBZ = OFF_SBVT + al256((size_t)NTOK * 512 * 2);
constexpr size_t OFF_NQ = OFF_SBZ + al256((size_t)NTOK * 512 * 2);
constexpr size_t OFF_KCR = OFF_NQ + al256((size_t)NTOK * 512 * 2);
constexpr size_t OFF_VCR = OFF_KCR + al256((size_t)NTOK * 128 * 2);
constexpr size_t OFF_KS = OFF_VCR + al256((size_t)NTOK * 128 * 2);
constexpr size_t OFF_VST = OFF_KS + al256((size_t)NTOK * 128 * 2);
constexpr size_t OFF_KW = OFF_VST + al256((size_t)NTOK * 128 * 2);
constexpr size_t OFF_VWT = OFF_KW + al256((size_t)NTOK * 128 * 2);
constexpr size_t OFF_NGATE = OFF_VWT + al256((size_t)NTOK * 128 * 2);
constexpr size_t OFF_NZ = OFF_NGATE + al256((size_t)NTOK * 32 * 4);
constexpr size_t OFF_GA = OFF_NZ + al256((size_t)NTOK * 512 * 2);
constexpr size_t OFF_GB = OFF_GA + al256((size_t)NTOK * 1024 * 2);
constexpr size_t OFF_HID = OFF_GB + al256((size_t)NTOK * 1024 * 2);
constexpr size_t OFF_KC = OFF_HID + al256((size_t)64 * 128 * 256 * 2);
constexpr size_t OFF_VCT = OFF_KC + al256((size_t)BATCH * 2 * 128 * 64 * 2);
constexpr size_t OFF_QNG = OFF_VCT + al256((size_t)BATCH * 2 * 64 * 128 * 2);
constexpr size_t OFF_KNG = OFF_QNG + al256((size_t)DEPTH * 64 * 4);
constexpr size_t WS_NEED = OFF_KNG + al256((size_t)DEPTH * 3 * 64 * 4);

struct Params {
  const float* x_in; const int* pos; const float* norm_g; const float* w_in; const float* q_norm_g; const float* k_norm_g;
  const float* cmp_pe; const float* cmp_w1; const float* cmp_b1; const float* cmp_w2; const float* w_up_a; const float* w_up_b; const float* w_out;
  float* out; unsigned char* ws;
#define WSBUF(T, name, OFF) DI T* name() const { return (T*)(ws + (OFF)); }
  WSBUF(bf16_t, wt_in, OFF_WT_IN) WSBUF(bf16_t, w1t, OFF_W1T) WSBUF(bf16_t, w2t, OFF_W2T) WSBUF(bf16_t, wupa_t, OFF_WUPA) WSBUF(bf16_t, wupb_t, OFF_WUPB) WSBUF(bf16_t, wout_t, OFF_WOUT)
  WSBUF(float, b1eff, OFF_B1EFF) WSBUF(float, cosT, OFF_COST) WSBUF(float, sinT, OFF_SINT) WSBUF(float, cosC, OFF_COSC) WSBUF(float, sinC, OFF_SINC)
  WSBUF(bf16_t, xb, OFF_XB) WSBUF(float, part, OFF_PART) WSBUF(bf16_t, sbq, OFF_SBQ) WSBUF(bf16_t, sbk, OFF_SBK) WSBUF(bf16_t, sbvt, OFF_SBVT) WSBUF(bf16_t, sbz, OFF_SBZ)
  WSBUF(bf16_t, nq, OFF_NQ) WSBUF(bf16_t, kcr, OFF_KCR) WSBUF(bf16_t, vcr, OFF_VCR) WSBUF(bf16_t, ks, OFF_KS) WSBUF(bf16_t, vst, OFF_VST) WSBUF(bf16_t, kw, OFF_KW) WSBUF(bf16_t, vwt, OFF_VWT)
  WSBUF(float, ngate, OFF_NGATE) WSBUF(bf16_t, nz, OFF_NZ) WSBUF(bf16_t, ga, OFF_GA) WSBUF(bf16_t, gb, OFF_GB) WSBUF(bf16_t, hid, OFF_HID) WSBUF(bf16_t, kc, OFF_KC) WSBUF(bf16_t, vct, OFF_VCT)
  WSBUF(bf16_t, merged, OFF_SBK)
  WSBUF(float, qng, OFF_QNG) WSBUF(float, kng, OFF_KNG)
};

DI int my_tid() { int t = threadIdx.x; asm volatile("" : "+v"(t)); return t; }
DI Params relaunder(const Params& p0) { Params p = p0; asm volatile("" : "+s"(p.ws)); return p; }

constexpr int LSTR = 40;
constexpr int TILE_E = 128 * LSTR;
constexpr int LDS_GEMM_BYTES = 2 * 2 * TILE_E * 2;

DI void gemm_core(const bf16_t* __restrict__ Ag, long lda, int amax, const bf16_t* __restrict__ Bg, long ldb, int bmax, int K,
                  bf16_t* lds, f32x4 (&acc)[4][4]) {
  const int tid = my_tid(), lane = tid & 63, w = tid >> 6, wa = w >> 1, wb = w & 1, qi = lane & 15, quad = lane >> 4;
  const int r0 = tid >> 2, kc = tid & 3;
  const bf16_t* a0 = Ag + (long)min(r0, amax) * lda + kc * 8;
  const bf16_t* a1 = Ag + (long)min(r0 + 64, amax) * lda + kc * 8;
  const bf16_t* b0 = Bg + (long)min(r0, bmax) * ldb + kc * 8;
  const bf16_t* b1 = Bg + (long)min(r0 + 64, bmax) * ldb + kc * 8;
  const int so0 = r0 * LSTR + kc * 8, so1 = (r0 + 64) * LSTR + kc * 8;
  u32x4 ga0 = *(const u32x4*)a0, ga1 = *(const u32x4*)a1, gb0 = *(const u32x4*)b0, gb1 = *(const u32x4*)b1;
  *(u32x4*)(lds + so0) = ga0; *(u32x4*)(lds + so1) = ga1; *(u32x4*)(lds + TILE_E + so0) = gb0; *(u32x4*)(lds + TILE_E + so1) = gb1;
  __syncthreads();
  const int KT = K >> 5;
  const int ra = (wa * 64 + qi) * LSTR + quad * 8, rb = (wb * 64 + qi) * LSTR + quad * 8;
  for (int kt = 0; kt < KT; ++kt) {
    const bool more = kt + 1 < KT;
    if (more) { const int ko = (kt + 1) * 32; ga0 = *(const u32x4*)(a0 + ko); ga1 = *(const u32x4*)(a1 + ko); gb0 = *(const u32x4*)(b0 + ko); gb1 = *(const u32x4*)(b1 + ko); }
    const bf16_t* sA = lds + (kt & 1) * 2 * TILE_E; const bf16_t* sB = sA + TILE_E;
    bf16x8 af[4], bfr[4];
#pragma unroll
    for (int i = 0; i < 4; ++i) af[i] = ld8(sA + ra + i * 16 * LSTR);
#pragma unroll
    for (int j = 0; j < 4; ++j) bfr[j] = ld8(sB + rb + j * 16 * LSTR);
#pragma unroll
    for (int i = 0; i < 4; ++i)
#pragma unroll
      for (int j = 0; j < 4; ++j) acc[i][j] = MFMA16(af[i], bfr[j], acc[i][j]);
    if (more) { bf16_t* d = lds + ((kt + 1) & 1) * 2 * TILE_E; *(u32x4*)(d + so0) = ga0; *(u32x4*)(d + so1) = ga1; *(u32x4*)(d + TILE_E + so0) = gb0; *(u32x4*)(d + TILE_E + so1) = gb1; }
    __syncthreads();
  }
}

DI void zero_acc(f32x4 (&acc)[4][4]) {
#pragma unroll
  for (int i = 0; i < 4; ++i)
#pragma unroll
    for (int j = 0; j < 4; ++j) acc[i][j] = (f32x4){0.f, 0.f, 0.f, 0.f};
}

DI bool tile_order(int it, int nN, int& mt, int& nt) {
  const int xcd = blockIdx.x & 7, slot = blockIdx.x >> 3, SL = gridDim.x >> 3;
  const int q = slot + it * SL, per = 8 * nN;
  if (q >= 4 * per) return false;
  const int mg = q / per, e = q - mg * per;
  nt = e >> 3; mt = xcd * 32 + mg * 8 + (e & 7);
  return true;
}

DI int inmap(int c) { return c < 3328 ? c : (c < 5888 ? c + 24 : (c < 5912 ? c - 2560 : -1)); }

DI void tr_tile(const float* __restrict__ src, int ld, int K, int k0, int n0, bool use_map, const float* __restrict__ scale, bf16_t* __restrict__ dst, float* tile) {
  const int tid = my_tid();
  {
    const int nl = tid & 63, kk = tid >> 6;
    const int n = n0 + nl; const int sc = use_map ? inmap(n) : n;
#pragma unroll
    for (int r = 0; r < 16; ++r) {
      const int k = k0 + r * 4 + kk;
      float v = 0.f;
      if (sc >= 0) { v = src[(long)k * ld + sc]; if (scale) v *= scale[k]; }
      tile[(r * 4 + kk) * 65 + nl] = v;
    }
  }
  __syncthreads();
  {
    const int nl = tid >> 2, ks = tid & 3;
    unsigned o[8];
#pragma unroll
    for (int e = 0; e < 8; ++e) o[e] = pk2(tile[(ks * 16 + 2 * e) * 65 + nl], tile[(ks * 16 + 2 * e + 1) * 65 + nl]);
    bf16_t* d = dst + (long)(n0 + nl) * K + k0 + ks * 16;
    *(u32x4*)d = (u32x4){o[0], o[1], o[2], o[3]};
    *(u32x4*)(d + 8) = (u32x4){o[4], o[5], o[6], o[7]};
  }
  __syncthreads();
}

DI void tr_job(const float* src, int ld, int K, int N, bool use_map, const float* scale, bf16_t* dst, float* tile) {
  const int nk = K >> 6, nn = N >> 6;
  for (int t = blockIdx.x; t < nk * nn; t += gridDim.x) tr_tile(src, ld, K, (t % nk) * 64, (t / nk) * 64, use_map, scale, dst, tile);
}

DI void convert_weights(const Params& p0, int l, unsigned char* lds) {
  const Params p = relaunder(p0);
  float* tile = (float*)lds;
  tr_job(p.w_in + (long)l * D_MODEL * N_IN, N_IN, D_MODEL, NP, true, p.norm_g + l * D_MODEL, p.wt_in(), tile);
  for (int kv = 0; kv < 2; ++kv) {
    tr_job(p.cmp_w1 + (long)(l * 2 + kv) * 2048 * 256, 256, 2048, 256, false, nullptr, p.w1t() + (long)kv * 256 * 2048, tile);
    tr_job(p.cmp_w2 + (long)(l * 2 + kv) * 256 * 64, 64, 256, 64, false, nullptr, p.w2t() + (long)kv * 64 * 256, tile);
  }
  tr_job(p.w_up_a + (long)l * 512 * 1024, 1024, 512, 1024, false, nullptr, p.wupa_t(), tile);
  tr_job(p.w_up_b + (long)l * 512 * 1024, 1024, 512, 1024, false, nullptr, p.wupb_t(), tile);
  tr_job(p.w_out + (long)l * 1024 * 1024, 1024, 1024, 1024, false, nullptr, p.wout_t(), tile);
}

DI void phase_prologue(const Params& p, unsigned char* lds) {
  const int tid = my_tid();
  convert_weights(p, 0, lds);
  for (int it = blockIdx.x; it < DEPTH * 2; it += gridDim.x) {
    const float* w1 = p.cmp_w1 + (long)it * 2048 * 256; const float* pe = p.cmp_pe + (long)it * 2048;
    float s = p.cmp_b1[it * 256 + tid];
    for (int k = 0; k < 2048; ++k) s += pe[k] * w1[(long)k * 256 + tid];
    p.b1eff()[it * 256 + tid] = s;
  }
  if (blockIdx.x == 0) { for (int i = tid; i < DEPTH * 64; i += 256) p.qng()[i] = p.q_norm_g[i]; for (int i = tid; i < DEPTH * 192; i += 256) p.kng()[i] = p.k_norm_g[i]; }
  const long gtid = (long)blockIdx.x * 256 + tid, gn = (long)gridDim.x * 256;
  for (long i = gtid; i < (long)NTOK * 32; i += gn) {
    const int f = (int)(i & 31); const long tok = i >> 5;
    const float ang = (float)p.pos[tok] * inv_freq(f);
    float sn, cs; sincos_acc(ang, sn, cs);
    p.cosT()[i] = cs; p.sinT()[i] = sn;
  }
  for (long i = gtid; i < (long)BATCH * 128 * 32; i += gn) {
    const int f = (int)(i & 31); const int c = (int)((i >> 5) & 127); const int b = (int)(i >> 12);
    float cs = 1.f, sn = 0.f;
    if (c < NCMP) {
      float sum = 0.f;
      for (int k = 0; k < 32; ++k) sum += (float)p.pos[b * SEQ + c * 16 + k];
      const float ang = (sum * (1.f / 32.f)) * inv_freq(f);
      sincos_acc(ang, sn, cs);
    }
    p.cosC()[i] = cs; p.sinC()[i] = sn;
  }
  const int lane = tid & 63;
  for (long row = (long)blockIdx.x * 4 + (tid >> 6); row < NTOK; row += (long)gridDim.x * 4) {
    const float* xr = p.x_in + row * D_MODEL; bf16_t* xo = p.xb() + row * D_MODEL;
    float ss = 0.f;
#pragma unroll
    for (int u = 0; u < 4; ++u) {
      const f32x4 v = *(const f32x4*)(xr + u * 256 + lane * 4);
      ss += v[0] * v[0] + v[1] * v[1] + v[2] * v[2] + v[3] * v[3];
      *(u32x2*)(xo + u * 256 + lane * 4) = (u32x2){pk2(v[0], v[1]), pk2(v[2], v[3])};
    }
#pragma unroll
    for (int o = 32; o >= 1; o >>= 1) ss += __shfl_xor(ss, o);
    if (lane < 16) p.part()[row * 16 + lane] = lane == 0 ? ss : 0.f;
  }
}

DI void phaseA_epilogue(const Params& p, int layer, int mt, int nt, const f32x4 (&acc)[4][4], const float* rs_s) {
  const int tid = my_tid(), lane = tid & 63, w = tid >> 6, wa = w >> 1, wb = w & 1, qi = lane & 15, quad = lane >> 4;
  const bool vtype = (nt >= 8 && nt < 12) || nt == 23 || nt == 25;
  if (vtype) {
    bf16_t* dstb; int nh, head;
    if (nt < 12) { dstb = p.sbvt(); nh = 8; head = (nt - 8) * 2 + wb; } else if (nt == 23) { dstb = p.vst(); nh = 2; head = wb; } else { dstb = p.vwt(); nh = 2; head = wb; }
    const int tok0 = mt * 128, b = tok0 >> 11, s0 = (tok0 & 2047) + wa * 64 + quad * 4;
#pragma unroll
    for (int i = 0; i < 4; ++i) {
      const int tl = wa * 64 + i * 16 + quad * 4;
      const float r0 = rs_s[tl], r1 = rs_s[tl + 1], r2 = rs_s[tl + 2], r3 = rs_s[tl + 3];
#pragma unroll
      for (int j = 0; j < 4; ++j) {
        const int d = j * 16 + qi;
        const f32x4 v = acc[i][j];
        bf16_t* dst = dstb + ((long)(b * nh + head) * 64 + d) * SEQ + s0 + i * 16;
        *(u32x2*)dst = (u32x2){pk2(v[0] * r0, v[1] * r1), pk2(v[2] * r2, v[3] * r3)};
      }
    }
    return;
  }
#pragma unroll
  for (int j = 0; j < 4; ++j) {
    const int tl = wb * 64 + j * 16 + qi; const long tok = (long)mt * 128 + tl; const int b = (int)(tok >> 11), s = (int)(tok & 2047);
    const float rs = rs_s[tl];
    f32x4 v[4];
#pragma unroll
    for (int i = 0; i < 4; ++i) v[i] = acc[i][j] * rs;
    const bool headtype = nt < 8 || (nt >= 16 && nt < 26);
    if (headtype) {
      bf16_t* dstb; int nh, head; const float* g = nullptr;
      if (nt < 4) { dstb = p.sbq(); nh = 8; head = nt * 2 + wa; }
      else if (nt < 8) { dstb = p.sbk(); nh = 8; head = (nt - 4) * 2 + wa; }
      else if (nt < 20) { dstb = p.nq(); nh = 8; head = (nt - 16) * 2 + wa; g = p.qng() + layer * 64; }
      else if (nt == 20) { dstb = p.kcr(); nh = 2; head = wa; }
      else if (nt == 21) { dstb = p.vcr(); nh = 2; head = wa; }
      else if (nt == 22) { dstb = p.ks(); nh = 2; head = wa; g = p.kng() + (layer * 3 + 1) * 64; }
      else { dstb = p.kw(); nh = 2; head = wa; g = p.kng() + (layer * 3 + 2) * 64; }
      if (g) {
        float ss = 0.f;
#pragma unroll
        for (int i = 0; i < 4; ++i) ss += v[i][0] * v[i][0] + v[i][1] * v[i][1] + v[i][2] * v[i][2] + v[i][3] * v[i][3];
        ss += __shfl_xor(ss, 16); ss += __shfl_xor(ss, 32);
        const float rn = rsqrtf(ss * (1.f / 64.f) + NORM_EPS);
#pragma unroll
        for (int i = 0; i < 4; ++i) { const f32x4 gg = *(const f32x4*)(g + i * 16 + quad * 4); v[i] = v[i] * rn * gg; }
#pragma unroll
        for (int i = 0; i < 2; ++i) {
          const f32x4 cs = *(const f32x4*)(p.cosT() + tok * 32 + i * 16 + quad * 4), sn = *(const f32x4*)(p.sinT() + tok * 32 + i * 16 + quad * 4);
          const f32x4 x1 = v[i], x2 = v[i + 2];
          v[i] = x1 * cs - x2 * sn; v[i + 2] = x2 * cs + x1 * sn;
        }
      }
      bf16_t* dst = dstb + ((long)(b * nh + head) * SEQ + s) * 64 + quad * 4;
#pragma unroll
      for (int i = 0; i < 4; ++i) *(u32x2*)(dst + i * 16) = (u32x2){pk2(v[i][0], v[i][1]), pk2(v[i][2], v[i][3])};
    } else if (nt == 46) {
      if (wa == 0) {
#pragma unroll
        for (int i = 0; i < 2; ++i) {
          const int f = i * 16 + quad * 4;
          if (f < 24) { const f32x4 o = {sigmoidf_(v[i][0]), sigmoidf_(v[i][1]), sigmoidf_(v[i][2]), sigmoidf_(v[i][3])}; *(f32x4*)(p.ngate() + tok * 32 + f) = o; }
        }
      }
    } else {
      bf16_t* dstb; int ldd, c0; bool sil;
      if (nt < 16) { dstb = p.sbz(); ldd = 512; c0 = (nt - 12) * 128; sil = true; }
      else if (nt < 30) { dstb = p.nz(); ldd = 512; c0 = (nt - 26) * 128; sil = true; }
      else if (nt < 38) { dstb = p.ga(); ldd = 1024; c0 = (nt - 30) * 128; sil = false; }
      else { dstb = p.gb(); ldd = 1024; c0 = (nt - 38) * 128; sil = false; }
      bf16_t* dst = dstb + tok * ldd + c0 + wa * 64 + quad * 4;
#pragma unroll
      for (int i = 0; i < 4; ++i) {
        f32x4 o;
#pragma unroll
        for (int r = 0; r < 4; ++r) o[r] = sil ? siluf_(v[i][r]) : sigmoidf_(v[i][r]);
        *(u32x2*)(dst + i * 16) = (u32x2){pk2(o[0], o[1]), pk2(o[2], o[3])};
      }
    }
  }
}

DI void phaseA(const Params& p0, int layer, unsigned char* lds) {
  const Params p = relaunder(p0);
  bf16_t* gl = (bf16_t*)lds; float* rs_s = (float*)(lds + LDS_GEMM_BYTES);
  const bf16_t* Wt = p.wt_in();
  int mt, nt;
  for (int it = 0; tile_order(it, NT_IN, mt, nt); ++it) {
    if (my_tid() < 128) {
      const float* pp = p.part() + ((long)mt * 128 + my_tid()) * 16;
      float s = 0.f;
#pragma unroll
      for (int u = 0; u < 4; ++u) { const f32x4 v = *(const f32x4*)(pp + u * 4); s += v[0] + v[1] + v[2] + v[3]; }
      rs_s[my_tid()] = rsqrtf(s * (1.f / 1024.f) + NORM_EPS);
    }
    const bool vtype = (nt >= 8 && nt < 12) || nt == 23 || nt == 25;
    const bf16_t* Xg = p.xb() + (long)mt * 128 * D_MODEL; const bf16_t* Wg = Wt + (long)nt * 128 * D_MODEL;
    f32x4 acc[4][4]; zero_acc(acc);
    if (vtype) gemm_core(Xg, D_MODEL, 127, Wg, D_MODEL, 127, D_MODEL, gl, acc);
    else gemm_core(Wg, D_MODEL, 127, Xg, D_MODEL, 127, D_MODEL, gl, acc);
    phaseA_epilogue(p, layer, mt, nt, acc, rs_s);
    __syncthreads();
  }
}

DI void compress_item(const Params& p, int layer, int item, unsigned char* lds) {
  bf16_t* gl = (bf16_t*)lds;
  const int tid = my_tid(), lane = tid & 63, w = tid >> 6, wa = w >> 1, wb = w & 1, qi = lane & 15, quad = lane >> 4;
  const int kv = item & 1, bg = item >> 1;
  const bf16_t* src = (kv ? p.vcr() : p.kcr()) + (long)bg * SEQ * 64;
  const bf16_t* W1 = p.w1t() + (long)kv * 256 * 2048;
  const float* b1 = p.b1eff() + (layer * 2 + kv) * 256;
  bf16_t* hid = p.hid() + (long)item * 128 * 256;
  for (int n2 = 0; n2 < 2; ++n2) {
    f32x4 acc[4][4]; zero_acc(acc);
    gemm_core(W1 + (long)n2 * 128 * 2048, 2048, 127, src, 1024, NCMP - 1, 2048, gl, acc);
#pragma unroll
    for (int i = 0; i < 4; ++i) {
      const int f = n2 * 128 + wa * 64 + i * 16 + quad * 4;
      const f32x4 bb = *(const f32x4*)(b1 + f);
#pragma unroll
      for (int j = 0; j < 4; ++j) {
        const int c = wb * 64 + j * 16 + qi;
        f32x4 v = acc[i][j] + bb;
        *(u32x2*)(hid + (long)c * 256 + f) = (u32x2){pk2(siluf_(v[0]), siluf_(v[1])), pk2(siluf_(v[2]), siluf_(v[3]))};
      }
    }
  }
  __threadfence_block();
  __syncthreads();
  const bf16_t* W2 = p.w2t() + (long)kv * 64 * 256;
  f32x4 o[4][2];
#pragma unroll
  for (int dt = 0; dt < 4; ++dt) { o[dt][0] = (f32x4){0.f, 0.f, 0.f, 0.f}; o[dt][1] = o[dt][0]; }
  for (int ksx = 0; ksx < 8; ++ksx) {
    bf16x8 wf[4], hf[2];
#pragma unroll
    for (int dt = 0; dt < 4; ++dt) wf[dt] = ld8(W2 + (long)(dt * 16 + qi) * 256 + ksx * 32 + quad * 8);
#pragma unroll
    for (int rt = 0; rt < 2; ++rt) hf[rt] = ld8(hid + (long)(w * 32 + rt * 16 + qi) * 256 + ksx * 32 + quad * 8);
#pragma unroll
    for (int dt = 0; dt < 4; ++dt)
#pragma unroll
      for (int rt = 0; rt < 2; ++rt) o[dt][rt] = kv ? MFMA16(hf[rt], wf[dt], o[dt][rt]) : MFMA16(wf[dt], hf[rt], o[dt][rt]);
  }
  if (kv == 0) {
    const float* g = p.kng() + (layer * 3 + 0) * 64;
    const int b = bg >> 1;
#pragma unroll
    for (int rt = 0; rt < 2; ++rt) {
      const int c = w * 32 + rt * 16 + qi;
      f32x4 v[4];
      float ss = 0.f;
#pragma unroll
      for (int dt = 0; dt < 4; ++dt) { v[dt] = o[dt][rt]; ss += v[dt][0] * v[dt][0] + v[dt][1] * v[dt][1] + v[dt][2] * v[dt][2] + v[dt][3] * v[dt][3]; }
      ss += __shfl_xor(ss, 16); ss += __shfl_xor(ss, 32);
      const float rn = rsqrtf(ss * (1.f / 64.f) + NORM_EPS);
#pragma unroll
      for (int dt = 0; dt < 4; ++dt) { const f32x4 gg = *(const f32x4*)(g + dt * 16 + quad * 4); v[dt] = v[dt] * rn * gg; }
#pragma unroll
      for (int dt = 0; dt < 2; ++dt) {
        const long ti = ((long)b * 128 + c) * 32 + dt * 16 + quad * 4;
        const f32x4 cs = *(const f32x4*)(p.cosC() + ti), sn = *(const f32x4*)(p.sinC() + ti);
        const f32x4 x1 = v[dt], x2 = v[dt + 2];
        v[dt] = x1 * cs - x2 * sn; v[dt + 2] = x2 * cs + x1 * sn;
      }
      bf16_t* dst = p.kc() + ((long)bg * 128 + c) * 64 + quad * 4;
#pragma unroll
      for (int dt = 0; dt < 4; ++dt) {
        u32x2 ov = (u32x2){pk2(v[dt][0], v[dt][1]), pk2(v[dt][2], v[dt][3])};
        if (c >= NCMP) ov = (u32x2){0u, 0u};
        *(u32x2*)(dst + dt * 16) = ov;
      }
    }
  } else {
#pragma unroll
    for (int dt = 0; dt < 4; ++dt)
#pragma unroll
      for (int rt = 0; rt < 2; ++rt) {
        const int c0 = w * 32 + rt * 16 + quad * 4;
        f32x4 v = o[dt][rt];
        if (c0 + 3 >= NCMP) v[3] = 0.f;
        *(u32x2*)(p.vct() + ((long)bg * 64 + dt * 16 + qi) * 128 + c0) = (u32x2){pk2(v[0], v[1]), pk2(v[2], v[3])};
      }
  }
  __syncthreads();
}

DI void sb_attn_wave(const Params& p, int b, int h, int t0) {
  const int lane = my_tid() & 63, qi = lane & 15, quad = lane >> 4;
  const bf16_t* Q = p.sbq() + (long)(b * 8 + h) * SEQ * 64;
  const bf16_t* K = p.sbk() + (long)(b * 8 + h) * SEQ * 64;
  const bf16_t* Vt = p.sbvt() + (long)(b * 8 + h) * 64 * SEQ;
  const int t = t0 + qi;
  bf16x8 qf[2];
  qf[0] = ld8(Q + (long)t * 64 + quad * 8); qf[1] = ld8(Q + (long)t * 64 + 32 + quad * 8);
  f32x4 o[4];
#pragma unroll
  for (int dt = 0; dt < 4; ++dt) o[dt] = (f32x4){0.f, 0.f, 0.f, 0.f};
  float carry = 0.f;
  const int krow = 8 * (qi >> 2) + (qi & 3);
  for (int kb = t0 & ~31; kb >= 0; kb -= 32) {
    f32x4 s[2];
#pragma unroll
    for (int a = 0; a < 2; ++a) {
      const bf16_t* kp = K + (long)(kb + krow + 4 * a) * 64 + quad * 8;
      const bf16x8 k0 = ld8(kp), k1 = ld8(kp + 32);
      s[a] = MFMA16(k0, qf[0], ((f32x4){0.f, 0.f, 0.f, 0.f}));
      s[a] = MFMA16(k1, qf[1], s[a]);
    }
    bf16x8 vf[4];
#pragma unroll
    for (int dt = 0; dt < 4; ++dt) vf[dt] = ld8(Vt + (long)(dt * 16 + qi) * SEQ + kb + 8 * quad);
    float L[8], ls[8]; bool val[8];
    float tot = 0.f;
#pragma unroll
    for (int idx = 0; idx < 8; ++idx) {
      const float z = s[idx >> 2][idx & 3] * 0.125f;
      const int key = kb + 8 * quad + idx;
      val[idx] = key < t;
      const float sp = fmaxf(z, 0.f) + __logf(1.f + __expf(-fabsf(z)));
      L[idx] = val[idx] ? -sp : 0.f;
      ls[idx] = z - sp;
      tot += L[idx];
    }
    const float a1 = __shfl_xor(tot, 16), a2 = __shfl_xor(tot, 32), a3 = __shfl_xor(a1, 32);
    const float higher = ((quad ^ 1) > quad ? a1 : 0.f) + ((quad ^ 2) > quad ? a2 : 0.f) + ((quad ^ 3) > quad ? a3 : 0.f);
    float run = carry + higher;
    float wv[8];
#pragma unroll
    for (int idx = 7; idx >= 0; --idx) {
      wv[idx] = val[idx] ? __expf(ls[idx] + run) : 0.f;
      run += L[idx];
    }
    carry += (tot + a1) + (a2 + a3);
    const bf16x8 pf = mk8((u32x4){pk2(wv[0], wv[1]), pk2(wv[2], wv[3]), pk2(wv[4], wv[5]), pk2(wv[6], wv[7])});
#pragma unroll
    for (int dt = 0; dt < 4; ++dt) o[dt] = MFMA16(vf[dt], pf, o[dt]);
  }
  bf16_t* zp = p.sbz() + ((long)b * SEQ + t) * 512 + h * 64 + quad * 4;
#pragma unroll
  for (int dt = 0; dt < 4; ++dt) {
    const u32x2 zz = *(const u32x2*)(zp + dt * 16);
    *(u32x2*)(zp + dt * 16) = (u32x2){pk2(o[dt][0] * bflo(zz[0]), o[dt][1] * bfhi(zz[0])), pk2(o[dt][2] * bflo(zz[1]), o[dt][3] * bfhi(zz[1]))};
  }
}

DI void phaseB(const Params& p0, int layer, unsigned char* lds) {
  const int NITEM = 64 + BATCH * 8 * 32;
  for (int it = blockIdx.x; it < NITEM; it += gridDim.x) {
    const Params p = relaunder(p0);
    if (it < 64) { compress_item(p, layer, it, lds); continue; }
    const int i = it - 64, qt = 31 - (i >> 7), bh = i & 127;
    sb_attn_wave(p, bh >> 3, bh & 7, qt * 64 + (my_tid() >> 6) * 16);
  }
}

template <int MODE>
DI void nsa_block(const bf16_t* __restrict__ Kb, const bf16_t* __restrict__ Vtb, int key0, int t, bool selbit, const bf16x8 (&qf)[4][2],
                  f32x4 (&O)[4][4], float (&m)[4], float (&l)[4], int qi, int quad) {
  const float SC = 0.125f * 1.44269504089f;
  const int krow = 8 * (qi >> 2) + (qi & 3);
#pragma unroll 1
  for (int c2 = 0; c2 < 2; ++c2) {
    const int kb = key0 + 32 * c2;
    bf16x8 kf[2][2];
#pragma unroll
    for (int a = 0; a < 2; ++a) { const bf16_t* kp = Kb + (long)(kb + krow + 4 * a) * 64 + quad * 8; kf[a][0] = ld8(kp); kf[a][1] = ld8(kp + 32); }
    bf16x8 vf[4];
#pragma unroll
    for (int dt = 0; dt < 4; ++dt) vf[dt] = ld8(Vtb + (long)(dt * 16 + qi) * SEQ + kb + 8 * quad);
    bool val[8];
#pragma unroll
    for (int idx = 0; idx < 8; ++idx) {
      const int key = kb + 8 * quad + idx;
      val[idx] = MODE == 0 ? (selbit && key <= t) : (key <= t && key > t - 512);
    }
#pragma unroll
    for (int hh = 0; hh < 4; ++hh) {
      f32x4 s[2];
#pragma unroll
      for (int a = 0; a < 2; ++a) { s[a] = MFMA16(kf[a][0], qf[hh][0], ((f32x4){0.f, 0.f, 0.f, 0.f})); s[a] = MFMA16(kf[a][1], qf[hh][1], s[a]); }
      float sv[8]; float cm = -1e30f;
#pragma unroll
      for (int idx = 0; idx < 8; ++idx) { sv[idx] = s[idx >> 2][idx & 3] * SC; if (val[idx]) cm = fmaxf(cm, sv[idx]); }
      cm = fmaxf(cm, __shfl_xor(cm, 16)); cm = fmaxf(cm, __shfl_xor(cm, 32));
      const float mn = fmaxf(m[hh], cm);
      const float alpha = exp2f(m[hh] - mn);
      m[hh] = mn;
      float pv[8]; float ps = 0.f;
#pragma unroll
      for (int idx = 0; idx < 8; ++idx) { pv[idx] = val[idx] ? exp2f(sv[idx] - mn) : 0.f; ps += pv[idx]; }
      l[hh] = l[hh] * alpha + ps;
      const bf16x8 pf = mk8((u32x4){pk2(pv[0], pv[1]), pk2(pv[2], pv[3]), pk2(pv[4], pv[5]), pk2(pv[6], pv[7])});
#pragma unroll
      for (int dt = 0; dt < 4; ++dt) { O[hh][dt] = O[hh][dt] * alpha; O[hh][dt] = MFMA16(vf[dt], pf, O[hh][dt]); }
    }
  }
}

template <bool LAST>
DI void nsa_finish(f32x4* lo, f32x4 (&O)[4][4], float (&m)[4], float (&l)[4], const float (&gate)[4], bf16_t* zp) {
#pragma unroll
  for (int hh = 0; hh < 4; ++hh) {
    float lt = l[hh]; lt += __shfl_xor(lt, 16); lt += __shfl_xor(lt, 32);
    const float f = lt > 0.f ? gate[hh] / lt : 0.f;
#pragma unroll
    for (int dt = 0; dt < 4; ++dt) {
      const f32x4 v = lo[(hh * 4 + dt) * 64] + O[hh][dt] * f;
      if (LAST) {
        bf16_t* a = zp + hh * 64 + dt * 16;
        const u32x2 zz = *(const u32x2*)a;
        *(u32x2*)a = (u32x2){pk2(v[0] * bflo(zz[0]), v[1] * bfhi(zz[0])), pk2(v[2] * bflo(zz[1]), v[3] * bfhi(zz[1]))};
      } else {
        lo[(hh * 4 + dt) * 64] = v;
        O[hh][dt] = (f32x4){0.f, 0.f, 0.f, 0.f};
      }
    }
    m[hh] = -1e30f; l[hh] = 0.f;
  }
}

DI void nsa_wave(const Params& p, int b, int g, int t0, unsigned char* lds) {
  const int lane = my_tid() & 63, qi = lane & 15, quad = lane >> 4;
  const int t = t0 + qi, cur = t0 >> 6;
  const long tok = (long)b * SEQ + t;
  const int bg = b * 2 + g;
  f32x4* lo = (f32x4*)lds + (my_tid() >> 6) * 1024 + lane;

  const float SC = 0.125f * 1.44269504089f;
  const bf16_t* Kc = p.kc() + (long)bg * 128 * 64;
  const bf16_t* Vc = p.vct() + (long)bg * 64 * 128;
  f32x4 ph[8];
#pragma unroll
  for (int kt = 0; kt < 8; ++kt) ph[kt] = (f32x4){0.f, 0.f, 0.f, 0.f};
#pragma unroll 1
  for (int hh = 0; hh < 4; ++hh) {
    const bf16_t* qp0 = p.nq() + ((long)(b * 8 + g * 4 + hh) * SEQ + t) * 64 + quad * 8;
    const bf16x8 q0 = ld8(qp0), q1 = ld8(qp0 + 32); const float gt = p.ngate()[tok * 32 + g * 4 + hh];
    f32x4 sc[8];
    float mx = -1e30f;
#pragma unroll
    for (int kt = 0; kt < 8; ++kt) {
      const bf16_t* kp = Kc + (long)(kt * 16 + qi) * 64 + quad * 8;
      sc[kt] = MFMA16(ld8(kp), q0, ((f32x4){0.f, 0.f, 0.f, 0.f}));
      sc[kt] = MFMA16(ld8(kp + 32), q1, sc[kt]);
#pragma unroll
      for (int r = 0; r < 4; ++r) {
        const int c = kt * 16 + quad * 4 + r;
        sc[kt][r] *= SC;
        if (c < NCMP && 16 * c + 31 <= t) mx = fmaxf(mx, sc[kt][r]);
      }
    }
    mx = fmaxf(mx, __shfl_xor(mx, 16)); mx = fmaxf(mx, __shfl_xor(mx, 32));
    float sum = 0.f;
#pragma unroll
    for (int kt = 0; kt < 8; ++kt)
#pragma unroll
      for (int r = 0; r < 4; ++r) {
        const int c = kt * 16 + quad * 4 + r;
        const float e = (c < NCMP && 16 * c + 31 <= t) ? exp2f(sc[kt][r] - mx) : 0.f;
        sc[kt][r] = e; sum += e;
      }
    sum += __shfl_xor(sum, 16); sum += __shfl_xor(sum, 32);
    const float inv = sum > 0.f ? 1.f / sum : 0.f;
#pragma unroll
    for (int kt = 0; kt < 8; ++kt) { sc[kt] = sc[kt] * inv; ph[kt] += sc[kt]; }
    f32x4 oc[4];
#pragma unroll
    for (int dt = 0; dt < 4; ++dt) oc[dt] = (f32x4){0.f, 0.f, 0.f, 0.f};
#pragma unroll
    for (int mm = 0; mm < 4; ++mm) {
      const bf16x8 pf = mk8((u32x4){pk2(sc[2 * mm][0], sc[2 * mm][1]), pk2(sc[2 * mm][2], sc[2 * mm][3]), pk2(sc[2 * mm + 1][0], sc[2 * mm + 1][1]), pk2(sc[2 * mm + 1][2], sc[2 * mm + 1][3])});
#pragma unroll
      for (int dt = 0; dt < 4; ++dt) {
        const bf16_t* vp = Vc + (long)(dt * 16 + qi) * 128 + 32 * mm + quad * 4;
        const u32x2 lo = *(const u32x2*)vp, hi = *(const u32x2*)(vp + 16);
        oc[dt] = MFMA16(mk8((u32x4){lo[0], lo[1], hi[0], hi[1]}), pf, oc[dt]);
      }
    }
#pragma unroll
    for (int dt = 0; dt < 4; ++dt) lo[(hh * 4 + dt) * 64] = oc[dt] * gt;
  }
  float imp[8];
  {
    float rot[8];
#pragma unroll
    for (int kt = 0; kt < 8; ++kt) rot[kt] = __shfl(ph[kt][3], (lane + 48) & 63);
#pragma unroll
    for (int kt = 0; kt < 8; ++kt) {
      const float extra = quad > 0 ? rot[kt] : (kt > 0 ? rot[kt > 0 ? kt - 1 : 0] : 0.f);
      const float v = (ph[kt][0] + ph[kt][1]) + (ph[kt][2] + ph[kt][3]) + extra;
      const int j = 4 * kt + quad;
      const bool forced = j == 0 || j == cur || j == cur - 1;
      imp[kt] = j <= cur ? v + (forced ? 1e4f : 0.f) : -1e30f;
    }
  }
  unsigned selmask = 0;
  {
    int rank[8];
#pragma unroll
    for (int kt = 0; kt < 8; ++kt) rank[kt] = 0;
#pragma unroll 1
    for (int q2 = 0; q2 < 4; ++q2)
#pragma unroll
      for (int k2 = 0; k2 < 8; ++k2) {
        const float ov = __shfl(imp[k2], qi + 16 * q2);
#pragma unroll
        for (int kt = 0; kt < 8; ++kt) {
          const bool before = k2 < kt || (k2 == kt && q2 < quad);
          rank[kt] += (ov > imp[kt] || (ov == imp[kt] && before)) ? 1 : 0;
        }
      }
#pragma unroll
    for (int kt = 0; kt < 8; ++kt) if (rank[kt] < 8 && 4 * kt + quad <= cur) selmask |= 1u << (4 * kt + quad);
    selmask |= __shfl_xor(selmask, 16); selmask |= __shfl_xor(selmask, 32);
  }

  bf16x8 qf[4][2];
#pragma unroll
  for (int hh = 0; hh < 4; ++hh) {
    const bf16_t* qp = p.nq() + ((long)(b * 8 + g * 4 + hh) * SEQ + t) * 64 + quad * 8;
    qf[hh][0] = ld8(qp); qf[hh][1] = ld8(qp + 32);
  }
  float gate[3][4];
#pragma unroll
  for (int br = 1; br < 3; ++br) { const f32x4 gv = *(const f32x4*)(p.ngate() + tok * 32 + br * 8 + g * 4); gate[br][0] = gv[0]; gate[br][1] = gv[1]; gate[br][2] = gv[2]; gate[br][3] = gv[3]; }
  f32x4 O[4][4]; float m[4], l[4];
#pragma unroll
  for (int hh = 0; hh < 4; ++hh) { m[hh] = -1e30f; l[hh] = 0.f;
#pragma unroll
    for (int dt = 0; dt < 4; ++dt) O[hh][dt] = (f32x4){0.f, 0.f, 0.f, 0.f}; }

  {
    const bf16_t* Kb = p.ks() + (long)bg * SEQ * 64; const bf16_t* Vtb = p.vst() + (long)bg * 64 * SEQ;
#pragma unroll 1
    for (int j = 0; j <= cur; ++j) {
      const bool bit = (selmask >> j) & 1u;
      if (!__any(bit)) continue;
      nsa_block<0>(Kb, Vtb, j * 64, t, bit, qf, O, m, l, qi, quad);
    }
    nsa_finish<false>(lo, O, m, l, gate[1], nullptr);
  }
  {
    const bf16_t* Kb = p.kw() + (long)bg * SEQ * 64; const bf16_t* Vtb = p.vwt() + (long)bg * 64 * SEQ;
#pragma unroll 1
    for (int j = (cur >= 8 ? cur - 8 : 0); j <= cur; ++j) nsa_block<1>(Kb, Vtb, j * 64, t, true, qf, O, m, l, qi, quad);
    nsa_finish<true>(lo, O, m, l, gate[2], p.nz() + tok * 512 + g * 256 + quad * 4);
  }
}

DI void phaseC(const Params& p0, unsigned char* lds) {
  const int NITEM = BATCH * 2 * 32;
  for (int it = blockIdx.x; it < NITEM; it += gridDim.x) {
    const Params p = relaunder(p0);
    const int qt = 31 - (it >> 5), bg = it & 31;
    nsa_wave(p, bg >> 1, bg & 1, qt * 64 + (my_tid() >> 6) * 16, lds);
  }
}

DI void phaseD(const Params& p0, int layer, unsigned char* lds) {
  const Params p = relaunder(p0);
  bf16_t* gl = (bf16_t*)lds;
  const int tid = my_tid(), lane = tid & 63, w = tid >> 6, wa = w >> 1, wb = w & 1, qi = lane & 15, quad = lane >> 4;
  int mt, nt;
  for (int it = 0; tile_order(it, 8, mt, nt); ++it) {
    f32x4 aa[4][4], ab[4][4]; zero_acc(aa); zero_acc(ab);
    gemm_core(p.wupa_t() + ((long)nt * 128) * 512, 512, 127, p.sbz() + (long)mt * 128 * 512, 512, 127, 512, gl, aa);
    gemm_core(p.wupb_t() + ((long)nt * 128) * 512, 512, 127, p.nz() + (long)mt * 128 * 512, 512, 127, 512, gl, ab);
#pragma unroll
    for (int j = 0; j < 4; ++j) {
      const long tok = (long)mt * 128 + wb * 64 + j * 16 + qi;
#pragma unroll
      for (int i = 0; i < 4; ++i) {
        const long off = tok * 1024 + nt * 128 + wa * 64 + i * 16 + quad * 4;
        const u32x2 xa = *(const u32x2*)(p.ga() + off), xb2 = *(const u32x2*)(p.gb() + off);
        const f32x4 va = aa[i][j], vb = ab[i][j];
        const float o0 = bflo(xa[0]) * va[0] + bflo(xb2[0]) * vb[0], o1 = bfhi(xa[0]) * va[1] + bfhi(xb2[0]) * vb[1];
        const float o2 = bflo(xa[1]) * va[2] + bflo(xb2[1]) * vb[2], o3 = bfhi(xa[1]) * va[3] + bfhi(xb2[1]) * vb[3];
        *(u32x2*)(p.merged() + off) = (u32x2){pk2(o0, o1), pk2(o2, o3)};
      }
    }
  }
}

DI void phaseE(const Params& p0, int layer, unsigned char* lds, const float* xsrc) {
  const Params p = relaunder(p0);
  bf16_t* gl = (bf16_t*)lds;
  const int tid = my_tid(), lane = tid & 63, w = tid >> 6, wa = w >> 1, wb = w & 1, qi = lane & 15, quad = lane >> 4;
  int mt, nt;
  for (int it = 0; tile_order(it, 8, mt, nt); ++it) {
    f32x4 acc[4][4]; zero_acc(acc);
    gemm_core(p.wout_t() + ((long)nt * 128) * 1024, 1024, 127, p.merged() + (long)mt * 128 * 1024, 1024, 127, 1024, gl, acc);
#pragma unroll
    for (int j = 0; j < 4; ++j) {
      const long tok = (long)mt * 128 + wb * 64 + j * 16 + qi;
      float ss = 0.f;
#pragma unroll
      for (int i = 0; i < 4; ++i) {
        const long off = tok * 1024 + nt * 128 + wa * 64 + i * 16 + quad * 4;
        const f32x4 xo = *(const f32x4*)(xsrc + off);
        const f32x4 xn = xo + acc[i][j];
        *(f32x4*)(p.out + off) = xn;
        *(u32x2*)(p.xb() + off) = (u32x2){pk2(xn[0], xn[1]), pk2(xn[2], xn[3])};
        ss += xn[0] * xn[0] + xn[1] * xn[1] + xn[2] * xn[2] + xn[3] * xn[3];
      }
      ss += __shfl_xor(ss, 16); ss += __shfl_xor(ss, 32);
      if (quad == 0) p.part()[tok * 16 + nt * 2 + wa] = ss;
    }
  }
}

#ifndef STOP_AFTER
#define STOP_AFTER 0
#endif
constexpr int LDS_BYTES = 65536;

__global__ void __launch_bounds__(256) hybrid_megakernel(Params p) {
  __shared__ __attribute__((aligned(16))) unsigned char lds[LDS_BYTES];
  cg::grid_group grid = cg::this_grid();
  phase_prologue(p, lds);
  grid.sync();
  for (int layer = 0; layer < DEPTH; ++layer) {
    if (layer > 0) { convert_weights(p, layer, lds); grid.sync(); }
    if (STOP_AFTER != 0 && STOP_AFTER == layer * 10) return;
    phaseA(p, layer, lds);
    grid.sync();
    if (STOP_AFTER == layer * 10 + 1) return;
    phaseB(p, layer, lds);
    grid.sync();
    if (STOP_AFTER == layer * 10 + 2) return;
    phaseC(p, lds);
    grid.sync();
    if (STOP_AFTER == layer * 10 + 3) return;
    phaseD(p, layer, lds);
    grid.sync();
    if (STOP_AFTER == layer * 10 + 4) return;
    if (layer == 0) phaseE(p, layer, lds, p.x_in); else phaseE(p, layer, lds, p.out);
    if (layer + 1 < DEPTH) grid.sync();
    if (STOP_AFTER == layer * 10 + 5) return;
  }
}

extern "C" void kernel_launch(void* const* d_in, const int* in_sizes, int n_in, void* d_out, int out_size,
                              void* d_ws, size_t ws_size, hipStream_t stream) {
  static int grid_blocks = 0;
  if (!grid_blocks) {
    int dev = 0, cus = 0, per_cu = 0;
    (void)hipGetDevice(&dev);
    (void)hipDeviceGetAttribute(&cus, hipDeviceAttributeMultiprocessorCount, dev);
    (void)hipOccupancyMaxActiveBlocksPerMultiprocessor(&per_cu, hybrid_megakernel, 256, 0);
    if (per_cu > 2) per_cu = 2;
    if (per_cu < 1) per_cu = 1;
    grid_blocks = (cus * per_cu) & ~7;
  }
  Params a{};
  a.x_in = (const float*)d_in[0]; a.pos = (const int*)d_in[1]; a.norm_g = (const float*)d_in[2]; a.w_in = (const float*)d_in[3];
  a.q_norm_g = (const float*)d_in[4]; a.k_norm_g = (const float*)d_in[5]; a.cmp_pe = (const float*)d_in[6]; a.cmp_w1 = (const float*)d_in[7];
  a.cmp_b1 = (const float*)d_in[8]; a.cmp_w2 = (const float*)d_in[9]; a.w_up_a = (const float*)d_in[10]; a.w_up_b = (const float*)d_in[11];
  a.w_out = (const float*)d_in[12];
  a.out = (float*)d_out; a.ws = (unsigned char*)d_ws;
  if (WS_NEED > ws_size) { fprintf(stderr, "workspace too small: need %zu have %zu\n", (size_t)WS_NEED, ws_size); return; }
  void* args[] = {&a};
  hipError_t e = hipLaunchCooperativeKernel((void*)hybrid_megakernel, dim3(grid_blocks), dim3(256), args, 0, stream);
  if (e != hipSuccess) fprintf(stderr, "cooperative launch failed: %s (grid %d)\n", hipGetErrorString(e), grid_blocks);
}
```

```cpp
#include <hip/hip_runtime.h>
#include <hip/hip_cooperative_groups.h>
#include <cstdio>
#include <cstdint>
namespace cg = cooperative_groups;

typedef unsigned short bf16_t;
typedef short bf16x8 __attribute__((ext_vector_type(8)));
typedef float f32x4 __attribute__((ext_vector_type(4)));
typedef float f32x2 __attribute__((ext_vector_type(2)));
typedef unsigned u32x4 __attribute__((ext_vector_type(4)));
typedef unsigned u32x2 __attribute__((ext_vector_type(2)));
typedef __bf16 bf16x2_t __attribute__((ext_vector_type(2)));

#define DI __device__ __forceinline__
#define MFMA16(a, b, c) __builtin_amdgcn_mfma_f32_16x16x32_bf16((a), (b), (c), 0, 0, 0)

constexpr int D_MODEL = 1024, BATCH = 16, SEQ = 2048, DEPTH = 4, NTOK = BATCH * SEQ;
constexpr int N_IN = 5912, NP = 6016, NT_IN = 47;
constexpr int NCMP = 127;
constexpr float NORM_EPS = 1e-6f;

DI unsigned pk2(float lo, float hi) { f32x2 v = {lo, hi}; bf16x2_t b = __builtin_convertvector(v, bf16x2_t); return __builtin_bit_cast(unsigned, b); }
DI float bflo(unsigned u) { return __uint_as_float(u << 16); }
DI float bfhi(unsigned u) { return __uint_as_float(u & 0xffff0000u); }
DI float sigmoidf_(float x) { return 1.f / (1.f + __expf(-x)); }
DI float siluf_(float x) { return x / (1.f + __expf(-x)); }
DI bf16x8 mk8(u32x4 v) { return __builtin_bit_cast(bf16x8, v); }
DI bf16x8 ld8(const bf16_t* p) { return __builtin_bit_cast(bf16x8, *(const u32x4*)p); }


DI void sincos_acc(float angf, float& sn, float& cs) {
  const double a = (double)angf;
  const double k = rint(a * 0.63661977236758134308);
  const double y = (a - k * 1.57079632679489655800) - k * 6.12323399573676603587e-17;
  const double y2 = y * y;
  const double sp = y * (1.0 + y2 * (-1.0 / 6 + y2 * (1.0 / 120 + y2 * (-1.0 / 5040 + y2 * (1.0 / 362880 + y2 * (-1.0 / 39916800 + y2 * (1.0 / 6227020800.0)))))));
  const double cp = 1.0 + y2 * (-0.5 + y2 * (1.0 / 24 + y2 * (-1.0 / 720 + y2 * (1.0 / 40320 + y2 * (-1.0 / 3628800 + y2 * (1.0 / 479001600.0))))));
  const int q = ((int)k) & 3;
  const double s_ = (q & 1) ? cp : sp, c_ = (q & 1) ? sp : cp;
  sn = (float)((q & 2) ? -s_ : s_);
  cs = (float)(((q + 1) & 2) ? -c_ : c_);
}
DI float inv_freq(int f) { return (float)exp(-(double)f * (9.21034037197618273607 / 32.0)); }

constexpr size_t al256(size_t x) { return (x + 255) & ~(size_t)255; }
constexpr size_t OFF_WT_IN = 0;
constexpr size_t OFF_W1T = OFF_WT_IN + al256((size_t)NP * 1024 * 2);
constexpr size_t OFF_W2T = OFF_W1T + al256((size_t)2 * 256 * 2048 * 2);
constexpr size_t OFF_WUPA = OFF_W2T + al256((size_t)2 * 64 * 256 * 2);
constexpr size_t OFF_WUPB = OFF_WUPA + al256((size_t)1024 * 512 * 2);
constexpr size_t OFF_WOUT = OFF_WUPB + al256((size_t)1024 * 512 * 2);
constexpr size_t OFF_B1EFF = OFF_WOUT + al256((size_t)1024 * 1024 * 2);
constexpr size_t OFF_COST = OFF_B1EFF + al256((size_t)DEPTH * 2 * 16 * 256 * 4);
constexpr size_t OFF_SINT = OFF_COST + al256((size_t)NTOK * 32 * 4);
constexpr size_t OFF_COSC = OFF_SINT + al256((size_t)NTOK * 32 * 4);
constexpr size_t OFF_SINC = OFF_COSC + al256((size_t)BATCH * 128 * 32 * 4);
constexpr size_t OFF_XB = OFF_SINC + al256((size_t)BATCH * 128 * 32 * 4);
constexpr size_t OFF_PART = OFF_XB + al256((size_t)NTOK * 1024 * 2);
constexpr size_t OFF_SBQ = OFF_PART + al256((size_t)NTOK * 16 * 4);
constexpr size_t OFF_SBK = OFF_SBQ + al256((size_t)NTOK * 512 * 2);
constexpr size_t OFF_SBVT = OFF_SBK + al256((size_t)NTOK * 512 * 2);
constexpr size_t OFF_SBZ = OFF_SBVT + al256((size_t)NTOK * 512 * 2);
constexpr size_t OFF_NQ = OFF_SBZ + al256((size_t)NTOK * 512 * 2);
constexpr size_t OFF_KCR = OFF_NQ + al256((size_t)NTOK * 512 * 2);
constexpr size_t OFF_VCR = OFF_KCR + al256((size_t)NTOK * 128 * 2);
constexpr size_t OFF_KS = OFF_VCR + al256((size_t)NTOK * 128 * 2);
constexpr size_t OFF_VST = OFF_KS + al256((size_t)NTOK * 128 * 2);
constexpr size_t OFF_KW = OFF_VST + al256((size_t)NTOK * 128 * 2);
constexpr size_t OFF_VWT = OFF_KW + al256((size_t)NTOK * 128 * 2);
constexpr size_t OFF_NGATE = OFF_VWT + al256((size_t)NTOK * 128 * 2);
constexpr size_t OFF_NZ = OFF_NGATE + al256((size_t)NTOK * 32 * 4);
constexpr size_t OFF_GA = OFF_NZ + al256((size_t)NTOK * 512 * 2);
constexpr size_t OFF_GB = OFF_GA + al256((size_t)NTOK * 1024 * 2);
constexpr size_t OFF_HID = OFF_GB + al256((size_t)NTOK * 1024 * 2);
constexpr size_t OFF_KC = OFF_HID + al256((size_t)64 * 128 * 256 * 2);
constexpr size_t OFF_VCT = OFF_KC + al256((size_t)BATCH * 2 * 128 * 64 * 2);
constexpr size_t OFF_QNG = OFF_VCT + al256((size_t)BATCH * 2 * 64 * 128 * 2);
constexpr size_t OFF_KNG = OFF_QNG + al256((size_t)DEPTH * 64 * 4);
constexpr size_t WS_NEED = OFF_KNG + al256((size_t)DEPTH * 3 * 64 * 4);

struct Params {
  const float* x_in; const int* pos; const float* norm_g; const float* w_in; const float* q_norm_g; const float* k_norm_g;
  const float* cmp_pe; const float* cmp_w1; const float* cmp_b1; const float* cmp_w2; const float* w_up_a; const float* w_up_b; const float* w_out;
  float* out; unsigned char* ws;
#define WSBUF(T, name, OFF) DI T* name() const { return (T*)(ws + (OFF)); }
  WSBUF(bf16_t, wt_in, OFF_WT_IN) WSBUF(bf16_t, w1t, OFF_W1T) WSBUF(bf16_t, w2t, OFF_W2T) WSBUF(bf16_t, wupa_t, OFF_WUPA) WSBUF(bf16_t, wupb_t, OFF_WUPB) WSBUF(bf16_t, wout_t, OFF_WOUT)
  WSBUF(float, b1eff, OFF_B1EFF) WSBUF(float, cosT, OFF_COST) WSBUF(float, sinT, OFF_SINT) WSBUF(float, cosC, OFF_COSC) WSBUF(float, sinC, OFF_SINC)
  WSBUF(bf16_t, xb, OFF_XB) WSBUF(float, part, OFF_PART) WSBUF(bf16_t, sbq, OFF_SBQ) WSBUF(bf16_t, sbk, OFF_SBK) WSBUF(bf16_t, sbvt, OFF_SBVT) WSBUF(bf16_t, sbz, OFF_SBZ)
  WSBUF(bf16_t, nq, OFF_NQ) WSBUF(bf16_t, kcr, OFF_KCR) WSBUF(bf16_t, vcr, OFF_VCR) WSBUF(bf16_t, ks, OFF_KS) WSBUF(bf16_t, vst, OFF_VST) WSBUF(bf16_t, kw, OFF_KW) WSBUF(bf16_t, vwt, OFF_VWT)
  WSBUF(float, ngate, OFF_NGATE) WSBUF(bf16_t, nz, OFF_NZ) WSBUF(bf16_t, ga, OFF_GA) WSBUF(bf16_t, gb, OFF_GB) WSBUF(bf16_t, hid, OFF_HID) WSBUF(bf16_t, kc, OFF_KC) WSBUF(bf16_t, vct, OFF_VCT)
  WSBUF(bf16_t, merged, OFF_SBK)
  WSBUF(float, qng, OFF_QNG) WSBUF(float, kng, OFF_KNG)
};

DI int my_tid() { int t = threadIdx.x; asm volatile("" : "+v"(t)); return t; }
DI Params relaunder(const Params& p0) { Params p = p0; asm volatile("" : "+s"(p.ws)); return p; }

constexpr int LSTR = 72;
constexpr int TILE_E = 128 * LSTR;
constexpr int STAGE_E = 2 * TILE_E;
constexpr int LDS_GEMM_BYTES = 2 * STAGE_E * 2;

struct GStage { u32x4 a[4], b[4]; };
DI void g_load(GStage& r, const bf16_t* const (&ap)[4], const bf16_t* const (&bp)[4], int ko) {
#pragma unroll
  for (int u = 0; u < 4; ++u) { r.a[u] = *(const u32x4*)(ap[u] + ko); r.b[u] = *(const u32x4*)(bp[u] + ko); }
}
DI void g_store(const GStage& r, bf16_t* buf, int so) {
#pragma unroll
  for (int u = 0; u < 4; ++u) { *(u32x4*)(buf + so + u * 32 * LSTR) = r.a[u]; *(u32x4*)(buf + TILE_E + so + u * 32 * LSTR) = r.b[u]; }
}
DI void g_compute(const bf16_t* buf, int ra, int rb, f32x4 (&acc)[4][4]) {
#pragma unroll
  for (int ks = 0; ks < 2; ++ks) {
    bf16x8 af[4], bfr[4];
#pragma unroll
    for (int i = 0; i < 4; ++i) af[i] = ld8(buf + ra + i * 16 * LSTR + ks * 32);
#pragma unroll
    for (int j = 0; j < 4; ++j) bfr[j] = ld8(buf + TILE_E + rb + j * 16 * LSTR + ks * 32);
#pragma unroll
    for (int i = 0; i < 4; ++i)
#pragma unroll
      for (int j = 0; j < 4; ++j) acc[i][j] = MFMA16(af[i], bfr[j], acc[i][j]);
  }
}

DI void gemm_core(const bf16_t* __restrict__ Ag, long lda, int amax, const bf16_t* __restrict__ Bg, long ldb, int bmax, int K,
                  bf16_t* lds, f32x4 (&acc)[4][4]) {
  const int tid = my_tid(), lane = tid & 63, w = tid >> 6, wa = w >> 1, wb = w & 1, qi = lane & 15, quad = lane >> 4;
  const int r0 = tid >> 3, kc = tid & 7;
  const bf16_t* ap[4]; const bf16_t* bp[4];
#pragma unroll
  for (int u = 0; u < 4; ++u) { ap[u] = Ag + (long)min(r0 + 32 * u, amax) * lda + kc * 8; bp[u] = Bg + (long)min(r0 + 32 * u, bmax) * ldb + kc * 8; }
  const int so = r0 * LSTR + kc * 8;
  const int ra = (wa * 64 + qi) * LSTR + quad * 8, rb = (wb * 64 + qi) * LSTR + quad * 8;
  bf16_t* buf0 = lds; bf16_t* buf1 = lds + STAGE_E;
  const int KT = K >> 6;
  GStage R0, R1;
  g_load(R0, ap, bp, 0);
  g_load(R1, ap, bp, 64);
  g_store(R0, buf0, so);
  __syncthreads();
  for (int kt = 0; kt < KT; kt += 2) {
    if (kt + 2 < KT) g_load(R0, ap, bp, (kt + 2) * 64);
    g_compute(buf0, ra, rb, acc);
    g_store(R1, buf1, so);
    __syncthreads();
    if (kt + 3 < KT) g_load(R1, ap, bp, (kt + 3) * 64);
    g_compute(buf1, ra, rb, acc);
    if (kt + 2 < KT) g_store(R0, buf0, so);
    __syncthreads();
  }
}

DI void zero_acc(f32x4 (&acc)[4][4]) {
#pragma unroll
  for (int i = 0; i < 4; ++i)
#pragma unroll
    for (int j = 0; j < 4; ++j) acc[i][j] = (f32x4){0.f, 0.f, 0.f, 0.f};
}

DI bool tile_order(int it, int nN, int& mt, int& nt) {
  const int xcd = blockIdx.x & 7, slot = blockIdx.x >> 3, SL = gridDim.x >> 3;
  const int q = slot + it * SL, per = 8 * nN;
  if (q >= 4 * per) return false;
  const int mg = q / per, e = q - mg * per;
  nt = e >> 3; mt = xcd * 32 + mg * 8 + (e & 7);
  return true;
}

DI int inmap(int c) { return c < 3328 ? c : (c < 5888 ? c + 24 : (c < 5912 ? c - 2560 : -1)); }

DI void tr_tile(const float* __restrict__ src, int ld, int K, int k0, int n0, bool use_map, const float* __restrict__ scale, bf16_t* __restrict__ dst, float* tile) {
  const int tid = my_tid();
  {
    const int nl = tid & 63, kk = tid >> 6;
    const int n = n0 + nl; const int sc = use_map ? inmap(n) : n;
#pragma unroll
    for (int r = 0; r < 16; ++r) {
      const int k = k0 + r * 4 + kk;
      float v = 0.f;
      if (sc >= 0) { v = src[(long)k * ld + sc]; if (scale) v *= scale[k]; }
      tile[(r * 4 + kk) * 65 + nl] = v;
    }
  }
  __syncthreads();
  {
    const int nl = tid >> 2, ks = tid & 3;
    unsigned o[8];
#pragma unroll
    for (int e = 0; e < 8; ++e) o[e] = pk2(tile[(ks * 16 + 2 * e) * 65 + nl], tile[(ks * 16 + 2 * e + 1) * 65 + nl]);
    bf16_t* d = dst + (long)(n0 + nl) * K + k0 + ks * 16;
    *(u32x4*)d = (u32x4){o[0], o[1], o[2], o[3]};
    *(u32x4*)(d + 8) = (u32x4){o[4], o[5], o[6], o[7]};
  }
  __syncthreads();
}

DI void tr_job(const float* src, int ld, int K, int N, bool use_map, const float* scale, bf16_t* dst, float* tile) {
  const int nk = K >> 6, nn = N >> 6;
  for (int t = blockIdx.x; t < nk * nn; t += gridDim.x) tr_tile(src, ld, K, (t % nk) * 64, (t / nk) * 64, use_map, scale, dst, tile);
}

DI void convert_weights(const Params& p0, int l, unsigned char* lds) {
  const Params p = relaunder(p0);
  float* tile = (float*)lds;
  tr_job(p.w_in + (long)l * D_MODEL * N_IN, N_IN, D_MODEL, NP, true, p.norm_g + l * D_MODEL, p.wt_in(), tile);
  for (int kv = 0; kv < 2; ++kv) {
    tr_job(p.cmp_w1 + (long)(l * 2 + kv) * 2048 * 256, 256, 2048, 256, false, nullptr, p.w1t() + (long)kv * 256 * 2048, tile);
    tr_job(p.cmp_w2 + (long)(l * 2 + kv) * 256 * 64, 64, 256, 64, false, nullptr, p.w2t() + (long)kv * 64 * 256, tile);
  }
  tr_job(p.w_up_a + (long)l * 512 * 1024, 1024, 512, 1024, false, nullptr, p.wupa_t(), tile);
  tr_job(p.w_up_b + (long)l * 512 * 1024, 1024, 512, 1024, false, nullptr, p.wupb_t(), tile);
  tr_job(p.w_out + (long)l * 1024 * 1024, 1024, 1024, 1024, false, nullptr, p.wout_t(), tile);
}

DI void phase_prologue(const Params& p, unsigned char* lds) {
  const int tid = my_tid();
  convert_weights(p, 0, lds);
  {
    const int lane = tid & 63;
    for (int wi = blockIdx.x * 4 + (tid >> 6); wi < DEPTH * 2 * 16 * 4; wi += gridDim.x * 4) {
      const int jq = wi & 3, kq = (wi >> 2) & 15, it = wi >> 6;
      const float* w1 = p.cmp_w1 + (long)it * 2048 * 256 + (long)kq * 128 * 256 + jq * 64 + lane; const float* pe = p.cmp_pe + (long)it * 2048 + kq * 128;
      float s0 = kq == 0 ? p.cmp_b1[it * 256 + jq * 64 + lane] : 0.f, s1 = 0.f, s2 = 0.f, s3 = 0.f;
#pragma unroll 4
      for (int k = 0; k < 128; k += 4) {
        s0 += pe[k] * w1[(long)k * 256]; s1 += pe[k + 1] * w1[(long)(k + 1) * 256]; s2 += pe[k + 2] * w1[(long)(k + 2) * 256]; s3 += pe[k + 3] * w1[(long)(k + 3) * 256];
      }
      p.b1eff()[(it * 16 + kq) * 256 + jq * 64 + lane] = (s0 + s1) + (s2 + s3);
    }
  }
  if (blockIdx.x == 0) { for (int i = tid; i < DEPTH * 64; i += 256) p.qng()[i] = p.q_norm_g[i]; for (int i = tid; i < DEPTH * 192; i += 256) p.kng()[i] = p.k_norm_g[i]; }
  const long gtid = (long)blockIdx.x * 256 + tid, gn = (long)gridDim.x * 256;
  for (long i = gtid; i < (long)NTOK * 32; i += gn) {
    const int f = (int)(i & 31); const long tok = i >> 5;
    const float ang = (float)p.pos[tok] * inv_freq(f);
    float sn, cs; sincos_acc(ang, sn, cs);
    p.cosT()[i] = cs; p.sinT()[i] = sn;
  }
  for (long i = gtid; i < (long)BATCH * 128 * 32; i += gn) {
    const int f = (int)(i & 31); const int c = (int)((i >> 5) & 127); const int b = (int)(i >> 12);
    float cs = 1.f, sn = 0.f;
    if (c < NCMP) {
      float sum = 0.f;
      for (int k = 0; k < 32; ++k) sum += (float)p.pos[b * SEQ + c * 16 + k];
      const float ang = (sum * (1.f / 32.f)) * inv_freq(f);
      sincos_acc(ang, sn, cs);
    }
    p.cosC()[i] = cs; p.sinC()[i] = sn;
  }
  const int lane = tid & 63;
  for (long row = (long)blockIdx.x * 4 + (tid >> 6); row < NTOK; row += (long)gridDim.x * 4) {
    const float* xr = p.x_in + row * D_MODEL; bf16_t* xo = p.xb() + row * D_MODEL;
    float ss = 0.f;
#pragma unroll
    for (int u = 0; u < 4; ++u) {
      const f32x4 v = *(const f32x4*)(xr + u * 256 + lane * 4);
      ss += v[0] * v[0] + v[1] * v[1] + v[2] * v[2] + v[3] * v[3];
      *(u32x2*)(xo + u * 256 + lane * 4) = (u32x2){pk2(v[0], v[1]), pk2(v[2], v[3])};
    }
#pragma unroll
    for (int o = 32; o >= 1; o >>= 1) ss += __shfl_xor(ss, o);
    if (lane < 16) p.part()[row * 16 + lane] = lane == 0 ? ss : 0.f;
  }
}

DI void phaseA_epilogue(const Params& p, int layer, int mt, int nt, const f32x4 (&acc)[4][4], const float* rs_s) {
  const int tid = my_tid(), lane = tid & 63, w = tid >> 6, wa = w >> 1, wb = w & 1, qi = lane & 15, quad = lane >> 4;
  const bool vtype = (nt >= 8 && nt < 12) || nt == 23 || nt == 25;
  if (vtype) {
    bf16_t* dstb; int nh, head;
    if (nt < 12) { dstb = p.sbvt(); nh = 8; head = (nt - 8) * 2 + wb; } else if (nt == 23) { dstb = p.vst(); nh = 2; head = wb; } else { dstb = p.vwt(); nh = 2; head = wb; }
    const int tok0 = mt * 128, b = tok0 >> 11, s0 = (tok0 & 2047) + wa * 64 + quad * 4;
#pragma unroll
    for (int i = 0; i < 4; ++i) {
      const int tl = wa * 64 + i * 16 + quad * 4;
      const float r0 = rs_s[tl], r1 = rs_s[tl + 1], r2 = rs_s[tl + 2], r3 = rs_s[tl + 3];
#pragma unroll
      for (int j = 0; j < 4; ++j) {
        const int d = j * 16 + qi;
        const f32x4 v = acc[i][j];
        bf16_t* dst = dstb + ((long)(b * nh + head) * 64 + d) * SEQ + s0 + i * 16;
        *(u32x2*)dst = (u32x2){pk2(v[0] * r0, v[1] * r1), pk2(v[2] * r2, v[3] * r3)};
      }
    }
    return;
  }
#pragma unroll
  for (int j = 0; j < 4; ++j) {
    const int tl = wb * 64 + j * 16 + qi; const long tok = (long)mt * 128 + tl; const int b = (int)(tok >> 11), s = (int)(tok & 2047);
    const float rs = rs_s[tl];
    f32x4 v[4];
#pragma unroll
    for (int i = 0; i < 4; ++i) v[i] = acc[i][j] * rs;
    const bool headtype = nt < 8 || (nt >= 16 && nt < 26);
    if (headtype) {
      bf16_t* dstb; int nh, head; const float* g = nullptr;
      if (nt < 4) { dstb = p.sbq(); nh = 8; head = nt * 2 + wa; }
      else if (nt < 8) { dstb = p.sbk(); nh = 8; head = (nt - 4) * 2 + wa; }
      else if (nt < 20) { dstb = p.nq(); nh = 8; head = (nt - 16) * 2 + wa; g = p.qng() + layer * 64; }
      else if (nt == 20) { dstb = p.kcr(); nh = 2; head = wa; }
      else if (nt == 21) { dstb = p.vcr(); nh = 2; head = wa; }
      else if (nt == 22) { dstb = p.ks(); nh = 2; head = wa; g = p.kng() + (layer * 3 + 1) * 64; }
      else { dstb = p.kw(); nh = 2; head = wa; g = p.kng() + (layer * 3 + 2) * 64; }
      if (g) {
        float ss = 0.f;
#pragma unroll
        for (int i = 0; i < 4; ++i) ss += v[i][0] * v[i][0] + v[i][1] * v[i][1] + v[i][2] * v[i][2] + v[i][3] * v[i][3];
        ss += __shfl_xor(ss, 16); ss += __shfl_xor(ss, 32);
        const float rn = rsqrtf(ss * (1.f / 64.f) + NORM_EPS);
#pragma unroll
        for (int i = 0; i < 4; ++i) { const f32x4 gg = *(const f32x4*)(g + i * 16 + quad * 4); v[i] = v[i] * rn * gg; }
#pragma unroll
        for (int i = 0; i < 2; ++i) {
          const f32x4 cs = *(const f32x4*)(p.cosT() + tok * 32 + i * 16 + quad * 4), sn = *(const f32x4*)(p.sinT() + tok * 32 + i * 16 + quad * 4);
          const f32x4 x1 = v[i], x2 = v[i + 2];
          v[i] = x1 * cs - x2 * sn; v[i + 2] = x2 * cs + x1 * sn;
        }
      }
      bf16_t* dst = dstb + ((long)(b * nh + head) * SEQ + s) * 64 + quad * 4;
#pragma unroll
      for (int i = 0; i < 4; ++i) *(u32x2*)(dst + i * 16) = (u32x2){pk2(v[i][0], v[i][1]), pk2(v[i][2], v[i][3])};
    } else if (nt == 46) {
      if (wa == 0) {
#pragma unroll
        for (int i = 0; i < 2; ++i) {
          const int f = i * 16 + quad * 4;
          if (f < 24) { const f32x4 o = {sigmoidf_(v[i][0]), sigmoidf_(v[i][1]), sigmoidf_(v[i][2]), sigmoidf_(v[i][3])}; *(f32x4*)(p.ngate() + tok * 32 + f) = o; }
        }
      }
    } else {
      bf16_t* dstb; int ldd, c0; bool sil;
      if (nt < 16) { dstb = p.sbz(); ldd = 512; c0 = (nt - 12) * 128; sil = true; }
      else if (nt < 30) { dstb = p.nz(); ldd = 512; c0 = (nt - 26) * 128; sil = true; }
      else if (nt < 38) { dstb = p.ga(); ldd = 1024; c0 = (nt - 30) * 128; sil = false; }
      else { dstb = p.gb(); ldd = 1024; c0 = (nt - 38) * 128; sil = false; }
      bf16_t* dst = dstb + tok * ldd + c0 + wa * 64 + quad * 4;
#pragma unroll
      for (int i = 0; i < 4; ++i) {
        f32x4 o;
#pragma unroll
        for (int r = 0; r < 4; ++r) o[r] = sil ? siluf_(v[i][r]) : sigmoidf_(v[i][r]);
        *(u32x2*)(dst + i * 16) = (u32x2){pk2(o[0], o[1]), pk2(o[2], o[3])};
      }
    }
  }
}

DI void phaseA(const Params& p0, int layer, unsigned char* lds) {
  const Params p = relaunder(p0);
  bf16_t* gl = (bf16_t*)lds; float* rs_s = (float*)(lds + LDS_GEMM_BYTES);
  const bf16_t* Wt = p.wt_in();
  int mt, nt;
  for (int it = 0; tile_order(it, NT_IN, mt, nt); ++it) {
    if (my_tid() < 128) {
      const float* pp = p.part() + ((long)mt * 128 + my_tid()) * 16;
      float s = 0.f;
#pragma unroll
      for (int u = 0; u < 4; ++u) { const f32x4 v = *(const f32x4*)(pp + u * 4); s += v[0] + v[1] + v[2] + v[3]; }
      rs_s[my_tid()] = rsqrtf(s * (1.f / 1024.f) + NORM_EPS);
    }
    const bool vtype = (nt >= 8 && nt < 12) || nt == 23 || nt == 25;
    const bf16_t* Xg = p.xb() + (long)mt * 128 * D_MODEL; const bf16_t* Wg = Wt + (long)nt * 128 * D_MODEL;
    f32x4 acc[4][4]; zero_acc(acc);
    if (vtype) gemm_core(Xg, D_MODEL, 127, Wg, D_MODEL, 127, D_MODEL, gl, acc);
    else gemm_core(Wg, D_MODEL, 127, Xg, D_MODEL, 127, D_MODEL, gl, acc);
    phaseA_epilogue(p, layer, mt, nt, acc, rs_s);
    __syncthreads();
  }
}

DI void compress_item(const Params& p, int layer, int item, unsigned char* lds) {
  bf16_t* gl = (bf16_t*)lds;
  const int tid = my_tid(), lane = tid & 63, w = tid >> 6, wa = w >> 1, wb = w & 1, qi = lane & 15, quad = lane >> 4;
  const int kv = item & 1, bg = item >> 1;
  const bf16_t* src = (kv ? p.vcr() : p.kcr()) + (long)bg * SEQ * 64;
  const bf16_t* W1 = p.w1t() + (long)kv * 256 * 2048;
  const float* b1 = p.b1eff() + (layer * 2 + kv) * 16 * 256;
  bf16_t* hid = p.hid() + (long)item * 128 * 256;
  for (int n2 = 0; n2 < 2; ++n2) {
    f32x4 acc[4][4]; zero_acc(acc);
    gemm_core(W1 + (long)n2 * 128 * 2048, 2048, 127, src, 1024, NCMP - 1, 2048, gl, acc);
#pragma unroll
    for (int i = 0; i < 4; ++i) {
      const int f = n2 * 128 + wa * 64 + i * 16 + quad * 4;
      f32x4 bb = *(const f32x4*)(b1 + f);
#pragma unroll
      for (int kq = 1; kq < 16; ++kq) bb += *(const f32x4*)(b1 + kq * 256 + f);
#pragma unroll
      for (int j = 0; j < 4; ++j) {
        const int c = wb * 64 + j * 16 + qi;
        f32x4 v = acc[i][j] + bb;
        *(u32x2*)(hid + (long)c * 256 + f) = (u32x2){pk2(siluf_(v[0]), siluf_(v[1])), pk2(siluf_(v[2]), siluf_(v[3]))};
      }
    }
  }
  __threadfence_block();
  __syncthreads();
  const bf16_t* W2 = p.w2t() + (long)kv * 64 * 256;
  f32x4 o[4][2];
#pragma unroll
  for (int dt = 0; dt < 4; ++dt) { o[dt][0] = (f32x4){0.f, 0.f, 0.f, 0.f}; o[dt][1] = o[dt][0]; }
  for (int ksx = 0; ksx < 8; ++ksx) {
    bf16x8 wf[4], hf[2];
#pragma unroll
    for (int dt = 0; dt < 4; ++dt) wf[dt] = ld8(W2 + (long)(dt * 16 + qi) * 256 + ksx * 32 + quad * 8);
#pragma unroll
    for (int rt = 0; rt < 2; ++rt) hf[rt] = ld8(hid + (long)(w * 32 + rt * 16 + qi) * 256 + ksx * 32 + quad * 8);
#pragma unroll
    for (int dt = 0; dt < 4; ++dt)
#pragma unroll
      for (int rt = 0; rt < 2; ++rt) o[dt][rt] = kv ? MFMA16(hf[rt], wf[dt], o[dt][rt]) : MFMA16(wf[dt], hf[rt], o[dt][rt]);
  }
  if (kv == 0) {
    const float* g = p.kng() + (layer * 3 + 0) * 64;
    const int b = bg >> 1;
#pragma unroll
    for (int rt = 0; rt < 2; ++rt) {
      const int c = w * 32 + rt * 16 + qi;
      f32x4 v[4];
      float ss = 0.f;
#pragma unroll
      for (int dt = 0; dt < 4; ++dt) { v[dt] = o[dt][rt]; ss += v[dt][0] * v[dt][0] + v[dt][1] * v[dt][1] + v[dt][2] * v[dt][2] + v[dt][3] * v[dt][3]; }
      ss += __shfl_xor(ss, 16); ss += __shfl_xor(ss, 32);
      const float rn = rsqrtf(ss * (1.f / 64.f) + NORM_EPS);
#pragma unroll
      for (int dt = 0; dt < 4; ++dt) { const f32x4 gg = *(const f32x4*)(g + dt * 16 + quad * 4); v[dt] = v[dt] * rn * gg; }
#pragma unroll
      for (int dt = 0; dt < 2; ++dt) {
        const long ti = ((long)b * 128 + c) * 32 + dt * 16 + quad * 4;
        const f32x4 cs = *(const f32x4*)(p.cosC() + ti), sn = *(const f32x4*)(p.sinC() + ti);
        const f32x4 x1 = v[dt], x2 = v[dt + 2];
        v[dt] = x1 * cs - x2 * sn; v[dt + 2] = x2 * cs + x1 * sn;
      }
      bf16_t* dst = p.kc() + ((long)bg * 128 + c) * 64 + quad * 4;
#pragma unroll
      for (int dt = 0; dt < 4; ++dt) {
        u32x2 ov = (u32x2){pk2(v[dt][0], v[dt][1]), pk2(v[dt][2], v[dt][3])};
        if (c >= NCMP) ov = (u32x2){0u, 0u};
        *(u32x2*)(dst + dt * 16) = ov;
      }
    }
  } else {
#pragma unroll
    for (int dt = 0; dt < 4; ++dt)
#pragma unroll
      for (int rt = 0; rt < 2; ++rt) {
        const int c0 = w * 32 + rt * 16 + quad * 4;
        f32x4 v = o[dt][rt];
        if (c0 + 3 >= NCMP) v[3] = 0.f;
        *(u32x2*)(p.vct() + ((long)bg * 64 + dt * 16 + qi) * 128 + c0) = (u32x2){pk2(v[0], v[1]), pk2(v[2], v[3])};
      }
  }
  __syncthreads();
}

DI void sb_attn_wave(const Params& p, int b, int h, int t0) {
  const int lane = my_tid() & 63, qi = lane & 15, quad = lane >> 4;
  const bf16_t* Q = p.sbq() + (long)(b * 8 + h) * SEQ * 64;
  const bf16_t* K = p.sbk() + (long)(b * 8 + h) * SEQ * 64;
  const bf16_t* Vt = p.sbvt() + (long)(b * 8 + h) * 64 * SEQ;
  const int t = t0 + qi;
  bf16x8 qf[2];
  qf[0] = ld8(Q + (long)t * 64 + quad * 8); qf[1] = ld8(Q + (long)t * 64 + 32 + quad * 8);
  f32x4 o[4];
#pragma unroll
  for (int dt = 0; dt < 4; ++dt) o[dt] = (f32x4){0.f, 0.f, 0.f, 0.f};
  float carry = 0.f;
  const int krow = 8 * (qi >> 2) + (qi & 3);
  const bf16_t* kp0 = K + (long)krow * 64 + quad * 8;
  const bf16_t* vp0 = Vt + (long)qi * SEQ + 8 * quad;
  int kb = t0 & ~31;
  bf16x8 kf[2][2], vf[4];
#pragma unroll
  for (int a = 0; a < 2; ++a) { kf[a][0] = ld8(kp0 + (long)(kb + 4 * a) * 64); kf[a][1] = ld8(kp0 + (long)(kb + 4 * a) * 64 + 32); }
#pragma unroll
  for (int dt = 0; dt < 4; ++dt) vf[dt] = ld8(vp0 + (long)dt * 16 * SEQ + kb);
  for (; kb >= 0; kb -= 32) {
    bf16x8 kn[2][2], vn[4];
    const int kbn = kb >= 32 ? kb - 32 : 0;
#pragma unroll
    for (int a = 0; a < 2; ++a) { kn[a][0] = ld8(kp0 + (long)(kbn + 4 * a) * 64); kn[a][1] = ld8(kp0 + (long)(kbn + 4 * a) * 64 + 32); }
#pragma unroll
    for (int dt = 0; dt < 4; ++dt) vn[dt] = ld8(vp0 + (long)dt * 16 * SEQ + kbn);
    f32x4 s[2];
#pragma unroll
    for (int a = 0; a < 2; ++a) {
      s[a] = MFMA16(kf[a][0], qf[0], ((f32x4){0.f, 0.f, 0.f, 0.f}));
      s[a] = MFMA16(kf[a][1], qf[1], s[a]);
    }
    float L[8], ls[8]; bool val[8];
    float tot = 0.f;
#pragma unroll
    for (int idx = 0; idx < 8; ++idx) {
      const float z = s[idx >> 2][idx & 3] * 0.125f;
      const int key = kb + 8 * quad + idx;
      val[idx] = key < t;
      const float sp = fmaxf(z, 0.f) + __logf(1.f + __expf(-fabsf(z)));
      L[idx] = val[idx] ? -sp : 0.f;
      ls[idx] = z - sp;
      tot += L[idx];
    }
    const float a1 = __shfl_xor(tot, 16), a2 = __shfl_xor(tot, 32), a3 = __shfl_xor(a1, 32);
    const float higher = ((quad ^ 1) > quad ? a1 : 0.f) + ((quad ^ 2) > quad ? a2 : 0.f) + ((quad ^ 3) > quad ? a3 : 0.f);
    float run = carry + higher;
    float wv[8];
#pragma unroll
    for (int idx = 7; idx >= 0; --idx) {
      wv[idx] = val[idx] ? __expf(ls[idx] + run) : 0.f;
      run += L[idx];
    }
    carry += (tot + a1) + (a2 + a3);
    const bf16x8 pf = mk8((u32x4){pk2(wv[0], wv[1]), pk2(wv[2], wv[3]), pk2(wv[4], wv[5]), pk2(wv[6], wv[7])});
#pragma unroll
    for (int dt = 0; dt < 4; ++dt) o[dt] = MFMA16(vf[dt], pf, o[dt]);
    if (__all(carry < -110.f)) break;
#pragma unroll
    for (int a = 0; a < 2; ++a) { kf[a][0] = kn[a][0]; kf[a][1] = kn[a][1]; }
#pragma unroll
    for (int dt = 0; dt < 4; ++dt) vf[dt] = vn[dt];
  }
  bf16_t* zp = p.sbz() + ((long)b * SEQ + t) * 512 + h * 64 + quad * 4;
#pragma unroll
  for (int dt = 0; dt < 4; ++dt) {
    const u32x2 zz = *(const u32x2*)(zp + dt * 16);
    *(u32x2*)(zp + dt * 16) = (u32x2){pk2(o[dt][0] * bflo(zz[0]), o[dt][1] * bfhi(zz[0])), pk2(o[dt][2] * bflo(zz[1]), o[dt][3] * bfhi(zz[1]))};
  }
}

DI void phaseB(const Params& p0, int layer, unsigned char* lds) {
  const int NITEM = 64 + BATCH * 8 * 32;
  for (int it = blockIdx.x; it < NITEM; it += gridDim.x) {
    const Params p = relaunder(p0);
    if (it < 64) { compress_item(p, layer, it, lds); continue; }
    const int i = it - 64, qt = 31 - (i >> 7), bh = i & 127;
    sb_attn_wave(p, bh >> 3, bh & 7, qt * 64 + (my_tid() >> 6) * 16);
  }
}

struct KVFrag { bf16x8 k[2][2]; bf16x8 v[4]; };
DI void nsa_load(KVFrag& f, const bf16_t* __restrict__ kp0, const bf16_t* __restrict__ vp0, int kb) {
#pragma unroll
  for (int a = 0; a < 2; ++a) { f.k[a][0] = ld8(kp0 + (long)(kb + 4 * a) * 64); f.k[a][1] = ld8(kp0 + (long)(kb + 4 * a) * 64 + 32); }
#pragma unroll
  for (int dt = 0; dt < 4; ++dt) f.v[dt] = ld8(vp0 + (long)dt * 16 * SEQ + kb);
}
template <int MODE>
DI void nsa_chunk(const KVFrag& f, int kb, int t, bool selbit, const bf16x8 (&qf)[2][2], f32x4 (&O)[2][4], float (&m)[2], float (&l)[2], int quad) {
  const float SC = 0.125f * 1.44269504089f;
  bool val[8];
#pragma unroll
  for (int idx = 0; idx < 8; ++idx) {
    const int key = kb + 8 * quad + idx;
    val[idx] = MODE == 0 ? (selbit && key <= t) : (key <= t && key > t - 512);
  }
#pragma unroll
  for (int hh = 0; hh < 2; ++hh) {
    f32x4 s[2];
#pragma unroll
    for (int a = 0; a < 2; ++a) { s[a] = MFMA16(f.k[a][0], qf[hh][0], ((f32x4){0.f, 0.f, 0.f, 0.f})); s[a] = MFMA16(f.k[a][1], qf[hh][1], s[a]); }
    float sv[8]; float cm = -1e30f;
#pragma unroll
    for (int idx = 0; idx < 8; ++idx) { sv[idx] = s[idx >> 2][idx & 3] * SC; if (val[idx]) cm = fmaxf(cm, sv[idx]); }
    cm = fmaxf(cm, __shfl_xor(cm, 16)); cm = fmaxf(cm, __shfl_xor(cm, 32));
    const float mn = fmaxf(m[hh], cm);
    const float alpha = exp2f(m[hh] - mn);
    m[hh] = mn;
    float pv[8]; float ps = 0.f;
#pragma unroll
    for (int idx = 0; idx < 8; ++idx) { pv[idx] = val[idx] ? exp2f(sv[idx] - mn) : 0.f; ps += pv[idx]; }
    l[hh] = l[hh] * alpha + ps;
    const bf16x8 pf = mk8((u32x4){pk2(pv[0], pv[1]), pk2(pv[2], pv[3]), pk2(pv[4], pv[5]), pk2(pv[6], pv[7])});
#pragma unroll
    for (int dt = 0; dt < 4; ++dt) { O[hh][dt] = O[hh][dt] * alpha; O[hh][dt] = MFMA16(f.v[dt], pf, O[hh][dt]); }
  }
}

template <bool LAST>
DI void nsa_finish(f32x4* lo, f32x4 (&O)[2][4], float (&m)[2], float (&l)[2], const float (&gate)[2], bf16_t* zp) {
#pragma unroll
  for (int hh = 0; hh < 2; ++hh) {
    float lt = l[hh]; lt += __shfl_xor(lt, 16); lt += __shfl_xor(lt, 32);
    const float f = lt > 0.f ? gate[hh] / lt : 0.f;
#pragma unroll
    for (int dt = 0; dt < 4; ++dt) {
      const f32x4 v = lo[(hh * 4 + dt) * 64] + O[hh][dt] * f;
      if (LAST) {
        bf16_t* a = zp + hh * 64 + dt * 16;
        const u32x2 zz = *(const u32x2*)a;
        *(u32x2*)a = (u32x2){pk2(v[0] * bflo(zz[0]), v[1] * bfhi(zz[0])), pk2(v[2] * bflo(zz[1]), v[3] * bfhi(zz[1]))};
      } else {
        lo[(hh * 4 + dt) * 64] = v;
        O[hh][dt] = (f32x4){0.f, 0.f, 0.f, 0.f};
      }
    }
    m[hh] = -1e30f; l[hh] = 0.f;
  }
}

DI void nsa_wave(const Params& p, int b, int g, int t0, unsigned char* lds) {
  const int lane = my_tid() & 63, qi = lane & 15, quad = lane >> 4;
  const int t = t0 + qi, cur = t0 >> 6;
  const long tok = (long)b * SEQ + t;
  const int bg = b * 2 + g;
  f32x4* lo = (f32x4*)lds + (my_tid() >> 6) * 1024 + lane;

  const float SC = 0.125f * 1.44269504089f;
  const bf16_t* Kc = p.kc() + (long)bg * 128 * 64;
  const bf16_t* Vc = p.vct() + (long)bg * 64 * 128;
  f32x4 ph[8];
#pragma unroll
  for (int kt = 0; kt < 8; ++kt) ph[kt] = (f32x4){0.f, 0.f, 0.f, 0.f};
#pragma unroll 1
  for (int hh = 0; hh < 4; ++hh) {
    const bf16_t* qp0 = p.nq() + ((long)(b * 8 + g * 4 + hh) * SEQ + t) * 64 + quad * 8;
    const bf16x8 q0 = ld8(qp0), q1 = ld8(qp0 + 32); const float gt = p.ngate()[tok * 32 + g * 4 + hh];
    f32x4 sc[8];
    float mx = -1e30f;
#pragma unroll
    for (int kt = 0; kt < 8; ++kt) {
      const bf16_t* kp = Kc + (long)(kt * 16 + qi) * 64 + quad * 8;
      sc[kt] = MFMA16(ld8(kp), q0, ((f32x4){0.f, 0.f, 0.f, 0.f}));
      sc[kt] = MFMA16(ld8(kp + 32), q1, sc[kt]);
#pragma unroll
      for (int r = 0; r < 4; ++r) {
        const int c = kt * 16 + quad * 4 + r;
        sc[kt][r] *= SC;
        if (c < NCMP && 16 * c + 31 <= t) mx = fmaxf(mx, sc[kt][r]);
      }
    }
    mx = fmaxf(mx, __shfl_xor(mx, 16)); mx = fmaxf(mx, __shfl_xor(mx, 32));
    float sum = 0.f;
#pragma unroll
    for (int kt = 0; kt < 8; ++kt)
#pragma unroll
      for (int r = 0; r < 4; ++r) {
        const int c = kt * 16 + quad * 4 + r;
        const float e = (c < NCMP && 16 * c + 31 <= t) ? exp2f(sc[kt][r] - mx) : 0.f;
        sc[kt][r] = e; sum += e;
      }
    sum += __shfl_xor(sum, 16); sum += __shfl_xor(sum, 32);
    const float inv = sum > 0.f ? 1.f / sum : 0.f;
#pragma unroll
    for (int kt = 0; kt < 8; ++kt) { sc[kt] = sc[kt] * inv; ph[kt] += sc[kt]; }
    f32x4 oc[4];
#pragma unroll
    for (int dt = 0; dt < 4; ++dt) oc[dt] = (f32x4){0.f, 0.f, 0.f, 0.f};
#pragma unroll
    for (int mm = 0; mm < 4; ++mm) {
      const bf16x8 pf = mk8((u32x4){pk2(sc[2 * mm][0], sc[2 * mm][1]), pk2(sc[2 * mm][2], sc[2 * mm][3]), pk2(sc[2 * mm + 1][0], sc[2 * mm + 1][1]), pk2(sc[2 * mm + 1][2], sc[2 * mm + 1][3])});
#pragma unroll
      for (int dt = 0; dt < 4; ++dt) {
        const bf16_t* vp = Vc + (long)(dt * 16 + qi) * 128 + 32 * mm + quad * 4;
        const u32x2 lo = *(const u32x2*)vp, hi = *(const u32x2*)(vp + 16);
        oc[dt] = MFMA16(mk8((u32x4){lo[0], lo[1], hi[0], hi[1]}), pf, oc[dt]);
      }
    }
#pragma unroll
    for (int dt = 0; dt < 4; ++dt) lo[(hh * 4 + dt) * 64] = oc[dt] * gt;
  }
  float imp[8];
  {
    float rot[8];
#pragma unroll
    for (int kt = 0; kt < 8; ++kt) rot[kt] = __shfl(ph[kt][3], (lane + 48) & 63);
#pragma unroll
    for (int kt = 0; kt < 8; ++kt) {
      const float extra = quad > 0 ? rot[kt] : (kt > 0 ? rot[kt > 0 ? kt - 1 : 0] : 0.f);
      const float v = (ph[kt][0] + ph[kt][1]) + (ph[kt][2] + ph[kt][3]) + extra;
      const int j = 4 * kt + quad;
      const bool forced = j == 0 || j == cur || j == cur - 1;
      imp[kt] = j <= cur ? v + (forced ? 1e4f : 0.f) : -1e30f;
    }
  }
  unsigned selmask = 0;
  {
    int rank[8];
#pragma unroll
    for (int kt = 0; kt < 8; ++kt) rank[kt] = 0;
#pragma unroll 1
    for (int q2 = 0; q2 < 4; ++q2)
#pragma unroll
      for (int k2 = 0; k2 < 8; ++k2) {
        const float ov = __shfl(imp[k2], qi + 16 * q2);
#pragma unroll
        for (int kt = 0; kt < 8; ++kt) {
          const bool before = k2 < kt || (k2 == kt && q2 < quad);
          rank[kt] += (ov > imp[kt] || (ov == imp[kt] && before)) ? 1 : 0;
        }
      }
#pragma unroll
    for (int kt = 0; kt < 8; ++kt) if (rank[kt] < 8 && 4 * kt + quad <= cur) selmask |= 1u << (4 * kt + quad);
    selmask |= __shfl_xor(selmask, 16); selmask |= __shfl_xor(selmask, 32);
  }

  unsigned umall = selmask;
  umall |= __shfl_xor(umall, 1); umall |= __shfl_xor(umall, 2); umall |= __shfl_xor(umall, 4); umall |= __shfl_xor(umall, 8);
  umall = __builtin_amdgcn_readfirstlane(umall);
#pragma unroll 1
  for (int hp = 0; hp < 2; ++hp) {
  f32x4* lo2 = lo + hp * 8 * 64;
  bf16x8 qf[2][2];
#pragma unroll
  for (int hh = 0; hh < 2; ++hh) {
    const bf16_t* qp = p.nq() + ((long)(b * 8 + g * 4 + hp * 2 + hh) * SEQ + t) * 64 + quad * 8;
    qf[hh][0] = ld8(qp); qf[hh][1] = ld8(qp + 32);
  }
  float gate[3][2];
#pragma unroll
  for (int br = 1; br < 3; ++br) { const f32x2 gv = *(const f32x2*)(p.ngate() + tok * 32 + br * 8 + g * 4 + hp * 2); gate[br][0] = gv[0]; gate[br][1] = gv[1]; }
  f32x4 O[2][4]; float m[2], l[2];
#pragma unroll
  for (int hh = 0; hh < 2; ++hh) { m[hh] = -1e30f; l[hh] = 0.f;
#pragma unroll
    for (int dt = 0; dt < 4; ++dt) O[hh][dt] = (f32x4){0.f, 0.f, 0.f, 0.f}; }

  const int krow = 8 * (qi >> 2) + (qi & 3);
  {
    const bf16_t* kp0 = p.ks() + (long)bg * SEQ * 64 + (long)krow * 64 + quad * 8;
    const bf16_t* vp0 = p.vst() + (long)bg * 64 * SEQ + (long)qi * SEQ + 8 * quad;
    unsigned um = umall;
    int j = __builtin_ctz(um); um &= um - 1;
    KVFrag fa, fb;
    nsa_load(fa, kp0, vp0, j * 64);
#pragma unroll 1
    while (true) {
      nsa_load(fb, kp0, vp0, j * 64 + 32);
      const bool bit = (selmask >> j) & 1u;
      nsa_chunk<0>(fa, j * 64, t, bit, qf, O, m, l, quad);
      const int jn = um ? __builtin_ctz(um) : -1; um &= um - 1;
      if (jn >= 0) nsa_load(fa, kp0, vp0, jn * 64);
      nsa_chunk<0>(fb, j * 64 + 32, t, bit, qf, O, m, l, quad);
      if (jn < 0) break;
      j = jn;
    }
    nsa_finish<false>(lo2, O, m, l, gate[1], nullptr);
  }
  {
    const bf16_t* kp0 = p.kw() + (long)bg * SEQ * 64 + (long)krow * 64 + quad * 8;
    const bf16_t* vp0 = p.vwt() + (long)bg * 64 * SEQ + (long)qi * SEQ + 8 * quad;
    int j = cur >= 8 ? cur - 8 : 0;
    KVFrag fa, fb;
    nsa_load(fa, kp0, vp0, j * 64);
#pragma unroll 1
    while (true) {
      nsa_load(fb, kp0, vp0, j * 64 + 32);
      nsa_chunk<1>(fa, j * 64, t, true, qf, O, m, l, quad);
      if (j < cur) nsa_load(fa, kp0, vp0, (j + 1) * 64);
      nsa_chunk<1>(fb, j * 64 + 32, t, true, qf, O, m, l, quad);
      if (j >= cur) break;
      ++j;
    }
    nsa_finish<true>(lo2, O, m, l, gate[2], p.nz() + tok * 512 + g * 256 + hp * 128 + quad * 4);
  }
  }
}

DI void phaseC(const Params& p0, unsigned char* lds) {
  const int NITEM = BATCH * 2 * 32;
  for (int it = blockIdx.x; it < NITEM; it += gridDim.x) {
    const Params p = relaunder(p0);
    const int qt = 31 - (it >> 5), bg = it & 31;
    nsa_wave(p, bg >> 1, bg & 1, qt * 64 + (my_tid() >> 6) * 16, lds);
  }
}

DI void phaseD(const Params& p0, int layer, unsigned char* lds) {
  const Params p = relaunder(p0);
  bf16_t* gl = (bf16_t*)lds;
  const int tid = my_tid(), lane = tid & 63, w = tid >> 6, wa = w >> 1, wb = w & 1, qi = lane & 15, quad = lane >> 4;
  int mt, nt;
  for (int it = 0; tile_order(it, 8, mt, nt); ++it) {
    u32x2 pa[4][4];
    {
      f32x4 aa[4][4]; zero_acc(aa);
      gemm_core(p.wupa_t() + ((long)nt * 128) * 512, 512, 127, p.sbz() + (long)mt * 128 * 512, 512, 127, 512, gl, aa);
#pragma unroll
      for (int j = 0; j < 4; ++j) {
        const long tok = (long)mt * 128 + wb * 64 + j * 16 + qi;
#pragma unroll
        for (int i = 0; i < 4; ++i) {
          const long off = tok * 1024 + nt * 128 + wa * 64 + i * 16 + quad * 4;
          const u32x2 xa = *(const u32x2*)(p.ga() + off);
          const f32x4 va = aa[i][j];
          pa[i][j] = (u32x2){pk2(bflo(xa[0]) * va[0], bfhi(xa[0]) * va[1]), pk2(bflo(xa[1]) * va[2], bfhi(xa[1]) * va[3])};
        }
      }
    }
    f32x4 ab[4][4]; zero_acc(ab);
    gemm_core(p.wupb_t() + ((long)nt * 128) * 512, 512, 127, p.nz() + (long)mt * 128 * 512, 512, 127, 512, gl, ab);
#pragma unroll
    for (int j = 0; j < 4; ++j) {
      const long tok = (long)mt * 128 + wb * 64 + j * 16 + qi;
#pragma unroll
      for (int i = 0; i < 4; ++i) {
        const long off = tok * 1024 + nt * 128 + wa * 64 + i * 16 + quad * 4;
        const u32x2 xb2 = *(const u32x2*)(p.gb() + off);
        const f32x4 vb = ab[i][j];
        const u32x2 a = pa[i][j];
        const float o0 = bflo(a[0]) + bflo(xb2[0]) * vb[0], o1 = bfhi(a[0]) + bfhi(xb2[0]) * vb[1];
        const float o2 = bflo(a[1]) + bflo(xb2[1]) * vb[2], o3 = bfhi(a[1]) + bfhi(xb2[1]) * vb[3];
        *(u32x2*)(p.merged() + off) = (u32x2){pk2(o0, o1), pk2(o2, o3)};
      }
    }
  }
}

DI void phaseE(const Params& p0, int layer, unsigned char* lds, const float* xsrc) {
  const Params p = relaunder(p0);
  bf16_t* gl = (bf16_t*)lds;
  const int tid = my_tid(), lane = tid & 63, w = tid >> 6, wa = w >> 1, wb = w & 1, qi = lane & 15, quad = lane >> 4;
  int mt, nt;
  for (int it = 0; tile_order(it, 8, mt, nt); ++it) {
    f32x4 acc[4][4]; zero_acc(acc);
    gemm_core(p.wout_t() + ((long)nt * 128) * 1024, 1024, 127, p.merged() + (long)mt * 128 * 1024, 1024, 127, 1024, gl, acc);
#pragma unroll
    for (int j = 0; j < 4; ++j) {
      const long tok = (long)mt * 128 + wb * 64 + j * 16 + qi;
      float ss = 0.f;
#pragma unroll
      for (int i = 0; i < 4; ++i) {
        const long off = tok * 1024 + nt * 128 + wa * 64 + i * 16 + quad * 4;
        const f32x4 xo = *(const f32x4*)(xsrc + off);
        const f32x4 xn = xo + acc[i][j];
        *(f32x4*)(p.out + off) = xn;
        *(u32x2*)(p.xb() + off) = (u32x2){pk2(xn[0], xn[1]), pk2(xn[2], xn[3])};
        ss += xn[0] * xn[0] + xn[1] * xn[1] + xn[2] * xn[2] + xn[3] * xn[3];
      }
      ss += __shfl_xor(ss, 16); ss += __shfl_xor(ss, 32);
      if (quad == 0) p.part()[tok * 16 + nt * 2 + wa] = ss;
    }
  }
}

#ifndef STOP_AFTER
#define STOP_AFTER 0
#endif
constexpr int LDS_BYTES = LDS_GEMM_BYTES + 512;

__global__ void __launch_bounds__(256, 2) hybrid_megakernel(Params p) {
  __shared__ __attribute__((aligned(16))) unsigned char lds[LDS_BYTES];
  cg::grid_group grid = cg::this_grid();
  phase_prologue(p, lds);
  grid.sync();
  for (int layer = 0; layer < DEPTH; ++layer) {
    if (layer > 0) { convert_weights(p, layer, lds); grid.sync(); }
    if (STOP_AFTER != 0 && STOP_AFTER == layer * 10) return;
    phaseA(p, layer, lds);
    grid.sync();
    if (STOP_AFTER == layer * 10 + 1) return;
    phaseB(p, layer, lds);
    grid.sync();
    if (STOP_AFTER == layer * 10 + 2) return;
    phaseC(p, lds);
    grid.sync();
    if (STOP_AFTER == layer * 10 + 3) return;
    phaseD(p, layer, lds);
    grid.sync();
    if (STOP_AFTER == layer * 10 + 4) return;
    if (layer == 0) phaseE(p, layer, lds, p.x_in); else phaseE(p, layer, lds, p.out);
    if (layer + 1 < DEPTH) grid.sync();
    if (STOP_AFTER == layer * 10 + 5) return;
  }
}

extern "C" void kernel_launch(void* const* d_in, const int* in_sizes, int n_in, void* d_out, int out_size,
                              void* d_ws, size_t ws_size, hipStream_t stream) {
  static int grid_blocks = 0;
  if (!grid_blocks) {
    int dev = 0, cus = 0, per_cu = 0;
    (void)hipGetDevice(&dev);
    (void)hipDeviceGetAttribute(&cus, hipDeviceAttributeMultiprocessorCount, dev);
    (void)hipOccupancyMaxActiveBlocksPerMultiprocessor(&per_cu, hybrid_megakernel, 256, 0);
    if (per_cu > 2) per_cu = 2;
    if (per_cu < 1) per_cu = 1;
    grid_blocks = (cus * per_cu) & ~7;
  }
  Params a{};
  a.x_in = (const float*)d_in[0]; a.pos = (const int*)d_in[1]; a.norm_g = (const float*)d_in[2]; a.w_in = (const float*)d_in[3];
  a.q_norm_g = (const float*)d_in[4]; a.k_norm_g = (const float*)d_in[5]; a.cmp_pe = (const float*)d_in[6]; a.cmp_w1 = (const float*)d_in[7];
  a.cmp_b1 = (const float*)d_in[8]; a.cmp_w2 = (const float*)d_in[9]; a.w_up_a = (const float*)d_in[10]; a.w_up_b = (const float*)d_in[11];
  a.w_out = (const float*)d_in[12];
  a.out = (float*)d_out; a.ws = (unsigned char*)d_ws;
  if (WS_NEED > ws_size) { fprintf(stderr, "workspace too small: need %zu have %zu\n", (size_t)WS_NEED, ws_size); return; }
  void* args[] = {&a};
  hipError_t e = hipLaunchCooperativeKernel((void*)hybrid_megakernel, dim3(grid_blocks), dim3(256), args, 0, stream);
  if (e != hipSuccess) fprintf(stderr, "cooperative launch failed: %s (grid %d)\n", hipGetErrorString(e), grid_blocks);
}
```

```cpp
#include <hip/hip_runtime.h>
#include <hip/hip_cooperative_groups.h>
#include <cstdio>
#include <cstdint>
namespace cg = cooperative_groups;

typedef unsigned short bf16_t;
typedef short bf16x8 __attribute__((ext_vector_type(8)));
typedef float f32x4 __attribute__((ext_vector_type(4)));
typedef float f32x2 __attribute__((ext_vector_type(2)));
typedef unsigned u32x4 __attribute__((ext_vector_type(4)));
typedef unsigned u32x2 __attribute__((ext_vector_type(2)));
typedef __bf16 bf16x2_t __attribute__((ext_vector_type(2)));

#define DI __device__ __forceinline__
#define MFMA16(a, b, c) __builtin_amdgcn_mfma_f32_16x16x32_bf16((a), (b), (c), 0, 0, 0)

constexpr int D_MODEL = 1024, BATCH = 16, SEQ = 2048, DEPTH = 4, NTOK = BATCH * SEQ;
constexpr int N_IN = 5912, NP = 6144, NT_IN = 24;
constexpr int NTHR = 512;
constexpr int NCMP = 127;
constexpr float NORM_EPS = 1e-6f;

DI unsigned pk2(float lo, float hi) { f32x2 v = {lo, hi}; bf16x2_t b = __builtin_convertvector(v, bf16x2_t); return __builtin_bit_cast(unsigned, b); }
DI float bflo(unsigned u) { return __uint_as_float(u << 16); }
DI float bfhi(unsigned u) { return __uint_as_float(u & 0xffff0000u); }
DI float sigmoidf_(float x) { return 1.f / (1.f + __expf(-x)); }
DI float siluf_(float x) { return x / (1.f + __expf(-x)); }
DI bf16x8 mk8(u32x4 v) { return __builtin_bit_cast(bf16x8, v); }
DI bf16x8 ld8(const bf16_t* p) { return __builtin_bit_cast(bf16x8, *(const u32x4*)p); }


DI void sincos_acc(float angf, float& sn, float& cs) {
  const double a = (double)angf;
  const double k = rint(a * 0.63661977236758134308);
  const double y = (a - k * 1.57079632679489655800) - k * 6.12323399573676603587e-17;
  const double y2 = y * y;
  const double sp = y * (1.0 + y2 * (-1.0 / 6 + y2 * (1.0 / 120 + y2 * (-1.0 / 5040 + y2 * (1.0 / 362880 + y2 * (-1.0 / 39916800 + y2 * (1.0 / 6227020800.0)))))));
  const double cp = 1.0 + y2 * (-0.5 + y2 * (1.0 / 24 + y2 * (-1.0 / 720 + y2 * (1.0 / 40320 + y2 * (-1.0 / 3628800 + y2 * (1.0 / 479001600.0))))));
  const int q = ((int)k) & 3;
  const double s_ = (q & 1) ? cp : sp, c_ = (q & 1) ? sp : cp;
  sn = (float)((q & 2) ? -s_ : s_);
  cs = (float)(((q + 1) & 2) ? -c_ : c_);
}
DI float inv_freq(int f) { return (float)exp(-(double)f * (9.21034037197618273607 / 32.0)); }

constexpr size_t al256(size_t x) { return (x + 255) & ~(size_t)255; }
constexpr size_t OFF_WT_IN = 0;
constexpr size_t OFF_W1T = OFF_WT_IN + al256((size_t)NP * 1024 * 2);
constexpr size_t OFF_W2T = OFF_W1T + al256((size_t)2 * 256 * 2048 * 2);
constexpr size_t OFF_WUPA = OFF_W2T + al256((size_t)2 * 64 * 256 * 2);
constexpr size_t OFF_WUPB = OFF_WUPA + al256((size_t)1024 * 512 * 2);
constexpr size_t OFF_WOUT = OFF_WUPB + al256((size_t)1024 * 512 * 2);
constexpr size_t OFF_B1EFF = OFF_WOUT + al256((size_t)1024 * 1024 * 2);
constexpr size_t OFF_COST = OFF_B1EFF + al256((size_t)DEPTH * 2 * 16 * 256 * 4);
constexpr size_t OFF_SINT = OFF_COST + al256((size_t)NTOK * 32 * 4);
constexpr size_t OFF_COSC = OFF_SINT + al256((size_t)NTOK * 32 * 4);
constexpr size_t OFF_SINC = OFF_COSC + al256((size_t)BATCH * 128 * 32 * 4);
constexpr size_t OFF_XB = OFF_SINC + al256((size_t)BATCH * 128 * 32 * 4);
constexpr size_t OFF_PART = OFF_XB + al256((size_t)NTOK * 1024 * 2);
constexpr size_t OFF_SBQ = OFF_PART + al256((size_t)NTOK * 16 * 4);
constexpr size_t OFF_SBK = OFF_SBQ + al256((size_t)NTOK * 512 * 2);
constexpr size_t OFF_SBVT = OFF_SBK + al256((size_t)NTOK * 512 * 2);
constexpr size_t OFF_SBZ = OFF_SBVT + al256((size_t)NTOK * 512 * 2);
constexpr size_t OFF_NQ = OFF_SBZ + al256((size_t)NTOK * 512 * 2);
constexpr size_t OFF_KCR = OFF_NQ + al256((size_t)NTOK * 512 * 2);
constexpr size_t OFF_VCR = OFF_KCR + al256((size_t)NTOK * 128 * 2);
constexpr size_t OFF_KS = OFF_VCR + al256((size_t)NTOK * 128 * 2);
constexpr size_t OFF_VST = OFF_KS + al256((size_t)NTOK * 128 * 2);
constexpr size_t OFF_KW = OFF_VST + al256((size_t)NTOK * 128 * 2);
constexpr size_t OFF_VWT = OFF_KW + al256((size_t)NTOK * 128 * 2);
constexpr size_t OFF_NGATE = OFF_VWT + al256((size_t)NTOK * 128 * 2);
constexpr size_t OFF_NZ = OFF_NGATE + al256((size_t)NTOK * 32 * 4);
constexpr size_t OFF_GA = OFF_NZ + al256((size_t)NTOK * 512 * 2);
constexpr size_t OFF_GB = OFF_GA + al256((size_t)NTOK * 1024 * 2);
constexpr size_t OFF_HID = OFF_GB + al256((size_t)NTOK * 1024 * 2);
constexpr size_t OFF_KC = OFF_HID + al256((size_t)64 * 128 * 256 * 2);
constexpr size_t OFF_VCT = OFF_KC + al256((size_t)BATCH * 2 * 128 * 64 * 2);
constexpr size_t OFF_QNG = OFF_VCT + al256((size_t)BATCH * 2 * 64 * 128 * 2);
constexpr size_t OFF_KNG = OFF_QNG + al256((size_t)DEPTH * 64 * 4);
constexpr size_t OFF_MFIX = OFF_KNG + al256((size_t)DEPTH * 3 * 64 * 4);
constexpr size_t OFF_DUMMY = OFF_MFIX + 256;
#if defined(PROBE_B) || defined(PROBE_C) || defined(PROBE_A)
constexpr size_t WS_NEED = OFF_DUMMY + al256((size_t)NTOK * 512 * 2);
#else
constexpr size_t WS_NEED = OFF_DUMMY;
#endif

struct Params {
  const float* x_in; const int* pos; const float* norm_g; const float* w_in; const float* q_norm_g; const float* k_norm_g;
  const float* cmp_pe; const float* cmp_w1; const float* cmp_b1; const float* cmp_w2; const float* w_up_a; const float* w_up_b; const float* w_out;
  float* out; unsigned char* ws;
#define WSBUF(T, name, OFF) DI T* name() const { return (T*)(ws + (OFF)); }
  WSBUF(bf16_t, wt_in, OFF_WT_IN) WSBUF(bf16_t, w1t, OFF_W1T) WSBUF(bf16_t, w2t, OFF_W2T) WSBUF(bf16_t, wupa_t, OFF_WUPA) WSBUF(bf16_t, wupb_t, OFF_WUPB) WSBUF(bf16_t, wout_t, OFF_WOUT)
  WSBUF(float, b1eff, OFF_B1EFF) WSBUF(float, cosT, OFF_COST) WSBUF(float, sinT, OFF_SINT) WSBUF(float, cosC, OFF_COSC) WSBUF(float, sinC, OFF_SINC)
  WSBUF(bf16_t, xb, OFF_XB) WSBUF(float, part, OFF_PART) WSBUF(bf16_t, sbq, OFF_SBQ) WSBUF(bf16_t, sbk, OFF_SBK) WSBUF(bf16_t, sbvt, OFF_SBVT) WSBUF(bf16_t, sbz, OFF_SBZ)
  WSBUF(bf16_t, nq, OFF_NQ) WSBUF(bf16_t, kcr, OFF_KCR) WSBUF(bf16_t, vcr, OFF_VCR) WSBUF(bf16_t, ks, OFF_KS) WSBUF(bf16_t, vst, OFF_VST) WSBUF(bf16_t, kw, OFF_KW) WSBUF(bf16_t, vwt, OFF_VWT)
  WSBUF(float, ngate, OFF_NGATE) WSBUF(bf16_t, nz, OFF_NZ) WSBUF(bf16_t, ga, OFF_GA) WSBUF(bf16_t, gb, OFF_GB) WSBUF(bf16_t, hid, OFF_HID) WSBUF(bf16_t, kc, OFF_KC) WSBUF(bf16_t, vct, OFF_VCT)
  WSBUF(bf16_t, merged, OFF_SBK)
  WSBUF(bf16_t, dummy, OFF_DUMMY) WSBUF(float, mfix, OFF_MFIX)
  WSBUF(float, qng, OFF_QNG) WSBUF(float, kng, OFF_KNG)
};

DI int my_tid() { int t = threadIdx.x; asm volatile("" : "+v"(t)); return t; }
DI Params relaunder(const Params& p0) { Params p = p0; asm volatile("" : "+s"(p.ws)); return p; }

constexpr int LSTR = 72;
constexpr int TILE_E = 256 * LSTR;
constexpr int STAGE_E = 2 * TILE_E;
constexpr int LDS_GEMM_BYTES = 2 * STAGE_E * 2;

struct GStage { u32x4 a[4], b[4]; };
DI void g_load(GStage& r, const bf16_t* __restrict__ Ag, const bf16_t* __restrict__ Bg, const unsigned (&ao)[4], const unsigned (&bo)[4], int ko) {
#pragma unroll
  for (int u = 0; u < 4; ++u) { r.a[u] = *(const u32x4*)(Ag + (ao[u] + ko)); r.b[u] = *(const u32x4*)(Bg + (bo[u] + ko)); }
}
DI void g_store(const GStage& r, bf16_t* buf, int so) {
#pragma unroll
  for (int u = 0; u < 4; ++u) { *(u32x4*)(buf + so + u * 64 * LSTR) = r.a[u]; *(u32x4*)(buf + TILE_E + so + u * 64 * LSTR) = r.b[u]; }
}
DI void g_compute(const bf16_t* buf, int ra, int rb, f32x4 (&acc)[8][4]) {
#pragma unroll
  for (int ks = 0; ks < 2; ++ks) {
    bf16x8 bfr[4];
#pragma unroll
    for (int j = 0; j < 4; ++j) bfr[j] = ld8(buf + TILE_E + rb + j * 16 * LSTR + ks * 32);
#pragma unroll
    for (int ih = 0; ih < 2; ++ih) {
      bf16x8 af[4];
#pragma unroll
      for (int i = 0; i < 4; ++i) af[i] = ld8(buf + ra + (ih * 4 + i) * 16 * LSTR + ks * 32);
#pragma unroll
      for (int i = 0; i < 4; ++i)
#pragma unroll
        for (int j = 0; j < 4; ++j) acc[ih * 4 + i][j] = MFMA16(af[i], bfr[j], acc[ih * 4 + i][j]);
    }
    __builtin_amdgcn_sched_barrier(0);
  }
}

DI void gemm_core(const bf16_t* __restrict__ Ag, long lda, const bf16_t* __restrict__ Bg, long ldb, int K,
                  bf16_t* lds, f32x4 (&acc)[8][4], int kstep = 64) {
  const int tid = my_tid(), lane = tid & 63, w = tid >> 6, wa = w >> 2, wb = w & 3, qi = lane & 15, quad = lane >> 4;
  const int r0 = tid >> 3, kc = tid & 7;
  unsigned ap[4], bp[4];
#pragma unroll
  for (int u = 0; u < 4; ++u) { ap[u] = (unsigned)((r0 + 64 * u) * (int)lda + kc * 8); bp[u] = (unsigned)((r0 + 64 * u) * (int)ldb + kc * 8); }
  const int so = r0 * LSTR + kc * 8;
  const int ra = (wa * 128 + qi) * LSTR + quad * 8, rb = (wb * 64 + qi) * LSTR + quad * 8;
  bf16_t* buf0 = lds; bf16_t* buf1 = lds + STAGE_E;
  const int KT = K >> 6;
  GStage R;
  g_load(R, Ag, Bg, ap, bp, 0);
  g_store(R, buf0, so);
  __syncthreads();
  for (int kt = 0; kt < KT; kt += 2) {
    g_load(R, Ag, Bg, ap, bp, (kt + 1) * kstep);
    g_compute(buf0, ra, rb, acc);
    g_store(R, buf1, so);
    __syncthreads();
    g_load(R, Ag, Bg, ap, bp, min(kt + 2, KT - 1) * kstep);
    g_compute(buf1, ra, rb, acc);
    g_store(R, buf0, so);
    __syncthreads();
  }
}

DI void zero_acc(f32x4 (&acc)[8][4]) {
#pragma unroll
  for (int i = 0; i < 8; ++i)
#pragma unroll
    for (int j = 0; j < 4; ++j) acc[i][j] = (f32x4){0.f, 0.f, 0.f, 0.f};
}

DI bool tile_order(int it, int nN, int& mt, int& nt) {
  const int xcd = blockIdx.x & 7, slot = blockIdx.x >> 3, SL = gridDim.x >> 3;
  const int q = slot + it * SL, per = 8 * nN;
  if (q >= 2 * per) return false;
  const int mg = q / per, e = q - mg * per;
  nt = e >> 3; mt = xcd * 16 + mg * 8 + (e & 7);
  return true;
}

DI int inmap(int c) {
  if (c < 1024) return c;
  if (c < 1536) return c + 512;
  if (c < 2048) return c + 512;
  if (c < 2304) return c + 512;
  if (c < 2432) return c + 512;
  if (c < 2560) return c + 640;
  if (c < 3072) return c + 792;
  if (c < 4096) return c + 792;
  if (c < 5120) return c + 792;
  if (c < 5376) return c < 5144 ? c - 1792 : -1;
  if (c < 5888) return c - 4352;
  if (c < 6016) return c - 2944;
  return c - 2816;
}

DI void tr_tile(const float* __restrict__ src, int ld, int K, int k0, int n0, bool use_map, const float* __restrict__ scale, bf16_t* __restrict__ dst, float* tile) {
  const int tid = my_tid();
  {
    const int nl = tid & 63, kk = tid >> 6;
    const int n = n0 + nl; const int sc = use_map ? inmap(n) : n;
#pragma unroll
    for (int r = 0; r < 8; ++r) {
      const int k = k0 + r * 8 + kk;
      float v = 0.f;
      if (sc >= 0) { v = src[(long)k * ld + sc]; if (scale) v *= scale[k]; }
      tile[(r * 8 + kk) * 65 + nl] = v;
    }
  }
  __syncthreads();
  {
    const int nl = tid >> 3, ks = tid & 7;
    unsigned o[4];
#pragma unroll
    for (int e = 0; e < 4; ++e) o[e] = pk2(tile[(ks * 8 + 2 * e) * 65 + nl], tile[(ks * 8 + 2 * e + 1) * 65 + nl]);
    *(u32x4*)(dst + (long)(n0 + nl) * K + k0 + ks * 8) = (u32x4){o[0], o[1], o[2], o[3]};
  }
  __syncthreads();
}

DI void tr_job(const float* src, int ld, int K, int N, bool use_map, const float* scale, bf16_t* dst, float* tile) {
  const int nk = K >> 6, nn = N >> 6;
  for (int t = blockIdx.x; t < nk * nn; t += gridDim.x) tr_tile(src, ld, K, (t % nk) * 64, (t / nk) * 64, use_map, scale, dst, tile);
}

DI void convert_weights(const Params& p0, int l, unsigned char* lds) {
  const Params p = relaunder(p0);
  float* tile = (float*)lds;
  tr_job(p.w_in + (long)l * D_MODEL * N_IN, N_IN, D_MODEL, NP, true, p.norm_g + l * D_MODEL, p.wt_in(), tile);
  for (int kv = 0; kv < 2; ++kv) {
    tr_job(p.cmp_w1 + (long)(l * 2 + kv) * 2048 * 256, 256, 2048, 256, false, nullptr, p.w1t() + (long)kv * 256 * 2048, tile);
    tr_job(p.cmp_w2 + (long)(l * 2 + kv) * 256 * 64, 64, 256, 64, false, nullptr, p.w2t() + (long)kv * 64 * 256, tile);
  }
  tr_job(p.w_up_a + (long)l * 512 * 1024, 1024, 512, 1024, false, nullptr, p.wupa_t(), tile);
  tr_job(p.w_up_b + (long)l * 512 * 1024, 1024, 512, 1024, false, nullptr, p.wupb_t(), tile);
  tr_job(p.w_out + (long)l * 1024 * 1024, 1024, 1024, 1024, false, nullptr, p.wout_t(), tile);
}

DI void phase_prologue(const Params& p, unsigned char* lds) {
  const int tid = my_tid();
  convert_weights(p, 0, lds);
  {
    const int lane = tid & 63;
    for (int wi = blockIdx.x * 8 + (tid >> 6); wi < DEPTH * 2 * 16 * 4; wi += gridDim.x * 8) {
      const int jq = wi & 3, kq = (wi >> 2) & 15, it = wi >> 6;
      const float* w1 = p.cmp_w1 + (long)it * 2048 * 256 + (long)kq * 128 * 256 + jq * 64 + lane; const float* pe = p.cmp_pe + (long)it * 2048 + kq * 128;
      float s0 = kq == 0 ? p.cmp_b1[it * 256 + jq * 64 + lane] : 0.f, s1 = 0.f, s2 = 0.f, s3 = 0.f;
#pragma unroll 4
      for (int k = 0; k < 128; k += 4) {
        s0 += pe[k] * w1[(long)k * 256]; s1 += pe[k + 1] * w1[(long)(k + 1) * 256]; s2 += pe[k + 2] * w1[(long)(k + 2) * 256]; s3 += pe[k + 3] * w1[(long)(k + 3) * 256];
      }
      p.b1eff()[(it * 16 + kq) * 256 + jq * 64 + lane] = (s0 + s1) + (s2 + s3);
    }
  }
  if (blockIdx.x == 1 && tid < DEPTH * 3) {
    const int l = tid / 3, br = tid % 3;
    float mq = 0.f, mk = 0.f;
    for (int d = 0; d < 64; ++d) { mq = fmaxf(mq, fabsf(p.q_norm_g[l * 64 + d])); mk = fmaxf(mk, fabsf(p.k_norm_g[(l * 3 + br) * 64 + d])); }
    p.mfix()[l * 4 + br] = 8.f * 1.44269504089f * mq * mk * 1.02f + 0.25f;
  }
  if (blockIdx.x == 0) { for (int i = tid; i < DEPTH * 64; i += NTHR) p.qng()[i] = p.q_norm_g[i]; for (int i = tid; i < DEPTH * 192; i += NTHR) p.kng()[i] = p.k_norm_g[i]; }
  const long gtid = (long)blockIdx.x * NTHR + tid, gn = (long)gridDim.x * NTHR;
  for (long i = gtid; i < (long)NTOK * 32; i += gn) {
    const int f = (int)(i & 31); const long tok = i >> 5;
    const float ang = (float)p.pos[tok] * inv_freq(f);
    float sn, cs; sincos_acc(ang, sn, cs);
    p.cosT()[i] = cs; p.sinT()[i] = sn;
  }
  for (long i = gtid; i < (long)BATCH * 128 * 32; i += gn) {
    const int f = (int)(i & 31); const int c = (int)((i >> 5) & 127); const int b = (int)(i >> 12);
    float cs = 1.f, sn = 0.f;
    if (c < NCMP) {
      float sum = 0.f;
      for (int k = 0; k < 32; ++k) sum += (float)p.pos[b * SEQ + c * 16 + k];
      const float ang = (sum * (1.f / 32.f)) * inv_freq(f);
      sincos_acc(ang, sn, cs);
    }
    p.cosC()[i] = cs; p.sinC()[i] = sn;
  }
  const int lane = tid & 63;
  for (long row = (long)blockIdx.x * 8 + (tid >> 6); row < NTOK; row += (long)gridDim.x * 8) {
    const float* xr = p.x_in + row * D_MODEL; bf16_t* xo = p.xb() + row * D_MODEL;
    float ss = 0.f;
#pragma unroll
    for (int u = 0; u < 4; ++u) {
      const f32x4 v = *(const f32x4*)(xr + u * 256 + lane * 4);
      ss += v[0] * v[0] + v[1] * v[1] + v[2] * v[2] + v[3] * v[3];
      *(u32x2*)(xo + u * 256 + lane * 4) = (u32x2){pk2(v[0], v[1]), pk2(v[2], v[3])};
    }
#pragma unroll
    for (int o = 32; o >= 1; o >>= 1) ss += __shfl_xor(ss, o);
    if (lane < 8) p.part()[row * 16 + lane] = lane == 0 ? ss : 0.f;
  }
}

DI void phaseA_epilogue(const Params& p, int layer, int mt, int nt, const f32x4 (&acc)[8][4], const float* rs_s) {
  const int tid = my_tid(), lane = tid & 63, w = tid >> 6, wa = w >> 2, wb = w & 3, qi = lane & 15, quad = lane >> 4;
  if (nt >= 21) {
    bf16_t* dstb; int nh, head;
    if (nt < 23) { dstb = p.sbvt(); nh = 8; head = (nt - 21) * 4 + wb; } else if (wb < 2) { dstb = p.vst(); nh = 2; head = wb; } else { dstb = p.vwt(); nh = 2; head = wb - 2; }
    const int tok0 = mt * 256, b = tok0 >> 11, s0 = (tok0 & 2047) + wa * 128 + quad * 4;
#pragma unroll
    for (int i = 0; i < 8; ++i) {
      const int tl = wa * 128 + i * 16 + quad * 4;
      const float r0 = rs_s[tl], r1 = rs_s[tl + 1], r2 = rs_s[tl + 2], r3 = rs_s[tl + 3];
#pragma unroll
      for (int j = 0; j < 4; ++j) {
        const int d = j * 16 + qi;
        const f32x4 v = acc[i][j];
        bf16_t* dst = dstb + ((long)(b * nh + head) * 64 + d) * SEQ + s0 + i * 16;
        *(u32x2*)dst = (u32x2){pk2(v[0] * r0, v[1] * r1), pk2(v[2] * r2, v[3] * r3)};
      }
    }
    return;
  }
  const bool headtype = nt < 4 || (nt >= 6 && nt < 10);
#pragma unroll
  for (int j = 0; j < 4; ++j) {
    const int tl = wb * 64 + j * 16 + qi; const long tok = (long)mt * 256 + tl; const int b = (int)(tok >> 11), sq = (int)(tok & 2047);
    const float rs = rs_s[tl];
    if (headtype) {
#pragma unroll
      for (int ih = 0; ih < 2; ++ih) {
        const int hit = wa * 2 + ih;
        f32x4 v[4];
#pragma unroll
        for (int i = 0; i < 4; ++i) v[i] = acc[ih * 4 + i][j] * rs;
        bf16_t* dstb; int nh, head; const float* g = nullptr;
        if (nt < 2) { dstb = p.sbq(); nh = 8; head = nt * 4 + hit; }
        else if (nt < 4) { dstb = p.sbk(); nh = 8; head = (nt - 2) * 4 + hit; }
        else if (nt < 8) { dstb = p.nq(); nh = 8; head = (nt - 6) * 4 + hit; g = p.qng() + layer * 64; }
        else if (nt == 8) { dstb = hit < 2 ? p.kcr() : p.vcr(); nh = 2; head = hit & 1; }
        else { dstb = hit < 2 ? p.ks() : p.kw(); nh = 2; head = hit & 1; g = p.kng() + (layer * 3 + (hit < 2 ? 1 : 2)) * 64; }
        if (g) {
          float ss = 0.f;
#pragma unroll
          for (int i = 0; i < 4; ++i) ss += v[i][0] * v[i][0] + v[i][1] * v[i][1] + v[i][2] * v[i][2] + v[i][3] * v[i][3];
          ss += __shfl_xor(ss, 16); ss += __shfl_xor(ss, 32);
          const float rn = rsqrtf(ss * (1.f / 64.f) + NORM_EPS);
#pragma unroll
          for (int i = 0; i < 4; ++i) { const f32x4 gg = *(const f32x4*)(g + i * 16 + quad * 4); v[i] = v[i] * rn * gg; }
#pragma unroll
          for (int i = 0; i < 2; ++i) {
            const f32x4 cs = *(const f32x4*)(p.cosT() + tok * 32 + i * 16 + quad * 4), sn = *(const f32x4*)(p.sinT() + tok * 32 + i * 16 + quad * 4);
            const f32x4 x1 = v[i], x2 = v[i + 2];
            v[i] = x1 * cs - x2 * sn; v[i + 2] = x2 * cs + x1 * sn;
          }
        }
        bf16_t* dst = dstb + ((long)(b * nh + head) * SEQ + sq) * 64 + quad * 4;
#pragma unroll
        for (int i = 0; i < 4; ++i) *(u32x2*)(dst + i * 16) = (u32x2){pk2(v[i][0], v[i][1]), pk2(v[i][2], v[i][3])};
        asm volatile("" ::: "memory");
      }
    } else if (nt == 20) {
      if (wa == 0) {
#pragma unroll
        for (int i = 0; i < 2; ++i) {
          const int f = i * 16 + quad * 4;
          const f32x4 v = acc[i][j] * rs;
          if (f < 24) { const f32x4 o = {sigmoidf_(v[0]), sigmoidf_(v[1]), sigmoidf_(v[2]), sigmoidf_(v[3])}; *(f32x4*)(p.ngate() + tok * 32 + f) = o; }
        }
      }
    } else {
      bf16_t* dstb; int ldd, c0; bool sil;
      if (nt < 6) { dstb = p.sbz(); ldd = 512; c0 = (nt - 4) * 256; sil = true; }
      else if (nt < 12) { dstb = p.nz(); ldd = 512; c0 = (nt - 10) * 256; sil = true; }
      else if (nt < 16) { dstb = p.ga(); ldd = 1024; c0 = (nt - 12) * 256; sil = false; }
      else { dstb = p.gb(); ldd = 1024; c0 = (nt - 16) * 256; sil = false; }
      bf16_t* dst = dstb + tok * ldd + c0 + wa * 128 + quad * 4;
#pragma unroll
      for (int i = 0; i < 8; ++i) {
        const f32x4 v = acc[i][j] * rs;
        f32x4 o;
#pragma unroll
        for (int r = 0; r < 4; ++r) o[r] = sil ? siluf_(v[r]) : sigmoidf_(v[r]);
        *(u32x2*)(dst + i * 16) = (u32x2){pk2(o[0], o[1]), pk2(o[2], o[3])};
      }
    }
    asm volatile("" ::: "memory");
  }
}

DI void phaseA(const Params& p0, int layer, unsigned char* lds, bool fake = false) {
  const Params p = relaunder(p0);
  bf16_t* gl = (bf16_t*)lds; float* rs_s = (float*)(lds + LDS_GEMM_BYTES);
  const bf16_t* Wt = p.wt_in();
  int mt, nt;
  for (int it = 0; tile_order(it, NT_IN, mt, nt); ++it) {
    if (my_tid() < 256) {
      const float* pp = p.part() + ((long)mt * 256 + my_tid()) * 16;
      const f32x4 v0 = *(const f32x4*)pp, v1 = *(const f32x4*)(pp + 4);
      const float s = ((v0[0] + v0[1]) + (v0[2] + v0[3])) + ((v1[0] + v1[1]) + (v1[2] + v1[3]));
      rs_s[my_tid()] = rsqrtf(s * (1.f / 1024.f) + NORM_EPS);
    }
    const bf16_t* Xg = p.xb() + (long)mt * 256 * D_MODEL; const bf16_t* Wg = Wt + (long)nt * 256 * D_MODEL;
    f32x4 acc[8][4]; zero_acc(acc);
    const int kstep = fake ? 0 : 64;
    gemm_core(nt >= 21 ? Xg : Wg, D_MODEL, nt >= 21 ? Wg : Xg, D_MODEL, D_MODEL, gl, acc, kstep);
    if (!fake) phaseA_epilogue(p, layer, mt, nt, acc, rs_s);
    else if (acc[0][0][0] == 123.456f && acc[7][3][3] == 5.f) p.dummy()[0] = 1;
    __syncthreads();
  }
}

DI void compress_item(const Params& p, int layer, int item, unsigned char* lds) {
  bf16_t* gl = (bf16_t*)lds;
  const int tid = my_tid(), lane = tid & 63, w = tid >> 6, wa = w >> 2, wb = w & 3, qi = lane & 15, quad = lane >> 4;
  const int kv = item & 1, pair = item >> 1;
  const bf16_t* src = (kv ? p.vcr() : p.kcr()) + (long)pair * 256 * 1024;
  const bf16_t* W1 = p.w1t() + (long)kv * 256 * 2048;
  const float* b1 = p.b1eff() + (layer * 2 + kv) * 16 * 256;
  bf16_t* hid = p.hid() + (long)item * 256 * 256;
  {
    f32x4 acc[8][4]; zero_acc(acc);
    gemm_core(W1, 2048, src, 1024, 2048, gl, acc);
#pragma unroll
    for (int i = 0; i < 8; ++i) {
      const int f = wa * 128 + i * 16 + quad * 4;
      f32x4 bb = *(const f32x4*)(b1 + f);
#pragma unroll
      for (int kq = 1; kq < 16; ++kq) bb += *(const f32x4*)(b1 + kq * 256 + f);
#pragma unroll
      for (int j = 0; j < 4; ++j) {
        const int row = wb * 64 + j * 16 + qi;
        f32x4 v = acc[i][j] + bb;
        *(u32x2*)(hid + (long)row * 256 + f) = (u32x2){pk2(siluf_(v[0]), siluf_(v[1])), pk2(siluf_(v[2]), siluf_(v[3]))};
      }
    }
  }
  __threadfence_block();
  __syncthreads();
  const bf16_t* W2 = p.w2t() + (long)kv * 64 * 256;
  f32x4 o[4][2];
#pragma unroll
  for (int dt = 0; dt < 4; ++dt) { o[dt][0] = (f32x4){0.f, 0.f, 0.f, 0.f}; o[dt][1] = o[dt][0]; }
  for (int ksx = 0; ksx < 8; ++ksx) {
    bf16x8 wf[4], hf[2];
#pragma unroll
    for (int dt = 0; dt < 4; ++dt) wf[dt] = ld8(W2 + (long)(dt * 16 + qi) * 256 + ksx * 32 + quad * 8);
#pragma unroll
    for (int rt = 0; rt < 2; ++rt) hf[rt] = ld8(hid + (long)(w * 32 + rt * 16 + qi) * 256 + ksx * 32 + quad * 8);
#pragma unroll
    for (int dt = 0; dt < 4; ++dt)
#pragma unroll
      for (int rt = 0; rt < 2; ++rt) o[dt][rt] = kv ? MFMA16(hf[rt], wf[dt], o[dt][rt]) : MFMA16(wf[dt], hf[rt], o[dt][rt]);
  }
  const int bg = pair * 2 + (w >> 2);
  if (kv == 0) {
    const float* g = p.kng() + (layer * 3 + 0) * 64;
    const int b = bg >> 1;
#pragma unroll
    for (int rt = 0; rt < 2; ++rt) {
      const int c = (w & 3) * 32 + rt * 16 + qi;
      f32x4 v[4];
      float ss = 0.f;
#pragma unroll
      for (int dt = 0; dt < 4; ++dt) { v[dt] = o[dt][rt]; ss += v[dt][0] * v[dt][0] + v[dt][1] * v[dt][1] + v[dt][2] * v[dt][2] + v[dt][3] * v[dt][3]; }
      ss += __shfl_xor(ss, 16); ss += __shfl_xor(ss, 32);
      const float rn = rsqrtf(ss * (1.f / 64.f) + NORM_EPS);
#pragma unroll
      for (int dt = 0; dt < 4; ++dt) { const f32x4 gg = *(const f32x4*)(g + dt * 16 + quad * 4); v[dt] = v[dt] * rn * gg; }
#pragma unroll
      for (int dt = 0; dt < 2; ++dt) {
        const long ti = ((long)b * 128 + c) * 32 + dt * 16 + quad * 4;
        const f32x4 cs = *(const f32x4*)(p.cosC() + ti), sn = *(const f32x4*)(p.sinC() + ti);
        const f32x4 x1 = v[dt], x2 = v[dt + 2];
        v[dt] = x1 * cs - x2 * sn; v[dt + 2] = x2 * cs + x1 * sn;
      }
      bf16_t* dst = p.kc() + ((long)bg * 128 + c) * 64 + quad * 4;
#pragma unroll
      for (int dt = 0; dt < 4; ++dt) {
        u32x2 ov = (u32x2){pk2(v[dt][0], v[dt][1]), pk2(v[dt][2], v[dt][3])};
        if (c >= NCMP) ov = (u32x2){0u, 0u};
        *(u32x2*)(dst + dt * 16) = ov;
      }
    }
  } else {
#pragma unroll
    for (int dt = 0; dt < 4; ++dt)
#pragma unroll
      for (int rt = 0; rt < 2; ++rt) {
        const int c0 = (w & 3) * 32 + rt * 16 + quad * 4;
        f32x4 v = o[dt][rt];
        if (c0 + 3 >= NCMP) v[3] = 0.f;
        *(u32x2*)(p.vct() + ((long)bg * 64 + dt * 16 + qi) * 128 + c0) = (u32x2){pk2(v[0], v[1]), pk2(v[2], v[3])};
      }
  }
  __syncthreads();
}

DI void sb_attn_wave(const Params& p, int b, int h, int t0, bf16_t* ybase) {
  const int lane = my_tid() & 63, qi = lane & 15, quad = lane >> 4;
  const bf16_t* Q = p.sbq() + (long)(b * 8 + h) * SEQ * 64;
  const bf16_t* K = p.sbk() + (long)(b * 8 + h) * SEQ * 64;
  const bf16_t* Vt = p.sbvt() + (long)(b * 8 + h) * 64 * SEQ;
  const int t = t0 + qi;
  bf16x8 qf[2];
  qf[0] = ld8(Q + (long)t * 64 + quad * 8); qf[1] = ld8(Q + (long)t * 64 + 32 + quad * 8);
  f32x4 o[4];
#pragma unroll
  for (int dt = 0; dt < 4; ++dt) o[dt] = (f32x4){0.f, 0.f, 0.f, 0.f};
  float carry = 0.f;
  const int krow = 8 * (qi >> 2) + (qi & 3);
  const bf16_t* kp0 = K + (long)krow * 64 + quad * 8;
  const bf16_t* vp0 = Vt + (long)qi * SEQ + 8 * quad;
  int kb = t0 & ~31;
  bf16x8 kf[2][2], vf[4];
#pragma unroll
  for (int a = 0; a < 2; ++a) { kf[a][0] = ld8(kp0 + (long)(kb + 4 * a) * 64); kf[a][1] = ld8(kp0 + (long)(kb + 4 * a) * 64 + 32); }
#pragma unroll
  for (int dt = 0; dt < 4; ++dt) vf[dt] = ld8(vp0 + (long)dt * 16 * SEQ + kb);
  for (; kb >= 0; kb -= 32) {
    bf16x8 kn[2][2], vn[4];
    const int kbn = kb >= 32 ? kb - 32 : 0;
#pragma unroll
    for (int a = 0; a < 2; ++a) { kn[a][0] = ld8(kp0 + (long)(kbn + 4 * a) * 64); kn[a][1] = ld8(kp0 + (long)(kbn + 4 * a) * 64 + 32); }
#pragma unroll
    for (int dt = 0; dt < 4; ++dt) vn[dt] = ld8(vp0 + (long)dt * 16 * SEQ + kbn);
    f32x4 s[2];
#pragma unroll
    for (int a = 0; a < 2; ++a) {
      s[a] = MFMA16(kf[a][0], qf[0], ((f32x4){0.f, 0.f, 0.f, 0.f}));
      s[a] = MFMA16(kf[a][1], qf[1], s[a]);
    }
    float L[8], ls[8]; bool val[8];
    float tot = 0.f;
#pragma unroll
    for (int idx = 0; idx < 8; ++idx) {
      const float z = s[idx >> 2][idx & 3] * 0.125f;
      const int key = kb + 8 * quad + idx;
      val[idx] = key < t;
      const float sp = fmaxf(z, 0.f) + __logf(1.f + __expf(-fabsf(z)));
      L[idx] = val[idx] ? -sp : 0.f;
      ls[idx] = z - sp;
      tot += L[idx];
    }
    const float a1 = __shfl_xor(tot, 16), a2 = __shfl_xor(tot, 32), a3 = __shfl_xor(a1, 32);
    const float higher = ((quad ^ 1) > quad ? a1 : 0.f) + ((quad ^ 2) > quad ? a2 : 0.f) + ((quad ^ 3) > quad ? a3 : 0.f);
    float run = carry + higher;
    float wv[8];
#pragma unroll
    for (int idx = 7; idx >= 0; --idx) {
      wv[idx] = val[idx] ? __expf(ls[idx] + run) : 0.f;
      run += L[idx];
    }
    carry += (tot + a1) + (a2 + a3);
    const bf16x8 pf = mk8((u32x4){pk2(wv[0], wv[1]), pk2(wv[2], wv[3]), pk2(wv[4], wv[5]), pk2(wv[6], wv[7])});
#pragma unroll
    for (int dt = 0; dt < 4; ++dt) o[dt] = MFMA16(vf[dt], pf, o[dt]);
    if (__all(carry < -110.f)) break;
#pragma unroll
    for (int a = 0; a < 2; ++a) { kf[a][0] = kn[a][0]; kf[a][1] = kn[a][1]; }
#pragma unroll
    for (int dt = 0; dt < 4; ++dt) vf[dt] = vn[dt];
  }
  const long zo = ((long)b * SEQ + t) * 512 + h * 64 + quad * 4;
  const bf16_t* zp = p.sbz() + zo; bf16_t* yp = ybase + zo;
#pragma unroll
  for (int dt = 0; dt < 4; ++dt) {
    const u32x2 zz = *(const u32x2*)(zp + dt * 16);
    *(u32x2*)(yp + dt * 16) = (u32x2){pk2(o[dt][0] * bflo(zz[0]), o[dt][1] * bfhi(zz[0])), pk2(o[dt][2] * bflo(zz[1]), o[dt][3] * bfhi(zz[1]))};
  }
}

DI void phaseB(const Params& p0, int layer, unsigned char* lds, bool probe) {
  const int NITEM = 32 + BATCH * 8 * 16;
  for (int it = blockIdx.x; it < NITEM; it += gridDim.x) {
    const Params p = relaunder(p0);
    if (it < 32) { compress_item(p, layer, it, lds); continue; }
    const int i = it - 32, qt = 15 - (i >> 7), bh = i & 127;
    sb_attn_wave(p, bh >> 3, bh & 7, qt * 128 + (my_tid() >> 6) * 16, probe ? p.dummy() : p.sbz());
  }
}

struct KVFrag { bf16x8 k[2][2]; bf16x8 v[4]; };
DI void nsa_load(KVFrag& f, const bf16_t* __restrict__ kp0, const bf16_t* __restrict__ vp0, int kb) {
#pragma unroll
  for (int a = 0; a < 2; ++a) { f.k[a][0] = ld8(kp0 + (long)(kb + 4 * a) * 64); f.k[a][1] = ld8(kp0 + (long)(kb + 4 * a) * 64 + 32); }
#pragma unroll
  for (int dt = 0; dt < 4; ++dt) f.v[dt] = ld8(vp0 + (long)dt * 16 * SEQ + kb);
}
template <int MODE>
DI void nsa_chunk(const KVFrag& f, int kb, int t, bool selbit, const bf16x8 (&qf)[2][2], f32x4 (&O)[2][4], float (&m)[2], float (&l)[2], int quad, bool online) {
  const float SC = 0.125f * 1.44269504089f;
  bool val[8];
#pragma unroll
  for (int idx = 0; idx < 8; ++idx) {
    const int key = kb + 8 * quad + idx;
    val[idx] = MODE == 0 ? (selbit && key <= t) : (key <= t && key > t - 512);
  }
#pragma unroll
  for (int hh = 0; hh < 2; ++hh) {
    f32x4 s[2];
#pragma unroll
    for (int a = 0; a < 2; ++a) { s[a] = MFMA16(f.k[a][0], qf[hh][0], ((f32x4){0.f, 0.f, 0.f, 0.f})); s[a] = MFMA16(f.k[a][1], qf[hh][1], s[a]); }
    float mn = m[hh];
    if (online) {
      float cm = -1e30f;
#pragma unroll
      for (int idx = 0; idx < 8; ++idx) if (val[idx]) cm = fmaxf(cm, s[idx >> 2][idx & 3] * SC);
      cm = fmaxf(cm, __shfl_xor(cm, 16)); cm = fmaxf(cm, __shfl_xor(cm, 32));
      mn = fmaxf(mn, cm);
      const float alpha = __builtin_amdgcn_exp2f(m[hh] - mn);
      m[hh] = mn; l[hh] *= alpha;
#pragma unroll
      for (int dt = 0; dt < 4; ++dt) O[hh][dt] = O[hh][dt] * alpha;
    }
    float pv[8]; float ps = 0.f;
#pragma unroll
    for (int idx = 0; idx < 8; ++idx) { pv[idx] = val[idx] ? __builtin_amdgcn_exp2f(fmaf(s[idx >> 2][idx & 3], SC, -mn)) : 0.f; ps += pv[idx]; }
    l[hh] += ps;
    const bf16x8 pf = mk8((u32x4){pk2(pv[0], pv[1]), pk2(pv[2], pv[3]), pk2(pv[4], pv[5]), pk2(pv[6], pv[7])});
#pragma unroll
    for (int dt = 0; dt < 4; ++dt) O[hh][dt] = MFMA16(f.v[dt], pf, O[hh][dt]);
  }
}

template <bool LAST>
DI void nsa_finish(f32x4* lo, f32x4 (&O)[2][4], float (&m)[2], float (&l)[2], const float (&gate)[2], const bf16_t* zp, bf16_t* yp, float minit) {
#pragma unroll
  for (int hh = 0; hh < 2; ++hh) {
    float lt = l[hh]; lt += __shfl_xor(lt, 16); lt += __shfl_xor(lt, 32);
    const float f = lt > 0.f ? gate[hh] / lt : 0.f;
#pragma unroll
    for (int dt = 0; dt < 4; ++dt) {
      const f32x4 v = lo[(hh * 4 + dt) * 64] + O[hh][dt] * f;
      if (LAST) {
        const u32x2 zz = *(const u32x2*)(zp + hh * 64 + dt * 16);
        *(u32x2*)(yp + hh * 64 + dt * 16) = (u32x2){pk2(v[0] * bflo(zz[0]), v[1] * bfhi(zz[0])), pk2(v[2] * bflo(zz[1]), v[3] * bfhi(zz[1]))};
      } else {
        lo[(hh * 4 + dt) * 64] = v;
        O[hh][dt] = (f32x4){0.f, 0.f, 0.f, 0.f};
      }
    }
    m[hh] = minit; l[hh] = 0.f;
  }
}

DI void nsa_wave(const Params& p, int layer, int b, int g, int t0, unsigned char* lds, bf16_t* ybase) {
  const int lane = my_tid() & 63, qi = lane & 15, quad = lane >> 4;
  const int t = t0 + qi, cur = t0 >> 6;
  const long tok = (long)b * SEQ + t;
  const int bg = b * 2 + g;
  f32x4* lo = (f32x4*)lds + (my_tid() >> 6) * 1024 + lane;

  const float mf_c = p.mfix()[layer * 4 + 0], mf_s = p.mfix()[layer * 4 + 1], mf_w = p.mfix()[layer * 4 + 2];
  const bool on_c = mf_c > 60.f, on_s = mf_s > 60.f, on_w = mf_w > 60.f;
  const float SC = 0.125f * 1.44269504089f;
  const bf16_t* Kc = p.kc() + (long)bg * 128 * 64;
  const bf16_t* Vc = p.vct() + (long)bg * 64 * 128;
  f32x4 ph[8];
#pragma unroll
  for (int kt = 0; kt < 8; ++kt) ph[kt] = (f32x4){0.f, 0.f, 0.f, 0.f};
#pragma unroll 1
  for (int hh = 0; hh < 4; ++hh) {
    const bf16_t* qp0 = p.nq() + ((long)(b * 8 + g * 4 + hh) * SEQ + t) * 64 + quad * 8;
    const bf16x8 q0 = ld8(qp0), q1 = ld8(qp0 + 32); const float gt = p.ngate()[tok * 32 + g * 4 + hh];
    f32x4 sc[8];
    float mx = on_c ? -1e30f : mf_c;
#pragma unroll
    for (int kt = 0; kt < 8; ++kt) {
      const bf16_t* kp = Kc + (long)(kt * 16 + qi) * 64 + quad * 8;
      sc[kt] = MFMA16(ld8(kp), q0, ((f32x4){0.f, 0.f, 0.f, 0.f}));
      sc[kt] = MFMA16(ld8(kp + 32), q1, sc[kt]);
      sc[kt] = sc[kt] * SC;
    }
    if (on_c) {
#pragma unroll
      for (int kt = 0; kt < 8; ++kt)
#pragma unroll
        for (int r = 0; r < 4; ++r) { const int c = kt * 16 + quad * 4 + r; if (c < NCMP && 16 * c + 31 <= t) mx = fmaxf(mx, sc[kt][r]); }
      mx = fmaxf(mx, __shfl_xor(mx, 16)); mx = fmaxf(mx, __shfl_xor(mx, 32));
    }
    float sum = 0.f;
#pragma unroll
    for (int kt = 0; kt < 8; ++kt)
#pragma unroll
      for (int r = 0; r < 4; ++r) {
        const int c = kt * 16 + quad * 4 + r;
        const float e = (c < NCMP && 16 * c + 31 <= t) ? __builtin_amdgcn_exp2f(sc[kt][r] - mx) : 0.f;
        sc[kt][r] = e; sum += e;
      }
    sum += __shfl_xor(sum, 16); sum += __shfl_xor(sum, 32);
    const float inv = sum > 0.f ? 1.f / sum : 0.f;
#pragma unroll
    for (int kt = 0; kt < 8; ++kt) { sc[kt] = sc[kt] * inv; ph[kt] += sc[kt]; }
    f32x4 oc[4];
#pragma unroll
    for (int dt = 0; dt < 4; ++dt) oc[dt] = (f32x4){0.f, 0.f, 0.f, 0.f};
#pragma unroll
    for (int mm = 0; mm < 4; ++mm) {
      const bf16x8 pf = mk8((u32x4){pk2(sc[2 * mm][0], sc[2 * mm][1]), pk2(sc[2 * mm][2], sc[2 * mm][3]), pk2(sc[2 * mm + 1][0], sc[2 * mm + 1][1]), pk2(sc[2 * mm + 1][2], sc[2 * mm + 1][3])});
#pragma unroll
      for (int dt = 0; dt < 4; ++dt) {
        const bf16_t* vp = Vc + (long)(dt * 16 + qi) * 128 + 32 * mm + quad * 4;
        const u32x2 lo = *(const u32x2*)vp, hi = *(const u32x2*)(vp + 16);
        oc[dt] = MFMA16(mk8((u32x4){lo[0], lo[1], hi[0], hi[1]}), pf, oc[dt]);
      }
    }
#pragma unroll
    for (int dt = 0; dt < 4; ++dt) lo[(hh * 4 + dt) * 64] = oc[dt] * gt;
  }
  float imp[8];
  {
    float rot[8];
#pragma unroll
    for (int kt = 0; kt < 8; ++kt) rot[kt] = __shfl(ph[kt][3], (lane + 48) & 63);
#pragma unroll
    for (int kt = 0; kt < 8; ++kt) {
      const float extra = quad > 0 ? rot[kt] : (kt > 0 ? rot[kt > 0 ? kt - 1 : 0] : 0.f);
      const float v = (ph[kt][0] + ph[kt][1]) + (ph[kt][2] + ph[kt][3]) + extra;
      const int j = 4 * kt + quad;
      const bool forced = j == 0 || j == cur || j == cur - 1;
      imp[kt] = j <= cur ? v + (forced ? 1e4f : 0.f) : -1e30f;
    }
  }
  unsigned selmask = 0;
  {
    int rank[8];
#pragma unroll
    for (int kt = 0; kt < 8; ++kt) rank[kt] = 0;
#pragma unroll 1
    for (int q2 = 0; q2 < 4; ++q2)
#pragma unroll
      for (int k2 = 0; k2 < 8; ++k2) {
        const float ov = __shfl(imp[k2], qi + 16 * q2);
#pragma unroll
        for (int kt = 0; kt < 8; ++kt) {
          const bool before = k2 < kt || (k2 == kt && q2 < quad);
          rank[kt] += (ov > imp[kt] || (ov == imp[kt] && before)) ? 1 : 0;
        }
      }
#pragma unroll
    for (int kt = 0; kt < 8; ++kt) if (rank[kt] < 8 && 4 * kt + quad <= cur) selmask |= 1u << (4 * kt + quad);
    selmask |= __shfl_xor(selmask, 16); selmask |= __shfl_xor(selmask, 32);
  }

  unsigned umall = selmask;
  umall |= __shfl_xor(umall, 1); umall |= __shfl_xor(umall, 2); umall |= __shfl_xor(umall, 4); umall |= __shfl_xor(umall, 8);
  umall = __builtin_amdgcn_readfirstlane(umall);
#pragma unroll 1
  for (int hp = 0; hp < 2; ++hp) {
  f32x4* lo2 = lo + hp * 8 * 64;
  bf16x8 qf[2][2];
#pragma unroll
  for (int hh = 0; hh < 2; ++hh) {
    const bf16_t* qp = p.nq() + ((long)(b * 8 + g * 4 + hp * 2 + hh) * SEQ + t) * 64 + quad * 8;
    qf[hh][0] = ld8(qp); qf[hh][1] = ld8(qp + 32);
  }
  float gate[3][2];
#pragma unroll
  for (int br = 1; br < 3; ++br) { const f32x2 gv = *(const f32x2*)(p.ngate() + tok * 32 + br * 8 + g * 4 + hp * 2); gate[br][0] = gv[0]; gate[br][1] = gv[1]; }
  f32x4 O[2][4]; float m[2], l[2];
#pragma unroll
  for (int hh = 0; hh < 2; ++hh) { m[hh] = on_s ? -1e30f : mf_s; l[hh] = 0.f;
#pragma unroll
    for (int dt = 0; dt < 4; ++dt) O[hh][dt] = (f32x4){0.f, 0.f, 0.f, 0.f}; }

  const int krow = 8 * (qi >> 2) + (qi & 3);
  {
    const bf16_t* kp0 = p.ks() + (long)bg * SEQ * 64 + (long)krow * 64 + quad * 8;
    const bf16_t* vp0 = p.vst() + (long)bg * 64 * SEQ + (long)qi * SEQ + 8 * quad;
    unsigned um = umall;
    int j = __builtin_ctz(um); um &= um - 1;
    KVFrag fa, fb;
    nsa_load(fa, kp0, vp0, j * 64);
#pragma unroll 1
    while (true) {
      nsa_load(fb, kp0, vp0, j * 64 + 32);
      const bool bit = (selmask >> j) & 1u;
      nsa_chunk<0>(fa, j * 64, t, bit, qf, O, m, l, quad, on_s);
      const bool more = um != 0;
      const int jn = more ? __builtin_ctz(um) : j; um &= um - 1;
      nsa_load(fa, kp0, vp0, jn * 64);
      nsa_chunk<0>(fb, j * 64 + 32, t, bit, qf, O, m, l, quad, on_s);
      if (!more) break;
      j = jn;
    }
    nsa_finish<false>(lo2, O, m, l, gate[1], nullptr, nullptr, on_w ? -1e30f : mf_w);
  }
  {
    const bf16_t* kp0 = p.kw() + (long)bg * SEQ * 64 + (long)krow * 64 + quad * 8;
    const bf16_t* vp0 = p.vwt() + (long)bg * 64 * SEQ + (long)qi * SEQ + 8 * quad;
    int j = cur >= 8 ? cur - 8 : 0;
    KVFrag fa, fb;
    nsa_load(fa, kp0, vp0, j * 64);
#pragma unroll 1
    while (true) {
      nsa_load(fb, kp0, vp0, j * 64 + 32);
      nsa_chunk<1>(fa, j * 64, t, true, qf, O, m, l, quad, on_w);
      nsa_load(fa, kp0, vp0, (j < cur ? j + 1 : j) * 64);
      nsa_chunk<1>(fb, j * 64 + 32, t, true, qf, O, m, l, quad, on_w);
      if (j >= cur) break;
      ++j;
    }
    nsa_finish<true>(lo2, O, m, l, gate[2], p.nz() + tok * 512 + g * 256 + hp * 128 + quad * 4, ybase + tok * 512 + g * 256 + hp * 128 + quad * 4, 0.f);
  }
  }
}

DI void phaseC(const Params& p0, int layer, unsigned char* lds, bool probe) {
  const int NITEM = BATCH * 2 * 16;
  for (int it = blockIdx.x; it < NITEM; it += gridDim.x) {
    const Params p = relaunder(p0);
    const int qt = 15 - (it >> 5), bg = it & 31;
    nsa_wave(p, layer, bg >> 1, bg & 1, qt * 128 + (my_tid() >> 6) * 16, lds, probe ? p.dummy() : p.nz());
  }
}

DI void phaseD(const Params& p0, int layer, unsigned char* lds) {
  const Params p = relaunder(p0);
  bf16_t* gl = (bf16_t*)lds;
  int mt, nt;
  for (int it = 0; tile_order(it, 4, mt, nt); ++it) {
#pragma unroll 1
    for (int which = 0; which < 2; ++which) {
      const bf16_t* Wg = (which ? p.wupb_t() : p.wupa_t()) + ((long)nt * 256) * 512;
      const bf16_t* Yg = (which ? p.nz() : p.sbz()) + (long)mt * 256 * 512;
      const bf16_t* Gg = which ? p.gb() : p.ga();
      f32x4 acc[8][4]; zero_acc(acc);
      gemm_core(Wg, 512, Yg, 512, 512, gl, acc);
      const int tid = my_tid(), lane = tid & 63, w = tid >> 6, wa = w >> 2, wb = w & 3, qi = lane & 15, quad = lane >> 4;
#pragma unroll
      for (int j = 0; j < 4; ++j) {
        const long tok = (long)mt * 256 + wb * 64 + j * 16 + qi;
#pragma unroll
        for (int i = 0; i < 8; ++i) {
          const long off = tok * 1024 + nt * 256 + wa * 128 + i * 16 + quad * 4;
          const u32x2 xg = *(const u32x2*)(Gg + off);
          const f32x4 v = acc[i][j];
          float o0 = bflo(xg[0]) * v[0], o1 = bfhi(xg[0]) * v[1], o2 = bflo(xg[1]) * v[2], o3 = bfhi(xg[1]) * v[3];
          if (which) { const u32x2 a = *(const u32x2*)(p.merged() + off); o0 += bflo(a[0]); o1 += bfhi(a[0]); o2 += bflo(a[1]); o3 += bfhi(a[1]); }
          *(u32x2*)(p.merged() + off) = (u32x2){pk2(o0, o1), pk2(o2, o3)};
          if ((i & 3) == 3) asm volatile("" ::: "memory");
        }
      }
    }
  }
}

DI void phaseE(const Params& p0, int layer, unsigned char* lds, const float* xsrc) {
  const Params p = relaunder(p0);
  bf16_t* gl = (bf16_t*)lds;
  int mt, nt;
  for (int it = 0; tile_order(it, 4, mt, nt); ++it) {
    f32x4 acc[8][4]; zero_acc(acc);
    gemm_core(p.wout_t() + ((long)nt * 256) * 1024, 1024, p.merged() + (long)mt * 256 * 1024, 1024, 1024, gl, acc);
    const int tid = my_tid(), lane = tid & 63, w = tid >> 6, wa = w >> 2, wb = w & 3, qi = lane & 15, quad = lane >> 4;
#pragma unroll
    for (int j = 0; j < 4; ++j) {
      const long tok = (long)mt * 256 + wb * 64 + j * 16 + qi;
      float ss = 0.f;
#pragma unroll
      for (int i = 0; i < 8; ++i) {
        const long off = tok * 1024 + nt * 256 + wa * 128 + i * 16 + quad * 4;
        const f32x4 xo = *(const f32x4*)(xsrc + off);
        const f32x4 xn = xo + acc[i][j];
        *(f32x4*)(p.out + off) = xn;
        *(u32x2*)(p.xb() + off) = (u32x2){pk2(xn[0], xn[1]), pk2(xn[2], xn[3])};
        ss += xn[0] * xn[0] + xn[1] * xn[1] + xn[2] * xn[2] + xn[3] * xn[3];
      }
      ss += __shfl_xor(ss, 16); ss += __shfl_xor(ss, 32);
      if (quad == 0) p.part()[tok * 16 + nt * 2 + wa] = ss;
    }
  }
}

#ifndef STOP_AFTER
#define STOP_AFTER 0
#endif
constexpr int LDS_BYTES = LDS_GEMM_BYTES + 1024;

__global__ void __launch_bounds__(512) hybrid_megakernel(Params p) {
  extern __shared__ __attribute__((aligned(16))) unsigned char lds[];
  cg::grid_group grid = cg::this_grid();
  phase_prologue(p, lds);
  grid.sync();
  for (int layer = 0; layer < DEPTH; ++layer) {
    if (layer > 0) { convert_weights(p, layer, lds); grid.sync(); }
    if (STOP_AFTER != 0 && STOP_AFTER == layer * 10) return;
    phaseA(p, layer, lds);
    grid.sync();
#ifdef PROBE_A
    phaseA(p, layer, lds, PROBE_A == 2);
    grid.sync();
#endif
    if (STOP_AFTER == layer * 10 + 1) return;
#ifdef PROBE_B
    phaseB(p, layer, lds, true);
    grid.sync();
#endif
    phaseB(p, layer, lds, false);
    grid.sync();
    if (STOP_AFTER == layer * 10 + 2) return;
#ifdef PROBE_C
    phaseC(p, layer, lds, true);
    grid.sync();
#endif
    phaseC(p, layer, lds, false);
    grid.sync();
    if (STOP_AFTER == layer * 10 + 3) return;
    phaseD(p, layer, lds);
    grid.sync();
#ifdef PROBE_D
    phaseD(p, layer, lds);
    grid.sync();
#endif
    if (STOP_AFTER == layer * 10 + 4) return;
    if (layer == 0) phaseE(p, layer, lds, p.x_in); else phaseE(p, layer, lds, p.out);
    if (layer + 1 < DEPTH) grid.sync();
    if (STOP_AFTER == layer * 10 + 5) return;
  }
}

extern "C" void kernel_launch(void* const* d_in, const int* in_sizes, int n_in, void* d_out, int out_size,
                              void* d_ws, size_t ws_size, hipStream_t stream) {
  static int grid_blocks = 0;
  if (!grid_blocks) {
    int dev = 0, cus = 0, per_cu = 0;
    (void)hipGetDevice(&dev);
    (void)hipDeviceGetAttribute(&cus, hipDeviceAttributeMultiprocessorCount, dev);
    if (hipFuncSetAttribute((const void*)hybrid_megakernel, hipFuncAttributeMaxDynamicSharedMemorySize, LDS_BYTES) != hipSuccess) fprintf(stderr, "hipFuncSetAttribute(max dynamic LDS) failed\n");
    (void)hipOccupancyMaxActiveBlocksPerMultiprocessor(&per_cu, hybrid_megakernel, NTHR, LDS_BYTES);
    (void)hipGetLastError();
    if (per_cu > 1) per_cu = 1;
    if (per_cu < 1) per_cu = 1;
    grid_blocks = (cus * per_cu) & ~7;
  }
  Params a{};
  a.x_in = (const float*)d_in[0]; a.pos = (const int*)d_in[1]; a.norm_g = (const float*)d_in[2]; a.w_in = (const float*)d_in[3];
  a.q_norm_g = (const float*)d_in[4]; a.k_norm_g = (const float*)d_in[5]; a.cmp_pe = (const float*)d_in[6]; a.cmp_w1 = (const float*)d_in[7];
  a.cmp_b1 = (const float*)d_in[8]; a.cmp_w2 = (const float*)d_in[9]; a.w_up_a = (const float*)d_in[10]; a.w_up_b = (const float*)d_in[11];
  a.w_out = (const float*)d_in[12];
  a.out = (float*)d_out; a.ws = (unsigned char*)d_ws;
  if (WS_NEED > ws_size) { fprintf(stderr, "workspace too small: need %zu have %zu\n", (size_t)WS_NEED, ws_size); return; }
  void* args[] = {&a};
  hipError_t e = hipLaunchCooperativeKernel((void*)hybrid_megakernel, dim3(grid_blocks), dim3(NTHR), args, LDS_BYTES, stream);
  if (e != hipSuccess) fprintf(stderr, "cooperative launch failed: %s (grid %d)\n", hipGetErrorString(e), grid_blocks);
}
```

```cpp
#include <hip/hip_runtime.h>
#include <hip/hip_cooperative_groups.h>
#include <cstdio>
#include <cstdint>
namespace cg = cooperative_groups;

typedef unsigned short bf16_t;
typedef short bf16x8 __attribute__((ext_vector_type(8)));
typedef float f32x4 __attribute__((ext_vector_type(4)));
typedef float f32x2 __attribute__((ext_vector_type(2)));
typedef unsigned u32x4 __attribute__((ext_vector_type(4)));
typedef unsigned u32x2 __attribute__((ext_vector_type(2)));
typedef __bf16 bf16x2_t __attribute__((ext_vector_type(2)));

#define DI __device__ __forceinline__
#define MFMA16(a, b, c) __builtin_amdgcn_mfma_f32_16x16x32_bf16((a), (b), (c), 0, 0, 0)

constexpr int D_MODEL = 1024, BATCH = 16, SEQ = 2048, DEPTH = 4, NTOK = BATCH * SEQ;
constexpr int N_IN = 5912, NP = 6144, NT_IN = 24;
constexpr int NTHR = 512;
constexpr int LDX = D_MODEL + 64;
constexpr int NCMP = 127;
constexpr float NORM_EPS = 1e-6f;

DI unsigned pk2(float lo, float hi) { f32x2 v = {lo, hi}; bf16x2_t b = __builtin_convertvector(v, bf16x2_t); return __builtin_bit_cast(unsigned, b); }
DI float bflo(unsigned u) { return __uint_as_float(u << 16); }
DI float bfhi(unsigned u) { return __uint_as_float(u & 0xffff0000u); }
DI float sigmoidf_(float x) { return 1.f / (1.f + __expf(-x)); }
DI float siluf_(float x) { return x / (1.f + __expf(-x)); }
DI bf16x8 mk8(u32x4 v) { return __builtin_bit_cast(bf16x8, v); }
DI bf16x8 ld8(const bf16_t* p) { return __builtin_bit_cast(bf16x8, *(const u32x4*)p); }


DI void sincos_acc(float angf, float& sn, float& cs) {
  const double a = (double)angf;
  const double k = rint(a * 0.63661977236758134308);
  const double y = (a - k * 1.57079632679489655800) - k * 6.12323399573676603587e-17;
  const double y2 = y * y;
  const double sp = y * (1.0 + y2 * (-1.0 / 6 + y2 * (1.0 / 120 + y2 * (-1.0 / 5040 + y2 * (1.0 / 362880 + y2 * (-1.0 / 39916800 + y2 * (1.0 / 6227020800.0)))))));
  const double cp = 1.0 + y2 * (-0.5 + y2 * (1.0 / 24 + y2 * (-1.0 / 720 + y2 * (1.0 / 40320 + y2 * (-1.0 / 3628800 + y2 * (1.0 / 479001600.0))))));
  const int q = ((int)k) & 3;
  const double s_ = (q & 1) ? cp : sp, c_ = (q & 1) ? sp : cp;
  sn = (float)((q & 2) ? -s_ : s_);
  cs = (float)(((q + 1) & 2) ? -c_ : c_);
}
DI float inv_freq(int f) { return (float)exp(-(double)f * (9.21034037197618273607 / 32.0)); }

constexpr size_t al256(size_t x) { return (x + 255) & ~(size_t)255; }
constexpr size_t OFF_WT_IN = 0;
constexpr size_t OFF_W1T = OFF_WT_IN + al256((size_t)NP * LDX * 2);
constexpr size_t OFF_W2T = OFF_W1T + al256((size_t)2 * 256 * 2048 * 2);
constexpr size_t OFF_WUPA = OFF_W2T + al256((size_t)2 * 64 * 256 * 2);
constexpr size_t OFF_WUPB = OFF_WUPA + al256((size_t)1024 * 512 * 2);
constexpr size_t OFF_WOUT = OFF_WUPB + al256((size_t)1024 * 512 * 2);
constexpr size_t OFF_B1EFF = OFF_WOUT + al256((size_t)1024 * 1024 * 2);
constexpr size_t OFF_COST = OFF_B1EFF + al256((size_t)DEPTH * 2 * 16 * 256 * 4);
constexpr size_t OFF_SINT = OFF_COST + al256((size_t)NTOK * 32 * 4);
constexpr size_t OFF_COSC = OFF_SINT + al256((size_t)NTOK * 32 * 4);
constexpr size_t OFF_SINC = OFF_COSC + al256((size_t)BATCH * 128 * 32 * 4);
constexpr size_t OFF_XB = OFF_SINC + al256((size_t)BATCH * 128 * 32 * 4);
constexpr size_t OFF_PART = OFF_XB + al256((size_t)NTOK * LDX * 2);
constexpr size_t OFF_SBQ = OFF_PART + al256((size_t)NTOK * 16 * 4);
constexpr size_t OFF_SBK = OFF_SBQ + al256((size_t)NTOK * 512 * 2);
constexpr size_t OFF_SBVT = OFF_SBK + al256((size_t)NTOK * 512 * 2);
constexpr size_t OFF_SBZ = OFF_SBVT + al256((size_t)NTOK * 512 * 2);
constexpr size_t OFF_NQ = OFF_SBZ + al256((size_t)NTOK * 512 * 2);
constexpr size_t OFF_KCR = OFF_NQ + al256((size_t)NTOK * 512 * 2);
constexpr size_t OFF_VCR = OFF_KCR + al256((size_t)NTOK * 128 * 2);
constexpr size_t OFF_KS = OFF_VCR + al256((size_t)NTOK * 128 * 2);
constexpr size_t OFF_VST = OFF_KS + al256((size_t)NTOK * 128 * 2);
constexpr size_t OFF_KW = OFF_VST + al256((size_t)NTOK * 128 * 2);
constexpr size_t OFF_VWT = OFF_KW + al256((size_t)NTOK * 128 * 2);
constexpr size_t OFF_NGATE = OFF_VWT + al256((size_t)NTOK * 128 * 2);
constexpr size_t OFF_NZ = OFF_NGATE + al256((size_t)NTOK * 32 * 4);
constexpr size_t OFF_GA = OFF_NZ + al256((size_t)NTOK * 512 * 2);
constexpr size_t OFF_GB = OFF_GA + al256((size_t)NTOK * 1024 * 2);
constexpr size_t OFF_HID = OFF_GB + al256((size_t)NTOK * 1024 * 2);
constexpr size_t OFF_KC = OFF_HID + al256((size_t)64 * 128 * 256 * 2);
constexpr size_t OFF_VCT = OFF_KC + al256((size_t)BATCH * 2 * 128 * 64 * 2);
constexpr size_t OFF_QNG = OFF_VCT + al256((size_t)BATCH * 2 * 64 * 128 * 2);
constexpr size_t OFF_KNG = OFF_QNG + al256((size_t)DEPTH * 64 * 4);
constexpr size_t OFF_CTL = OFF_KNG + al256((size_t)DEPTH * 3 * 64 * 4);
constexpr size_t OFF_MFIX_BASE = OFF_CTL + 256;
constexpr size_t OFF_MFIX_OLD = OFF_KNG + al256((size_t)DEPTH * 3 * 64 * 4);
constexpr size_t OFF_MFIX = OFF_MFIX_BASE;
constexpr size_t OFF_DUMMY = OFF_MFIX + 256;
#if defined(PROBE_B) || defined(PROBE_C) || defined(PROBE_A)
constexpr size_t WS_NEED = OFF_DUMMY + al256((size_t)NTOK * 512 * 2);
#else
constexpr size_t WS_NEED = OFF_DUMMY;
#endif

struct Params {
  const float* x_in; const int* pos; const float* norm_g; const float* w_in; const float* q_norm_g; const float* k_norm_g;
  const float* cmp_pe; const float* cmp_w1; const float* cmp_b1; const float* cmp_w2; const float* w_up_a; const float* w_up_b; const float* w_out;
  float* out; unsigned char* ws;
#define WSBUF(T, name, OFF) DI T* name() const { return (T*)(ws + (OFF)); }
  WSBUF(bf16_t, wt_in, OFF_WT_IN) WSBUF(bf16_t, w1t, OFF_W1T) WSBUF(bf16_t, w2t, OFF_W2T) WSBUF(bf16_t, wupa_t, OFF_WUPA) WSBUF(bf16_t, wupb_t, OFF_WUPB) WSBUF(bf16_t, wout_t, OFF_WOUT)
  WSBUF(float, b1eff, OFF_B1EFF) WSBUF(float, cosT, OFF_COST) WSBUF(float, sinT, OFF_SINT) WSBUF(float, cosC, OFF_COSC) WSBUF(float, sinC, OFF_SINC)
  WSBUF(bf16_t, xb, OFF_XB) WSBUF(float, part, OFF_PART) WSBUF(bf16_t, sbq, OFF_SBQ) WSBUF(bf16_t, sbk, OFF_SBK) WSBUF(bf16_t, sbvt, OFF_SBVT) WSBUF(bf16_t, sbz, OFF_SBZ)
  WSBUF(bf16_t, nq, OFF_NQ) WSBUF(bf16_t, kcr, OFF_KCR) WSBUF(bf16_t, vcr, OFF_VCR) WSBUF(bf16_t, ks, OFF_KS) WSBUF(bf16_t, vst, OFF_VST) WSBUF(bf16_t, kw, OFF_KW) WSBUF(bf16_t, vwt, OFF_VWT)
  WSBUF(float, ngate, OFF_NGATE) WSBUF(bf16_t, nz, OFF_NZ) WSBUF(bf16_t, ga, OFF_GA) WSBUF(bf16_t, gb, OFF_GB) WSBUF(bf16_t, hid, OFF_HID) WSBUF(bf16_t, kc, OFF_KC) WSBUF(bf16_t, vct, OFF_VCT)
  WSBUF(bf16_t, merged, OFF_SBK)
  WSBUF(bf16_t, dummy, OFF_DUMMY) WSBUF(float, mfix, OFF_MFIX) WSBUF(unsigned, ctl, OFF_CTL)
  WSBUF(float, qng, OFF_QNG) WSBUF(float, kng, OFF_KNG)
};

DI int my_tid() { int t = threadIdx.x; asm volatile("" : "+v"(t)); return t; }
DI Params relaunder(const Params& p0) { Params p = p0; size_t z = 0; asm volatile("" : "+s"(z)); p.ws = p0.ws + z; return p; }

constexpr int LSTR = 72;
constexpr int TILE_E = 256 * LSTR;
constexpr int STAGE_E = 2 * TILE_E;
constexpr int LDS_GEMM_BYTES = 2 * STAGE_E * 2;

struct GStage { u32x4 a[4], b[4]; };
DI void g_load(GStage& r, const bf16_t* __restrict__ Ag, const bf16_t* __restrict__ Bg, const unsigned (&ao)[4], const unsigned (&bo)[4], int ko) {
#pragma unroll
  for (int u = 0; u < 4; ++u) { r.a[u] = *(const u32x4*)(Ag + (ao[u] + ko)); r.b[u] = *(const u32x4*)(Bg + (bo[u] + ko)); }
}
DI void g_store(const GStage& r, bf16_t* buf, int so) {
#pragma unroll
  for (int u = 0; u < 4; ++u) { *(u32x4*)(buf + so + u * 64 * LSTR) = r.a[u]; *(u32x4*)(buf + TILE_E + so + u * 64 * LSTR) = r.b[u]; }
}
DI void g_compute(const bf16_t* buf, int ra, int rb, f32x4 (&acc)[8][4]) {
#pragma unroll
  for (int ks = 0; ks < 2; ++ks) {
    bf16x8 bfr[4];
#pragma unroll
    for (int j = 0; j < 4; ++j) bfr[j] = ld8(buf + TILE_E + rb + j * 16 * LSTR + ks * 32);
#pragma unroll
    for (int ih = 0; ih < 2; ++ih) {
      bf16x8 af[4];
#pragma unroll
      for (int i = 0; i < 4; ++i) af[i] = ld8(buf + ra + (ih * 4 + i) * 16 * LSTR + ks * 32);
#pragma unroll
      for (int i = 0; i < 4; ++i)
#pragma unroll
        for (int j = 0; j < 4; ++j) acc[ih * 4 + i][j] = MFMA16(af[i], bfr[j], acc[ih * 4 + i][j]);
    }
    __builtin_amdgcn_sched_barrier(0);
  }
}

DI void gemm_core(const bf16_t* __restrict__ Ag, long lda, const bf16_t* __restrict__ Bg, long ldb, int K,
                  bf16_t* lds, f32x4 (&acc)[8][4], int kstep = 64) {
  const int tid = my_tid(), lane = tid & 63, w = tid >> 6, wa = w >> 2, wb = w & 3, qi = lane & 15, quad = lane >> 4;
  const int r0 = tid >> 3, kc = tid & 7;
  unsigned ap[4], bp[4];
#pragma unroll
  for (int u = 0; u < 4; ++u) { ap[u] = (unsigned)((r0 + 64 * u) * (int)lda + kc * 8); bp[u] = (unsigned)((r0 + 64 * u) * (int)ldb + kc * 8); }
  const int so = r0 * LSTR + kc * 8;
  const int ra = (wa * 128 + qi) * LSTR + quad * 8, rb = (wb * 64 + qi) * LSTR + quad * 8;
  bf16_t* buf0 = lds; bf16_t* buf1 = lds + STAGE_E;
  const int KT = K >> 6;
  GStage R0, R1;
  g_load(R0, Ag, Bg, ap, bp, 0);
  g_load(R1, Ag, Bg, ap, bp, kstep);
  g_store(R0, buf0, so);
  __syncthreads();
  for (int kt = 0; kt < KT; kt += 2) {
    g_load(R0, Ag, Bg, ap, bp, min(kt + 2, KT - 2) * kstep);
    g_compute(buf0, ra, rb, acc);
    g_store(R1, buf1, so);
    __syncthreads();
    g_load(R1, Ag, Bg, ap, bp, min(kt + 3, KT - 1) * kstep);
    g_compute(buf1, ra, rb, acc);
    g_store(R0, buf0, so);
    __syncthreads();
  }
}

DI void zero_acc(f32x4 (&acc)[8][4]) {
#pragma unroll
  for (int i = 0; i < 8; ++i)
#pragma unroll
    for (int j = 0; j < 4; ++j) acc[i][j] = (f32x4){0.f, 0.f, 0.f, 0.f};
}

struct Slot { int xcd, slot; };
DI bool tile_order(const Slot sl, int it, int nN, int& mt, int& nt) {
  const int xcd = sl.xcd, slot = sl.slot, SL = gridDim.x >> 3;
  const int q = slot + it * SL, per = 8 * nN;
  if (q >= 2 * per) return false;
  const int mg = q / per, e = q - mg * per;
  nt = e >> 3; mt = xcd * 16 + mg * 8 + (e & 7);
  return true;
}

DI int inmap(int c) {
  if (c < 1024) return c;
  if (c < 1536) return c + 512;
  if (c < 2048) return c + 512;
  if (c < 2304) return c + 512;
  if (c < 2432) return c + 512;
  if (c < 2560) return c + 640;
  if (c < 3072) return c + 792;
  if (c < 4096) return c + 792;
  if (c < 5120) return c + 792;
  if (c < 5376) return c < 5144 ? c - 1792 : -1;
  if (c < 5888) return c - 4352;
  if (c < 6016) return c - 2944;
  return c - 2816;
}

DI void tr_tile(const float* __restrict__ src, int ld, int K, int k0, int n0, bool use_map, const float* __restrict__ scale, bf16_t* __restrict__ dst, int ldd, float* tile) {
  const int tid = my_tid();
  {
    const int nl = tid & 63, kk = tid >> 6;
    const int n = n0 + nl; const int sc = use_map ? inmap(n) : n;
#pragma unroll
    for (int r = 0; r < 8; ++r) {
      const int k = k0 + r * 8 + kk;
      float v = 0.f;
      if (sc >= 0) { v = src[(long)k * ld + sc]; if (scale) v *= scale[k]; }
      tile[(r * 8 + kk) * 65 + nl] = v;
    }
  }
  __syncthreads();
  {
    const int nl = tid >> 3, ks = tid & 7;
    unsigned o[4];
#pragma unroll
    for (int e = 0; e < 4; ++e) o[e] = pk2(tile[(ks * 8 + 2 * e) * 65 + nl], tile[(ks * 8 + 2 * e + 1) * 65 + nl]);
    *(u32x4*)(dst + (long)(n0 + nl) * ldd + k0 + ks * 8) = (u32x4){o[0], o[1], o[2], o[3]};
  }
  __syncthreads();
}

DI void tr_job(const float* src, int ld, int K, int N, bool use_map, const float* scale, bf16_t* dst, int ldd, float* tile) {
  const int nk = K >> 6, nn = N >> 6;
  for (int t = blockIdx.x; t < nk * nn; t += gridDim.x) tr_tile(src, ld, K, (t % nk) * 64, (t / nk) * 64, use_map, scale, dst, ldd, tile);
}

DI void convert_weights(const Params& p0, int l, unsigned char* lds) {
  const Params p = relaunder(p0);
  float* tile = (float*)lds;
  tr_job(p.w_in + (long)l * D_MODEL * N_IN, N_IN, D_MODEL, NP, true, p.norm_g + l * D_MODEL, p.wt_in(), LDX, tile);
  for (int kv = 0; kv < 2; ++kv) {
    tr_job(p.cmp_w1 + (long)(l * 2 + kv) * 2048 * 256, 256, 2048, 256, false, nullptr, p.w1t() + (long)kv * 256 * 2048, 2048, tile);
    tr_job(p.cmp_w2 + (long)(l * 2 + kv) * 256 * 64, 64, 256, 64, false, nullptr, p.w2t() + (long)kv * 64 * 256, 256, tile);
  }
  tr_job(p.w_up_a + (long)l * 512 * 1024, 1024, 512, 1024, false, nullptr, p.wupa_t(), 512, tile);
  tr_job(p.w_up_b + (long)l * 512 * 1024, 1024, 512, 1024, false, nullptr, p.wupb_t(), 512, tile);
  tr_job(p.w_out + (long)l * 1024 * 1024, 1024, 1024, 1024, false, nullptr, p.wout_t(), 1024, tile);
}

DI void phase_prologue(const Params& p, unsigned char* lds) {
  const int tid = my_tid();
  convert_weights(p, 0, lds);
  {
    const int lane = tid & 63;
    for (int wi = blockIdx.x * 8 + (tid >> 6); wi < DEPTH * 2 * 16 * 4; wi += gridDim.x * 8) {
      const int jq = wi & 3, kq = (wi >> 2) & 15, it = wi >> 6;
      const float* w1 = p.cmp_w1 + (long)it * 2048 * 256 + (long)kq * 128 * 256 + jq * 64 + lane; const float* pe = p.cmp_pe + (long)it * 2048 + kq * 128;
      float s0 = kq == 0 ? p.cmp_b1[it * 256 + jq * 64 + lane] : 0.f, s1 = 0.f, s2 = 0.f, s3 = 0.f;
#pragma unroll 4
      for (int k = 0; k < 128; k += 4) {
        s0 += pe[k] * w1[(long)k * 256]; s1 += pe[k + 1] * w1[(long)(k + 1) * 256]; s2 += pe[k + 2] * w1[(long)(k + 2) * 256]; s3 += pe[k + 3] * w1[(long)(k + 3) * 256];
      }
      p.b1eff()[(it * 16 + kq) * 256 + jq * 64 + lane] = (s0 + s1) + (s2 + s3);
    }
  }
  if (blockIdx.x == 1 && tid < DEPTH * 3) {
    const int l = tid / 3, br = tid % 3;
    float mq = 0.f, mk = 0.f;
    for (int d = 0; d < 64; ++d) { mq = fmaxf(mq, fabsf(p.q_norm_g[l * 64 + d])); mk = fmaxf(mk, fabsf(p.k_norm_g[(l * 3 + br) * 64 + d])); }
    p.mfix()[l * 4 + br] = 8.f * 1.44269504089f * mq * mk * 1.02f + 0.25f;
  }
  if (blockIdx.x == 0) { for (int i = tid; i < DEPTH * 64; i += NTHR) p.qng()[i] = p.q_norm_g[i]; for (int i = tid; i < DEPTH * 192; i += NTHR) p.kng()[i] = p.k_norm_g[i]; }
  const long gtid = (long)blockIdx.x * NTHR + tid, gn = (long)gridDim.x * NTHR;
  for (long i = gtid; i < (long)NTOK * 32; i += gn) {
    const int f = (int)(i & 31); const long tok = i >> 5;
    const float ang = (float)p.pos[tok] * inv_freq(f);
    float sn, cs; sincos_acc(ang, sn, cs);
    p.cosT()[i] = cs; p.sinT()[i] = sn;
  }
  for (long i = gtid; i < (long)BATCH * 128 * 32; i += gn) {
    const int f = (int)(i & 31); const int c = (int)((i >> 5) & 127); const int b = (int)(i >> 12);
    float cs = 1.f, sn = 0.f;
    if (c < NCMP) {
      float sum = 0.f;
      for (int k = 0; k < 32; ++k) sum += (float)p.pos[b * SEQ + c * 16 + k];
      const float ang = (sum * (1.f / 32.f)) * inv_freq(f);
      sincos_acc(ang, sn, cs);
    }
    p.cosC()[i] = cs; p.sinC()[i] = sn;
  }
  const int lane = tid & 63;
  for (long row = (long)blockIdx.x * 8 + (tid >> 6); row < NTOK; row += (long)gridDim.x * 8) {
    const float* xr = p.x_in + row * D_MODEL; bf16_t* xo = p.xb() + row * LDX;
    float ss = 0.f;
#pragma unroll
    for (int u = 0; u < 4; ++u) {
      const f32x4 v = *(const f32x4*)(xr + u * 256 + lane * 4);
      ss += v[0] * v[0] + v[1] * v[1] + v[2] * v[2] + v[3] * v[3];
      *(u32x2*)(xo + u * 256 + lane * 4) = (u32x2){pk2(v[0], v[1]), pk2(v[2], v[3])};
    }
#pragma unroll
    for (int o = 32; o >= 1; o >>= 1) ss += __shfl_xor(ss, o);
    if (lane < 8) p.part()[row * 16 + lane] = lane == 0 ? ss : 0.f;
  }
}

DI void phaseA_epilogue(const Params& p, int layer, int mt, int nt, const f32x4 (&acc)[8][4], const float* rs_s) {
  const int tid = my_tid(), lane = tid & 63, w = tid >> 6, wa = w >> 2, wb = w & 3, qi = lane & 15, quad = lane >> 4;
  if (nt >= 21) {
    bf16_t* dstb; int nh, head;
    if (nt < 23) { dstb = p.sbvt(); nh = 8; head = (nt - 21) * 4 + wb; } else if (wb < 2) { dstb = p.vst(); nh = 2; head = wb; } else { dstb = p.vwt(); nh = 2; head = wb - 2; }
    const int tok0 = mt * 256, b = tok0 >> 11, s0 = (tok0 & 2047) + wa * 128 + quad * 4;
#pragma unroll
    for (int i = 0; i < 8; ++i) {
      const int tl = wa * 128 + i * 16 + quad * 4;
      const float r0 = rs_s[tl], r1 = rs_s[tl + 1], r2 = rs_s[tl + 2], r3 = rs_s[tl + 3];
#pragma unroll
      for (int j = 0; j < 4; ++j) {
        const int d = j * 16 + qi;
        const f32x4 v = acc[i][j];
        bf16_t* dst = dstb + ((long)(b * nh + head) * 64 + d) * SEQ + s0 + i * 16;
        *(u32x2*)dst = (u32x2){pk2(v[0] * r0, v[1] * r1), pk2(v[2] * r2, v[3] * r3)};
      }
    }
    return;
  }
  const bool headtype = nt < 4 || (nt >= 6 && nt < 10);
#pragma unroll
  for (int j = 0; j < 4; ++j) {
    const int tl = wb * 64 + j * 16 + qi; const long tok = (long)mt * 256 + tl; const int b = (int)(tok >> 11), sq = (int)(tok & 2047);
    const float rs = rs_s[tl];
    if (headtype) {
#pragma unroll
      for (int ih = 0; ih < 2; ++ih) {
        const int hit = wa * 2 + ih;
        f32x4 v[4];
#pragma unroll
        for (int i = 0; i < 4; ++i) v[i] = acc[ih * 4 + i][j] * rs;
        bf16_t* dstb; int nh, head; const float* g = nullptr;
        if (nt < 2) { dstb = p.sbq(); nh = 8; head = nt * 4 + hit; }
        else if (nt < 4) { dstb = p.sbk(); nh = 8; head = (nt - 2) * 4 + hit; }
        else if (nt < 8) { dstb = p.nq(); nh = 8; head = (nt - 6) * 4 + hit; g = p.qng() + layer * 64; }
        else if (nt == 8) { dstb = hit < 2 ? p.kcr() : p.vcr(); nh = 2; head = hit & 1; }
        else { dstb = hit < 2 ? p.ks() : p.kw(); nh = 2; head = hit & 1; g = p.kng() + (layer * 3 + (hit < 2 ? 1 : 2)) * 64; }
        if (g) {
          float ss = 0.f;
#pragma unroll
          for (int i = 0; i < 4; ++i) ss += v[i][0] * v[i][0] + v[i][1] * v[i][1] + v[i][2] * v[i][2] + v[i][3] * v[i][3];
          ss += __shfl_xor(ss, 16); ss += __shfl_xor(ss, 32);
          const float rn = rsqrtf(ss * (1.f / 64.f) + NORM_EPS);
#pragma unroll
          for (int i = 0; i < 4; ++i) { const f32x4 gg = *(const f32x4*)(g + i * 16 + quad * 4); v[i] = v[i] * rn * gg; }
#pragma unroll
          for (int i = 0; i < 2; ++i) {
            const f32x4 cs = *(const f32x4*)(p.cosT() + tok * 32 + i * 16 + quad * 4), sn = *(const f32x4*)(p.sinT() + tok * 32 + i * 16 + quad * 4);
            const f32x4 x1 = v[i], x2 = v[i + 2];
            v[i] = x1 * cs - x2 * sn; v[i + 2] = x2 * cs + x1 * sn;
          }
        }
        bf16_t* dst = dstb + ((long)(b * nh + head) * SEQ + sq) * 64 + quad * 4;
#pragma unroll
        for (int i = 0; i < 4; ++i) *(u32x2*)(dst + i * 16) = (u32x2){pk2(v[i][0], v[i][1]), pk2(v[i][2], v[i][3])};
        asm volatile("" ::: "memory");
      }
    } else if (nt == 20) {
      if (wa == 0) {
#pragma unroll
        for (int i = 0; i < 2; ++i) {
          const int f = i * 16 + quad * 4;
          const f32x4 v = acc[i][j] * rs;
          if (f < 24) { const f32x4 o = {sigmoidf_(v[0]), sigmoidf_(v[1]), sigmoidf_(v[2]), sigmoidf_(v[3])}; *(f32x4*)(p.ngate() + tok * 32 + f) = o; }
        }
      }
    } else {
      bf16_t* dstb; int ldd, c0; bool sil;
      if (nt < 6) { dstb = p.sbz(); ldd = 512; c0 = (nt - 4) * 256; sil = true; }
      else if (nt < 12) { dstb = p.nz(); ldd = 512; c0 = (nt - 10) * 256; sil = true; }
      else if (nt < 16) { dstb = p.ga(); ldd = 1024; c0 = (nt - 12) * 256; sil = false; }
      else { dstb = p.gb(); ldd = 1024; c0 = (nt - 16) * 256; sil = false; }
      bf16_t* dst = dstb + tok * ldd + c0 + wa * 128 + quad * 4;
#pragma unroll
      for (int i = 0; i < 8; ++i) {
        const f32x4 v = acc[i][j] * rs;
        f32x4 o;
#pragma unroll
        for (int r = 0; r < 4; ++r) o[r] = sil ? siluf_(v[r]) : sigmoidf_(v[r]);
        *(u32x2*)(dst + i * 16) = (u32x2){pk2(o[0], o[1]), pk2(o[2], o[3])};
      }
    }
    asm volatile("" ::: "memory");
  }
}

DI void phaseA(const Params& p0, const Slot sl, int layer, unsigned char* lds, int fake = 0) {
  const Params p = relaunder(p0);
  bf16_t* gl = (bf16_t*)lds; float* rs_s = (float*)(lds + LDS_GEMM_BYTES);
  const bf16_t* Wt = p.wt_in();
  int mt, nt;
  for (int it = 0; tile_order(sl, it, NT_IN, mt, nt); ++it) {
    if (my_tid() < 256) {
      const float* pp = p.part() + ((long)mt * 256 + my_tid()) * 16;
      const f32x4 v0 = *(const f32x4*)pp, v1 = *(const f32x4*)(pp + 4);
      const float s = ((v0[0] + v0[1]) + (v0[2] + v0[3])) + ((v1[0] + v1[1]) + (v1[2] + v1[3]));
      rs_s[my_tid()] = rsqrtf(s * (1.f / 1024.f) + NORM_EPS);
    }
    const int mtl = fake == 3 ? 0 : (fake == 4 ? sl.xcd * 16 + (sl.slot & 7) : mt), ntl = fake == 3 ? 0 : (fake == 4 ? (sl.slot >> 3) : nt);
    const bf16_t* Xg = p.xb() + (long)mtl * 256 * LDX; const bf16_t* Wg = Wt + (long)ntl * 256 * LDX;
    f32x4 acc[8][4]; zero_acc(acc);
    const int kstep = (fake == 1 || fake == 2) ? 0 : 64;
    gemm_core(nt >= 21 ? Xg : Wg, LDX, nt >= 21 ? Wg : Xg, LDX, D_MODEL, gl, acc, kstep);
    if (!fake) phaseA_epilogue(p, layer, mt, nt, acc, rs_s);
    else if (acc[0][0][0] == 123.456f && acc[7][3][3] == 5.f) p.dummy()[0] = 1;
    __syncthreads();
  }
}

DI void compress_item(const Params& p, int layer, int item, unsigned char* lds) {
  bf16_t* gl = (bf16_t*)lds;
  const int tid = my_tid(), lane = tid & 63, w = tid >> 6, wa = w >> 2, wb = w & 3, qi = lane & 15, quad = lane >> 4;
  const int kv = item & 1, pair = item >> 1;
  const bf16_t* src = (kv ? p.vcr() : p.kcr()) + (long)pair * 256 * 1024;
  const bf16_t* W1 = p.w1t() + (long)kv * 256 * 2048;
  const float* b1 = p.b1eff() + (layer * 2 + kv) * 16 * 256;
  bf16_t* hid = p.hid() + (long)item * 256 * 256;
  {
    f32x4 acc[8][4]; zero_acc(acc);
    gemm_core(W1, 2048, src, 1024, 2048, gl, acc);
#pragma unroll
    for (int i = 0; i < 8; ++i) {
      const int f = wa * 128 + i * 16 + quad * 4;
      f32x4 bb = *(const f32x4*)(b1 + f);
#pragma unroll
      for (int kq = 1; kq < 16; ++kq) bb += *(const f32x4*)(b1 + kq * 256 + f);
#pragma unroll
      for (int j = 0; j < 4; ++j) {
        const int row = wb * 64 + j * 16 + qi;
        f32x4 v = acc[i][j] + bb;
        *(u32x2*)(hid + (long)row * 256 + f) = (u32x2){pk2(siluf_(v[0]), siluf_(v[1])), pk2(siluf_(v[2]), siluf_(v[3]))};
      }
    }
  }
  __threadfence_block();
  __syncthreads();
  const bf16_t* W2 = p.w2t() + (long)kv * 64 * 256;
  f32x4 o[4][2];
#pragma unroll
  for (int dt = 0; dt < 4; ++dt) { o[dt][0] = (f32x4){0.f, 0.f, 0.f, 0.f}; o[dt][1] = o[dt][0]; }
  for (int ksx = 0; ksx < 8; ++ksx) {
    bf16x8 wf[4], hf[2];
#pragma unroll
    for (int dt = 0; dt < 4; ++dt) wf[dt] = ld8(W2 + (long)(dt * 16 + qi) * 256 + ksx * 32 + quad * 8);
#pragma unroll
    for (int rt = 0; rt < 2; ++rt) hf[rt] = ld8(hid + (long)(w * 32 + rt * 16 + qi) * 256 + ksx * 32 + quad * 8);
#pragma unroll
    for (int dt = 0; dt < 4; ++dt)
#pragma unroll
      for (int rt = 0; rt < 2; ++rt) o[dt][rt] = kv ? MFMA16(hf[rt], wf[dt], o[dt][rt]) : MFMA16(wf[dt], hf[rt], o[dt][rt]);
  }
  const int bg = pair * 2 + (w >> 2);
  if (kv == 0) {
    const float* g = p.kng() + (layer * 3 + 0) * 64;
    const int b = bg >> 1;
#pragma unroll
    for (int rt = 0; rt < 2; ++rt) {
      const int c = (w & 3) * 32 + rt * 16 + qi;
      f32x4 v[4];
      float ss = 0.f;
#pragma unroll
      for (int dt = 0; dt < 4; ++dt) { v[dt] = o[dt][rt]; ss += v[dt][0] * v[dt][0] + v[dt][1] * v[dt][1] + v[dt][2] * v[dt][2] + v[dt][3] * v[dt][3]; }
      ss += __shfl_xor(ss, 16); ss += __shfl_xor(ss, 32);
      const float rn = rsqrtf(ss * (1.f / 64.f) + NORM_EPS);
#pragma unroll
      for (int dt = 0; dt < 4; ++dt) { const f32x4 gg = *(const f32x4*)(g + dt * 16 + quad * 4); v[dt] = v[dt] * rn * gg; }
#pragma unroll
      for (int dt = 0; dt < 2; ++dt) {
        const long ti = ((long)b * 128 + c) * 32 + dt * 16 + quad * 4;
        const f32x4 cs = *(const f32x4*)(p.cosC() + ti), sn = *(const f32x4*)(p.sinC() + ti);
        const f32x4 x1 = v[dt], x2 = v[dt + 2];
        v[dt] = x1 * cs - x2 * sn; v[dt + 2] = x2 * cs + x1 * sn;
      }
      bf16_t* dst = p.kc() + ((long)bg * 128 + c) * 64 + quad * 4;
#pragma unroll
      for (int dt = 0; dt < 4; ++dt) {
        u32x2 ov = (u32x2){pk2(v[dt][0], v[dt][1]), pk2(v[dt][2], v[dt][3])};
        if (c >= NCMP) ov = (u32x2){0u, 0u};
        *(u32x2*)(dst + dt * 16) = ov;
      }
    }
  } else {
#pragma unroll
    for (int dt = 0; dt < 4; ++dt)
#pragma unroll
      for (int rt = 0; rt < 2; ++rt) {
        const int c0 = (w & 3) * 32 + rt * 16 + quad * 4;
        f32x4 v = o[dt][rt];
        if (c0 + 3 >= NCMP) v[3] = 0.f;
        *(u32x2*)(p.vct() + ((long)bg * 64 + dt * 16 + qi) * 128 + c0) = (u32x2){pk2(v[0], v[1]), pk2(v[2], v[3])};
      }
  }
  __syncthreads();
}

DI void sb_attn_wave(const Params& p, int b, int h, int t0, bf16_t* ybase) {
  const int lane = my_tid() & 63, qi = lane & 15, quad = lane >> 4;
  const bf16_t* Q = p.sbq() + (long)(b * 8 + h) * SEQ * 64;
  const bf16_t* K = p.sbk() + (long)(b * 8 + h) * SEQ * 64;
  const bf16_t* Vt = p.sbvt() + (long)(b * 8 + h) * 64 * SEQ;
  const int t = t0 + qi;
  bf16x8 qf[2];
  qf[0] = ld8(Q + (long)t * 64 + quad * 8); qf[1] = ld8(Q + (long)t * 64 + 32 + quad * 8);
  f32x4 o[4];
#pragma unroll
  for (int dt = 0; dt < 4; ++dt) o[dt] = (f32x4){0.f, 0.f, 0.f, 0.f};
  float carry = 0.f;
  const int krow = 8 * (qi >> 2) + (qi & 3);
  const bf16_t* kp0 = K + (long)krow * 64 + quad * 8;
  const bf16_t* vp0 = Vt + (long)qi * SEQ + 8 * quad;
  int kb = t0 & ~31;
  bf16x8 kf[2][2], vf[4];
#pragma unroll
  for (int a = 0; a < 2; ++a) { kf[a][0] = ld8(kp0 + (long)(kb + 4 * a) * 64); kf[a][1] = ld8(kp0 + (long)(kb + 4 * a) * 64 + 32); }
#pragma unroll
  for (int dt = 0; dt < 4; ++dt) vf[dt] = ld8(vp0 + (long)dt * 16 * SEQ + kb);
  for (; kb >= 0; kb -= 32) {
    bf16x8 kn[2][2], vn[4];
    const int kbn = kb >= 32 ? kb - 32 : 0;
#pragma unroll
    for (int a = 0; a < 2; ++a) { kn[a][0] = ld8(kp0 + (long)(kbn + 4 * a) * 64); kn[a][1] = ld8(kp0 + (long)(kbn + 4 * a) * 64 + 32); }
#pragma unroll
    for (int dt = 0; dt < 4; ++dt) vn[dt] = ld8(vp0 + (long)dt * 16 * SEQ + kbn);
    f32x4 s[2];
#pragma unroll
    for (int a = 0; a < 2; ++a) {
      s[a] = MFMA16(kf[a][0], qf[0], ((f32x4){0.f, 0.f, 0.f, 0.f}));
      s[a] = MFMA16(kf[a][1], qf[1], s[a]);
    }
    float L[8], ls[8]; bool val[8];
    float tot = 0.f;
#pragma unroll
    for (int idx = 0; idx < 8; ++idx) {
      const float z = s[idx >> 2][idx & 3] * 0.125f;
      const int key = kb + 8 * quad + idx;
      val[idx] = key < t;
      const float sp = fmaxf(z, 0.f) + __logf(1.f + __expf(-fabsf(z)));
      L[idx] = val[idx] ? -sp : 0.f;
      ls[idx] = z - sp;
      tot += L[idx];
    }
    const float a1 = __shfl_xor(tot, 16), a2 = __shfl_xor(tot, 32), a3 = __shfl_xor(a1, 32);
    const float higher = ((quad ^ 1) > quad ? a1 : 0.f) + ((quad ^ 2) > quad ? a2 : 0.f) + ((quad ^ 3) > quad ? a3 : 0.f);
    float run = carry + higher;
    float wv[8];
#pragma unroll
    for (int idx = 7; idx >= 0; --idx) {
      wv[idx] = val[idx] ? __expf(ls[idx] + run) : 0.f;
      run += L[idx];
    }
    carry += (tot + a1) + (a2 + a3);
    const bf16x8 pf = mk8((u32x4){pk2(wv[0], wv[1]), pk2(wv[2], wv[3]), pk2(wv[4], wv[5]), pk2(wv[6], wv[7])});
#pragma unroll
    for (int dt = 0; dt < 4; ++dt) o[dt] = MFMA16(vf[dt], pf, o[dt]);
    if (__all(carry < -110.f)) break;
#pragma unroll
    for (int a = 0; a < 2; ++a) { kf[a][0] = kn[a][0]; kf[a][1] = kn[a][1]; }
#pragma unroll
    for (int dt = 0; dt < 4; ++dt) vf[dt] = vn[dt];
  }
  const long zo = ((long)b * SEQ + t) * 512 + h * 64 + quad * 4;
  const bf16_t* zp = p.sbz() + zo; bf16_t* yp = ybase + zo;
#pragma unroll
  for (int dt = 0; dt < 4; ++dt) {
    const u32x2 zz = *(const u32x2*)(zp + dt * 16);
    *(u32x2*)(yp + dt * 16) = (u32x2){pk2(o[dt][0] * bflo(zz[0]), o[dt][1] * bfhi(zz[0])), pk2(o[dt][2] * bflo(zz[1]), o[dt][3] * bfhi(zz[1]))};
  }
}

DI void phaseB(const Params& p0, int layer, unsigned char* lds, bool probe) {
  const int NITEM = 32 + BATCH * 8 * 16;
  for (int it = blockIdx.x; it < NITEM; it += gridDim.x) {
    const Params p = relaunder(p0);
    if (it < 32) { compress_item(p, layer, it, lds); continue; }
    const int i = it - 32, qt = 15 - (i >> 7), bh = i & 127;
    sb_attn_wave(p, bh >> 3, bh & 7, qt * 128 + (my_tid() >> 6) * 16, probe ? p.dummy() : p.sbz());
  }
}

constexpr int NSA_LO_BYTES = 8 * 8192;
constexpr int NSA_KROW = 144, NSA_VROW = 80;
constexpr int NSA_SLOT = 32 * NSA_KROW + 64 * NSA_VROW;
constexpr int NSA_SLOT0 = NSA_LO_BYTES, NSA_BLIST = NSA_SLOT0 + 2 * NSA_SLOT, NSA_UMW = NSA_BLIST + 64 * 4;

struct KVFrag { bf16x8 k[2][2]; bf16x8 v[4]; };
DI void nsa_ldsfrag(KVFrag& f, const unsigned char* slot, int qi, int quad) {
  const int krow = 8 * (qi >> 2) + (qi & 3);
#pragma unroll
  for (int a = 0; a < 2; ++a) { const unsigned char* kp = slot + (krow + 4 * a) * NSA_KROW + quad * 16; f.k[a][0] = mk8(*(const u32x4*)kp); f.k[a][1] = mk8(*(const u32x4*)(kp + 64)); }
#pragma unroll
  for (int dt = 0; dt < 4; ++dt) f.v[dt] = mk8(*(const u32x4*)(slot + 32 * NSA_KROW + (dt * 16 + qi) * NSA_VROW + quad * 16));
}
template <int MODE>
DI void nsa_chunk(const KVFrag& f, int kb, int t, bool selbit, const bf16x8 (&qf)[4][2], f32x4 (&O)[4][4], float (&m)[4], float (&l)[4], int quad, bool online) {
  const float SC = 0.125f * 1.44269504089f;
  bool val[8];
#pragma unroll
  for (int idx = 0; idx < 8; ++idx) {
    const int key = kb + 8 * quad + idx;
    val[idx] = MODE == 0 ? (selbit && key <= t) : (key <= t && key > t - 512);
  }
#pragma unroll
  for (int hh = 0; hh < 4; ++hh) {
    f32x4 s[2];
#pragma unroll
    for (int a = 0; a < 2; ++a) { s[a] = MFMA16(f.k[a][0], qf[hh][0], ((f32x4){0.f, 0.f, 0.f, 0.f})); s[a] = MFMA16(f.k[a][1], qf[hh][1], s[a]); }
    float mn = m[hh];
    if (online) {
      float cm = -1e30f;
#pragma unroll
      for (int idx = 0; idx < 8; ++idx) if (val[idx]) cm = fmaxf(cm, s[idx >> 2][idx & 3] * SC);
      cm = fmaxf(cm, __shfl_xor(cm, 16)); cm = fmaxf(cm, __shfl_xor(cm, 32));
      mn = fmaxf(mn, cm);
      const float alpha = __builtin_amdgcn_exp2f(m[hh] - mn);
      m[hh] = mn; l[hh] *= alpha;
#pragma unroll
      for (int dt = 0; dt < 4; ++dt) O[hh][dt] = O[hh][dt] * alpha;
    }
    float pv[8]; float ps = 0.f;
#pragma unroll
    for (int idx = 0; idx < 8; ++idx) { pv[idx] = val[idx] ? __builtin_amdgcn_exp2f(fmaf(s[idx >> 2][idx & 3], SC, -mn)) : 0.f; ps += pv[idx]; }
    l[hh] += ps;
    const bf16x8 pf = mk8((u32x4){pk2(pv[0], pv[1]), pk2(pv[2], pv[3]), pk2(pv[4], pv[5]), pk2(pv[6], pv[7])});
#pragma unroll
    for (int dt = 0; dt < 4; ++dt) O[hh][dt] = MFMA16(f.v[dt], pf, O[hh][dt]);
  }
}

template <int MODE>
DI void nsa_branch(const bf16_t* __restrict__ Kb, const bf16_t* __restrict__ Vtb, unsigned char* lds, int nb, int t, int cur, unsigned selmask, unsigned umall,
                   const bf16x8 (&qf)[4][2], f32x4 (&O)[4][4], float (&m)[4], float (&l)[4], bool online) {
  const int tid = my_tid(), lane = tid & 63, qi = lane & 15, quad = lane >> 4;
  const int* blist = (const int*)(lds + NSA_BLIST);
  const bool isv = tid >= 256;
  const int t2 = tid & 255;
  const bf16_t* gsrc = isv ? Vtb + (long)(t2 >> 2) * SEQ + (t2 & 3) * 8 : Kb + (long)(t2 >> 3) * 64 + (t2 & 7) * 8;
  const long gmul = isv ? 1 : 64;
  const int ldst = isv ? 32 * NSA_KROW + (t2 >> 2) * NSA_VROW + (t2 & 3) * 16 : (t2 >> 3) * NSA_KROW + (t2 & 7) * 16;
  unsigned char* slot0 = lds + NSA_SLOT0; unsigned char* slot1 = slot0 + NSA_SLOT;
  const int N = 2 * nb;
  auto kbof = [&](int n) { return blist[n >> 1] * 64 + (n & 1) * 32; };
  u32x4 ra = *(const u32x4*)(gsrc + (long)kbof(0) * gmul), rb = *(const u32x4*)(gsrc + (long)kbof(1) * gmul);
  *(u32x4*)(slot0 + ldst) = ra;
  __syncthreads();
#pragma unroll 1
  for (int n = 0; n < N; n += 2) {
    const int j = blist[n >> 1];
    const bool won = MODE == 0 ? ((umall >> j) & 1u) != 0 : (j >= cur - 8 && j <= cur);
    const bool bit = (selmask >> j) & 1u;
    ra = *(const u32x4*)(gsrc + (long)kbof(min(n + 2, N - 2)) * gmul);
    if (won) { KVFrag f; nsa_ldsfrag(f, slot0, qi, quad); nsa_chunk<MODE>(f, j * 64, t, bit, qf, O, m, l, quad, online); }
    *(u32x4*)(slot1 + ldst) = rb;
    __syncthreads();
    rb = *(const u32x4*)(gsrc + (long)kbof(min(n + 3, N - 1)) * gmul);
    if (won) { KVFrag f; nsa_ldsfrag(f, slot1, qi, quad); nsa_chunk<MODE>(f, j * 64 + 32, t, bit, qf, O, m, l, quad, online); }
    *(u32x4*)(slot0 + ldst) = ra;
    __syncthreads();
  }
}

template <bool LAST>
DI void nsa_finish(u32x2* lo, f32x4 (&O)[4][4], float (&m)[4], float (&l)[4], const float (&gate)[4], const bf16_t* zp, bf16_t* yp, float minit) {
#pragma unroll
  for (int hh = 0; hh < 4; ++hh) {
    float lt = l[hh]; lt += __shfl_xor(lt, 16); lt += __shfl_xor(lt, 32);
    const float f = lt > 0.f ? gate[hh] / lt : 0.f;
#pragma unroll
    for (int dt = 0; dt < 4; ++dt) {
      const u32x2 a = lo[(hh * 4 + dt) * 64];
      const f32x4 v = (f32x4){bflo(a[0]), bfhi(a[0]), bflo(a[1]), bfhi(a[1])} + O[hh][dt] * f;
      if (LAST) {
        const u32x2 zz = *(const u32x2*)(zp + hh * 64 + dt * 16);
        *(u32x2*)(yp + hh * 64 + dt * 16) = (u32x2){pk2(v[0] * bflo(zz[0]), v[1] * bfhi(zz[0])), pk2(v[2] * bflo(zz[1]), v[3] * bfhi(zz[1]))};
      } else {
        lo[(hh * 4 + dt) * 64] = (u32x2){pk2(v[0], v[1]), pk2(v[2], v[3])};
        O[hh][dt] = (f32x4){0.f, 0.f, 0.f, 0.f};
      }
    }
    m[hh] = minit; l[hh] = 0.f;
  }
}

DI void nsa_wave(const Params& p, int layer, int b, int g, int t0, unsigned char* lds, bf16_t* ybase) {
  const int lane = my_tid() & 63, qi = lane & 15, quad = lane >> 4;
  const int t = t0 + qi, cur = t0 >> 6;
  const long tok = (long)b * SEQ + t;
  const int bg = b * 2 + g;
  u32x2* lo = (u32x2*)lds + (my_tid() >> 6) * 1024 + lane;

  const float mf_c = p.mfix()[layer * 4 + 0], mf_s = p.mfix()[layer * 4 + 1], mf_w = p.mfix()[layer * 4 + 2];
  const bool on_c = mf_c > 60.f, on_s = mf_s > 60.f, on_w = mf_w > 60.f;
  const float SC = 0.125f * 1.44269504089f;
  const bf16_t* Kc = p.kc() + (long)bg * 128 * 64;
  const bf16_t* Vc = p.vct() + (long)bg * 64 * 128;
  f32x4 ph[8];
#pragma unroll
  for (int kt = 0; kt < 8; ++kt) ph[kt] = (f32x4){0.f, 0.f, 0.f, 0.f};
#pragma unroll 1
  for (int hh = 0; hh < 4; ++hh) {
    const bf16_t* qp0 = p.nq() + ((long)(b * 8 + g * 4 + hh) * SEQ + t) * 64 + quad * 8;
    const bf16x8 q0 = ld8(qp0), q1 = ld8(qp0 + 32); const float gt = p.ngate()[tok * 32 + g * 4 + hh];
    f32x4 sc[8];
    float mx = on_c ? -1e30f : mf_c;
#pragma unroll
    for (int kt = 0; kt < 8; ++kt) {
      const bf16_t* kp = Kc + (long)(kt * 16 + qi) * 64 + quad * 8;
      sc[kt] = MFMA16(ld8(kp), q0, ((f32x4){0.f, 0.f, 0.f, 0.f}));
      sc[kt] = MFMA16(ld8(kp + 32), q1, sc[kt]);
      sc[kt] = sc[kt] * SC;
    }
    if (on_c) {
#pragma unroll
      for (int kt = 0; kt < 8; ++kt)
#pragma unroll
        for (int r = 0; r < 4; ++r) { const int c = kt * 16 + quad * 4 + r; if (c < NCMP && 16 * c + 31 <= t) mx = fmaxf(mx, sc[kt][r]); }
      mx = fmaxf(mx, __shfl_xor(mx, 16)); mx = fmaxf(mx, __shfl_xor(mx, 32));
    }
    float sum = 0.f;
#pragma unroll
    for (int kt = 0; kt < 8; ++kt)
#pragma unroll
      for (int r = 0; r < 4; ++r) {
        const int c = kt * 16 + quad * 4 + r;
        const float e = (c < NCMP && 16 * c + 31 <= t) ? __builtin_amdgcn_exp2f(sc[kt][r] - mx) : 0.f;
        sc[kt][r] = e; sum += e;
      }
    sum += __shfl_xor(sum, 16); sum += __shfl_xor(sum, 32);
    const float inv = sum > 0.f ? 1.f / sum : 0.f;
#pragma unroll
    for (int kt = 0; kt < 8; ++kt) { sc[kt] = sc[kt] * inv; ph[kt] += sc[kt]; }
    f32x4 oc[4];
#pragma unroll
    for (int dt = 0; dt < 4; ++dt) oc[dt] = (f32x4){0.f, 0.f, 0.f, 0.f};
#pragma unroll
    for (int mm = 0; mm < 4; ++mm) {
      const bf16x8 pf = mk8((u32x4){pk2(sc[2 * mm][0], sc[2 * mm][1]), pk2(sc[2 * mm][2], sc[2 * mm][3]), pk2(sc[2 * mm + 1][0], sc[2 * mm + 1][1]), pk2(sc[2 * mm + 1][2], sc[2 * mm + 1][3])});
#pragma unroll
      for (int dt = 0; dt < 4; ++dt) {
        const bf16_t* vp = Vc + (long)(dt * 16 + qi) * 128 + 32 * mm + quad * 4;
        const u32x2 lo = *(const u32x2*)vp, hi = *(const u32x2*)(vp + 16);
        oc[dt] = MFMA16(mk8((u32x4){lo[0], lo[1], hi[0], hi[1]}), pf, oc[dt]);
      }
    }
#pragma unroll
    for (int dt = 0; dt < 4; ++dt) { const f32x4 v = oc[dt] * gt; lo[(hh * 4 + dt) * 64] = (u32x2){pk2(v[0], v[1]), pk2(v[2], v[3])}; }
  }
  float imp[8];
  {
    float rot[8];
#pragma unroll
    for (int kt = 0; kt < 8; ++kt) rot[kt] = __shfl(ph[kt][3], (lane + 48) & 63);
#pragma unroll
    for (int kt = 0; kt < 8; ++kt) {
      const float extra = quad > 0 ? rot[kt] : (kt > 0 ? rot[kt > 0 ? kt - 1 : 0] : 0.f);
      const float v = (ph[kt][0] + ph[kt][1]) + (ph[kt][2] + ph[kt][3]) + extra;
      const int j = 4 * kt + quad;
      const bool forced = j == 0 || j == cur || j == cur - 1;
      imp[kt] = j <= cur ? v + (forced ? 1e4f : 0.f) : -1e30f;
    }
  }
  unsigned selmask = 0;
  {
    int rank[8];
#pragma unroll
    for (int kt = 0; kt < 8; ++kt) rank[kt] = 0;
#pragma unroll 1
    for (int q2 = 0; q2 < 4; ++q2)
#pragma unroll
      for (int k2 = 0; k2 < 8; ++k2) {
        const float ov = __shfl(imp[k2], qi + 16 * q2);
#pragma unroll
        for (int kt = 0; kt < 8; ++kt) {
          const bool before = k2 < kt || (k2 == kt && q2 < quad);
          rank[kt] += (ov > imp[kt] || (ov == imp[kt] && before)) ? 1 : 0;
        }
      }
#pragma unroll
    for (int kt = 0; kt < 8; ++kt) if (rank[kt] < 8 && 4 * kt + quad <= cur) selmask |= 1u << (4 * kt + quad);
    selmask |= __shfl_xor(selmask, 16); selmask |= __shfl_xor(selmask, 32);
  }

  unsigned umall = selmask;
  umall |= __shfl_xor(umall, 1); umall |= __shfl_xor(umall, 2); umall |= __shfl_xor(umall, 4); umall |= __shfl_xor(umall, 8);
  umall = __builtin_amdgcn_readfirstlane(umall);
  const int wv = my_tid() >> 6;
  unsigned* umw = (unsigned*)(lds + NSA_UMW); int* blist = (int*)(lds + NSA_BLIST);
  if (lane == 0) umw[wv] = umall;
  bf16x8 qf[4][2];
#pragma unroll
  for (int hh = 0; hh < 4; ++hh) {
    const bf16_t* qp = p.nq() + ((long)(b * 8 + g * 4 + hh) * SEQ + t) * 64 + quad * 8;
    qf[hh][0] = ld8(qp); qf[hh][1] = ld8(qp + 32);
  }
  float gate[3][4];
#pragma unroll
  for (int br = 1; br < 3; ++br) { const f32x4 gv = *(const f32x4*)(p.ngate() + tok * 32 + br * 8 + g * 4); gate[br][0] = gv[0]; gate[br][1] = gv[1]; gate[br][2] = gv[2]; gate[br][3] = gv[3]; }
  f32x4 O[4][4]; float m[4], l[4];
#pragma unroll
  for (int hh = 0; hh < 4; ++hh) { m[hh] = on_s ? -1e30f : mf_s; l[hh] = 0.f;
#pragma unroll
    for (int dt = 0; dt < 4; ++dt) O[hh][dt] = (f32x4){0.f, 0.f, 0.f, 0.f}; }
  __syncthreads();
  int nb;
  {
    unsigned ub = 0;
#pragma unroll
    for (int i = 0; i < 8; ++i) ub |= umw[i];
    nb = __builtin_popcount(ub);
    if (my_tid() < 32) { if ((ub >> my_tid()) & 1u) blist[__builtin_popcount(ub & ((1u << my_tid()) - 1u))] = my_tid(); }
    __syncthreads();
    nsa_branch<0>(p.ks() + (long)bg * SEQ * 64, p.vst() + (long)bg * 64 * SEQ, lds, nb, t, cur, selmask, umall, qf, O, m, l, on_s);
    nsa_finish<false>(lo, O, m, l, gate[1], nullptr, nullptr, on_w ? -1e30f : mf_w);
  }
  {
    const int cur0 = (t0 >> 7) * 2, jlo = cur0 >= 8 ? cur0 - 8 : 0;
    nb = cur0 + 2 - jlo;
    if (my_tid() < nb) blist[my_tid()] = jlo + my_tid();
    __syncthreads();
    nsa_branch<1>(p.kw() + (long)bg * SEQ * 64, p.vwt() + (long)bg * 64 * SEQ, lds, nb, t, cur, selmask, umall, qf, O, m, l, on_w);
    nsa_finish<true>(lo, O, m, l, gate[2], p.nz() + tok * 512 + g * 256 + quad * 4, ybase + tok * 512 + g * 256 + quad * 4, 0.f);
  }
  __syncthreads();
}

DI void phaseC(const Params& p0, int layer, unsigned char* lds, bool probe) {
  const int NITEM = BATCH * 2 * 16;
  for (int it = blockIdx.x; it < NITEM; it += gridDim.x) {
    const Params p = relaunder(p0);
    const int qt = 15 - (it >> 5), bg = it & 31;
    nsa_wave(p, layer, bg >> 1, bg & 1, qt * 128 + (my_tid() >> 6) * 16, lds, probe ? p.dummy() : p.nz());
  }
}

DI void phaseD(const Params& p0, const Slot sl, int layer, unsigned char* lds) {
  const Params p = relaunder(p0);
  bf16_t* gl = (bf16_t*)lds;
  int mt, nt;
  for (int it = 0; tile_order(sl, it, 4, mt, nt); ++it) {
#pragma unroll 1
    for (int which = 0; which < 2; ++which) {
      const bf16_t* Wg = (which ? p.wupb_t() : p.wupa_t()) + ((long)nt * 256) * 512;
      const bf16_t* Yg = (which ? p.nz() : p.sbz()) + (long)mt * 256 * 512;
      const bf16_t* Gg = which ? p.gb() : p.ga();
      f32x4 acc[8][4]; zero_acc(acc);
      gemm_core(Wg, 512, Yg, 512, 512, gl, acc);
      const int tid = my_tid(), lane = tid & 63, w = tid >> 6, wa = w >> 2, wb = w & 3, qi = lane & 15, quad = lane >> 4;
#pragma unroll
      for (int j = 0; j < 4; ++j) {
        const long tok = (long)mt * 256 + wb * 64 + j * 16 + qi;
#pragma unroll
        for (int i = 0; i < 8; ++i) {
          const long off = tok * 1024 + nt * 256 + wa * 128 + i * 16 + quad * 4;
          const u32x2 xg = *(const u32x2*)(Gg + off);
          const f32x4 v = acc[i][j];
          float o0 = bflo(xg[0]) * v[0], o1 = bfhi(xg[0]) * v[1], o2 = bflo(xg[1]) * v[2], o3 = bfhi(xg[1]) * v[3];
          if (which) { const u32x2 a = *(const u32x2*)(p.merged() + off); o0 += bflo(a[0]); o1 += bfhi(a[0]); o2 += bflo(a[1]); o3 += bfhi(a[1]); }
          *(u32x2*)(p.merged() + off) = (u32x2){pk2(o0, o1), pk2(o2, o3)};
          if ((i & 3) == 3) asm volatile("" ::: "memory");
        }
      }
    }
  }
}

DI void phaseE(const Params& p0, const Slot sl, int layer, unsigned char* lds, const float* xsrc) {
  const Params p = relaunder(p0);
  bf16_t* gl = (bf16_t*)lds;
  int mt, nt;
  for (int it = 0; tile_order(sl, it, 4, mt, nt); ++it) {
    f32x4 acc[8][4]; zero_acc(acc);
    gemm_core(p.wout_t() + ((long)nt * 256) * 1024, 1024, p.merged() + (long)mt * 256 * 1024, 1024, 1024, gl, acc);
    const int tid = my_tid(), lane = tid & 63, w = tid >> 6, wa = w >> 2, wb = w & 3, qi = lane & 15, quad = lane >> 4;
#pragma unroll
    for (int j = 0; j < 4; ++j) {
      const long tok = (long)mt * 256 + wb * 64 + j * 16 + qi;
      float ss = 0.f;
#pragma unroll
      for (int i = 0; i < 8; ++i) {
        const long off = tok * 1024 + nt * 256 + wa * 128 + i * 16 + quad * 4;
        const f32x4 xo = *(const f32x4*)(xsrc + off);
        const f32x4 xn = xo + acc[i][j];
        *(f32x4*)(p.out + off) = xn;
        *(u32x2*)(p.xb() + off + tok * (LDX - D_MODEL)) = (u32x2){pk2(xn[0], xn[1]), pk2(xn[2], xn[3])};
        ss += xn[0] * xn[0] + xn[1] * xn[1] + xn[2] * xn[2] + xn[3] * xn[3];
      }
      ss += __shfl_xor(ss, 16); ss += __shfl_xor(ss, 32);
      if (quad == 0) p.part()[tok * 16 + nt * 2 + wa] = ss;
    }
  }
}

#ifndef STOP_AFTER
#define STOP_AFTER 0
#endif
constexpr int LDS_BYTES = LDS_GEMM_BYTES + 1024;

__global__ void __launch_bounds__(512) hybrid_megakernel(Params p) {
  extern __shared__ __attribute__((aligned(16))) unsigned char lds[];
  cg::grid_group grid = cg::this_grid();
  __shared__ int s_xcc, s_rank, s_ok;
  if (threadIdx.x == 0) {
    const unsigned xcc = (unsigned)__builtin_amdgcn_s_getreg((3 << 11) | 20) & 7u;
    s_xcc = (int)xcc; s_rank = (int)atomicAdd(p.ctl() + xcc, 1u);
  }
  phase_prologue(p, lds);
  grid.sync();
  if (threadIdx.x == 0) {
    int ok = 1;
    for (int i = 0; i < 8; ++i) ok &= (__hip_atomic_load(p.ctl() + i, __ATOMIC_RELAXED, __HIP_MEMORY_SCOPE_AGENT) == (gridDim.x >> 3));
    s_ok = ok;
  }
  __syncthreads();
  const Slot sl = {s_ok ? s_xcc : (int)(blockIdx.x & 7), s_ok ? s_rank : (int)(blockIdx.x >> 3)};
  for (int layer = 0; layer < DEPTH; ++layer) {
    if (layer > 0) { convert_weights(p, layer, lds); grid.sync(); }
    if (STOP_AFTER != 0 && STOP_AFTER == layer * 10) return;
    phaseA(p, sl, layer, lds);
    grid.sync();
#ifdef PROBE_A
    phaseA(p, sl, layer, lds, PROBE_A >= 2 ? PROBE_A : 0);
    grid.sync();
#endif
    if (STOP_AFTER == layer * 10 + 1) return;
#ifdef PROBE_B
    phaseB(p, layer, lds, true);
    grid.sync();
#endif
    phaseB(p, layer, lds, false);
    grid.sync();
    if (STOP_AFTER == layer * 10 + 2) return;
#ifdef PROBE_C
    phaseC(p, layer, lds, true);
    grid.sync();
#endif
    phaseC(p, layer, lds, false);
    grid.sync();
    if (STOP_AFTER == layer * 10 + 3) return;
    phaseD(p, sl, layer, lds);
    grid.sync();
#ifdef PROBE_D
    phaseD(p, sl, layer, lds);
    grid.sync();
#endif
    if (STOP_AFTER == layer * 10 + 4) return;
    if (layer == 0) phaseE(p, sl, layer, lds, p.x_in); else phaseE(p, sl, layer, lds, p.out);
    if (layer + 1 < DEPTH) grid.sync();
    if (STOP_AFTER == layer * 10 + 5) return;
  }
}

extern "C" void kernel_launch(void* const* d_in, const int* in_sizes, int n_in, void* d_out, int out_size,
                              void* d_ws, size_t ws_size, hipStream_t stream) {
  static int grid_blocks = 0;
  if (!grid_blocks) {
    int dev = 0, cus = 0, per_cu = 0;
    (void)hipGetDevice(&dev);
    (void)hipDeviceGetAttribute(&cus, hipDeviceAttributeMultiprocessorCount, dev);
    if (hipFuncSetAttribute((const void*)hybrid_megakernel, hipFuncAttributeMaxDynamicSharedMemorySize, LDS_BYTES) != hipSuccess) fprintf(stderr, "hipFuncSetAttribute(max dynamic LDS) failed\n");
    (void)hipOccupancyMaxActiveBlocksPerMultiprocessor(&per_cu, hybrid_megakernel, NTHR, LDS_BYTES);
    (void)hipGetLastError();
    if (per_cu > 1) per_cu = 1;
    if (per_cu < 1) per_cu = 1;
    grid_blocks = (cus * per_cu) & ~7;
  }
  Params a{};
  a.x_in = (const float*)d_in[0]; a.pos = (const int*)d_in[1]; a.norm_g = (const float*)d_in[2]; a.w_in = (const float*)d_in[3];
  a.q_norm_g = (const float*)d_in[4]; a.k_norm_g = (const float*)d_in[5]; a.cmp_pe = (const float*)d_in[6]; a.cmp_w1 = (const float*)d_in[7];
  a.cmp_b1 = (const float*)d_in[8]; a.cmp_w2 = (const float*)d_in[9]; a.w_up_a = (const float*)d_in[10]; a.w_up_b = (const float*)d_in[11];
  a.w_out = (const float*)d_in[12];
  a.out = (float*)d_out; a.ws = (unsigned char*)d_ws;
  if (WS_NEED > ws_size) { fprintf(stderr, "workspace too small: need %zu have %zu\n", (size_t)WS_NEED, ws_size); return; }
  (void)hipMemsetAsync((unsigned char*)d_ws + OFF_CTL, 0, 256, stream);
  void* args[] = {&a};
  hipError_t e = hipLaunchCooperativeKernel((void*)hybrid_megakernel, dim3(grid_blocks), dim3(NTHR), args, LDS_BYTES, stream);
  if (e != hipSuccess) fprintf(stderr, "cooperative launch failed: %s (grid %d)\n", hipGetErrorString(e), grid_blocks);
}
```

```cpp
#include <hip/hip_runtime.h>
#include <hip/hip_cooperative_groups.h>
#include <cstdio>
#include <cstdint>
namespace cg = cooperative_groups;

typedef unsigned short bf16_t;
typedef short bf16x8 __attribute__((ext_vector_type(8)));
typedef float f32x4 __attribute__((ext_vector_type(4)));
typedef float f32x2 __attribute__((ext_vector_type(2)));
typedef unsigned u32x4 __attribute__((ext_vector_type(4)));
typedef unsigned u32x2 __attribute__((ext_vector_type(2)));
typedef __bf16 bf16x2_t __attribute__((ext_vector_type(2)));

#define DI __device__ __forceinline__
#define MFMA16(a, b, c) __builtin_amdgcn_mfma_f32_16x16x32_bf16((a), (b), (c), 0, 0, 0)

constexpr int D_MODEL = 1024, BATCH = 16, SEQ = 2048, DEPTH = 4, NTOK = BATCH * SEQ;
constexpr int N_IN = 5912, NP = 6144, NT_IN = 24;
constexpr int NTHR = 512;
constexpr int LDX = D_MODEL + 64;
constexpr int NCMP = 127;
constexpr float NORM_EPS = 1e-6f;

DI unsigned pk2(float lo, float hi) { f32x2 v = {lo, hi}; bf16x2_t b = __builtin_convertvector(v, bf16x2_t); return __builtin_bit_cast(unsigned, b); }
DI float bflo(unsigned u) { return __uint_as_float(u << 16); }
DI float bfhi(unsigned u) { return __uint_as_float(u & 0xffff0000u); }
DI float sigmoidf_(float x) { return __builtin_amdgcn_rcpf(1.f + __builtin_amdgcn_exp2f(-1.44269504089f * x)); }
DI float siluf_(float x) { return x * __builtin_amdgcn_rcpf(1.f + __builtin_amdgcn_exp2f(-1.44269504089f * x)); }
DI bf16x8 mk8(u32x4 v) { return __builtin_bit_cast(bf16x8, v); }
DI bf16x8 ld8(const bf16_t* p) { return __builtin_bit_cast(bf16x8, *(const u32x4*)p); }


DI void sincos_acc(float angf, float& sn, float& cs) {
  const double a = (double)angf;
  const double k = rint(a * 0.63661977236758134308);
  const double y = (a - k * 1.57079632679489655800) - k * 6.12323399573676603587e-17;
  const double y2 = y * y;
  const double sp = y * (1.0 + y2 * (-1.0 / 6 + y2 * (1.0 / 120 + y2 * (-1.0 / 5040 + y2 * (1.0 / 362880 + y2 * (-1.0 / 39916800 + y2 * (1.0 / 6227020800.0)))))));
  const double cp = 1.0 + y2 * (-0.5 + y2 * (1.0 / 24 + y2 * (-1.0 / 720 + y2 * (1.0 / 40320 + y2 * (-1.0 / 3628800 + y2 * (1.0 / 479001600.0))))));
  const int q = ((int)k) & 3;
  const double s_ = (q & 1) ? cp : sp, c_ = (q & 1) ? sp : cp;
  sn = (float)((q & 2) ? -s_ : s_);
  cs = (float)(((q + 1) & 2) ? -c_ : c_);
}
DI float inv_freq(int f) { return (float)exp(-(double)f * (9.21034037197618273607 / 32.0)); }

constexpr size_t al256(size_t x) { return (x + 255) & ~(size_t)255; }
constexpr size_t OFF_WT_IN = 0;
constexpr size_t OFF_W1T = OFF_WT_IN + al256((size_t)NP * LDX * 2);
constexpr size_t OFF_W2T = OFF_W1T + al256((size_t)2 * 256 * 2048 * 2);
constexpr size_t OFF_WUPA = OFF_W2T + al256((size_t)2 * 64 * 256 * 2);
constexpr size_t OFF_WUPB = OFF_WUPA + al256((size_t)1024 * 512 * 2);
constexpr size_t OFF_WOUT = OFF_WUPB + al256((size_t)1024 * 512 * 2);
constexpr size_t OFF_B1EFF = OFF_WOUT + al256((size_t)1024 * 1024 * 2);
constexpr size_t OFF_COST = OFF_B1EFF + al256((size_t)DEPTH * 2 * 16 * 256 * 4);
constexpr size_t OFF_SINT = OFF_COST + al256((size_t)NTOK * 32 * 4);
constexpr size_t OFF_COSC = OFF_SINT + al256((size_t)NTOK * 32 * 4);
constexpr size_t OFF_SINC = OFF_COSC + al256((size_t)BATCH * 128 * 32 * 4);
constexpr size_t OFF_XB = OFF_SINC + al256((size_t)BATCH * 128 * 32 * 4);
constexpr size_t OFF_PART = OFF_XB + al256((size_t)NTOK * LDX * 2);
constexpr size_t OFF_SBQ = OFF_PART + al256((size_t)NTOK * 16 * 4);
constexpr size_t OFF_SBK = OFF_SBQ + al256((size_t)NTOK * 512 * 2);
constexpr size_t OFF_SBVT = OFF_SBK + al256((size_t)NTOK * 512 * 2);
constexpr size_t OFF_SBZ = OFF_SBVT + al256((size_t)NTOK * 512 * 2);
constexpr size_t OFF_NQ = OFF_SBZ + al256((size_t)NTOK * 512 * 2);
constexpr size_t OFF_KCR = OFF_NQ + al256((size_t)NTOK * 512 * 2);
constexpr size_t OFF_VCR = OFF_KCR + al256((size_t)NTOK * 128 * 2);
constexpr size_t OFF_KS = OFF_VCR + al256((size_t)NTOK * 128 * 2);
constexpr size_t OFF_VST = OFF_KS + al256((size_t)NTOK * 128 * 2);
constexpr size_t OFF_KW = OFF_VST + al256((size_t)NTOK * 128 * 2);
constexpr size_t OFF_VWT = OFF_KW + al256((size_t)NTOK * 128 * 2);
constexpr size_t OFF_NGATE = OFF_VWT + al256((size_t)NTOK * 128 * 2);
constexpr size_t OFF_NZ = OFF_NGATE + al256((size_t)NTOK * 32 * 4);
constexpr size_t OFF_GA = OFF_NZ + al256((size_t)NTOK * 512 * 2);
constexpr size_t OFF_GB = OFF_GA + al256((size_t)NTOK * 1024 * 2);
constexpr size_t OFF_HID = OFF_GB + al256((size_t)NTOK * 1024 * 2);
constexpr size_t OFF_KC = OFF_HID + al256((size_t)4 * 32 * 256 * 256 * 4);
constexpr size_t OFF_VCT = OFF_KC + al256((size_t)BATCH * 2 * 128 * 64 * 2);
constexpr size_t OFF_QNG = OFF_VCT + al256((size_t)BATCH * 2 * 64 * 128 * 2);
constexpr size_t OFF_KNG = OFF_QNG + al256((size_t)DEPTH * 64 * 4);
constexpr size_t OFF_CTL = OFF_KNG + al256((size_t)DEPTH * 3 * 64 * 4);
constexpr size_t OFF_MFIX_BASE = OFF_CTL + 256;
constexpr size_t OFF_MFIX_OLD = OFF_KNG + al256((size_t)DEPTH * 3 * 64 * 4);
constexpr size_t OFF_MFIX = OFF_MFIX_BASE;
constexpr size_t OFF_DUMMY = OFF_MFIX + 256;
constexpr size_t WS_NEED = OFF_DUMMY + 256;

struct Params {
  const float* x_in; const int* pos; const float* norm_g; const float* w_in; const float* q_norm_g; const float* k_norm_g;
  const float* cmp_pe; const float* cmp_w1; const float* cmp_b1; const float* cmp_w2; const float* w_up_a; const float* w_up_b; const float* w_out;
  float* out; unsigned char* ws;
#define WSBUF(T, name, OFF) DI T* name() const { return (T*)(ws + (OFF)); }
  WSBUF(bf16_t, wt_in, OFF_WT_IN) WSBUF(bf16_t, w1t, OFF_W1T) WSBUF(bf16_t, w2t, OFF_W2T) WSBUF(bf16_t, wupa_t, OFF_WUPA) WSBUF(bf16_t, wupb_t, OFF_WUPB) WSBUF(bf16_t, wout_t, OFF_WOUT)
  WSBUF(float, b1eff, OFF_B1EFF) WSBUF(float, cosT, OFF_COST) WSBUF(float, sinT, OFF_SINT) WSBUF(float, cosC, OFF_COSC) WSBUF(float, sinC, OFF_SINC)
  WSBUF(bf16_t, xb, OFF_XB) WSBUF(float, part, OFF_PART) WSBUF(bf16_t, sbq, OFF_SBQ) WSBUF(bf16_t, sbk, OFF_SBK) WSBUF(bf16_t, sbvt, OFF_SBVT) WSBUF(bf16_t, sbz, OFF_SBZ)
  WSBUF(bf16_t, nq, OFF_NQ) WSBUF(bf16_t, kcr, OFF_KCR) WSBUF(bf16_t, vcr, OFF_VCR) WSBUF(bf16_t, ks, OFF_KS) WSBUF(bf16_t, vst, OFF_VST) WSBUF(bf16_t, kw, OFF_KW) WSBUF(bf16_t, vwt, OFF_VWT)
  WSBUF(float, ngate, OFF_NGATE) WSBUF(bf16_t, nz, OFF_NZ) WSBUF(bf16_t, ga, OFF_GA) WSBUF(bf16_t, gb, OFF_GB) WSBUF(float, hpre, OFF_HID) WSBUF(bf16_t, kc, OFF_KC) WSBUF(bf16_t, vct, OFF_VCT)
  WSBUF(bf16_t, merged, OFF_SBK)
  WSBUF(bf16_t, dummy, OFF_XB)     WSBUF(float, mfix, OFF_MFIX) WSBUF(unsigned, ctl, OFF_CTL)
  WSBUF(float, qng, OFF_QNG) WSBUF(float, kng, OFF_KNG)
};

DI int my_tid() { int t = threadIdx.x; asm volatile("" : "+v"(t)); return t; }
DI Params relaunder(const Params& p0) { Params p = p0; size_t z = 0; asm volatile("" : "+s"(z)); p.ws = p0.ws + z; return p; }

constexpr int TILE_B = 32 * 1024;
constexpr int STAGE_B = 2 * TILE_B;
constexpr int LDS_GEMM_BYTES = 2 * STAGE_B;
typedef __attribute__((address_space(3))) unsigned lds_u32;

DI void g_dma(const bf16_t* __restrict__ base, const unsigned (&off)[8], int ko, unsigned char* stage, int w) {
#pragma unroll
  for (int u = 0; u < 8; ++u)
    __builtin_amdgcn_global_load_lds((const unsigned*)(base + (off[u] + ko)), (lds_u32*)(stage + (w * 8 + u) * 1024), 16, 0, 0);
}
#define G_LDA(dst, ih, ks) _Pragma("unroll") for (int i = 0; i < 4; ++i) dst[i] = mk8(*(const u32x4*)(stage + ra + (((ih) * 4 + i) * 2 + (ks)) * 1024))
#define G_LDB(dst, ks) _Pragma("unroll") for (int j = 0; j < 4; ++j) dst[j] = mk8(*(const u32x4*)(stage + TILE_B + rb + (j * 2 + (ks)) * 1024))
#define G_MMA(ih, A, B) do { __builtin_amdgcn_s_setprio(1); _Pragma("unroll") for (int i = 0; i < 4; ++i) _Pragma("unroll") for (int j = 0; j < 4; ++j) acc[(ih) * 4 + i][j] = MFMA16(A[i], B[j], acc[(ih) * 4 + i][j]); __builtin_amdgcn_s_setprio(0); } while (0)
DI void g_compute(const unsigned char* stage, int ra, int rb, f32x4 (&acc)[8][4]) {
  bf16x8 b0[4], b1[4], a0[4], a1[4];
  G_LDB(b0, 0); G_LDA(a0, 0, 0);
  __builtin_amdgcn_sched_barrier(0);
  G_LDA(a1, 1, 0);
  G_MMA(0, a0, b0);
  __builtin_amdgcn_sched_barrier(0);
  G_LDB(b1, 1); G_LDA(a0, 0, 1);
  G_MMA(1, a1, b0);
  __builtin_amdgcn_sched_barrier(0);
  G_LDA(a1, 1, 1);
  G_MMA(0, a0, b1);
  __builtin_amdgcn_sched_barrier(0);
  G_MMA(1, a1, b1);
  __builtin_amdgcn_sched_barrier(0);
}

DI void gemm_core(const bf16_t* __restrict__ Ag, long lda, const bf16_t* __restrict__ Bg, long ldb, int K,
                  bf16_t* ldsb, f32x4 (&acc)[8][4], int kstep = 64) {
  unsigned char* lds = (unsigned char*)ldsb;
  const int tid = my_tid(), lane = tid & 63, w = __builtin_amdgcn_readfirstlane(tid >> 6), wa = w >> 2, wb = w & 3, qi = lane & 15, quad = lane >> 4;
  const bf16_t* base = w >= 4 ? Bg : Ag; const int ld = (int)(w >= 4 ? ldb : lda);
  unsigned off[8];
#pragma unroll
  for (int u = 0; u < 8; ++u) { const int blk = (w & 3) * 8 + u, rg = blk >> 1, kh = blk & 1; off[u] = (unsigned)((rg * 16 + (lane >> 2)) * ld + kh * 32 + (lane & 3) * 8); }
  const int ra = (wa * 8) * 2 * 1024 + (qi * 4 + quad) * 16, rb = (wb * 4) * 2 * 1024 + (qi * 4 + quad) * 16;
  unsigned char* buf0 = lds; unsigned char* buf1 = lds + STAGE_B;
  const int KT = K >> 6;
  g_dma(base, off, 0, buf0, w);
  asm volatile("s_waitcnt vmcnt(0)" ::: "memory");
  __syncthreads();
  for (int kt = 0; kt < KT; kt += 2) {
    g_dma(base, off, (kt + 1) * kstep, buf1, w);
    g_compute(buf0, ra, rb, acc);
    asm volatile("s_waitcnt vmcnt(0)" ::: "memory");
    __syncthreads();
    g_dma(base, off, min(kt + 2, KT - 1) * kstep, buf0, w);
    g_compute(buf1, ra, rb, acc);
    asm volatile("s_waitcnt vmcnt(0)" ::: "memory");
    __syncthreads();
  }
}

DI void zero_acc(f32x4 (&acc)[8][4]) {
#pragma unroll
  for (int i = 0; i < 8; ++i)
#pragma unroll
    for (int j = 0; j < 4; ++j) acc[i][j] = (f32x4){0.f, 0.f, 0.f, 0.f};
}

struct Slot { int xcd, slot; };
DI bool tile_order(const Slot sl, int it, int nN, int& mt, int& nt) {
  const int xcd = sl.xcd, slot = sl.slot, SL = gridDim.x >> 3;
  const int q = slot + it * SL, per = 8 * nN;
  if (q >= 2 * per) return false;
  const int mg = q / per, e = q - mg * per;
  nt = e >> 3; mt = xcd * 16 + mg * 8 + (e & 7);
  return true;
}

DI int inmap(int c) {
  if (c < 1024) return c;
  if (c < 1536) return c + 512;
  if (c < 2048) return c + 512;
  if (c < 2304) return c + 512;
  if (c < 2432) return c + 512;
  if (c < 2560) return c + 640;
  if (c < 3072) return c + 792;
  if (c < 4096) return c + 792;
  if (c < 5120) return c + 792;
  if (c < 5376) return c < 5144 ? c - 1792 : -1;
  if (c < 5888) return c - 4352;
  if (c < 6016) return c - 2944;
  return c - 2816;
}

DI void tr_tile(const float* __restrict__ src, int ld, int K, int k0, int n0, bool use_map, const float* __restrict__ scale, bf16_t* __restrict__ dst, int ldd, float* tile) {
  const int tid = my_tid();
  {
    const int nl = tid & 63, kk = tid >> 6;
    int n = n0 + nl; asm volatile("" : "+v"(n));
    const int sc = use_map ? inmap(n) : n;
#pragma unroll
    for (int r = 0; r < 8; ++r) {
      const int k = k0 + r * 8 + kk;
      float v = 0.f;
      if (sc >= 0) { v = src[(long)k * ld + sc]; if (scale) v *= scale[k]; }
      tile[(r * 8 + kk) * 65 + nl] = v;
    }
  }
  __syncthreads();
  {
    const int nl = tid >> 3, ks = tid & 7;
    unsigned o[4];
#pragma unroll
    for (int e = 0; e < 4; ++e) o[e] = pk2(tile[(ks * 8 + 2 * e) * 65 + nl], tile[(ks * 8 + 2 * e + 1) * 65 + nl]);
    *(u32x4*)(dst + (long)(n0 + nl) * ldd + k0 + ks * 8) = (u32x4){o[0], o[1], o[2], o[3]};
  }
  __syncthreads();
}

DI void tr_job(const float* src, int ld, int K, int N, bool use_map, const float* scale, bf16_t* dst, int ldd, float* tile) {
  const int nk = K >> 6, nn = N >> 6;
  for (int t = blockIdx.x; t < nk * nn; t += gridDim.x) tr_tile(src, ld, K, (t % nk) * 64, (t / nk) * 64, use_map, scale, dst, ldd, tile);
}

DI void convert_weights(const Params& p0, int l, unsigned char* lds) {
  const Params p = relaunder(p0);
  float* tile = (float*)lds;
  tr_job(p.w_in + (long)l * D_MODEL * N_IN, N_IN, D_MODEL, NP, true, p.norm_g + l * D_MODEL, p.wt_in(), LDX, tile);
  for (int kv = 0; kv < 2; ++kv) {
    tr_job(p.cmp_w1 + (long)(l * 2 + kv) * 2048 * 256, 256, 2048, 256, false, nullptr, p.w1t() + (long)kv * 256 * 2048, 2048, tile);
    tr_job(p.cmp_w2 + (long)(l * 2 + kv) * 256 * 64, 64, 256, 64, false, nullptr, p.w2t() + (long)kv * 64 * 256, 256, tile);
  }
  tr_job(p.w_up_a + (long)l * 512 * 1024, 1024, 512, 1024, false, nullptr, p.wupa_t(), 512, tile);
  tr_job(p.w_up_b + (long)l * 512 * 1024, 1024, 512, 1024, false, nullptr, p.wupb_t(), 512, tile);
  tr_job(p.w_out + (long)l * 1024 * 1024, 1024, 1024, 1024, false, nullptr, p.wout_t(), 1024, tile);
}

DI void phase_prologue(const Params& p, unsigned char* lds) {
  const int tid = my_tid();
  convert_weights(p, 0, lds);
  {
    const int lane = tid & 63;
    for (int wi = blockIdx.x * 8 + (tid >> 6); wi < DEPTH * 2 * 16 * 4; wi += gridDim.x * 8) {
      const int jq = wi & 3, kq = (wi >> 2) & 15, it = wi >> 6;
      const float* w1 = p.cmp_w1 + (long)it * 2048 * 256 + (long)kq * 128 * 256 + jq * 64 + lane; const float* pe = p.cmp_pe + (long)it * 2048 + kq * 128;
      float s0 = kq == 0 ? p.cmp_b1[it * 256 + jq * 64 + lane] : 0.f, s1 = 0.f, s2 = 0.f, s3 = 0.f;
#pragma unroll 4
      for (int k = 0; k < 128; k += 4) {
        s0 += pe[k] * w1[(long)k * 256]; s1 += pe[k + 1] * w1[(long)(k + 1) * 256]; s2 += pe[k + 2] * w1[(long)(k + 2) * 256]; s3 += pe[k + 3] * w1[(long)(k + 3) * 256];
      }
      p.b1eff()[(it * 16 + kq) * 256 + jq * 64 + lane] = (s0 + s1) + (s2 + s3);
    }
  }
  if (blockIdx.x == 1 && tid < DEPTH * 3) {
    const int l = tid / 3, br = tid % 3;
    float mq = 0.f, mk = 0.f;
    for (int d = 0; d < 64; ++d) { mq = fmaxf(mq, fabsf(p.q_norm_g[l * 64 + d])); mk = fmaxf(mk, fabsf(p.k_norm_g[(l * 3 + br) * 64 + d])); }
    p.mfix()[l * 4 + br] = 8.f * 1.44269504089f * mq * mk * 1.02f + 0.25f;
  }
  if (blockIdx.x == 0) { for (int i = tid; i < DEPTH * 64; i += NTHR) p.qng()[i] = p.q_norm_g[i]; for (int i = tid; i < DEPTH * 192; i += NTHR) p.kng()[i] = p.k_norm_g[i]; }
  const long gtid = (long)blockIdx.x * NTHR + tid, gn = (long)gridDim.x * NTHR;
  for (long i = gtid; i < (long)NTOK * 32; i += gn) {
    const int f = (int)(i & 31); const long tok = i >> 5;
    const float ang = (float)p.pos[tok] * inv_freq(f);
    float sn, cs; sincos_acc(ang, sn, cs);
    p.cosT()[i] = cs; p.sinT()[i] = sn;
  }
  for (long i = gtid; i < (long)BATCH * 128 * 32; i += gn) {
    const int f = (int)(i & 31); const int c = (int)((i >> 5) & 127); const int b = (int)(i >> 12);
    float cs = 1.f, sn = 0.f;
    if (c < NCMP) {
      float sum = 0.f;
      for (int k = 0; k < 32; ++k) sum += (float)p.pos[b * SEQ + c * 16 + k];
      const float ang = (sum * (1.f / 32.f)) * inv_freq(f);
      sincos_acc(ang, sn, cs);
    }
    p.cosC()[i] = cs; p.sinC()[i] = sn;
  }
  const int lane = tid & 63;
  for (long row = (long)blockIdx.x * 8 + (tid >> 6); row < NTOK; row += (long)gridDim.x * 8) {
    const float* xr = p.x_in + row * D_MODEL; bf16_t* xo = p.xb() + row * LDX;
    float ss = 0.f;
#pragma unroll
    for (int u = 0; u < 4; ++u) {
      const f32x4 v = *(const f32x4*)(xr + u * 256 + lane * 4);
      ss += v[0] * v[0] + v[1] * v[1] + v[2] * v[2] + v[3] * v[3];
      *(u32x2*)(xo + u * 256 + lane * 4) = (u32x2){pk2(v[0], v[1]), pk2(v[2], v[3])};
    }
#pragma unroll
    for (int o = 32; o >= 1; o >>= 1) ss += __shfl_xor(ss, o);
    if (lane < 8) p.part()[row * 16 + lane] = lane == 0 ? ss : 0.f;
  }
}

DI void phaseA_epilogue(const Params& p, int layer, int mt, int nt, const f32x4 (&acc)[8][4], const float* rs_s) {
  const int tid = my_tid(), lane = tid & 63, w = tid >> 6, wa = w >> 2, wb = w & 3, qi = lane & 15, quad = lane >> 4;
  if (nt >= 21) {
    bf16_t* dstb; int nh, head;
    if (nt < 23) { dstb = p.sbvt(); nh = 8; head = (nt - 21) * 4 + wb; } else if (wb < 2) { dstb = p.vst(); nh = 2; head = wb; } else { dstb = p.vwt(); nh = 2; head = wb - 2; }
    const int tok0 = mt * 256, b = tok0 >> 11, s0 = (tok0 & 2047) + wa * 128 + quad * 4;
#pragma unroll
    for (int i = 0; i < 8; ++i) {
      const int tl = wa * 128 + i * 16 + quad * 4;
      const float r0 = rs_s[tl], r1 = rs_s[tl + 1], r2 = rs_s[tl + 2], r3 = rs_s[tl + 3];
#pragma unroll
      for (int j = 0; j < 4; ++j) {
        const int d = j * 16 + qi;
        const f32x4 v = acc[i][j];
        bf16_t* dst = dstb + ((long)(b * nh + head) * 64 + d) * SEQ + s0 + i * 16;
        *(u32x2*)dst = (u32x2){pk2(v[0] * r0, v[1] * r1), pk2(v[2] * r2, v[3] * r3)};
      }
    }
    return;
  }
  const bool headtype = nt < 4 || (nt >= 6 && nt < 10);
#pragma unroll
  for (int j = 0; j < 4; ++j) {
    const int tl = wb * 64 + j * 16 + qi; const long tok = (long)mt * 256 + tl; const int b = (int)(tok >> 11), sq = (int)(tok & 2047);
    const float rs = rs_s[tl];
    if (headtype) {
#pragma unroll
      for (int ih = 0; ih < 2; ++ih) {
        const int hit = wa * 2 + ih;
        f32x4 v[4];
#pragma unroll
        for (int i = 0; i < 4; ++i) v[i] = acc[ih * 4 + i][j] * rs;
        bf16_t* dstb; int nh, head; const float* g = nullptr;
        if (nt < 2) { dstb = p.sbq(); nh = 8; head = nt * 4 + hit; }
        else if (nt < 4) { dstb = p.sbk(); nh = 8; head = (nt - 2) * 4 + hit; }
        else if (nt < 8) { dstb = p.nq(); nh = 8; head = (nt - 6) * 4 + hit; g = p.qng() + layer * 64; }
        else if (nt == 8) { dstb = hit < 2 ? p.kcr() : p.vcr(); nh = 2; head = hit & 1; }
        else { dstb = hit < 2 ? p.ks() : p.kw(); nh = 2; head = hit & 1; g = p.kng() + (layer * 3 + (hit < 2 ? 1 : 2)) * 64; }
        if (g) {
          float ss = 0.f;
#pragma unroll
          for (int i = 0; i < 4; ++i) ss += v[i][0] * v[i][0] + v[i][1] * v[i][1] + v[i][2] * v[i][2] + v[i][3] * v[i][3];
          ss += __shfl_xor(ss, 16); ss += __shfl_xor(ss, 32);
          const float rn = rsqrtf(ss * (1.f / 64.f) + NORM_EPS);
#pragma unroll
          for (int i = 0; i < 4; ++i) { const f32x4 gg = *(const f32x4*)(g + i * 16 + quad * 4); v[i] = v[i] * rn * gg; }
#pragma unroll
          for (int i = 0; i < 2; ++i) {
            const f32x4 cs = *(const f32x4*)(p.cosT() + tok * 32 + i * 16 + quad * 4), sn = *(const f32x4*)(p.sinT() + tok * 32 + i * 16 + quad * 4);
            const f32x4 x1 = v[i], x2 = v[i + 2];
            v[i] = x1 * cs - x2 * sn; v[i + 2] = x2 * cs + x1 * sn;
          }
        }
        bf16_t* dst = dstb + ((long)(b * nh + head) * SEQ + sq) * 64 + quad * 4;
#pragma unroll
        for (int i = 0; i < 4; ++i) *(u32x2*)(dst + i * 16) = (u32x2){pk2(v[i][0], v[i][1]), pk2(v[i][2], v[i][3])};
        asm volatile("" ::: "memory");
      }
    } else if (nt == 20) {
      if (wa == 0) {
#pragma unroll
        for (int i = 0; i < 2; ++i) {
          const int f = i * 16 + quad * 4;
          const f32x4 v = acc[i][j] * rs;
          if (f < 24) { const f32x4 o = {sigmoidf_(v[0]), sigmoidf_(v[1]), sigmoidf_(v[2]), sigmoidf_(v[3])}; *(f32x4*)(p.ngate() + tok * 32 + f) = o; }
        }
      }
    } else {
      bf16_t* dstb; int ldd, c0; bool sil;
      if (nt < 6) { dstb = p.sbz(); ldd = 512; c0 = (nt - 4) * 256; sil = true; }
      else if (nt < 12) { dstb = p.nz(); ldd = 512; c0 = (nt - 10) * 256; sil = true; }
      else if (nt < 16) { dstb = p.ga(); ldd = 1024; c0 = (nt - 12) * 256; sil = false; }
      else { dstb = p.gb(); ldd = 1024; c0 = (nt - 16) * 256; sil = false; }
      bf16_t* dst = dstb + tok * ldd + c0 + wa * 128 + quad * 4;
#pragma unroll
      for (int i = 0; i < 8; ++i) {
        const f32x4 v = acc[i][j] * rs;
        f32x4 o;
#pragma unroll
        for (int r = 0; r < 4; ++r) o[r] = sil ? siluf_(v[r]) : sigmoidf_(v[r]);
        *(u32x2*)(dst + i * 16) = (u32x2){pk2(o[0], o[1]), pk2(o[2], o[3])};
      }
    }
    asm volatile("" ::: "memory");
  }
}

DI void phaseA(const Params& p0, const Slot sl, int layer, unsigned char* lds, int fake = 0) {
  const Params p = relaunder(p0);
  bf16_t* gl = (bf16_t*)lds; float* rs_s = (float*)(lds + LDS_GEMM_BYTES);
  const bf16_t* Wt = p.wt_in();
  int mt, nt;
  for (int it = 0; tile_order(sl, it, NT_IN, mt, nt); ++it) {
    if (my_tid() < 256) {
      const float* pp = p.part() + ((long)mt * 256 + my_tid()) * 16;
      const f32x4 v0 = *(const f32x4*)pp, v1 = *(const f32x4*)(pp + 4);
      const float s = ((v0[0] + v0[1]) + (v0[2] + v0[3])) + ((v1[0] + v1[1]) + (v1[2] + v1[3]));
      rs_s[my_tid()] = rsqrtf(s * (1.f / 1024.f) + NORM_EPS);
    }
    const int mtl = fake == 3 ? 0 : (fake == 4 ? sl.xcd * 16 + (sl.slot & 7) : mt), ntl = fake == 3 ? 0 : (fake == 4 ? (sl.slot >> 3) : nt);
    const bf16_t* Xg = p.xb() + (long)mtl * 256 * LDX; const bf16_t* Wg = Wt + (long)ntl * 256 * LDX;
    f32x4 acc[8][4]; zero_acc(acc);
    const int kstep = (fake == 1 || fake == 2) ? 0 : 64;
    gemm_core(nt >= 21 ? Xg : Wg, LDX, nt >= 21 ? Wg : Xg, LDX, D_MODEL, gl, acc, kstep);
    if (!fake) phaseA_epilogue(p, layer, mt, nt, acc, rs_s);
    else if (acc[0][0][0] == 123.456f && acc[7][3][3] == 5.f) p.dummy()[0] = 1;
    __syncthreads();
  }
}

DI void compress_partial(const Params& p, int ci, unsigned char* lds) {
  bf16_t* gl = (bf16_t*)lds;
  const int split = ci & 3, item = ci >> 2, kv = item & 1, pair = item >> 1;
  const bf16_t* src = (kv ? p.vcr() : p.kcr()) + (long)pair * 256 * 1024 + split * 512;
  const bf16_t* W1 = p.w1t() + (long)kv * 256 * 2048 + split * 512;
  f32x4 acc[8][4]; zero_acc(acc);
  gemm_core(W1, 2048, src, 1024, 512, gl, acc);
  const int tid = my_tid(), lane = tid & 63, w = tid >> 6, wa = w >> 2, wb = w & 3, qi = lane & 15, quad = lane >> 4;
  float* dst = p.hpre() + ((long)(split * 32 + item) * 256) * 256;
#pragma unroll
  for (int i = 0; i < 8; ++i)
#pragma unroll
    for (int j = 0; j < 4; ++j) *(f32x4*)(dst + (long)(wb * 64 + j * 16 + qi) * 256 + wa * 128 + i * 16 + quad * 4) = acc[i][j];
}

DI void phaseB2(const Params& p0, int layer, unsigned char* lds) {
  const Params p = relaunder(p0);
  const int tid = my_tid(), lane = tid & 63, w = tid >> 6, qi = lane & 15, quad = lane >> 4;
  float* bias_s = (float*)lds;
  {
    const float* b1 = p.b1eff() + (long)(layer * 2 + (tid >> 8)) * 16 * 256 + (tid & 255);
    float sacc = 0.f;
#pragma unroll
    for (int kq = 0; kq < 16; ++kq) sacc += b1[kq * 256];
    bias_s[tid] = sacc;
  }
  __syncthreads();
  const int wi = blockIdx.x * 2 + w;
  if (w < 2 && wi < 32 * 16) {
    const int item = wi >> 4, r16 = wi & 15, kv = item & 1, pair = item >> 1;
    const int row = r16 * 16 + qi;
    const bf16_t* W2 = p.w2t() + (long)kv * 64 * 256;
    const float* hp = p.hpre() + ((long)item * 256 + row) * 256 + quad * 8;
    f32x4 o[4];
#pragma unroll
    for (int dt = 0; dt < 4; ++dt) o[dt] = (f32x4){0.f, 0.f, 0.f, 0.f};
#pragma unroll 1
    for (int ksx = 0; ksx < 8; ++ksx) {
      f32x4 h0 = *(const f32x4*)(bias_s + kv * 256 + ksx * 32 + quad * 8), h1 = *(const f32x4*)(bias_s + kv * 256 + ksx * 32 + quad * 8 + 4);
#pragma unroll
      for (int sp = 0; sp < 4; ++sp) { const float* q = hp + (long)sp * 32 * 256 * 256 + ksx * 32; h0 += *(const f32x4*)q; h1 += *(const f32x4*)(q + 4); }
      const bf16x8 hf = mk8((u32x4){pk2(siluf_(h0[0]), siluf_(h0[1])), pk2(siluf_(h0[2]), siluf_(h0[3])), pk2(siluf_(h1[0]), siluf_(h1[1])), pk2(siluf_(h1[2]), siluf_(h1[3]))});
#pragma unroll
      for (int dt = 0; dt < 4; ++dt) {
        const bf16x8 wf = ld8(W2 + (long)(dt * 16 + qi) * 256 + ksx * 32 + quad * 8);
        o[dt] = kv ? MFMA16(hf, wf, o[dt]) : MFMA16(wf, hf, o[dt]);
      }
    }
    const int bg = pair * 2 + (r16 >> 3);
    if (kv == 0) {
      const float* g = p.kng() + (layer * 3 + 0) * 64;
      const int b = bg >> 1, c = (r16 & 7) * 16 + qi;
      float ss = 0.f;
#pragma unroll
      for (int dt = 0; dt < 4; ++dt) ss += o[dt][0] * o[dt][0] + o[dt][1] * o[dt][1] + o[dt][2] * o[dt][2] + o[dt][3] * o[dt][3];
      ss += __shfl_xor(ss, 16); ss += __shfl_xor(ss, 32);
      const float rn = rsqrtf(ss * (1.f / 64.f) + NORM_EPS);
#pragma unroll
      for (int dt = 0; dt < 4; ++dt) { const f32x4 gg = *(const f32x4*)(g + dt * 16 + quad * 4); o[dt] = o[dt] * rn * gg; }
#pragma unroll
      for (int dt = 0; dt < 2; ++dt) {
        const long ti = ((long)b * 128 + c) * 32 + dt * 16 + quad * 4;
        const f32x4 cs = *(const f32x4*)(p.cosC() + ti), sn = *(const f32x4*)(p.sinC() + ti);
        const f32x4 x1 = o[dt], x2 = o[dt + 2];
        o[dt] = x1 * cs - x2 * sn; o[dt + 2] = x2 * cs + x1 * sn;
      }
      bf16_t* dst = p.kc() + ((long)bg * 128 + c) * 64 + quad * 4;
#pragma unroll
      for (int dt = 0; dt < 4; ++dt) {
        u32x2 ov = (u32x2){pk2(o[dt][0], o[dt][1]), pk2(o[dt][2], o[dt][3])};
        if (c >= NCMP) ov = (u32x2){0u, 0u};
        *(u32x2*)(dst + dt * 16) = ov;
      }
    } else {
#pragma unroll
      for (int dt = 0; dt < 4; ++dt) {
        const int c0 = (r16 & 7) * 16 + quad * 4;
        f32x4 v = o[dt];
        if (c0 + 3 >= NCMP) v[3] = 0.f;
        *(u32x2*)(p.vct() + ((long)bg * 64 + dt * 16 + qi) * 128 + c0) = (u32x2){pk2(v[0], v[1]), pk2(v[2], v[3])};
      }
    }
  }
  __syncthreads();
}

DI void sb_attn_wave(const Params& p, int b, int h, int t0, bf16_t* ybase) {
  const int lane = my_tid() & 63, qi = lane & 15, quad = lane >> 4;
  const bf16_t* Q = p.sbq() + (long)(b * 8 + h) * SEQ * 64;
  const bf16_t* K = p.sbk() + (long)(b * 8 + h) * SEQ * 64;
  const bf16_t* Vt = p.sbvt() + (long)(b * 8 + h) * 64 * SEQ;
  const int t = t0 + qi;
  bf16x8 qf[2];
  qf[0] = ld8(Q + (long)t * 64 + quad * 8); qf[1] = ld8(Q + (long)t * 64 + 32 + quad * 8);
  f32x4 o[4];
#pragma unroll
  for (int dt = 0; dt < 4; ++dt) o[dt] = (f32x4){0.f, 0.f, 0.f, 0.f};
  float carry = 0.f;
  const int krow = 8 * (qi >> 2) + (qi & 3);
  const bf16_t* kp0 = K + (long)krow * 64 + quad * 8;
  const bf16_t* vp0 = Vt + (long)qi * SEQ + 8 * quad;
  int kb = t0 & ~31;
  bf16x8 kf[2][2], vf[4];
#pragma unroll
  for (int a = 0; a < 2; ++a) { kf[a][0] = ld8(kp0 + (long)(kb + 4 * a) * 64); kf[a][1] = ld8(kp0 + (long)(kb + 4 * a) * 64 + 32); }
#pragma unroll
  for (int dt = 0; dt < 4; ++dt) vf[dt] = ld8(vp0 + (long)dt * 16 * SEQ + kb);
  for (; kb >= 0; kb -= 32) {
    bf16x8 kn[2][2], vn[4];
    const int kbn = kb >= 32 ? kb - 32 : 0;
#pragma unroll
    for (int a = 0; a < 2; ++a) { kn[a][0] = ld8(kp0 + (long)(kbn + 4 * a) * 64); kn[a][1] = ld8(kp0 + (long)(kbn + 4 * a) * 64 + 32); }
#pragma unroll
    for (int dt = 0; dt < 4; ++dt) vn[dt] = ld8(vp0 + (long)dt * 16 * SEQ + kbn);
    f32x4 s[2];
#pragma unroll
    for (int a = 0; a < 2; ++a) {
      s[a] = MFMA16(kf[a][0], qf[0], ((f32x4){0.f, 0.f, 0.f, 0.f}));
      s[a] = MFMA16(kf[a][1], qf[1], s[a]);
    }
    float L[8], ls[8]; bool val[8];
    float tot = 0.f;
#pragma unroll
    for (int idx = 0; idx < 8; ++idx) {
      const float z = s[idx >> 2][idx & 3] * 0.125f;
      const int key = kb + 8 * quad + idx;
      val[idx] = key < t;
      const float sp = fmaxf(z, 0.f) + __logf(1.f + __expf(-fabsf(z)));
      L[idx] = val[idx] ? -sp : 0.f;
      ls[idx] = z - sp;
      tot += L[idx];
    }
    const float a1 = __shfl_xor(tot, 16), a2 = __shfl_xor(tot, 32), a3 = __shfl_xor(a1, 32);
    const float higher = ((quad ^ 1) > quad ? a1 : 0.f) + ((quad ^ 2) > quad ? a2 : 0.f) + ((quad ^ 3) > quad ? a3 : 0.f);
    float run = carry + higher;
    float wv[8];
#pragma unroll
    for (int idx = 7; idx >= 0; --idx) {
      wv[idx] = val[idx] ? __expf(ls[idx] + run) : 0.f;
      run += L[idx];
    }
    carry += (tot + a1) + (a2 + a3);
    const bf16x8 pf = mk8((u32x4){pk2(wv[0], wv[1]), pk2(wv[2], wv[3]), pk2(wv[4], wv[5]), pk2(wv[6], wv[7])});
#pragma unroll
    for (int dt = 0; dt < 4; ++dt) o[dt] = MFMA16(vf[dt], pf, o[dt]);
    if (__all(carry < -110.f)) break;
#pragma unroll
    for (int a = 0; a < 2; ++a) { kf[a][0] = kn[a][0]; kf[a][1] = kn[a][1]; }
#pragma unroll
    for (int dt = 0; dt < 4; ++dt) vf[dt] = vn[dt];
  }
  const long zo = ((long)b * SEQ + t) * 512 + h * 64 + quad * 4;
  const bf16_t* zp = p.sbz() + zo; bf16_t* yp = ybase + zo;
#pragma unroll
  for (int dt = 0; dt < 4; ++dt) {
    const u32x2 zz = *(const u32x2*)(zp + dt * 16);
    *(u32x2*)(yp + dt * 16) = (u32x2){pk2(o[dt][0] * bflo(zz[0]), o[dt][1] * bfhi(zz[0])), pk2(o[dt][2] * bflo(zz[1]), o[dt][3] * bfhi(zz[1]))};
  }
}

DI void phaseB(const Params& p0, int layer, unsigned char* lds, bool probe) {
  const int NITEM = 128 + BATCH * 8 * 16;
  for (int it = blockIdx.x; it < NITEM; it += gridDim.x) {
    const Params p = relaunder(p0);
    if (it < 128) { compress_partial(p, it, lds); continue; }
    const int i = it - 128, qt = 15 - (i >> 7), bh = i & 127;
    sb_attn_wave(p, bh >> 3, bh & 7, qt * 128 + (my_tid() >> 6) * 16, probe ? p.dummy() : p.sbz());
  }
}

constexpr int NSA_LO_BYTES = 8 * 8192;
constexpr int NSA_KROW = 144, NSA_VROW = 80;
constexpr int NSA_SLOT = 32 * NSA_KROW + 64 * NSA_VROW;
constexpr int NSA_SLOT0 = NSA_LO_BYTES, NSA_BLIST = NSA_SLOT0 + 2 * NSA_SLOT, NSA_UMW = NSA_BLIST + 64 * 4;

struct KVFrag { bf16x8 k[2][2]; bf16x8 v[4]; };
DI void nsa_ldsfrag(KVFrag& f, const unsigned char* slot, int qi, int quad) {
  const int krow = 8 * (qi >> 2) + (qi & 3);
#pragma unroll
  for (int a = 0; a < 2; ++a) { const unsigned char* kp = slot + (krow + 4 * a) * NSA_KROW + quad * 16; f.k[a][0] = mk8(*(const u32x4*)kp); f.k[a][1] = mk8(*(const u32x4*)(kp + 64)); }
#pragma unroll
  for (int dt = 0; dt < 4; ++dt) f.v[dt] = mk8(*(const u32x4*)(slot + 32 * NSA_KROW + (dt * 16 + qi) * NSA_VROW + quad * 16));
}
template <int MODE>
DI void nsa_chunk(const KVFrag& f, int kb, int t, bool selbit, const bf16x8 (&qf)[4][2], f32x4 (&O)[4][4], float (&m)[4], float (&l)[4], int quad, bool online) {
  const float SC = 0.125f * 1.44269504089f;
  bool val[8];
#pragma unroll
  for (int idx = 0; idx < 8; ++idx) {
    const int key = kb + 8 * quad + idx;
    val[idx] = MODE == 0 ? (selbit && key <= t) : (key <= t && key > t - 512);
  }
#pragma unroll
  for (int hh = 0; hh < 4; ++hh) {
    f32x4 s[2];
#pragma unroll
    for (int a = 0; a < 2; ++a) { s[a] = MFMA16(f.k[a][0], qf[hh][0], ((f32x4){0.f, 0.f, 0.f, 0.f})); s[a] = MFMA16(f.k[a][1], qf[hh][1], s[a]); }
    float mn = m[hh];
    if (online) {
      float cm = -1e30f;
#pragma unroll
      for (int idx = 0; idx < 8; ++idx) if (val[idx]) cm = fmaxf(cm, s[idx >> 2][idx & 3] * SC);
      cm = fmaxf(cm, __shfl_xor(cm, 16)); cm = fmaxf(cm, __shfl_xor(cm, 32));
      mn = fmaxf(mn, cm);
      const float alpha = __builtin_amdgcn_exp2f(m[hh] - mn);
      m[hh] = mn; l[hh] *= alpha;
#pragma unroll
      for (int dt = 0; dt < 4; ++dt) O[hh][dt] = O[hh][dt] * alpha;
    }
    float pv[8]; float ps = 0.f;
#pragma unroll
    for (int idx = 0; idx < 8; ++idx) { pv[idx] = val[idx] ? __builtin_amdgcn_exp2f(fmaf(s[idx >> 2][idx & 3], SC, -mn)) : 0.f; ps += pv[idx]; }
    l[hh] += ps;
    const bf16x8 pf = mk8((u32x4){pk2(pv[0], pv[1]), pk2(pv[2], pv[3]), pk2(pv[4], pv[5]), pk2(pv[6], pv[7])});
#pragma unroll
    for (int dt = 0; dt < 4; ++dt) O[hh][dt] = MFMA16(f.v[dt], pf, O[hh][dt]);
  }
}

template <int MODE>
DI void nsa_branch(const bf16_t* __restrict__ Kb, const bf16_t* __restrict__ Vtb, unsigned char* lds, int nb, int t, int cur, unsigned selmask, unsigned umall,
                   const bf16x8 (&qf)[4][2], f32x4 (&O)[4][4], float (&m)[4], float (&l)[4], bool online) {
  const int tid = my_tid(), lane = tid & 63, qi = lane & 15, quad = lane >> 4;
  const int* blist = (const int*)(lds + NSA_BLIST);
  const bool isv = tid >= 256;
  const int t2 = tid & 255;
  const bf16_t* gsrc = isv ? Vtb + (long)(t2 >> 2) * SEQ + (t2 & 3) * 8 : Kb + (long)(t2 >> 3) * 64 + (t2 & 7) * 8;
  const long gmul = isv ? 1 : 64;
  const int ldst = isv ? 32 * NSA_KROW + (t2 >> 2) * NSA_VROW + (t2 & 3) * 16 : (t2 >> 3) * NSA_KROW + (t2 & 7) * 16;
  unsigned char* slot0 = lds + NSA_SLOT0; unsigned char* slot1 = slot0 + NSA_SLOT;
  const int N = 2 * nb;
  auto kbof = [&](int n) { return blist[n >> 1] * 64 + (n & 1) * 32; };
  u32x4 ra = *(const u32x4*)(gsrc + (long)kbof(0) * gmul), rb = *(const u32x4*)(gsrc + (long)kbof(1) * gmul);
  *(u32x4*)(slot0 + ldst) = ra;
  __syncthreads();
#pragma unroll 1
  for (int n = 0; n < N; n += 2) {
    const int j = blist[n >> 1];
    const bool won = MODE == 0 ? ((umall >> j) & 1u) != 0 : (j >= cur - 8 && j <= cur);
    const bool bit = (selmask >> j) & 1u;
    ra = *(const u32x4*)(gsrc + (long)kbof(min(n + 2, N - 2)) * gmul);
    if (won) { KVFrag f; nsa_ldsfrag(f, slot0, qi, quad); nsa_chunk<MODE>(f, j * 64, t, bit, qf, O, m, l, quad, online); }
    *(u32x4*)(slot1 + ldst) = rb;
    __syncthreads();
    rb = *(const u32x4*)(gsrc + (long)kbof(min(n + 3, N - 1)) * gmul);
    if (won) { KVFrag f; nsa_ldsfrag(f, slot1, qi, quad); nsa_chunk<MODE>(f, j * 64 + 32, t, bit, qf, O, m, l, quad, online); }
    *(u32x4*)(slot0 + ldst) = ra;
    __syncthreads();
  }
}

template <bool LAST>
DI void nsa_finish(u32x2* lo, f32x4 (&O)[4][4], float (&m)[4], float (&l)[4], const float (&gate)[4], const bf16_t* zp, bf16_t* yp, float minit) {
#pragma unroll
  for (int hh = 0; hh < 4; ++hh) {
    float lt = l[hh]; lt += __shfl_xor(lt, 16); lt += __shfl_xor(lt, 32);
    const float f = lt > 0.f ? gate[hh] / lt : 0.f;
#pragma unroll
    for (int dt = 0; dt < 4; ++dt) {
      const u32x2 a = lo[(hh * 4 + dt) * 64];
      const f32x4 v = (f32x4){bflo(a[0]), bfhi(a[0]), bflo(a[1]), bfhi(a[1])} + O[hh][dt] * f;
      if (LAST) {
        const u32x2 zz = *(const u32x2*)(zp + hh * 64 + dt * 16);
        *(u32x2*)(yp + hh * 64 + dt * 16) = (u32x2){pk2(v[0] * bflo(zz[0]), v[1] * bfhi(zz[0])), pk2(v[2] * bflo(zz[1]), v[3] * bfhi(zz[1]))};
      } else {
        lo[(hh * 4 + dt) * 64] = (u32x2){pk2(v[0], v[1]), pk2(v[2], v[3])};
        O[hh][dt] = (f32x4){0.f, 0.f, 0.f, 0.f};
      }
    }
    m[hh] = minit; l[hh] = 0.f;
  }
}

DI void nsa_wave(const Params& p, int layer, int b, int g, int t0, unsigned char* lds, bf16_t* ybase) {
  const int lane = my_tid() & 63, qi = lane & 15, quad = lane >> 4;
  const int t = t0 + qi, cur = t0 >> 6;
  const long tok = (long)b * SEQ + t;
  const int bg = b * 2 + g;
  u32x2* lo = (u32x2*)lds + (my_tid() >> 6) * 1024 + lane;

  const float mf_c = p.mfix()[layer * 4 + 0], mf_s = p.mfix()[layer * 4 + 1], mf_w = p.mfix()[layer * 4 + 2];
  const bool on_c = mf_c > 60.f, on_s = mf_s > 60.f, on_w = mf_w > 60.f;
  const float SC = 0.125f * 1.44269504089f;
  const bf16_t* Kc = p.kc() + (long)bg * 128 * 64;
  const bf16_t* Vc = p.vct() + (long)bg * 64 * 128;
  f32x4 ph[8];
#pragma unroll
  for (int kt = 0; kt < 8; ++kt) ph[kt] = (f32x4){0.f, 0.f, 0.f, 0.f};
#pragma unroll 1
  for (int hh = 0; hh < 4; ++hh) {
    const bf16_t* qp0 = p.nq() + ((long)(b * 8 + g * 4 + hh) * SEQ + t) * 64 + quad * 8;
    const bf16x8 q0 = ld8(qp0), q1 = ld8(qp0 + 32); const float gt = p.ngate()[tok * 32 + g * 4 + hh];
    f32x4 sc[8];
    float mx = on_c ? -1e30f : mf_c;
#pragma unroll
    for (int kt = 0; kt < 8; ++kt) {
      const bf16_t* kp = Kc + (long)(kt * 16 + qi) * 64 + quad * 8;
      sc[kt] = MFMA16(ld8(kp), q0, ((f32x4){0.f, 0.f, 0.f, 0.f}));
      sc[kt] = MFMA16(ld8(kp + 32), q1, sc[kt]);
      sc[kt] = sc[kt] * SC;
    }
    if (on_c) {
#pragma unroll
      for (int kt = 0; kt < 8; ++kt)
#pragma unroll
        for (int r = 0; r < 4; ++r) { const int c = kt * 16 + quad * 4 + r; if (c < NCMP && 16 * c + 31 <= t) mx = fmaxf(mx, sc[kt][r]); }
      mx = fmaxf(mx, __shfl_xor(mx, 16)); mx = fmaxf(mx, __shfl_xor(mx, 32));
    }
    float sum = 0.f;
#pragma unroll
    for (int kt = 0; kt < 8; ++kt)
#pragma unroll
      for (int r = 0; r < 4; ++r) {
        const int c = kt * 16 + quad * 4 + r;
        const float e = (c < NCMP && 16 * c + 31 <= t) ? __builtin_amdgcn_exp2f(sc[kt][r] - mx) : 0.f;
        sc[kt][r] = e; sum += e;
      }
    sum += __shfl_xor(sum, 16); sum += __shfl_xor(sum, 32);
    const float inv = sum > 0.f ? 1.f / sum : 0.f;
#pragma unroll
    for (int kt = 0; kt < 8; ++kt) { sc[kt] = sc[kt] * inv; ph[kt] += sc[kt]; }
    f32x4 oc[4];
#pragma unroll
    for (int dt = 0; dt < 4; ++dt) oc[dt] = (f32x4){0.f, 0.f, 0.f, 0.f};
#pragma unroll
    for (int mm = 0; mm < 4; ++mm) {
      const bf16x8 pf = mk8((u32x4){pk2(sc[2 * mm][0], sc[2 * mm][1]), pk2(sc[2 * mm][2], sc[2 * mm][3]), pk2(sc[2 * mm + 1][0], sc[2 * mm + 1][1]), pk2(sc[2 * mm + 1][2], sc[2 * mm + 1][3])});
#pragma unroll
      for (int dt = 0; dt < 4; ++dt) {
        const bf16_t* vp = Vc + (long)(dt * 16 + qi) * 128 + 32 * mm + quad * 4;
        const u32x2 lo = *(const u32x2*)vp, hi = *(const u32x2*)(vp + 16);
        oc[dt] = MFMA16(mk8((u32x4){lo[0], lo[1], hi[0], hi[1]}), pf, oc[dt]);
      }
    }
#pragma unroll
    for (int dt = 0; dt < 4; ++dt) { const f32x4 v = oc[dt] * gt; lo[(hh * 4 + dt) * 64] = (u32x2){pk2(v[0], v[1]), pk2(v[2], v[3])}; }
  }
  float imp[8];
  {
    float rot[8];
#pragma unroll
    for (int kt = 0; kt < 8; ++kt) rot[kt] = __shfl(ph[kt][3], (lane + 48) & 63);
#pragma unroll
    for (int kt = 0; kt < 8; ++kt) {
      const float extra = quad > 0 ? rot[kt] : (kt > 0 ? rot[kt > 0 ? kt - 1 : 0] : 0.f);
      const float v = (ph[kt][0] + ph[kt][1]) + (ph[kt][2] + ph[kt][3]) + extra;
      const int j = 4 * kt + quad;
      const bool forced = j == 0 || j == cur || j == cur - 1;
      imp[kt] = j <= cur ? v + (forced ? 1e4f : 0.f) : -1e30f;
    }
  }
  unsigned selmask = 0;
  {
    int rank[8];
#pragma unroll
    for (int kt = 0; kt < 8; ++kt) rank[kt] = 0;
#pragma unroll 1
    for (int q2 = 0; q2 < 4; ++q2)
#pragma unroll
      for (int k2 = 0; k2 < 8; ++k2) {
        const float ov = __shfl(imp[k2], qi + 16 * q2);
#pragma unroll
        for (int kt = 0; kt < 8; ++kt) {
          const bool before = k2 < kt || (k2 == kt && q2 < quad);
          rank[kt] += (ov > imp[kt] || (ov == imp[kt] && before)) ? 1 : 0;
        }
      }
#pragma unroll
    for (int kt = 0; kt < 8; ++kt) if (rank[kt] < 8 && 4 * kt + quad <= cur) selmask |= 1u << (4 * kt + quad);
    selmask |= __shfl_xor(selmask, 16); selmask |= __shfl_xor(selmask, 32);
  }

  unsigned umall = selmask;
  umall |= __shfl_xor(umall, 1); umall |= __shfl_xor(umall, 2); umall |= __shfl_xor(umall, 4); umall |= __shfl_xor(umall, 8);
  umall = __builtin_amdgcn_readfirstlane(umall);
  const int wv = my_tid() >> 6;
  unsigned* umw = (unsigned*)(lds + NSA_UMW); int* blist = (int*)(lds + NSA_BLIST);
  if (lane == 0) umw[wv] = umall;
  bf16x8 qf[4][2];
#pragma unroll
  for (int hh = 0; hh < 4; ++hh) {
    const bf16_t* qp = p.nq() + ((long)(b * 8 + g * 4 + hh) * SEQ + t) * 64 + quad * 8;
    qf[hh][0] = ld8(qp); qf[hh][1] = ld8(qp + 32);
  }
  float gate[3][4];
#pragma unroll
  for (int br = 1; br < 3; ++br) { const f32x4 gv = *(const f32x4*)(p.ngate() + tok * 32 + br * 8 + g * 4); gate[br][0] = gv[0]; gate[br][1] = gv[1]; gate[br][2] = gv[2]; gate[br][3] = gv[3]; }
  f32x4 O[4][4]; float m[4], l[4];
#pragma unroll
  for (int hh = 0; hh < 4; ++hh) { m[hh] = on_s ? -1e30f : mf_s; l[hh] = 0.f;
#pragma unroll
    for (int dt = 0; dt < 4; ++dt) O[hh][dt] = (f32x4){0.f, 0.f, 0.f, 0.f}; }
  __syncthreads();
  int nb;
  {
    unsigned ub = 0;
#pragma unroll
    for (int i = 0; i < 8; ++i) ub |= umw[i];
    nb = __builtin_popcount(ub);
    if (my_tid() < 32) { if ((ub >> my_tid()) & 1u) blist[__builtin_popcount(ub & ((1u << my_tid()) - 1u))] = my_tid(); }
    __syncthreads();
    nsa_branch<0>(p.ks() + (long)bg * SEQ * 64, p.vst() + (long)bg * 64 * SEQ, lds, nb, t, cur, selmask, umall, qf, O, m, l, on_s);
    nsa_finish<false>(lo, O, m, l, gate[1], nullptr, nullptr, on_w ? -1e30f : mf_w);
  }
  {
    const int cur0 = (t0 >> 7) * 2, jlo = cur0 >= 8 ? cur0 - 8 : 0;
    nb = cur0 + 2 - jlo;
    if (my_tid() < nb) blist[my_tid()] = jlo + my_tid();
    __syncthreads();
    nsa_branch<1>(p.kw() + (long)bg * SEQ * 64, p.vwt() + (long)bg * 64 * SEQ, lds, nb, t, cur, selmask, umall, qf, O, m, l, on_w);
    nsa_finish<true>(lo, O, m, l, gate[2], p.nz() + tok * 512 + g * 256 + quad * 4, ybase + tok * 512 + g * 256 + quad * 4, 0.f);
  }
  __syncthreads();
}

DI void phaseC(const Params& p0, int layer, unsigned char* lds, bool probe) {
  const int NITEM = BATCH * 2 * 16;
  for (int it = blockIdx.x; it < NITEM; it += gridDim.x) {
    const Params p = relaunder(p0);
    const int qt = 15 - (it >> 5), bg = it & 31;
    nsa_wave(p, layer, bg >> 1, bg & 1, qt * 128 + (my_tid() >> 6) * 16, lds, probe ? p.dummy() : p.nz());
  }
}

DI void phaseD(const Params& p0, const Slot sl, int layer, unsigned char* lds) {
  const Params p = relaunder(p0);
  bf16_t* gl = (bf16_t*)lds;
  int mt, nt;
  for (int it = 0; tile_order(sl, it, 4, mt, nt); ++it) {
#pragma unroll 1
    for (int which = 0; which < 2; ++which) {
      const bf16_t* Wg = (which ? p.wupb_t() : p.wupa_t()) + ((long)nt * 256) * 512;
      const bf16_t* Yg = (which ? p.nz() : p.sbz()) + (long)mt * 256 * 512;
      const bf16_t* Gg = which ? p.gb() : p.ga();
      f32x4 acc[8][4]; zero_acc(acc);
      gemm_core(Wg, 512, Yg, 512, 512, gl, acc);
      const int tid = my_tid(), lane = tid & 63, w = tid >> 6, wa = w >> 2, wb = w & 3, qi = lane & 15, quad = lane >> 4;
#pragma unroll
      for (int j = 0; j < 4; ++j) {
        const long tok = (long)mt * 256 + wb * 64 + j * 16 + qi;
#pragma unroll
        for (int i = 0; i < 8; ++i) {
          const long off = tok * 1024 + nt * 256 + wa * 128 + i * 16 + quad * 4;
          const u32x2 xg = *(const u32x2*)(Gg + off);
          const f32x4 v = acc[i][j];
          float o0 = bflo(xg[0]) * v[0], o1 = bfhi(xg[0]) * v[1], o2 = bflo(xg[1]) * v[2], o3 = bfhi(xg[1]) * v[3];
          if (which) { const u32x2 a = *(const u32x2*)(p.merged() + off); o0 += bflo(a[0]); o1 += bfhi(a[0]); o2 += bflo(a[1]); o3 += bfhi(a[1]); }
          *(u32x2*)(p.merged() + off) = (u32x2){pk2(o0, o1), pk2(o2, o3)};
          if ((i & 3) == 3) asm volatile("" ::: "memory");
        }
      }
    }
  }
}

DI void phaseE(const Params& p0, const Slot sl, int layer, unsigned char* lds, const float* xsrc) {
  const Params p = relaunder(p0);
  bf16_t* gl = (bf16_t*)lds;
  int mt, nt;
  for (int it = 0; tile_order(sl, it, 4, mt, nt); ++it) {
    f32x4 acc[8][4]; zero_acc(acc);
    gemm_core(p.wout_t() + ((long)nt * 256) * 1024, 1024, p.merged() + (long)mt * 256 * 1024, 1024, 1024, gl, acc);
    const int tid = my_tid(), lane = tid & 63, w = tid >> 6, wa = w >> 2, wb = w & 3, qi = lane & 15, quad = lane >> 4;
#pragma unroll
    for (int j = 0; j < 4; ++j) {
      const long tok = (long)mt * 256 + wb * 64 + j * 16 + qi;
      float ss = 0.f;
#pragma unroll
      for (int i = 0; i < 8; ++i) {
        const long off = tok * 1024 + nt * 256 + wa * 128 + i * 16 + quad * 4;
        const f32x4 xo = *(const f32x4*)(xsrc + off);
        const f32x4 xn = xo + acc[i][j];
        *(f32x4*)(p.out + off) = xn;
        *(u32x2*)(p.xb() + off + tok * (LDX - D_MODEL)) = (u32x2){pk2(xn[0], xn[1]), pk2(xn[2], xn[3])};
        ss += xn[0] * xn[0] + xn[1] * xn[1] + xn[2] * xn[2] + xn[3] * xn[3];
      }
      ss += __shfl_xor(ss, 16); ss += __shfl_xor(ss, 32);
      if (quad == 0) p.part()[tok * 16 + nt * 2 + wa] = ss;
    }
  }
}

#ifndef STOP_AFTER
#define STOP_AFTER 0
#endif
constexpr int LDS_BYTES = LDS_GEMM_BYTES + 1024;

__global__ void __launch_bounds__(512) hybrid_megakernel(Params p) {
  extern __shared__ __attribute__((aligned(16))) unsigned char lds[];
  cg::grid_group grid = cg::this_grid();
  __shared__ int s_xcc, s_rank, s_ok;
  if (threadIdx.x == 0) {
    const unsigned xcc = (unsigned)__builtin_amdgcn_s_getreg((3 << 11) | 20) & 7u;
    s_xcc = (int)xcc; s_rank = (int)atomicAdd(p.ctl() + xcc, 1u);
  }
  phase_prologue(p, lds);
  grid.sync();
  if (threadIdx.x == 0) {
    int ok = 1;
    for (int i = 0; i < 8; ++i) ok &= (__hip_atomic_load(p.ctl() + i, __ATOMIC_RELAXED, __HIP_MEMORY_SCOPE_AGENT) == (gridDim.x >> 3));
    s_ok = ok;
  }
  __syncthreads();
  const Slot sl = {s_ok ? s_xcc : (int)(blockIdx.x & 7), s_ok ? s_rank : (int)(blockIdx.x >> 3)};
  for (int layer = 0; layer < DEPTH; ++layer) {
    if (layer > 0) { convert_weights(p, layer, lds); grid.sync(); }
    if (STOP_AFTER != 0 && STOP_AFTER == layer * 10) return;
    phaseA(p, sl, layer, lds);
    grid.sync();
#ifdef PROBE_A
    phaseA(p, sl, layer, lds, PROBE_A >= 2 ? PROBE_A : 0);
    grid.sync();
#endif
    if (STOP_AFTER == layer * 10 + 1) return;
#ifdef PROBE_B
    phaseB(p, layer, lds, true);
    grid.sync();
#endif
    phaseB(p, layer, lds, false);
    grid.sync();
    phaseB2(p, layer, lds);
    grid.sync();
    if (STOP_AFTER == layer * 10 + 2) return;
#ifdef PROBE_C
    phaseC(p, layer, lds, true);
    grid.sync();
#endif
    phaseC(p, layer, lds, false);
    grid.sync();
    if (STOP_AFTER == layer * 10 + 3) return;
    phaseD(p, sl, layer, lds);
    grid.sync();
#ifdef PROBE_D
    phaseD(p, sl, layer, lds);
    grid.sync();
#endif
    if (STOP_AFTER == layer * 10 + 4) return;
    if (layer == 0) phaseE(p, sl, layer, lds, p.x_in); else phaseE(p, sl, layer, lds, p.out);
    if (layer + 1 < DEPTH) grid.sync();
    if (STOP_AFTER == layer * 10 + 5) return;
  }
}

extern "C" void kernel_launch(void* const* d_in, const int* in_sizes, int n_in, void* d_out, int out_size,
                              void* d_ws, size_t ws_size, hipStream_t stream) {
  static int grid_blocks = 0;
  if (!grid_blocks) {
    int dev = 0, cus = 0, per_cu = 0;
    (void)hipGetDevice(&dev);
    (void)hipDeviceGetAttribute(&cus, hipDeviceAttributeMultiprocessorCount, dev);
    if (hipFuncSetAttribute((const void*)hybrid_megakernel, hipFuncAttributeMaxDynamicSharedMemorySize, LDS_BYTES) != hipSuccess) fprintf(stderr, "hipFuncSetAttribute(max dynamic LDS) failed\n");
    (void)hipOccupancyMaxActiveBlocksPerMultiprocessor(&per_cu, hybrid_megakernel, NTHR, LDS_BYTES);
    (void)hipGetLastError();
    if (per_cu > 1) per_cu = 1;
    if (per_cu < 1) per_cu = 1;
    grid_blocks = (cus * per_cu) & ~7;
  }
  Params a{};
  a.x_in = (const float*)d_in[0]; a.pos = (const int*)d_in[1]; a.norm_g = (const float*)d_in[2]; a.w_in = (const float*)d_in[3];
  a.q_norm_g = (const float*)d_in[4]; a.k_norm_g = (const float*)d_in[5]; a.cmp_pe = (const float*)d_in[6]; a.cmp_w1 = (const float*)d_in[7];
  a.cmp_b1 = (const float*)d_in[8]; a.cmp_w2 = (const float*)d_in[9]; a.w_up_a = (const float*)d_in[10]; a.w_up_b = (const float*)d_in[11];
  a.w_out = (const float*)d_in[12];
  a.out = (float*)d_out; a.ws = (unsigned char*)d_ws;
  if (WS_NEED > ws_size) { fprintf(stderr, "workspace too small: need %zu have %zu\n", (size_t)WS_NEED, ws_size); return; }
  (void)hipMemsetAsync((unsigned char*)d_ws + OFF_CTL, 0, 256, stream);
  void* args[] = {&a};
  hipError_t e = hipLaunchCooperativeKernel((void*)hybrid_megakernel, dim3(grid_blocks), dim3(NTHR), args, LDS_BYTES, stream);
  if (e != hipSuccess) fprintf(stderr, "cooperative launch failed: %s (grid %d)\n", hipGetErrorString(e), grid_blocks);
}
```

```cpp
#include <hip/hip_runtime.h>
#include <hip/hip_cooperative_groups.h>
#include <cstdio>
#include <cstdint>
namespace cg = cooperative_groups;

typedef unsigned short bf16_t;
typedef short bf16x8 __attribute__((ext_vector_type(8)));
typedef float f32x4 __attribute__((ext_vector_type(4)));
typedef float f32x2 __attribute__((ext_vector_type(2)));
typedef unsigned u32x4 __attribute__((ext_vector_type(4)));
typedef unsigned u32x2 __attribute__((ext_vector_type(2)));
typedef __bf16 bf16x2_t __attribute__((ext_vector_type(2)));

#define DI __device__ __forceinline__
#define MFMA16(a, b, c) __builtin_amdgcn_mfma_f32_16x16x32_bf16((a), (b), (c), 0, 0, 0)

constexpr int D_MODEL = 1024, BATCH = 16, SEQ = 2048, DEPTH = 4, NTOK = BATCH * SEQ;
constexpr int N_IN = 5912, NP = 6144, NT_IN = 24;
constexpr int NTHR = 512;
constexpr int LDX = D_MODEL + 64;
constexpr int NCMP = 127;
constexpr float NORM_EPS = 1e-6f;

DI unsigned pk2(float lo, float hi) { f32x2 v = {lo, hi}; bf16x2_t b = __builtin_convertvector(v, bf16x2_t); return __builtin_bit_cast(unsigned, b); }
DI float bflo(unsigned u) { return __uint_as_float(u << 16); }
DI float bfhi(unsigned u) { return __uint_as_float(u & 0xffff0000u); }
DI float sigmoidf_(float x) { return __builtin_amdgcn_rcpf(1.f + __builtin_amdgcn_exp2f(-1.44269504089f * x)); }
DI float siluf_(float x) { return x * __builtin_amdgcn_rcpf(1.f + __builtin_amdgcn_exp2f(-1.44269504089f * x)); }
DI bf16x8 mk8(u32x4 v) { return __builtin_bit_cast(bf16x8, v); }
DI bf16x8 ld8(const bf16_t* p) { return __builtin_bit_cast(bf16x8, *(const u32x4*)p); }


DI void sincos_acc(float angf, float& sn, float& cs) {
  const double a = (double)angf;
  const double k = rint(a * 0.63661977236758134308);
  const double y = (a - k * 1.57079632679489655800) - k * 6.12323399573676603587e-17;
  const double y2 = y * y;
  const double sp = y * (1.0 + y2 * (-1.0 / 6 + y2 * (1.0 / 120 + y2 * (-1.0 / 5040 + y2 * (1.0 / 362880 + y2 * (-1.0 / 39916800 + y2 * (1.0 / 6227020800.0)))))));
  const double cp = 1.0 + y2 * (-0.5 + y2 * (1.0 / 24 + y2 * (-1.0 / 720 + y2 * (1.0 / 40320 + y2 * (-1.0 / 3628800 + y2 * (1.0 / 479001600.0))))));
  const int q = ((int)k) & 3;
  const double s_ = (q & 1) ? cp : sp, c_ = (q & 1) ? sp : cp;
  sn = (float)((q & 2) ? -s_ : s_);
  cs = (float)(((q + 1) & 2) ? -c_ : c_);
}
DI float inv_freq(int f) { return (float)exp(-(double)f * (9.21034037197618273607 / 32.0)); }

constexpr size_t al256(size_t x) { return (x + 255) & ~(size_t)255; }
constexpr size_t OFF_WT_IN = 0;
constexpr size_t OFF_W1T = OFF_WT_IN + al256((size_t)NP * LDX * 2);
constexpr size_t OFF_W2T = OFF_W1T + al256((size_t)2 * 256 * 2048 * 2);
constexpr size_t OFF_WUPA = OFF_W2T + al256((size_t)2 * 64 * 256 * 2);
constexpr size_t OFF_WUPB = OFF_WUPA + al256((size_t)1024 * 512 * 2);
constexpr size_t OFF_WOUT = OFF_WUPB + al256((size_t)1024 * 512 * 2);
constexpr size_t OFF_B1EFF = OFF_WOUT + al256((size_t)1024 * 1024 * 2);
constexpr size_t OFF_COST = OFF_B1EFF + al256((size_t)DEPTH * 2 * 16 * 256 * 4);
constexpr size_t OFF_SINT = OFF_COST + al256((size_t)NTOK * 32 * 4);
constexpr size_t OFF_COSC = OFF_SINT + al256((size_t)NTOK * 32 * 4);
constexpr size_t OFF_SINC = OFF_COSC + al256((size_t)BATCH * 128 * 32 * 4);
constexpr size_t OFF_XB = OFF_SINC + al256((size_t)BATCH * 128 * 32 * 4);
constexpr size_t OFF_PART = OFF_XB + al256((size_t)NTOK * LDX * 2);
constexpr size_t OFF_SBQ = OFF_PART + al256((size_t)NTOK * 16 * 4);
constexpr size_t OFF_SBK = OFF_SBQ + al256((size_t)NTOK * 512 * 2);
constexpr size_t OFF_SBVT = OFF_SBK + al256((size_t)NTOK * 512 * 2);
constexpr size_t OFF_SBZ = OFF_SBVT + al256((size_t)NTOK * 512 * 2);
constexpr size_t OFF_NQ = OFF_SBZ + al256((size_t)NTOK * 512 * 2);
constexpr size_t OFF_KCR = OFF_NQ + al256((size_t)NTOK * 512 * 2);
constexpr size_t OFF_VCR = OFF_KCR + al256((size_t)NTOK * 128 * 2);
constexpr size_t OFF_KS = OFF_VCR + al256((size_t)NTOK * 128 * 2);
constexpr size_t OFF_VST = OFF_KS + al256((size_t)NTOK * 128 * 2);
constexpr size_t OFF_KW = OFF_VST + al256((size_t)NTOK * 128 * 2);
constexpr size_t OFF_VWT = OFF_KW + al256((size_t)NTOK * 128 * 2);
constexpr size_t OFF_NGATE = OFF_VWT + al256((size_t)NTOK * 128 * 2);
constexpr size_t OFF_NZ = OFF_NGATE + al256((size_t)NTOK * 32 * 4);
constexpr size_t OFF_GA = OFF_NZ + al256((size_t)NTOK * 512 * 2);
constexpr size_t OFF_GB = OFF_GA + al256((size_t)NTOK * 1024 * 2);
constexpr size_t OFF_HID = OFF_GB + al256((size_t)NTOK * 1024 * 2);
constexpr size_t OFF_KC = OFF_HID + al256((size_t)4 * 32 * 256 * 256 * 4);
constexpr size_t OFF_VCT = OFF_KC + al256((size_t)BATCH * 2 * 128 * 64 * 2);
constexpr size_t OFF_QNG = OFF_VCT + al256((size_t)BATCH * 2 * 64 * 128 * 2);
constexpr size_t OFF_KNG = OFF_QNG + al256((size_t)DEPTH * 64 * 4);
constexpr size_t OFF_CTL = OFF_KNG + al256((size_t)DEPTH * 3 * 64 * 4);
constexpr size_t OFF_MFIX_BASE = OFF_CTL + 256;
constexpr size_t OFF_MFIX_OLD = OFF_KNG + al256((size_t)DEPTH * 3 * 64 * 4);
constexpr size_t OFF_MFIX = OFF_MFIX_BASE;
constexpr size_t OFF_DUMMY = OFF_MFIX + 256;
constexpr size_t WS_NEED = OFF_DUMMY + 256;

struct Params {
  const float* x_in; const int* pos; const float* norm_g; const float* w_in; const float* q_norm_g; const float* k_norm_g;
  const float* cmp_pe; const float* cmp_w1; const float* cmp_b1; const float* cmp_w2; const float* w_up_a; const float* w_up_b; const float* w_out;
  float* out; unsigned char* ws;
#define WSBUF(T, name, OFF) DI T* name() const { return (T*)(ws + (OFF)); }
  WSBUF(bf16_t, wt_in, OFF_WT_IN) WSBUF(bf16_t, w1t, OFF_W1T) WSBUF(bf16_t, w2t, OFF_W2T) WSBUF(bf16_t, wupa_t, OFF_WUPA) WSBUF(bf16_t, wupb_t, OFF_WUPB) WSBUF(bf16_t, wout_t, OFF_WOUT)
  WSBUF(float, b1eff, OFF_B1EFF) WSBUF(float, cosT, OFF_COST) WSBUF(float, sinT, OFF_SINT) WSBUF(float, cosC, OFF_COSC) WSBUF(float, sinC, OFF_SINC)
  WSBUF(bf16_t, xb, OFF_XB) WSBUF(float, part, OFF_PART) WSBUF(bf16_t, sbq, OFF_SBQ) WSBUF(bf16_t, sbk, OFF_SBK) WSBUF(bf16_t, sbvt, OFF_SBVT) WSBUF(bf16_t, sbz, OFF_SBZ)
  WSBUF(bf16_t, nq, OFF_NQ) WSBUF(bf16_t, kcr, OFF_KCR) WSBUF(bf16_t, vcr, OFF_VCR) WSBUF(bf16_t, ks, OFF_KS) WSBUF(bf16_t, vst, OFF_VST) WSBUF(bf16_t, kw, OFF_KW) WSBUF(bf16_t, vwt, OFF_VWT)
  WSBUF(float, ngate, OFF_NGATE) WSBUF(bf16_t, nz, OFF_NZ) WSBUF(bf16_t, ga, OFF_GA) WSBUF(bf16_t, gb, OFF_GB) WSBUF(float, hpre, OFF_HID) WSBUF(bf16_t, kc, OFF_KC) WSBUF(bf16_t, vct, OFF_VCT)
  WSBUF(bf16_t, merged, OFF_SBK)
  WSBUF(bf16_t, dummy, OFF_XB)     WSBUF(float, mfix, OFF_MFIX) WSBUF(unsigned, ctl, OFF_CTL)
  WSBUF(float, qng, OFF_QNG) WSBUF(float, kng, OFF_KNG)
};

DI int my_tid() { int t = threadIdx.x; asm volatile("" : "+v"(t)); return t; }
DI Params relaunder(const Params& p0) { Params p = p0; size_t z = 0; asm volatile("" : "+s"(z)); p.ws = p0.ws + z; return p; }

constexpr int TILE_B = 32 * 1024;
constexpr int STAGE_B = 2 * TILE_B;
constexpr int LDS_GEMM_BYTES = 2 * STAGE_B;
typedef __attribute__((address_space(3))) unsigned lds_u32;

DI void g_dma(const bf16_t* __restrict__ base, const unsigned (&off)[8], int ko, unsigned char* stage, int w) {
#pragma unroll
  for (int u = 0; u < 8; ++u)
    __builtin_amdgcn_global_load_lds((const unsigned*)(base + (off[u] + ko)), (lds_u32*)(stage + (w * 8 + u) * 1024), 16, 0, 0);
}
#define G_LDA(dst, ih, ks) _Pragma("unroll") for (int i = 0; i < 4; ++i) dst[i] = mk8(*(const u32x4*)(stage + ra + (((ih) * 4 + i) * 2 + (ks)) * 1024))
#define G_LDB(dst, ks) _Pragma("unroll") for (int j = 0; j < 4; ++j) dst[j] = mk8(*(const u32x4*)(stage + TILE_B + rb + (j * 2 + (ks)) * 1024))
#define G_MMA(ih, A, B) do { __builtin_amdgcn_s_setprio(1); _Pragma("unroll") for (int i = 0; i < 4; ++i) _Pragma("unroll") for (int j = 0; j < 4; ++j) acc[(ih) * 4 + i][j] = MFMA16(A[i], B[j], acc[(ih) * 4 + i][j]); __builtin_amdgcn_s_setprio(0); } while (0)
DI void g_compute(const unsigned char* stage, int ra, int rb, f32x4 (&acc)[8][4]) {
  bf16x8 b0[4], b1[4], a0[4], a1[4];
  G_LDB(b0, 0); G_LDA(a0, 0, 0);
  __builtin_amdgcn_sched_barrier(0);
  G_LDA(a1, 1, 0);
  G_MMA(0, a0, b0);
  __builtin_amdgcn_sched_barrier(0);
  G_LDB(b1, 1); G_LDA(a0, 0, 1);
  G_MMA(1, a1, b0);
  __builtin_amdgcn_sched_barrier(0);
  G_LDA(a1, 1, 1);
  G_MMA(0, a0, b1);
  __builtin_amdgcn_sched_barrier(0);
  G_MMA(1, a1, b1);
  __builtin_amdgcn_sched_barrier(0);
}

DI void gemm_core(const bf16_t* __restrict__ Ag, long lda, const bf16_t* __restrict__ Bg, long ldb, int K,
                  bf16_t* ldsb, f32x4 (&acc)[8][4], int kstep = 64) {
  unsigned char* lds = (unsigned char*)ldsb;
  const int tid = my_tid(), lane = tid & 63, w = __builtin_amdgcn_readfirstlane(tid >> 6), wa = w >> 2, wb = w & 3, qi = lane & 15, quad = lane >> 4;
  const bf16_t* base = w >= 4 ? Bg : Ag; const int ld = (int)(w >= 4 ? ldb : lda);
  unsigned off[8];
#pragma unroll
  for (int u = 0; u < 8; ++u) { const int blk = (w & 3) * 8 + u, rg = blk >> 1, kh = blk & 1; off[u] = (unsigned)((rg * 16 + (lane >> 2)) * ld + kh * 32 + (lane & 3) * 8); }
  const int ra = (wa * 8) * 2 * 1024 + (qi * 4 + quad) * 16, rb = (wb * 4) * 2 * 1024 + (qi * 4 + quad) * 16;
  unsigned char* buf0 = lds; unsigned char* buf1 = lds + STAGE_B;
  const int KT = K >> 6;
  g_dma(base, off, 0, buf0, w);
  asm volatile("s_waitcnt vmcnt(0)" ::: "memory");
  __syncthreads();
  for (int kt = 0; kt < KT; kt += 2) {
    g_dma(base, off, (kt + 1) * kstep, buf1, w);
    g_compute(buf0, ra, rb, acc);
    asm volatile("s_waitcnt vmcnt(0)" ::: "memory");
    __syncthreads();
    g_dma(base, off, min(kt + 2, KT - 1) * kstep, buf0, w);
    g_compute(buf1, ra, rb, acc);
    asm volatile("s_waitcnt vmcnt(0)" ::: "memory");
    __syncthreads();
  }
}

DI void zero_acc(f32x4 (&acc)[8][4]) {
#pragma unroll
  for (int i = 0; i < 8; ++i)
#pragma unroll
    for (int j = 0; j < 4; ++j) acc[i][j] = (f32x4){0.f, 0.f, 0.f, 0.f};
}

struct Slot { int xcd, slot; };
DI bool tile_order(const Slot sl, int it, int nN, int& mt, int& nt) {
  const int xcd = sl.xcd, slot = sl.slot, SL = gridDim.x >> 3;
  const int q = slot + it * SL, per = 8 * nN;
  if (q >= 2 * per) return false;
  const int mg = q / per, e = q - mg * per;
  nt = e >> 3; mt = xcd * 16 + mg * 8 + (e & 7);
  return true;
}

DI int inmap(int c) {
  if (c < 1024) return c;
  if (c < 1536) return c + 512;
  if (c < 2048) return c + 512;
  if (c < 2304) return c + 512;
  if (c < 2432) return c + 512;
  if (c < 2560) return c + 640;
  if (c < 3072) return c + 792;
  if (c < 4096) return c + 792;
  if (c < 5120) return c + 792;
  if (c < 5376) return c < 5144 ? c - 1792 : -1;
  if (c < 5888) return c - 4352;
  if (c < 6016) return c - 2944;
  return c - 2816;
}

DI void tr_tile(const float* __restrict__ src, int ld, int K, int k0, int n0, bool use_map, const float* __restrict__ scale, bf16_t* __restrict__ dst, int ldd, float* tile) {
  const int tid = my_tid();
  {
    const int nl = tid & 63, kk = tid >> 6;
    int n = n0 + nl; asm volatile("" : "+v"(n));
    const int sc = use_map ? inmap(n) : n;
#pragma unroll
    for (int r = 0; r < 8; ++r) {
      const int k = k0 + r * 8 + kk;
      float v = 0.f;
      if (sc >= 0) { v = src[(long)k * ld + sc]; if (scale) v *= scale[k]; }
      tile[(r * 8 + kk) * 65 + nl] = v;
    }
  }
  __syncthreads();
  {
    const int nl = tid >> 3, ks = tid & 7;
    unsigned o[4];
#pragma unroll
    for (int e = 0; e < 4; ++e) o[e] = pk2(tile[(ks * 8 + 2 * e) * 65 + nl], tile[(ks * 8 + 2 * e + 1) * 65 + nl]);
    *(u32x4*)(dst + (long)(n0 + nl) * ldd + k0 + ks * 8) = (u32x4){o[0], o[1], o[2], o[3]};
  }
  __syncthreads();
}

DI void tr_job(const float* src, int ld, int K, int N, bool use_map, const float* scale, bf16_t* dst, int ldd, float* tile) {
  const int nk = K >> 6, nn = N >> 6;
  for (int t = blockIdx.x; t < nk * nn; t += gridDim.x) tr_tile(src, ld, K, (t % nk) * 64, (t / nk) * 64, use_map, scale, dst, ldd, tile);
}

DI void convert_weights(const Params& p0, int l, unsigned char* lds, int which) {
  const Params p = relaunder(p0);
  float* tile = (float*)lds;
  if (which & 1) {
    tr_job(p.w_in + (long)l * D_MODEL * N_IN, N_IN, D_MODEL, NP, true, p.norm_g + l * D_MODEL, p.wt_in(), LDX, tile);
    for (int kv = 0; kv < 2; ++kv) {
      tr_job(p.cmp_w1 + (long)(l * 2 + kv) * 2048 * 256, 256, 2048, 256, false, nullptr, p.w1t() + (long)kv * 256 * 2048, 2048, tile);
      tr_job(p.cmp_w2 + (long)(l * 2 + kv) * 256 * 64, 64, 256, 64, false, nullptr, p.w2t() + (long)kv * 64 * 256, 256, tile);
    }
    tr_job(p.w_up_a + (long)l * 512 * 1024, 1024, 512, 1024, false, nullptr, p.wupa_t(), 512, tile);
    tr_job(p.w_up_b + (long)l * 512 * 1024, 1024, 512, 1024, false, nullptr, p.wupb_t(), 512, tile);
  }
  if (which & 2) tr_job(p.w_out + (long)l * 1024 * 1024, 1024, 1024, 1024, false, nullptr, p.wout_t(), 1024, tile);
}

DI void phase_prologue(const Params& p, unsigned char* lds) {
  const int tid = my_tid();
  convert_weights(p, 0, lds, 3);
  {
    const int lane = tid & 63;
    for (int wi = blockIdx.x * 8 + (tid >> 6); wi < DEPTH * 2 * 16 * 4; wi += gridDim.x * 8) {
      const int jq = wi & 3, kq = (wi >> 2) & 15, it = wi >> 6;
      const float* w1 = p.cmp_w1 + (long)it * 2048 * 256 + (long)kq * 128 * 256 + jq * 64 + lane; const float* pe = p.cmp_pe + (long)it * 2048 + kq * 128;
      float s0 = kq == 0 ? p.cmp_b1[it * 256 + jq * 64 + lane] : 0.f, s1 = 0.f, s2 = 0.f, s3 = 0.f;
#pragma unroll 4
      for (int k = 0; k < 128; k += 4) {
        s0 += pe[k] * w1[(long)k * 256]; s1 += pe[k + 1] * w1[(long)(k + 1) * 256]; s2 += pe[k + 2] * w1[(long)(k + 2) * 256]; s3 += pe[k + 3] * w1[(long)(k + 3) * 256];
      }
      p.b1eff()[(it * 16 + kq) * 256 + jq * 64 + lane] = (s0 + s1) + (s2 + s3);
    }
  }
  if (blockIdx.x == 1 && tid < DEPTH * 3) {
    const int l = tid / 3, br = tid % 3;
    float mq = 0.f, mk = 0.f;
    for (int d = 0; d < 64; ++d) { mq = fmaxf(mq, fabsf(p.q_norm_g[l * 64 + d])); mk = fmaxf(mk, fabsf(p.k_norm_g[(l * 3 + br) * 64 + d])); }
    p.mfix()[l * 4 + br] = 8.f * 1.44269504089f * mq * mk * 1.02f + 0.25f;
  }
  if (blockIdx.x == 0) { for (int i = tid; i < DEPTH * 64; i += NTHR) p.qng()[i] = p.q_norm_g[i]; for (int i = tid; i < DEPTH * 192; i += NTHR) p.kng()[i] = p.k_norm_g[i]; }
  const long gtid = (long)blockIdx.x * NTHR + tid, gn = (long)gridDim.x * NTHR;
  for (long i = gtid; i < (long)NTOK * 32; i += gn) {
    const int f = (int)(i & 31); const long tok = i >> 5;
    const float ang = (float)p.pos[tok] * inv_freq(f);
    float sn, cs; sincos_acc(ang, sn, cs);
    p.cosT()[i] = cs; p.sinT()[i] = sn;
  }
  for (long i = gtid; i < (long)BATCH * 128 * 32; i += gn) {
    const int f = (int)(i & 31); const int c = (int)((i >> 5) & 127); const int b = (int)(i >> 12);
    float cs = 1.f, sn = 0.f;
    if (c < NCMP) {
      float sum = 0.f;
      for (int k = 0; k < 32; ++k) sum += (float)p.pos[b * SEQ + c * 16 + k];
      const float ang = (sum * (1.f / 32.f)) * inv_freq(f);
      sincos_acc(ang, sn, cs);
    }
    p.cosC()[i] = cs; p.sinC()[i] = sn;
  }
  const int lane = tid & 63;
  for (long row = (long)blockIdx.x * 8 + (tid >> 6); row < NTOK; row += (long)gridDim.x * 8) {
    const float* xr = p.x_in + row * D_MODEL; bf16_t* xo = p.xb() + row * LDX;
    float ss = 0.f;
#pragma unroll
    for (int u = 0; u < 4; ++u) {
      const f32x4 v = *(const f32x4*)(xr + u * 256 + lane * 4);
      ss += v[0] * v[0] + v[1] * v[1] + v[2] * v[2] + v[3] * v[3];
      *(u32x2*)(xo + u * 256 + lane * 4) = (u32x2){pk2(v[0], v[1]), pk2(v[2], v[3])};
    }
#pragma unroll
    for (int o = 32; o >= 1; o >>= 1) ss += __shfl_xor(ss, o);
    if (lane < 8) p.part()[row * 16 + lane] = lane == 0 ? ss : 0.f;
  }
}

DI void phaseA_epilogue(const Params& p, int layer, int mt, int nt, const f32x4 (&acc)[8][4], const float* rs_s) {
  const int tid = my_tid(), lane = tid & 63, w = tid >> 6, wa = w >> 2, wb = w & 3, qi = lane & 15, quad = lane >> 4;
  if (nt >= 21) {
    bf16_t* dstb; int nh, head;
    if (nt < 23) { dstb = p.sbvt(); nh = 8; head = (nt - 21) * 4 + wb; } else if (wb < 2) { dstb = p.vst(); nh = 2; head = wb; } else { dstb = p.vwt(); nh = 2; head = wb - 2; }
    const int tok0 = mt * 256, b = tok0 >> 11, s0 = (tok0 & 2047) + wa * 128 + quad * 4;
#pragma unroll
    for (int i = 0; i < 8; ++i) {
      const int tl = wa * 128 + i * 16 + quad * 4;
      const float r0 = rs_s[tl], r1 = rs_s[tl + 1], r2 = rs_s[tl + 2], r3 = rs_s[tl + 3];
#pragma unroll
      for (int j = 0; j < 4; ++j) {
        const int d = j * 16 + qi;
        const f32x4 v = acc[i][j];
        bf16_t* dst = dstb + ((long)(b * nh + head) * 64 + d) * SEQ + s0 + i * 16;
        *(u32x2*)dst = (u32x2){pk2(v[0] * r0, v[1] * r1), pk2(v[2] * r2, v[3] * r3)};
      }
    }
    return;
  }
  const bool headtype = nt < 4 || (nt >= 6 && nt < 10);
#pragma unroll
  for (int j = 0; j < 4; ++j) {
    const int tl = wb * 64 + j * 16 + qi; const long tok = (long)mt * 256 + tl; const int b = (int)(tok >> 11), sq = (int)(tok & 2047);
    const float rs = rs_s[tl];
    if (headtype) {
#pragma unroll
      for (int ih = 0; ih < 2; ++ih) {
        const int hit = wa * 2 + ih;
        f32x4 v[4];
#pragma unroll
        for (int i = 0; i < 4; ++i) v[i] = acc[ih * 4 + i][j] * rs;
        bf16_t* dstb; int nh, head; const float* g = nullptr;
        if (nt < 2) { dstb = p.sbq(); nh = 8; head = nt * 4 + hit; }
        else if (nt < 4) { dstb = p.sbk(); nh = 8; head = (nt - 2) * 4 + hit; }
        else if (nt < 8) { dstb = p.nq(); nh = 8; head = (nt - 6) * 4 + hit; g = p.qng() + layer * 64; }
        else if (nt == 8) { dstb = hit < 2 ? p.kcr() : p.vcr(); nh = 2; head = hit & 1; }
        else { dstb = hit < 2 ? p.ks() : p.kw(); nh = 2; head = hit & 1; g = p.kng() + (layer * 3 + (hit < 2 ? 1 : 2)) * 64; }
        if (g) {
          float ss = 0.f;
#pragma unroll
          for (int i = 0; i < 4; ++i) ss += v[i][0] * v[i][0] + v[i][1] * v[i][1] + v[i][2] * v[i][2] + v[i][3] * v[i][3];
          ss += __shfl_xor(ss, 16); ss += __shfl_xor(ss, 32);
          const float rn = rsqrtf(ss * (1.f / 64.f) + NORM_EPS);
#pragma unroll
          for (int i = 0; i < 4; ++i) { const f32x4 gg = *(const f32x4*)(g + i * 16 + quad * 4); v[i] = v[i] * rn * gg; }
#pragma unroll
          for (int i = 0; i < 2; ++i) {
            const f32x4 cs = *(const f32x4*)(p.cosT() + tok * 32 + i * 16 + quad * 4), sn = *(const f32x4*)(p.sinT() + tok * 32 + i * 16 + quad * 4);
            const f32x4 x1 = v[i], x2 = v[i + 2];
            v[i] = x1 * cs - x2 * sn; v[i + 2] = x2 * cs + x1 * sn;
          }
        }
        bf16_t* dst = dstb + ((long)(b * nh + head) * SEQ + sq) * 64 + quad * 4;
#pragma unroll
        for (int i = 0; i < 4; ++i) *(u32x2*)(dst + i * 16) = (u32x2){pk2(v[i][0], v[i][1]), pk2(v[i][2], v[i][3])};
        asm volatile("" ::: "memory");
      }
    } else if (nt == 20) {
      if (wa == 0) {
#pragma unroll
        for (int i = 0; i < 2; ++i) {
          const int f = i * 16 + quad * 4;
          const f32x4 v = acc[i][j] * rs;
          if (f < 24) { const f32x4 o = {sigmoidf_(v[0]), sigmoidf_(v[1]), sigmoidf_(v[2]), sigmoidf_(v[3])}; *(f32x4*)(p.ngate() + tok * 32 + f) = o; }
        }
      }
    } else {
      bf16_t* dstb; int ldd, c0; bool sil;
      if (nt < 6) { dstb = p.sbz(); ldd = 512; c0 = (nt - 4) * 256; sil = true; }
      else if (nt < 12) { dstb = p.nz(); ldd = 512; c0 = (nt - 10) * 256; sil = true; }
      else if (nt < 16) { dstb = p.ga(); ldd = 1024; c0 = (nt - 12) * 256; sil = false; }
      else { dstb = p.gb(); ldd = 1024; c0 = (nt - 16) * 256; sil = false; }
      bf16_t* dst = dstb + tok * ldd + c0 + wa * 128 + quad * 4;
#pragma unroll
      for (int i = 0; i < 8; ++i) {
        const f32x4 v = acc[i][j] * rs;
        f32x4 o;
#pragma unroll
        for (int r = 0; r < 4; ++r) o[r] = sil ? siluf_(v[r]) : sigmoidf_(v[r]);
        *(u32x2*)(dst + i * 16) = (u32x2){pk2(o[0], o[1]), pk2(o[2], o[3])};
      }
    }
    asm volatile("" ::: "memory");
  }
}

DI void phaseA(const Params& p0, const Slot sl, int layer, unsigned char* lds, int fake = 0) {
  const Params p = relaunder(p0);
  bf16_t* gl = (bf16_t*)lds; float* rs_s = (float*)(lds + LDS_GEMM_BYTES);
  const bf16_t* Wt = p.wt_in();
  int mt, nt;
  for (int it = 0; tile_order(sl, it, NT_IN, mt, nt); ++it) {
    if (my_tid() < 256) {
      const float* pp = p.part() + ((long)mt * 256 + my_tid()) * 16;
      const f32x4 v0 = *(const f32x4*)pp, v1 = *(const f32x4*)(pp + 4);
      const float s = ((v0[0] + v0[1]) + (v0[2] + v0[3])) + ((v1[0] + v1[1]) + (v1[2] + v1[3]));
      rs_s[my_tid()] = rsqrtf(s * (1.f / 1024.f) + NORM_EPS);
    }
    const int mtl = fake == 3 ? 0 : (fake == 4 ? sl.xcd * 16 + (sl.slot & 7) : mt), ntl = fake == 3 ? 0 : (fake == 4 ? (sl.slot >> 3) : nt);
    const bf16_t* Xg = p.xb() + (long)mtl * 256 * LDX; const bf16_t* Wg = Wt + (long)ntl * 256 * LDX;
    f32x4 acc[8][4]; zero_acc(acc);
    const int kstep = (fake == 1 || fake == 2) ? 0 : 64;
    gemm_core(nt >= 21 ? Xg : Wg, LDX, nt >= 21 ? Wg : Xg, LDX, D_MODEL, gl, acc, kstep);
    if (!fake) phaseA_epilogue(p, layer, mt, nt, acc, rs_s);
    else if (acc[0][0][0] == 123.456f && acc[7][3][3] == 5.f) p.dummy()[0] = 1;
    __syncthreads();
  }
}

DI void compress_partial(const Params& p, int ci, unsigned char* lds) {
  bf16_t* gl = (bf16_t*)lds;
  const int split = ci & 3, item = ci >> 2, kv = item & 1, pair = item >> 1;
  const bf16_t* src = (kv ? p.vcr() : p.kcr()) + (long)pair * 256 * 1024 + split * 512;
  const bf16_t* W1 = p.w1t() + (long)kv * 256 * 2048 + split * 512;
  f32x4 acc[8][4]; zero_acc(acc);
  gemm_core(W1, 2048, src, 1024, 512, gl, acc);
  const int tid = my_tid(), lane = tid & 63, w = tid >> 6, wa = w >> 2, wb = w & 3, qi = lane & 15, quad = lane >> 4;
  float* dst = p.hpre() + ((long)(split * 32 + item) * 256) * 256;
#pragma unroll
  for (int i = 0; i < 8; ++i)
#pragma unroll
    for (int j = 0; j < 4; ++j) *(f32x4*)(dst + (long)(wb * 64 + j * 16 + qi) * 256 + wa * 128 + i * 16 + quad * 4) = acc[i][j];
}

DI void phaseB2(const Params& p0, int layer, unsigned char* lds) {
  const Params p = relaunder(p0);
  const int tid = my_tid(), lane = tid & 63, w = tid >> 6, qi = lane & 15, quad = lane >> 4;
  float* bias_s = (float*)lds;
  {
    const float* b1 = p.b1eff() + (long)(layer * 2 + (tid >> 8)) * 16 * 256 + (tid & 255);
    float sacc = 0.f;
#pragma unroll
    for (int kq = 0; kq < 16; ++kq) sacc += b1[kq * 256];
    bias_s[tid] = sacc;
  }
  __syncthreads();
  const int wi = blockIdx.x * 2 + w;
  if (w < 2 && wi < 32 * 16) {
    const int item = wi >> 4, r16 = wi & 15, kv = item & 1, pair = item >> 1;
    const int row = r16 * 16 + qi;
    const bf16_t* W2 = p.w2t() + (long)kv * 64 * 256;
    const float* hp = p.hpre() + ((long)item * 256 + row) * 256 + quad * 8;
    f32x4 o[4];
#pragma unroll
    for (int dt = 0; dt < 4; ++dt) o[dt] = (f32x4){0.f, 0.f, 0.f, 0.f};
#pragma unroll 1
    for (int ksx = 0; ksx < 8; ++ksx) {
      f32x4 h0 = *(const f32x4*)(bias_s + kv * 256 + ksx * 32 + quad * 8), h1 = *(const f32x4*)(bias_s + kv * 256 + ksx * 32 + quad * 8 + 4);
#pragma unroll
      for (int sp = 0; sp < 4; ++sp) { const float* q = hp + (long)sp * 32 * 256 * 256 + ksx * 32; h0 += *(const f32x4*)q; h1 += *(const f32x4*)(q + 4); }
      const bf16x8 hf = mk8((u32x4){pk2(siluf_(h0[0]), siluf_(h0[1])), pk2(siluf_(h0[2]), siluf_(h0[3])), pk2(siluf_(h1[0]), siluf_(h1[1])), pk2(siluf_(h1[2]), siluf_(h1[3]))});
#pragma unroll
      for (int dt = 0; dt < 4; ++dt) {
        const bf16x8 wf = ld8(W2 + (long)(dt * 16 + qi) * 256 + ksx * 32 + quad * 8);
        o[dt] = kv ? MFMA16(hf, wf, o[dt]) : MFMA16(wf, hf, o[dt]);
      }
    }
    const int bg = pair * 2 + (r16 >> 3);
    if (kv == 0) {
      const float* g = p.kng() + (layer * 3 + 0) * 64;
      const int b = bg >> 1, c = (r16 & 7) * 16 + qi;
      float ss = 0.f;
#pragma unroll
      for (int dt = 0; dt < 4; ++dt) ss += o[dt][0] * o[dt][0] + o[dt][1] * o[dt][1] + o[dt][2] * o[dt][2] + o[dt][3] * o[dt][3];
      ss += __shfl_xor(ss, 16); ss += __shfl_xor(ss, 32);
      const float rn = rsqrtf(ss * (1.f / 64.f) + NORM_EPS);
#pragma unroll
      for (int dt = 0; dt < 4; ++dt) { const f32x4 gg = *(const f32x4*)(g + dt * 16 + quad * 4); o[dt] = o[dt] * rn * gg; }
#pragma unroll
      for (int dt = 0; dt < 2; ++dt) {
        const long ti = ((long)b * 128 + c) * 32 + dt * 16 + quad * 4;
        const f32x4 cs = *(const f32x4*)(p.cosC() + ti), sn = *(const f32x4*)(p.sinC() + ti);
        const f32x4 x1 = o[dt], x2 = o[dt + 2];
        o[dt] = x1 * cs - x2 * sn; o[dt + 2] = x2 * cs + x1 * sn;
      }
      bf16_t* dst = p.kc() + ((long)bg * 128 + c) * 64 + quad * 4;
#pragma unroll
      for (int dt = 0; dt < 4; ++dt) {
        u32x2 ov = (u32x2){pk2(o[dt][0], o[dt][1]), pk2(o[dt][2], o[dt][3])};
        if (c >= NCMP) ov = (u32x2){0u, 0u};
        *(u32x2*)(dst + dt * 16) = ov;
      }
    } else {
#pragma unroll
      for (int dt = 0; dt < 4; ++dt) {
        const int c0 = (r16 & 7) * 16 + quad * 4;
        f32x4 v = o[dt];
        if (c0 + 3 >= NCMP) v[3] = 0.f;
        *(u32x2*)(p.vct() + ((long)bg * 64 + dt * 16 + qi) * 128 + c0) = (u32x2){pk2(v[0], v[1]), pk2(v[2], v[3])};
      }
    }
  }
  __syncthreads();
}

struct SbFrag { bf16x8 k[2][2]; bf16x8 v[4]; };
DI void sb_load(SbFrag& f, const bf16_t* __restrict__ kp0, const bf16_t* __restrict__ vp0, int kb) {
#pragma unroll
  for (int a = 0; a < 2; ++a) { f.k[a][0] = ld8(kp0 + (long)(kb + 4 * a) * 64); f.k[a][1] = ld8(kp0 + (long)(kb + 4 * a) * 64 + 32); }
#pragma unroll
  for (int dt = 0; dt < 4; ++dt) f.v[dt] = ld8(vp0 + (long)dt * 16 * SEQ + kb);
}
DI bool sb_chunk(const SbFrag& f, int kb, int t, int quad, const bf16x8 (&qf)[2], f32x4 (&o)[4], float& carry) {
  f32x4 s[2];
#pragma unroll
  for (int a = 0; a < 2; ++a) {
    s[a] = MFMA16(f.k[a][0], qf[0], ((f32x4){0.f, 0.f, 0.f, 0.f}));
    s[a] = MFMA16(f.k[a][1], qf[1], s[a]);
  }
  float L[8], ls[8]; bool val[8];
  float tot = 0.f;
#pragma unroll
  for (int idx = 0; idx < 8; ++idx) {
    const float z = s[idx >> 2][idx & 3] * 0.125f;
    const int key = kb + 8 * quad + idx;
    val[idx] = key < t;
    const float sp = fmaxf(z, 0.f) + __logf(1.f + __expf(-fabsf(z)));
    L[idx] = val[idx] ? -sp : 0.f;
    ls[idx] = z - sp;
    tot += L[idx];
  }
  const float a1 = __shfl_xor(tot, 16), a2 = __shfl_xor(tot, 32), a3 = __shfl_xor(a1, 32);
  const float higher = ((quad ^ 1) > quad ? a1 : 0.f) + ((quad ^ 2) > quad ? a2 : 0.f) + ((quad ^ 3) > quad ? a3 : 0.f);
  float run = carry + higher;
  float wv[8];
#pragma unroll
  for (int idx = 7; idx >= 0; --idx) {
    wv[idx] = val[idx] ? __expf(ls[idx] + run) : 0.f;
    run += L[idx];
  }
  carry += (tot + a1) + (a2 + a3);
  const bf16x8 pf = mk8((u32x4){pk2(wv[0], wv[1]), pk2(wv[2], wv[3]), pk2(wv[4], wv[5]), pk2(wv[6], wv[7])});
#pragma unroll
  for (int dt = 0; dt < 4; ++dt) o[dt] = MFMA16(f.v[dt], pf, o[dt]);
  return __all(carry < -110.f);
}

DI void sb_attn_wave(const Params& p, int b, int h, int t0, bf16_t* ybase) {
  const int lane = my_tid() & 63, qi = lane & 15, quad = lane >> 4;
  const bf16_t* Q = p.sbq() + (long)(b * 8 + h) * SEQ * 64;
  const bf16_t* K = p.sbk() + (long)(b * 8 + h) * SEQ * 64;
  const bf16_t* Vt = p.sbvt() + (long)(b * 8 + h) * 64 * SEQ;
  const int t = t0 + qi;
  bf16x8 qf[2];
  qf[0] = ld8(Q + (long)t * 64 + quad * 8); qf[1] = ld8(Q + (long)t * 64 + 32 + quad * 8);
  f32x4 o[4];
#pragma unroll
  for (int dt = 0; dt < 4; ++dt) o[dt] = (f32x4){0.f, 0.f, 0.f, 0.f};
  float carry = 0.f;
  const int krow = 8 * (qi >> 2) + (qi & 3);
  const bf16_t* kp0 = K + (long)krow * 64 + quad * 8;
  const bf16_t* vp0 = Vt + (long)qi * SEQ + 8 * quad;
  int kb = t0 & ~31;
  SbFrag f0, f1, f2;
  sb_load(f0, kp0, vp0, kb); sb_load(f1, kp0, vp0, max(kb - 32, 0));
  while (true) {
    sb_load(f2, kp0, vp0, max(kb - 64, 0));
    if (sb_chunk(f0, kb, t, quad, qf, o, carry) || kb < 32) break;
    sb_load(f0, kp0, vp0, max(kb - 96, 0));
    if (sb_chunk(f1, kb - 32, t, quad, qf, o, carry) || kb < 64) break;
    sb_load(f1, kp0, vp0, max(kb - 128, 0));
    if (sb_chunk(f2, kb - 64, t, quad, qf, o, carry) || kb < 96) break;
    kb -= 96;
  }
  const long zo = ((long)b * SEQ + t) * 512 + h * 64 + quad * 4;
  const bf16_t* zp = p.sbz() + zo; bf16_t* yp = ybase + zo;
#pragma unroll
  for (int dt = 0; dt < 4; ++dt) {
    const u32x2 zz = *(const u32x2*)(zp + dt * 16);
    *(u32x2*)(yp + dt * 16) = (u32x2){pk2(o[dt][0] * bflo(zz[0]), o[dt][1] * bfhi(zz[0])), pk2(o[dt][2] * bflo(zz[1]), o[dt][3] * bfhi(zz[1]))};
  }
}

DI void phaseB(const Params& p0, int layer, unsigned char* lds, bool probe) {
  const int NITEM = 128 + BATCH * 8 * 16;
  for (int it = blockIdx.x; it < NITEM; it += gridDim.x) {
    const Params p = relaunder(p0);
    if (it < 128) { compress_partial(p, it, lds); continue; }
    const int i = it - 128, qt = 15 - (i >> 7), bh = i & 127;
    sb_attn_wave(p, bh >> 3, bh & 7, qt * 128 + (my_tid() >> 6) * 16, probe ? p.dummy() : p.sbz());
  }
}

constexpr int NSA_LO_BYTES = 8 * 8192;
constexpr int NSA_KROW = 144, NSA_VROW = 80;
constexpr int NSA_SLOT = 32 * NSA_KROW + 64 * NSA_VROW;
constexpr int NSA_SLOT0 = NSA_LO_BYTES, NSA_BLIST = NSA_SLOT0 + 2 * NSA_SLOT, NSA_UMW = NSA_BLIST + 64 * 4;

struct KVFrag { bf16x8 k[2][2]; bf16x8 v[4]; };
DI void nsa_ldsfrag(KVFrag& f, const unsigned char* slot, int qi, int quad) {
  const int krow = 8 * (qi >> 2) + (qi & 3);
#pragma unroll
  for (int a = 0; a < 2; ++a) { const unsigned char* kp = slot + (krow + 4 * a) * NSA_KROW + quad * 16; f.k[a][0] = mk8(*(const u32x4*)kp); f.k[a][1] = mk8(*(const u32x4*)(kp + 64)); }
#pragma unroll
  for (int dt = 0; dt < 4; ++dt) f.v[dt] = mk8(*(const u32x4*)(slot + 32 * NSA_KROW + (dt * 16 + qi) * NSA_VROW + quad * 16));
}
template <int MODE>
DI void nsa_chunk(const KVFrag& f, int kb, int t, bool selbit, const bf16x8 (&qf)[4][2], f32x4 (&O)[4][4], float (&m)[4], float (&l)[4], int quad, bool online) {
  const float SC = 0.125f * 1.44269504089f;
  bool val[8];
#pragma unroll
  for (int idx = 0; idx < 8; ++idx) {
    const int key = kb + 8 * quad + idx;
    val[idx] = MODE == 0 ? (selbit && key <= t) : (key <= t && key > t - 512);
  }
#pragma unroll
  for (int hh = 0; hh < 4; ++hh) {
    f32x4 s[2];
#pragma unroll
    for (int a = 0; a < 2; ++a) { s[a] = MFMA16(f.k[a][0], qf[hh][0], ((f32x4){0.f, 0.f, 0.f, 0.f})); s[a] = MFMA16(f.k[a][1], qf[hh][1], s[a]); }
    float mn = m[hh];
    if (online) {
      float cm = -1e30f;
#pragma unroll
      for (int idx = 0; idx < 8; ++idx) if (val[idx]) cm = fmaxf(cm, s[idx >> 2][idx & 3] * SC);
      cm = fmaxf(cm, __shfl_xor(cm, 16)); cm = fmaxf(cm, __shfl_xor(cm, 32));
      mn = fmaxf(mn, cm);
      const float alpha = __builtin_amdgcn_exp2f(m[hh] - mn);
      m[hh] = mn; l[hh] *= alpha;
#pragma unroll
      for (int dt = 0; dt < 4; ++dt) O[hh][dt] = O[hh][dt] * alpha;
    }
    float pv[8]; float ps = 0.f;
#pragma unroll
    for (int idx = 0; idx < 8; ++idx) { pv[idx] = val[idx] ? __builtin_amdgcn_exp2f(fmaf(s[idx >> 2][idx & 3], SC, -mn)) : 0.f; ps += pv[idx]; }
    l[hh] += ps;
    const bf16x8 pf = mk8((u32x4){pk2(pv[0], pv[1]), pk2(pv[2], pv[3]), pk2(pv[4], pv[5]), pk2(pv[6], pv[7])});
#pragma unroll
    for (int dt = 0; dt < 4; ++dt) O[hh][dt] = MFMA16(f.v[dt], pf, O[hh][dt]);
  }
}

template <int MODE>
DI void nsa_branch(const bf16_t* __restrict__ Kb, const bf16_t* __restrict__ Vtb, unsigned char* lds, int nb, int t, int cur, unsigned selmask, unsigned umall,
                   const bf16x8 (&qf)[4][2], f32x4 (&O)[4][4], float (&m)[4], float (&l)[4], bool online) {
  const int tid = my_tid(), lane = tid & 63, qi = lane & 15, quad = lane >> 4;
  const int* blist = (const int*)(lds + NSA_BLIST);
  const bool isv = tid >= 256;
  const int t2 = tid & 255;
  const bf16_t* gsrc = isv ? Vtb + (long)(t2 >> 2) * SEQ + (t2 & 3) * 8 : Kb + (long)(t2 >> 3) * 64 + (t2 & 7) * 8;
  const long gmul = isv ? 1 : 64;
  const int ldst = isv ? 32 * NSA_KROW + (t2 >> 2) * NSA_VROW + (t2 & 3) * 16 : (t2 >> 3) * NSA_KROW + (t2 & 7) * 16;
  unsigned char* slot0 = lds + NSA_SLOT0; unsigned char* slot1 = slot0 + NSA_SLOT;
  const int N = 2 * nb;
  auto kbof = [&](int n) { return blist[n >> 1] * 64 + (n & 1) * 32; };
  u32x4 ra = *(const u32x4*)(gsrc + (long)kbof(0) * gmul), rb = *(const u32x4*)(gsrc + (long)kbof(1) * gmul);
  *(u32x4*)(slot0 + ldst) = ra;
  __syncthreads();
#pragma unroll 1
  for (int n = 0; n < N; n += 2) {
    const int j = blist[n >> 1];
    const bool won = MODE == 0 ? ((umall >> j) & 1u) != 0 : (j >= cur - 8 && j <= cur);
    const bool bit = (selmask >> j) & 1u;
    ra = *(const u32x4*)(gsrc + (long)kbof(min(n + 2, N - 2)) * gmul);
    if (won) { KVFrag f; nsa_ldsfrag(f, slot0, qi, quad); nsa_chunk<MODE>(f, j * 64, t, bit, qf, O, m, l, quad, online); }
    *(u32x4*)(slot1 + ldst) = rb;
    __syncthreads();
    rb = *(const u32x4*)(gsrc + (long)kbof(min(n + 3, N - 1)) * gmul);
    if (won) { KVFrag f; nsa_ldsfrag(f, slot1, qi, quad); nsa_chunk<MODE>(f, j * 64 + 32, t, bit, qf, O, m, l, quad, online); }
    *(u32x4*)(slot0 + ldst) = ra;
    __syncthreads();
  }
}

template <bool LAST>
DI void nsa_finish(u32x2* lo, f32x4 (&O)[4][4], float (&m)[4], float (&l)[4], const float (&gate)[4], const bf16_t* zp, bf16_t* yp, float minit) {
#pragma unroll
  for (int hh = 0; hh < 4; ++hh) {
    float lt = l[hh]; lt += __shfl_xor(lt, 16); lt += __shfl_xor(lt, 32);
    const float f = lt > 0.f ? gate[hh] / lt : 0.f;
#pragma unroll
    for (int dt = 0; dt < 4; ++dt) {
      const u32x2 a = lo[(hh * 4 + dt) * 64];
      const f32x4 v = (f32x4){bflo(a[0]), bfhi(a[0]), bflo(a[1]), bfhi(a[1])} + O[hh][dt] * f;
      if (LAST) {
        const u32x2 zz = *(const u32x2*)(zp + hh * 64 + dt * 16);
        *(u32x2*)(yp + hh * 64 + dt * 16) = (u32x2){pk2(v[0] * bflo(zz[0]), v[1] * bfhi(zz[0])), pk2(v[2] * bflo(zz[1]), v[3] * bfhi(zz[1]))};
      } else {
        lo[(hh * 4 + dt) * 64] = (u32x2){pk2(v[0], v[1]), pk2(v[2], v[3])};
        O[hh][dt] = (f32x4){0.f, 0.f, 0.f, 0.f};
      }
    }
    m[hh] = minit; l[hh] = 0.f;
  }
}

DI void nsa_wave(const Params& p, int layer, int b, int g, int t0, unsigned char* lds, bf16_t* ybase) {
  const int lane = my_tid() & 63, qi = lane & 15, quad = lane >> 4;
  const int t = t0 + qi, cur = t0 >> 6;
  const long tok = (long)b * SEQ + t;
  const int bg = b * 2 + g;
  u32x2* lo = (u32x2*)lds + (my_tid() >> 6) * 1024 + lane;

  const float mf_c = p.mfix()[layer * 4 + 0], mf_s = p.mfix()[layer * 4 + 1], mf_w = p.mfix()[layer * 4 + 2];
  const bool on_c = mf_c > 60.f, on_s = mf_s > 60.f, on_w = mf_w > 60.f;
  const float SC = 0.125f * 1.44269504089f;
  const bf16_t* Kc = p.kc() + (long)bg * 128 * 64;
  const bf16_t* Vc = p.vct() + (long)bg * 64 * 128;
  f32x4 ph[8];
#pragma unroll
  for (int kt = 0; kt < 8; ++kt) ph[kt] = (f32x4){0.f, 0.f, 0.f, 0.f};
#pragma unroll 1
  for (int hh = 0; hh < 4; ++hh) {
    const bf16_t* qp0 = p.nq() + ((long)(b * 8 + g * 4 + hh) * SEQ + t) * 64 + quad * 8;
    const bf16x8 q0 = ld8(qp0), q1 = ld8(qp0 + 32); const float gt = p.ngate()[tok * 32 + g * 4 + hh];
    f32x4 sc[8];
    float mx = on_c ? -1e30f : mf_c;
#pragma unroll
    for (int kt = 0; kt < 8; ++kt) {
      const bf16_t* kp = Kc + (long)(kt * 16 + qi) * 64 + quad * 8;
      sc[kt] = MFMA16(ld8(kp), q0, ((f32x4){0.f, 0.f, 0.f, 0.f}));
      sc[kt] = MFMA16(ld8(kp + 32), q1, sc[kt]);
      sc[kt] = sc[kt] * SC;
    }
    if (on_c) {
#pragma unroll
      for (int kt = 0; kt < 8; ++kt)
#pragma unroll
        for (int r = 0; r < 4; ++r) { const int c = kt * 16 + quad * 4 + r; if (c < NCMP && 16 * c + 31 <= t) mx = fmaxf(mx, sc[kt][r]); }
      mx = fmaxf(mx, __shfl_xor(mx, 16)); mx = fmaxf(mx, __shfl_xor(mx, 32));
    }
    float sum = 0.f;
#pragma unroll
    for (int kt = 0; kt < 8; ++kt)
#pragma unroll
      for (int r = 0; r < 4; ++r) {
        const int c = kt * 16 + quad * 4 + r;
        const float e = (c < NCMP && 16 * c + 31 <= t) ? __builtin_amdgcn_exp2f(sc[kt][r] - mx) : 0.f;
        sc[kt][r] = e; sum += e;
      }
    sum += __shfl_xor(sum, 16); sum += __shfl_xor(sum, 32);
    const float inv = sum > 0.f ? 1.f / sum : 0.f;
#pragma unroll
    for (int kt = 0; kt < 8; ++kt) { sc[kt] = sc[kt] * inv; ph[kt] += sc[kt]; }
    f32x4 oc[4];
#pragma unroll
    for (int dt = 0; dt < 4; ++dt) oc[dt] = (f32x4){0.f, 0.f, 0.f, 0.f};
#pragma unroll
    for (int mm = 0; mm < 4; ++mm) {
      const bf16x8 pf = mk8((u32x4){pk2(sc[2 * mm][0], sc[2 * mm][1]), pk2(sc[2 * mm][2], sc[2 * mm][3]), pk2(sc[2 * mm + 1][0], sc[2 * mm + 1][1]), pk2(sc[2 * mm + 1][2], sc[2 * mm + 1][3])});
#pragma unroll
      for (int dt = 0; dt < 4; ++dt) {
        const bf16_t* vp = Vc + (long)(dt * 16 + qi) * 128 + 32 * mm + quad * 4;
        const u32x2 lo = *(const u32x2*)vp, hi = *(const u32x2*)(vp + 16);
        oc[dt] = MFMA16(mk8((u32x4){lo[0], lo[1], hi[0], hi[1]}), pf, oc[dt]);
      }
    }
#pragma unroll
    for (int dt = 0; dt < 4; ++dt) { const f32x4 v = oc[dt] * gt; lo[(hh * 4 + dt) * 64] = (u32x2){pk2(v[0], v[1]), pk2(v[2], v[3])}; }
  }
  float imp[8];
  {
    float rot[8];
#pragma unroll
    for (int kt = 0; kt < 8; ++kt) rot[kt] = __shfl(ph[kt][3], (lane + 48) & 63);
#pragma unroll
    for (int kt = 0; kt < 8; ++kt) {
      const float extra = quad > 0 ? rot[kt] : (kt > 0 ? rot[kt > 0 ? kt - 1 : 0] : 0.f);
      const float v = (ph[kt][0] + ph[kt][1]) + (ph[kt][2] + ph[kt][3]) + extra;
      const int j = 4 * kt + quad;
      const bool forced = j == 0 || j == cur || j == cur - 1;
      imp[kt] = j <= cur ? v + (forced ? 1e4f : 0.f) : -1e30f;
    }
  }
  unsigned selmask = 0;
  {
    int rank[8];
#pragma unroll
    for (int kt = 0; kt < 8; ++kt) rank[kt] = 0;
#pragma unroll 1
    for (int q2 = 0; q2 < 4; ++q2)
#pragma unroll
      for (int k2 = 0; k2 < 8; ++k2) {
        const float ov = __shfl(imp[k2], qi + 16 * q2);
#pragma unroll
        for (int kt = 0; kt < 8; ++kt) {
          const bool before = k2 < kt || (k2 == kt && q2 < quad);
          rank[kt] += (ov > imp[kt] || (ov == imp[kt] && before)) ? 1 : 0;
        }
      }
#pragma unroll
    for (int kt = 0; kt < 8; ++kt) if (rank[kt] < 8 && 4 * kt + quad <= cur) selmask |= 1u << (4 * kt + quad);
    selmask |= __shfl_xor(selmask, 16); selmask |= __shfl_xor(selmask, 32);
  }

  unsigned umall = selmask;
  umall |= __shfl_xor(umall, 1); umall |= __shfl_xor(umall, 2); umall |= __shfl_xor(umall, 4); umall |= __shfl_xor(umall, 8);
  umall = __builtin_amdgcn_readfirstlane(umall);
  const int wv = my_tid() >> 6;
  unsigned* umw = (unsigned*)(lds + NSA_UMW); int* blist = (int*)(lds + NSA_BLIST);
  if (lane == 0) umw[wv] = umall;
  bf16x8 qf[4][2];
#pragma unroll
  for (int hh = 0; hh < 4; ++hh) {
    const bf16_t* qp = p.nq() + ((long)(b * 8 + g * 4 + hh) * SEQ + t) * 64 + quad * 8;
    qf[hh][0] = ld8(qp); qf[hh][1] = ld8(qp + 32);
  }
  float gate[3][4];
#pragma unroll
  for (int br = 1; br < 3; ++br) { const f32x4 gv = *(const f32x4*)(p.ngate() + tok * 32 + br * 8 + g * 4); gate[br][0] = gv[0]; gate[br][1] = gv[1]; gate[br][2] = gv[2]; gate[br][3] = gv[3]; }
  f32x4 O[4][4]; float m[4], l[4];
#pragma unroll
  for (int hh = 0; hh < 4; ++hh) { m[hh] = on_s ? -1e30f : mf_s; l[hh] = 0.f;
#pragma unroll
    for (int dt = 0; dt < 4; ++dt) O[hh][dt] = (f32x4){0.f, 0.f, 0.f, 0.f}; }
  __syncthreads();
  int nb;
  {
    unsigned ub = 0;
#pragma unroll
    for (int i = 0; i < 8; ++i) ub |= umw[i];
    nb = __builtin_popcount(ub);
    if (my_tid() < 32) { if ((ub >> my_tid()) & 1u) blist[__builtin_popcount(ub & ((1u << my_tid()) - 1u))] = my_tid(); }
    __syncthreads();
    nsa_branch<0>(p.ks() + (long)bg * SEQ * 64, p.vst() + (long)bg * 64 * SEQ, lds, nb, t, cur, selmask, umall, qf, O, m, l, on_s);
    nsa_finish<false>(lo, O, m, l, gate[1], nullptr, nullptr, on_w ? -1e30f : mf_w);
  }
  {
    const int cur0 = (t0 >> 7) * 2, jlo = cur0 >= 8 ? cur0 - 8 : 0;
    nb = cur0 + 2 - jlo;
    if (my_tid() < nb) blist[my_tid()] = jlo + my_tid();
    __syncthreads();
    nsa_branch<1>(p.kw() + (long)bg * SEQ * 64, p.vwt() + (long)bg * 64 * SEQ, lds, nb, t, cur, selmask, umall, qf, O, m, l, on_w);
    nsa_finish<true>(lo, O, m, l, gate[2], p.nz() + tok * 512 + g * 256 + quad * 4, ybase + tok * 512 + g * 256 + quad * 4, 0.f);
  }
  __syncthreads();
}

DI void phaseC(const Params& p0, int layer, unsigned char* lds, bool probe) {
  const int NITEM = BATCH * 2 * 16;
  for (int it = blockIdx.x; it < NITEM; it += gridDim.x) {
    const Params p = relaunder(p0);
    const int qt = 15 - (it >> 5), bg = it & 31;
    nsa_wave(p, layer, bg >> 1, bg & 1, qt * 128 + (my_tid() >> 6) * 16, lds, probe ? p.dummy() : p.nz());
  }
}

DI void phaseD(const Params& p0, const Slot sl, int layer, unsigned char* lds) {
  const Params p = relaunder(p0);
  bf16_t* gl = (bf16_t*)lds;
  int mt, nt;
  for (int it = 0; tile_order(sl, it, 4, mt, nt); ++it) {
#pragma unroll 1
    for (int which = 0; which < 2; ++which) {
      const bf16_t* Wg = (which ? p.wupb_t() : p.wupa_t()) + ((long)nt * 256) * 512;
      const bf16_t* Yg = (which ? p.nz() : p.sbz()) + (long)mt * 256 * 512;
      const bf16_t* Gg = which ? p.gb() : p.ga();
      f32x4 acc[8][4]; zero_acc(acc);
      gemm_core(Wg, 512, Yg, 512, 512, gl, acc);
      const int tid = my_tid(), lane = tid & 63, w = tid >> 6, wa = w >> 2, wb = w & 3, qi = lane & 15, quad = lane >> 4;
#pragma unroll
      for (int j = 0; j < 4; ++j) {
        const long tok = (long)mt * 256 + wb * 64 + j * 16 + qi;
#pragma unroll
        for (int i = 0; i < 8; ++i) {
          const long off = tok * 1024 + nt * 256 + wa * 128 + i * 16 + quad * 4;
          const u32x2 xg = *(const u32x2*)(Gg + off);
          const f32x4 v = acc[i][j];
          float o0 = bflo(xg[0]) * v[0], o1 = bfhi(xg[0]) * v[1], o2 = bflo(xg[1]) * v[2], o3 = bfhi(xg[1]) * v[3];
          if (which) { const u32x2 a = *(const u32x2*)(p.merged() + off); o0 += bflo(a[0]); o1 += bfhi(a[0]); o2 += bflo(a[1]); o3 += bfhi(a[1]); }
          *(u32x2*)(p.merged() + off) = (u32x2){pk2(o0, o1), pk2(o2, o3)};
          if ((i & 3) == 3) asm volatile("" ::: "memory");
        }
      }
    }
  }
}

DI void phaseE(const Params& p0, const Slot sl, int layer, unsigned char* lds, const float* xsrc) {
  const Params p = relaunder(p0);
  bf16_t* gl = (bf16_t*)lds;
  int mt, nt;
  for (int it = 0; tile_order(sl, it, 4, mt, nt); ++it) {
    f32x4 acc[8][4]; zero_acc(acc);
    gemm_core(p.wout_t() + ((long)nt * 256) * 1024, 1024, p.merged() + (long)mt * 256 * 1024, 1024, 1024, gl, acc);
    const int tid = my_tid(), lane = tid & 63, w = tid >> 6, wa = w >> 2, wb = w & 3, qi = lane & 15, quad = lane >> 4;
#pragma unroll
    for (int j = 0; j < 4; ++j) {
      const long tok = (long)mt * 256 + wb * 64 + j * 16 + qi;
      float ss = 0.f;
#pragma unroll
      for (int i = 0; i < 8; ++i) {
        const long off = tok * 1024 + nt * 256 + wa * 128 + i * 16 + quad * 4;
        const f32x4 xo = *(const f32x4*)(xsrc + off);
        const f32x4 xn = xo + acc[i][j];
        *(f32x4*)(p.out + off) = xn;
        *(u32x2*)(p.xb() + off + tok * (LDX - D_MODEL)) = (u32x2){pk2(xn[0], xn[1]), pk2(xn[2], xn[3])};
        ss += xn[0] * xn[0] + xn[1] * xn[1] + xn[2] * xn[2] + xn[3] * xn[3];
      }
      ss += __shfl_xor(ss, 16); ss += __shfl_xor(ss, 32);
      if (quad == 0) p.part()[tok * 16 + nt * 2 + wa] = ss;
    }
  }
}

#ifndef STOP_AFTER
#define STOP_AFTER 0
#endif
constexpr int LDS_BYTES = LDS_GEMM_BYTES + 1024;

__global__ void __launch_bounds__(512) hybrid_megakernel(Params p) {
  extern __shared__ __attribute__((aligned(16))) unsigned char lds[];
  cg::grid_group grid = cg::this_grid();
  __shared__ int s_xcc, s_rank, s_ok;
  if (threadIdx.x == 0) {
    const unsigned xcc = (unsigned)__builtin_amdgcn_s_getreg((3 << 11) | 20) & 7u;
    s_xcc = (int)xcc; s_rank = (int)atomicAdd(p.ctl() + xcc, 1u);
  }
  phase_prologue(p, lds);
  grid.sync();
  if (threadIdx.x == 0) {
    int ok = 1;
    for (int i = 0; i < 8; ++i) ok &= (__hip_atomic_load(p.ctl() + i, __ATOMIC_RELAXED, __HIP_MEMORY_SCOPE_AGENT) == (gridDim.x >> 3));
    s_ok = ok;
  }
  __syncthreads();
  const Slot sl = {s_ok ? s_xcc : (int)(blockIdx.x & 7), s_ok ? s_rank : (int)(blockIdx.x >> 3)};
  for (int layer = 0; layer < DEPTH; ++layer) {
    if (layer > 0) convert_weights(p, layer, lds, 2);
    if (STOP_AFTER != 0 && STOP_AFTER == layer * 10) return;
    phaseA(p, sl, layer, lds);
    grid.sync();
#ifdef PROBE_A
    phaseA(p, sl, layer, lds, PROBE_A >= 2 ? PROBE_A : 0);
    grid.sync();
#endif
    if (STOP_AFTER == layer * 10 + 1) return;
#ifdef PROBE_B
    phaseB(p, layer, lds, true);
    grid.sync();
#endif
    phaseB(p, layer, lds, false);
    grid.sync();
    phaseB2(p, layer, lds);
    grid.sync();
    if (STOP_AFTER == layer * 10 + 2) return;
#ifdef PROBE_C
    phaseC(p, layer, lds, true);
    grid.sync();
#endif
    phaseC(p, layer, lds, false);
    grid.sync();
    if (STOP_AFTER == layer * 10 + 3) return;
    phaseD(p, sl, layer, lds);
    grid.sync();
#ifdef PROBE_D
    phaseD(p, sl, layer, lds);
    grid.sync();
#endif
    if (STOP_AFTER == layer * 10 + 4) return;
    if (layer == 0) phaseE(p, sl, layer, lds, p.x_in); else phaseE(p, sl, layer, lds, p.out);
    if (layer + 1 < DEPTH) convert_weights(p, layer + 1, lds, 1);
    if (layer + 1 < DEPTH) grid.sync();
    if (STOP_AFTER == layer * 10 + 5) return;
  }
}

extern "C" void kernel_launch(void* const* d_in, const int* in_sizes, int n_in, void* d_out, int out_size,
                              void* d_ws, size_t ws_size, hipStream_t stream) {
  static int grid_blocks = 0;
  if (!grid_blocks) {
    int dev = 0, cus = 0, per_cu = 0;
    (void)hipGetDevice(&dev);
    (void)hipDeviceGetAttribute(&cus, hipDeviceAttributeMultiprocessorCount, dev);
    if (hipFuncSetAttribute((const void*)hybrid_megakernel, hipFuncAttributeMaxDynamicSharedMemorySize, LDS_BYTES) != hipSuccess) fprintf(stderr, "hipFuncSetAttribute(max dynamic LDS) failed\n");
    (void)hipOccupancyMaxActiveBlocksPerMultiprocessor(&per_cu, hybrid_megakernel, NTHR, LDS_BYTES);
    (void)hipGetLastError();
    if (per_cu > 1) per_cu = 1;
    if (per_cu < 1) per_cu = 1;
    grid_blocks = (cus * per_cu) & ~7;
  }
  Params a{};
  a.x_in = (const float*)d_in[0]; a.pos = (const int*)d_in[1]; a.norm_g = (const float*)d_in[2]; a.w_in = (const float*)d_in[3];
  a.q_norm_g = (const float*)d_in[4]; a.k_norm_g = (const float*)d_in[5]; a.cmp_pe = (const float*)d_in[6]; a.cmp_w1 = (const float*)d_in[7];
  a.cmp_b1 = (const float*)d_in[8]; a.cmp_w2 = (const float*)d_in[9]; a.w_up_a = (const float*)d_in[10]; a.w_up_b = (const float*)d_in[11];
  a.w_out = (const float*)d_in[12];
  a.out = (float*)d_out; a.ws = (unsigned char*)d_ws;
  if (WS_NEED > ws_size) { fprintf(stderr, "workspace too small: need %zu have %zu\n", (size_t)WS_NEED, ws_size); return; }
  (void)hipMemsetAsync((unsigned char*)d_ws + OFF_CTL, 0, 256, stream);
  void* args[] = {&a};
  hipError_t e = hipLaunchCooperativeKernel((void*)hybrid_megakernel, dim3(grid_blocks), dim3(NTHR), args, LDS_BYTES, stream);
  if (e != hipSuccess) fprintf(stderr, "cooperative launch failed: %s (grid %d)\n", hipGetErrorString(e), grid_blocks);
}
```

```cpp
#include <hip/hip_runtime.h>
#include <hip/hip_cooperative_groups.h>
#include <cstdio>
#include <cstdint>
namespace cg = cooperative_groups;

typedef unsigned short bf16_t;
typedef short bf16x8 __attribute__((ext_vector_type(8)));
typedef float f32x4 __attribute__((ext_vector_type(4)));
typedef float f32x2 __attribute__((ext_vector_type(2)));
typedef unsigned u32x4 __attribute__((ext_vector_type(4)));
typedef unsigned u32x2 __attribute__((ext_vector_type(2)));
typedef __bf16 bf16x2_t __attribute__((ext_vector_type(2)));

#define DI __device__ __forceinline__
#define MFMA16(a, b, c) __builtin_amdgcn_mfma_f32_16x16x32_bf16((a), (b), (c), 0, 0, 0)

constexpr int D_MODEL = 1024, BATCH = 16, SEQ = 2048, DEPTH = 4, NTOK = BATCH * SEQ;
constexpr int N_IN = 5912, NP = 6144, NT_IN = 24;
constexpr int NTHR = 512;
constexpr int LDX = D_MODEL + 64;
constexpr int NCMP = 127;
constexpr float NORM_EPS = 1e-6f;

DI unsigned pk2(float lo, float hi) { f32x2 v = {lo, hi}; bf16x2_t b = __builtin_convertvector(v, bf16x2_t); return __builtin_bit_cast(unsigned, b); }
DI float bflo(unsigned u) { return __uint_as_float(u << 16); }
DI float bfhi(unsigned u) { return __uint_as_float(u & 0xffff0000u); }
DI float sigmoidf_(float x) { return __builtin_amdgcn_rcpf(1.f + __builtin_amdgcn_exp2f(-1.44269504089f * x)); }
DI float siluf_(float x) { return x * __builtin_amdgcn_rcpf(1.f + __builtin_amdgcn_exp2f(-1.44269504089f * x)); }
DI bf16x8 mk8(u32x4 v) { return __builtin_bit_cast(bf16x8, v); }
DI bf16x8 ld8(const bf16_t* p) { return __builtin_bit_cast(bf16x8, *(const u32x4*)p); }


DI void sincos_acc(float angf, float& sn, float& cs) {
  const double a = (double)angf;
  const double k = rint(a * 0.63661977236758134308);
  const double y = (a - k * 1.57079632679489655800) - k * 6.12323399573676603587e-17;
  const double y2 = y * y;
  const double sp = y * (1.0 + y2 * (-1.0 / 6 + y2 * (1.0 / 120 + y2 * (-1.0 / 5040 + y2 * (1.0 / 362880 + y2 * (-1.0 / 39916800 + y2 * (1.0 / 6227020800.0)))))));
  const double cp = 1.0 + y2 * (-0.5 + y2 * (1.0 / 24 + y2 * (-1.0 / 720 + y2 * (1.0 / 40320 + y2 * (-1.0 / 3628800 + y2 * (1.0 / 479001600.0))))));
  const int q = ((int)k) & 3;
  const double s_ = (q & 1) ? cp : sp, c_ = (q & 1) ? sp : cp;
  sn = (float)((q & 2) ? -s_ : s_);
  cs = (float)(((q + 1) & 2) ? -c_ : c_);
}
DI float inv_freq(int f) { return (float)exp(-(double)f * (9.21034037197618273607 / 32.0)); }

constexpr size_t al256(size_t x) { return (x + 255) & ~(size_t)255; }
constexpr size_t OFF_WT_IN = 0;
constexpr size_t OFF_W1T = OFF_WT_IN + al256((size_t)NP * LDX * 2);
constexpr size_t OFF_W2T = OFF_W1T + al256((size_t)2 * 256 * 2048 * 2);
constexpr size_t OFF_WUPA = OFF_W2T + al256((size_t)2 * 64 * 256 * 2);
constexpr size_t OFF_WUPB = OFF_WUPA + al256((size_t)1024 * 512 * 2);
constexpr size_t OFF_WOUT = OFF_WUPB + al256((size_t)1024 * 512 * 2);
constexpr size_t OFF_B1EFF = OFF_WOUT + al256((size_t)1024 * 1024 * 2);
constexpr size_t OFF_COST = OFF_B1EFF + al256((size_t)DEPTH * 2 * 16 * 256 * 4);
constexpr size_t OFF_SINT = OFF_COST + al256((size_t)NTOK * 32 * 4);
constexpr size_t OFF_COSC = OFF_SINT + al256((size_t)NTOK * 32 * 4);
constexpr size_t OFF_SINC = OFF_COSC + al256((size_t)BATCH * 128 * 32 * 4);
constexpr size_t OFF_XB = OFF_SINC + al256((size_t)BATCH * 128 * 32 * 4);
constexpr size_t OFF_PART = OFF_XB + al256((size_t)NTOK * LDX * 2);
constexpr size_t OFF_SBQ = OFF_PART + al256((size_t)NTOK * 16 * 4);
constexpr size_t OFF_SBK = OFF_SBQ + al256((size_t)NTOK * 512 * 2);
constexpr size_t OFF_SBVT = OFF_SBK + al256((size_t)NTOK * 512 * 2);
constexpr size_t OFF_SBZ = OFF_SBVT + al256((size_t)NTOK * 512 * 2);
constexpr size_t OFF_NQ = OFF_SBZ + al256((size_t)NTOK * 512 * 2);
constexpr size_t OFF_KCR = OFF_NQ + al256((size_t)NTOK * 512 * 2);
constexpr size_t OFF_VCR = OFF_KCR + al256((size_t)NTOK * 128 * 2);
constexpr size_t OFF_KS = OFF_VCR + al256((size_t)NTOK * 128 * 2);
constexpr size_t OFF_VST = OFF_KS + al256((size_t)NTOK * 128 * 2);
constexpr size_t OFF_KW = OFF_VST + al256((size_t)NTOK * 128 * 2);
constexpr size_t OFF_VWT = OFF_KW + al256((size_t)NTOK * 128 * 2);
constexpr size_t OFF_NGATE = OFF_VWT + al256((size_t)NTOK * 128 * 2);
constexpr size_t OFF_NZ = OFF_NGATE + al256((size_t)NTOK * 32 * 4);
constexpr size_t OFF_GA = OFF_NZ + al256((size_t)NTOK * 512 * 2);
constexpr size_t OFF_GB = OFF_GA + al256((size_t)NTOK * 1024 * 2);
constexpr size_t OFF_HID = OFF_GB + al256((size_t)NTOK * 1024 * 2);
constexpr size_t OFF_KC = OFF_HID + al256((size_t)4 * 32 * 256 * 256 * 4);
constexpr size_t OFF_VCT = OFF_KC + al256((size_t)BATCH * 2 * 128 * 64 * 2);
constexpr size_t OFF_QNG = OFF_VCT + al256((size_t)BATCH * 2 * 64 * 128 * 2);
constexpr size_t OFF_KNG = OFF_QNG + al256((size_t)DEPTH * 64 * 4);
constexpr size_t OFF_CTL = OFF_KNG + al256((size_t)DEPTH * 3 * 64 * 4);
constexpr size_t OFF_MFIX_BASE = OFF_CTL + 256;
constexpr size_t OFF_MFIX_OLD = OFF_KNG + al256((size_t)DEPTH * 3 * 64 * 4);
constexpr size_t OFF_MFIX = OFF_MFIX_BASE;
constexpr size_t OFF_DUMMY = OFF_MFIX + 256;
constexpr size_t WS_NEED = OFF_DUMMY + 256;

struct Params {
  const float* x_in; const int* pos; const float* norm_g; const float* w_in; const float* q_norm_g; const float* k_norm_g;
  const float* cmp_pe; const float* cmp_w1; const float* cmp_b1; const float* cmp_w2; const float* w_up_a; const float* w_up_b; const float* w_out;
  float* out; unsigned char* ws;
#define WSBUF(T, name, OFF) DI T* name() const { return (T*)(ws + (OFF)); }
  WSBUF(bf16_t, wt_in, OFF_WT_IN) WSBUF(bf16_t, w1t, OFF_W1T) WSBUF(bf16_t, w2t, OFF_W2T) WSBUF(bf16_t, wupa_t, OFF_WUPA) WSBUF(bf16_t, wupb_t, OFF_WUPB) WSBUF(bf16_t, wout_t, OFF_WOUT)
  WSBUF(float, b1eff, OFF_B1EFF) WSBUF(float, cosT, OFF_COST) WSBUF(float, sinT, OFF_SINT) WSBUF(float, cosC, OFF_COSC) WSBUF(float, sinC, OFF_SINC)
  WSBUF(bf16_t, xb, OFF_XB) WSBUF(float, part, OFF_PART) WSBUF(bf16_t, sbq, OFF_SBQ) WSBUF(bf16_t, sbk, OFF_SBK) WSBUF(bf16_t, sbvt, OFF_SBVT) WSBUF(bf16_t, sbz, OFF_SBZ)
  WSBUF(bf16_t, nq, OFF_NQ) WSBUF(bf16_t, kcr, OFF_KCR) WSBUF(bf16_t, vcr, OFF_VCR) WSBUF(bf16_t, ks, OFF_KS) WSBUF(bf16_t, vst, OFF_VST) WSBUF(bf16_t, kw, OFF_KW) WSBUF(bf16_t, vwt, OFF_VWT)
  WSBUF(float, ngate, OFF_NGATE) WSBUF(bf16_t, nz, OFF_NZ) WSBUF(bf16_t, ga, OFF_GA) WSBUF(bf16_t, gb, OFF_GB) WSBUF(float, hpre, OFF_HID) WSBUF(bf16_t, kc, OFF_KC) WSBUF(bf16_t, vct, OFF_VCT)
  WSBUF(bf16_t, merged, OFF_SBK)
  WSBUF(bf16_t, dummy, OFF_XB)     WSBUF(float, mfix, OFF_MFIX) WSBUF(unsigned, ctl, OFF_CTL)
  WSBUF(float, qng, OFF_QNG) WSBUF(float, kng, OFF_KNG)
};

DI int my_tid() { int t = threadIdx.x; asm volatile("" : "+v"(t)); return t; }
DI Params relaunder(const Params& p0) { Params p = p0; size_t z = 0; asm volatile("" : "+s"(z)); p.ws = p0.ws + z; return p; }

constexpr int TILE_B = 32 * 1024;
constexpr int STAGE_B = 2 * TILE_B;
constexpr int LDS_GEMM_BYTES = 2 * STAGE_B;
typedef __attribute__((address_space(3))) unsigned lds_u32;

DI void g_dma(const bf16_t* __restrict__ base, const unsigned (&off)[8], int ko, unsigned char* stage, int w) {
#pragma unroll
  for (int u = 0; u < 8; ++u)
    __builtin_amdgcn_global_load_lds((const unsigned*)(base + (off[u] + ko)), (lds_u32*)(stage + (w * 8 + u) * 1024), 16, 0, 0);
}
#define G_LDA(dst, ih, ks) _Pragma("unroll") for (int i = 0; i < 4; ++i) dst[i] = mk8(*(const u32x4*)(stage + ra + (((ih) * 4 + i) * 2 + (ks)) * 1024))
#define G_LDB(dst, ks) _Pragma("unroll") for (int j = 0; j < 4; ++j) dst[j] = mk8(*(const u32x4*)(stage + TILE_B + rb + (j * 2 + (ks)) * 1024))
#define G_MMA(ih, A, B) do { __builtin_amdgcn_s_setprio(1); _Pragma("unroll") for (int i = 0; i < 4; ++i) _Pragma("unroll") for (int j = 0; j < 4; ++j) acc[(ih) * 4 + i][j] = MFMA16(A[i], B[j], acc[(ih) * 4 + i][j]); __builtin_amdgcn_s_setprio(0); } while (0)
DI void g_compute(const unsigned char* stage, int ra, int rb, f32x4 (&acc)[8][4]) {
  bf16x8 b0[4], b1[4], a0[4], a1[4];
  G_LDB(b0, 0); G_LDA(a0, 0, 0);
  __builtin_amdgcn_sched_barrier(0);
  G_LDA(a1, 1, 0);
  G_MMA(0, a0, b0);
  __builtin_amdgcn_sched_barrier(0);
  G_LDB(b1, 1); G_LDA(a0, 0, 1);
  G_MMA(1, a1, b0);
  __builtin_amdgcn_sched_barrier(0);
  G_LDA(a1, 1, 1);
  G_MMA(0, a0, b1);
  __builtin_amdgcn_sched_barrier(0);
  G_MMA(1, a1, b1);
  __builtin_amdgcn_sched_barrier(0);
}

DI void gemm_core(const bf16_t* __restrict__ Ag, long lda, const bf16_t* __restrict__ Bg, long ldb, int K,
                  bf16_t* ldsb, f32x4 (&acc)[8][4], int kstep = 64) {
  unsigned char* lds = (unsigned char*)ldsb;
  const int tid = my_tid(), lane = tid & 63, w = __builtin_amdgcn_readfirstlane(tid >> 6), wa = w >> 2, wb = w & 3, qi = lane & 15, quad = lane >> 4;
  const bf16_t* base = w >= 4 ? Bg : Ag; const int ld = (int)(w >= 4 ? ldb : lda);
  unsigned off[8];
#pragma unroll
  for (int u = 0; u < 8; ++u) { const int blk = (w & 3) * 8 + u, rg = blk >> 1, kh = blk & 1; off[u] = (unsigned)((rg * 16 + (lane >> 2)) * ld + kh * 32 + (lane & 3) * 8); }
  const int ra = (wa * 8) * 2 * 1024 + (qi * 4 + quad) * 16, rb = (wb * 4) * 2 * 1024 + (qi * 4 + quad) * 16;
  unsigned char* buf0 = lds; unsigned char* buf1 = lds + STAGE_B;
  const int KT = K >> 6;
  g_dma(base, off, 0, buf0, w);
  asm volatile("s_waitcnt vmcnt(0)" ::: "memory");
  __syncthreads();
  for (int kt = 0; kt < KT; kt += 2) {
    g_dma(base, off, (kt + 1) * kstep, buf1, w);
    g_compute(buf0, ra, rb, acc);
    asm volatile("s_waitcnt vmcnt(0)" ::: "memory");
    __syncthreads();
    g_dma(base, off, min(kt + 2, KT - 1) * kstep, buf0, w);
    g_compute(buf1, ra, rb, acc);
    asm volatile("s_waitcnt vmcnt(0)" ::: "memory");
    __syncthreads();
  }
}

DI void zero_acc(f32x4 (&acc)[8][4]) {
#pragma unroll
  for (int i = 0; i < 8; ++i)
#pragma unroll
    for (int j = 0; j < 4; ++j) acc[i][j] = (f32x4){0.f, 0.f, 0.f, 0.f};
}

struct Slot { int xcd, slot; };
DI bool tile_order(const Slot sl, int it, int nN, int& mt, int& nt) {
  const int xcd = sl.xcd, slot = sl.slot, SL = gridDim.x >> 3;
  const int q = slot + it * SL, per = 8 * nN;
  if (q >= 2 * per) return false;
  const int mg = q / per, e = q - mg * per;
  nt = e >> 3; mt = xcd * 16 + mg * 8 + (e & 7);
  return true;
}

DI int inmap(int c) {
  if (c < 1024) return c;
  if (c < 1536) return c + 512;
  if (c < 2048) return c + 512;
  if (c < 2304) return c + 512;
  if (c < 2432) return c + 512;
  if (c < 2560) return c + 640;
  if (c < 3072) return c + 792;
  if (c < 4096) return c + 792;
  if (c < 5120) return c + 792;
  if (c < 5376) return c < 5144 ? c - 1792 : -1;
  if (c < 5888) return c - 4352;
  if (c < 6016) return c - 2944;
  return c - 2816;
}

DI void tr_tile(const float* __restrict__ src, int ld, int K, int k0, int n0, bool use_map, const float* __restrict__ scale, bf16_t* __restrict__ dst, int ldd, float* tile) {
  const int tid = my_tid();
  {
    const int nl = tid & 63, kk = tid >> 6;
    int n = n0 + nl; asm volatile("" : "+v"(n));
    const int sc = use_map ? inmap(n) : n;
#pragma unroll
    for (int r = 0; r < 8; ++r) {
      const int k = k0 + r * 8 + kk;
      float v = 0.f;
      if (sc >= 0) { v = src[(long)k * ld + sc]; if (scale) v *= scale[k]; }
      tile[(r * 8 + kk) * 65 + nl] = v;
    }
  }
  __syncthreads();
  {
    const int nl = tid >> 3, ks = tid & 7;
    unsigned o[4];
#pragma unroll
    for (int e = 0; e < 4; ++e) o[e] = pk2(tile[(ks * 8 + 2 * e) * 65 + nl], tile[(ks * 8 + 2 * e + 1) * 65 + nl]);
    *(u32x4*)(dst + (long)(n0 + nl) * ldd + k0 + ks * 8) = (u32x4){o[0], o[1], o[2], o[3]};
  }
  __syncthreads();
}

DI void tr_job(const float* src, int ld, int K, int N, bool use_map, const float* scale, bf16_t* dst, int ldd, float* tile) {
  const int nk = K >> 6, nn = N >> 6;
  for (int t = blockIdx.x; t < nk * nn; t += gridDim.x) tr_tile(src, ld, K, (t % nk) * 64, (t / nk) * 64, use_map, scale, dst, ldd, tile);
}

DI void convert_weights(const Params& p0, int l, unsigned char* lds, int which) {
  const Params p = relaunder(p0);
  float* tile = (float*)lds;
  if (which & 1) {
    tr_job(p.w_in + (long)l * D_MODEL * N_IN, N_IN, D_MODEL, NP, true, p.norm_g + l * D_MODEL, p.wt_in(), LDX, tile);
    for (int kv = 0; kv < 2; ++kv) {
      tr_job(p.cmp_w1 + (long)(l * 2 + kv) * 2048 * 256, 256, 2048, 256, false, nullptr, p.w1t() + (long)kv * 256 * 2048, 2048, tile);
      tr_job(p.cmp_w2 + (long)(l * 2 + kv) * 256 * 64, 64, 256, 64, false, nullptr, p.w2t() + (long)kv * 64 * 256, 256, tile);
    }
    tr_job(p.w_up_a + (long)l * 512 * 1024, 1024, 512, 1024, false, nullptr, p.wupa_t(), 512, tile);
    tr_job(p.w_up_b + (long)l * 512 * 1024, 1024, 512, 1024, false, nullptr, p.wupb_t(), 512, tile);
  }
  if (which & 2) tr_job(p.w_out + (long)l * 1024 * 1024, 1024, 1024, 1024, false, nullptr, p.wout_t(), 1024, tile);
}

DI void phase_prologue(const Params& p, unsigned char* lds) {
  const int tid = my_tid();
  convert_weights(p, 0, lds, 3);
  {
    const int lane = tid & 63;
    for (int wi = blockIdx.x * 8 + (tid >> 6); wi < DEPTH * 2 * 16 * 4; wi += gridDim.x * 8) {
      const int jq = wi & 3, kq = (wi >> 2) & 15, it = wi >> 6;
      const float* w1 = p.cmp_w1 + (long)it * 2048 * 256 + (long)kq * 128 * 256 + jq * 64 + lane; const float* pe = p.cmp_pe + (long)it * 2048 + kq * 128;
      float s0 = kq == 0 ? p.cmp_b1[it * 256 + jq * 64 + lane] : 0.f, s1 = 0.f, s2 = 0.f, s3 = 0.f;
#pragma unroll 4
      for (int k = 0; k < 128; k += 4) {
        s0 += pe[k] * w1[(long)k * 256]; s1 += pe[k + 1] * w1[(long)(k + 1) * 256]; s2 += pe[k + 2] * w1[(long)(k + 2) * 256]; s3 += pe[k + 3] * w1[(long)(k + 3) * 256];
      }
      p.b1eff()[(it * 16 + kq) * 256 + jq * 64 + lane] = (s0 + s1) + (s2 + s3);
    }
  }
  if (blockIdx.x == 1 && tid < DEPTH * 3) {
    const int l = tid / 3, br = tid % 3;
    float mq = 0.f, mk = 0.f;
    for (int d = 0; d < 64; ++d) { mq = fmaxf(mq, fabsf(p.q_norm_g[l * 64 + d])); mk = fmaxf(mk, fabsf(p.k_norm_g[(l * 3 + br) * 64 + d])); }
    p.mfix()[l * 4 + br] = 8.f * 1.44269504089f * mq * mk * 1.02f + 0.25f;
  }
  if (blockIdx.x == 0) { for (int i = tid; i < DEPTH * 64; i += NTHR) p.qng()[i] = p.q_norm_g[i]; for (int i = tid; i < DEPTH * 192; i += NTHR) p.kng()[i] = p.k_norm_g[i]; }
  const long gtid = (long)blockIdx.x * NTHR + tid, gn = (long)gridDim.x * NTHR;
  for (long i = gtid; i < (long)NTOK * 32; i += gn) {
    const int f = (int)(i & 31); const long tok = i >> 5;
    const float ang = (float)p.pos[tok] * inv_freq(f);
    float sn, cs; sincos_acc(ang, sn, cs);
    p.cosT()[i] = cs; p.sinT()[i] = sn;
  }
  for (long i = gtid; i < (long)BATCH * 128 * 32; i += gn) {
    const int f = (int)(i & 31); const int c = (int)((i >> 5) & 127); const int b = (int)(i >> 12);
    float cs = 1.f, sn = 0.f;
    if (c < NCMP) {
      float sum = 0.f;
      for (int k = 0; k < 32; ++k) sum += (float)p.pos[b * SEQ + c * 16 + k];
      const float ang = (sum * (1.f / 32.f)) * inv_freq(f);
      sincos_acc(ang, sn, cs);
    }
    p.cosC()[i] = cs; p.sinC()[i] = sn;
  }
  const int lane = tid & 63;
  for (long row = (long)blockIdx.x * 8 + (tid >> 6); row < NTOK; row += (long)gridDim.x * 8) {
    const float* xr = p.x_in + row * D_MODEL; bf16_t* xo = p.xb() + row * LDX;
    float ss = 0.f;
#pragma unroll
    for (int u = 0; u < 4; ++u) {
      const f32x4 v = *(const f32x4*)(xr + u * 256 + lane * 4);
      ss += v[0] * v[0] + v[1] * v[1] + v[2] * v[2] + v[3] * v[3];
      *(u32x2*)(xo + u * 256 + lane * 4) = (u32x2){pk2(v[0], v[1]), pk2(v[2], v[3])};
    }
#pragma unroll
    for (int o = 32; o >= 1; o >>= 1) ss += __shfl_xor(ss, o);
    if (lane < 8) p.part()[row * 16 + lane] = lane == 0 ? ss : 0.f;
  }
}

DI void phaseA_epilogue(const Params& p, int layer, int mt, int nt, const f32x4 (&acc)[8][4], const float* rs_s) {
  const int tid = my_tid(), lane = tid & 63, w = tid >> 6, wa = w >> 2, wb = w & 3, qi = lane & 15, quad = lane >> 4;
  if (nt >= 21) {
    bf16_t* dstb; int nh, head;
    if (nt < 23) { dstb = p.sbvt(); nh = 8; head = (nt - 21) * 4 + wb; } else if (wb < 2) { dstb = p.vst(); nh = 2; head = wb; } else { dstb = p.vwt(); nh = 2; head = wb - 2; }
    const int tok0 = mt * 256, b = tok0 >> 11, s0 = (tok0 & 2047) + wa * 128 + quad * 4;
#pragma unroll
    for (int i = 0; i < 8; ++i) {
      const int tl = wa * 128 + i * 16 + quad * 4;
      const float r0 = rs_s[tl], r1 = rs_s[tl + 1], r2 = rs_s[tl + 2], r3 = rs_s[tl + 3];
#pragma unroll
      for (int j = 0; j < 4; ++j) {
        const int d = j * 16 + qi;
        const f32x4 v = acc[i][j];
        const int sq = s0 + i * 16;
        bf16_t* dst = dstb + (long)(b * nh + head) * 64 * SEQ + (long)(sq >> 5) * 2048 + d * 32 + (sq & 31);
        *(u32x2*)dst = (u32x2){pk2(v[0] * r0, v[1] * r1), pk2(v[2] * r2, v[3] * r3)};
      }
    }
    return;
  }
  const bool headtype = nt < 4 || (nt >= 6 && nt < 10);
#pragma unroll
  for (int j = 0; j < 4; ++j) {
    const int tl = wb * 64 + j * 16 + qi; const long tok = (long)mt * 256 + tl; const int b = (int)(tok >> 11), sq = (int)(tok & 2047);
    const float rs = rs_s[tl];
    if (headtype) {
#pragma unroll
      for (int ih = 0; ih < 2; ++ih) {
        const int hit = wa * 2 + ih;
        f32x4 v[4];
#pragma unroll
        for (int i = 0; i < 4; ++i) v[i] = acc[ih * 4 + i][j] * rs;
        bf16_t* dstb; int nh, head; const float* g = nullptr;
        if (nt < 2) { dstb = p.sbq(); nh = 8; head = nt * 4 + hit; }
        else if (nt < 4) { dstb = p.sbk(); nh = 8; head = (nt - 2) * 4 + hit; }
        else if (nt < 8) { dstb = p.nq(); nh = 8; head = (nt - 6) * 4 + hit; g = p.qng() + layer * 64; }
        else if (nt == 8) { dstb = hit < 2 ? p.kcr() : p.vcr(); nh = 2; head = hit & 1; }
        else { dstb = hit < 2 ? p.ks() : p.kw(); nh = 2; head = hit & 1; g = p.kng() + (layer * 3 + (hit < 2 ? 1 : 2)) * 64; }
        if (g) {
          float ss = 0.f;
#pragma unroll
          for (int i = 0; i < 4; ++i) ss += v[i][0] * v[i][0] + v[i][1] * v[i][1] + v[i][2] * v[i][2] + v[i][3] * v[i][3];
          ss += __shfl_xor(ss, 16); ss += __shfl_xor(ss, 32);
          const float rn = rsqrtf(ss * (1.f / 64.f) + NORM_EPS);
#pragma unroll
          for (int i = 0; i < 4; ++i) { const f32x4 gg = *(const f32x4*)(g + i * 16 + quad * 4); v[i] = v[i] * rn * gg; }
#pragma unroll
          for (int i = 0; i < 2; ++i) {
            const f32x4 cs = *(const f32x4*)(p.cosT() + tok * 32 + i * 16 + quad * 4), sn = *(const f32x4*)(p.sinT() + tok * 32 + i * 16 + quad * 4);
            const f32x4 x1 = v[i], x2 = v[i + 2];
            v[i] = x1 * cs - x2 * sn; v[i + 2] = x2 * cs + x1 * sn;
          }
        }
        bf16_t* dst = dstb + ((long)(b * nh + head) * SEQ + sq) * 64 + quad * 4;
#pragma unroll
        for (int i = 0; i < 4; ++i) *(u32x2*)(dst + i * 16) = (u32x2){pk2(v[i][0], v[i][1]), pk2(v[i][2], v[i][3])};
        asm volatile("" ::: "memory");
      }
    } else if (nt == 20) {
      if (wa == 0) {
#pragma unroll
        for (int i = 0; i < 2; ++i) {
          const int f = i * 16 + quad * 4;
          const f32x4 v = acc[i][j] * rs;
          if (f < 24) { const f32x4 o = {sigmoidf_(v[0]), sigmoidf_(v[1]), sigmoidf_(v[2]), sigmoidf_(v[3])}; *(f32x4*)(p.ngate() + tok * 32 + f) = o; }
        }
      }
    } else {
      bf16_t* dstb; int ldd, c0; bool sil;
      if (nt < 6) { dstb = p.sbz(); ldd = 512; c0 = (nt - 4) * 256; sil = true; }
      else if (nt < 12) { dstb = p.nz(); ldd = 512; c0 = (nt - 10) * 256; sil = true; }
      else if (nt < 16) { dstb = p.ga(); ldd = 1024; c0 = (nt - 12) * 256; sil = false; }
      else { dstb = p.gb(); ldd = 1024; c0 = (nt - 16) * 256; sil = false; }
      bf16_t* dst = dstb + tok * ldd + c0 + wa * 128 + quad * 4;
#pragma unroll
      for (int i = 0; i < 8; ++i) {
        const f32x4 v = acc[i][j] * rs;
        f32x4 o;
#pragma unroll
        for (int r = 0; r < 4; ++r) o[r] = sil ? siluf_(v[r]) : sigmoidf_(v[r]);
        *(u32x2*)(dst + i * 16) = (u32x2){pk2(o[0], o[1]), pk2(o[2], o[3])};
      }
    }
    asm volatile("" ::: "memory");
  }
}

DI void phaseA(const Params& p0, const Slot sl, int layer, unsigned char* lds, int fake = 0) {
  const Params p = relaunder(p0);
  bf16_t* gl = (bf16_t*)lds; float* rs_s = (float*)(lds + LDS_GEMM_BYTES);
  const bf16_t* Wt = p.wt_in();
  int mt, nt;
  for (int it = 0; tile_order(sl, it, NT_IN, mt, nt); ++it) {
    if (my_tid() < 256) {
      const float* pp = p.part() + ((long)mt * 256 + my_tid()) * 16;
      const f32x4 v0 = *(const f32x4*)pp, v1 = *(const f32x4*)(pp + 4);
      const float s = ((v0[0] + v0[1]) + (v0[2] + v0[3])) + ((v1[0] + v1[1]) + (v1[2] + v1[3]));
      rs_s[my_tid()] = rsqrtf(s * (1.f / 1024.f) + NORM_EPS);
    }
    const int mtl = fake == 3 ? 0 : (fake == 4 ? sl.xcd * 16 + (sl.slot & 7) : mt), ntl = fake == 3 ? 0 : (fake == 4 ? (sl.slot >> 3) : nt);
    const bf16_t* Xg = p.xb() + (long)mtl * 256 * LDX; const bf16_t* Wg = Wt + (long)ntl * 256 * LDX;
    f32x4 acc[8][4]; zero_acc(acc);
    const int kstep = (fake == 1 || fake == 2) ? 0 : 64;
    gemm_core(nt >= 21 ? Xg : Wg, LDX, nt >= 21 ? Wg : Xg, LDX, D_MODEL, gl, acc, kstep);
    if (!fake) phaseA_epilogue(p, layer, mt, nt, acc, rs_s);
    else if (acc[0][0][0] == 123.456f && acc[7][3][3] == 5.f) p.dummy()[0] = 1;
    __syncthreads();
  }
}

DI void compress_partial(const Params& p, int ci, unsigned char* lds) {
  bf16_t* gl = (bf16_t*)lds;
  const int split = ci & 3, item = ci >> 2, kv = item & 1, pair = item >> 1;
  const bf16_t* src = (kv ? p.vcr() : p.kcr()) + (long)pair * 256 * 1024 + split * 512;
  const bf16_t* W1 = p.w1t() + (long)kv * 256 * 2048 + split * 512;
  f32x4 acc[8][4]; zero_acc(acc);
  gemm_core(W1, 2048, src, 1024, 512, gl, acc);
  const int tid = my_tid(), lane = tid & 63, w = tid >> 6, wa = w >> 2, wb = w & 3, qi = lane & 15, quad = lane >> 4;
  float* dst = p.hpre() + ((long)(split * 32 + item) * 256) * 256;
#pragma unroll
  for (int i = 0; i < 8; ++i)
#pragma unroll
    for (int j = 0; j < 4; ++j) *(f32x4*)(dst + (long)(wb * 64 + j * 16 + qi) * 256 + wa * 128 + i * 16 + quad * 4) = acc[i][j];
}

DI void phaseB2(const Params& p0, int layer, unsigned char* lds) {
  const Params p = relaunder(p0);
  const int tid = my_tid(), lane = tid & 63, w = tid >> 6, qi = lane & 15, quad = lane >> 4;
  float* bias_s = (float*)lds;
  {
    const float* b1 = p.b1eff() + (long)(layer * 2 + (tid >> 8)) * 16 * 256 + (tid & 255);
    float sacc = 0.f;
#pragma unroll
    for (int kq = 0; kq < 16; ++kq) sacc += b1[kq * 256];
    bias_s[tid] = sacc;
  }
  __syncthreads();
  const int wi = blockIdx.x * 2 + w;
  if (w < 2 && wi < 32 * 16) {
    const int item = wi >> 4, r16 = wi & 15, kv = item & 1, pair = item >> 1;
    const int row = r16 * 16 + qi;
    const bf16_t* W2 = p.w2t() + (long)kv * 64 * 256;
    const float* hp = p.hpre() + ((long)item * 256 + row) * 256 + quad * 8;
    f32x4 o[4];
#pragma unroll
    for (int dt = 0; dt < 4; ++dt) o[dt] = (f32x4){0.f, 0.f, 0.f, 0.f};
#pragma unroll 1
    for (int ksx = 0; ksx < 8; ++ksx) {
      f32x4 h0 = *(const f32x4*)(bias_s + kv * 256 + ksx * 32 + quad * 8), h1 = *(const f32x4*)(bias_s + kv * 256 + ksx * 32 + quad * 8 + 4);
#pragma unroll
      for (int sp = 0; sp < 4; ++sp) { const float* q = hp + (long)sp * 32 * 256 * 256 + ksx * 32; h0 += *(const f32x4*)q; h1 += *(const f32x4*)(q + 4); }
      const bf16x8 hf = mk8((u32x4){pk2(siluf_(h0[0]), siluf_(h0[1])), pk2(siluf_(h0[2]), siluf_(h0[3])), pk2(siluf_(h1[0]), siluf_(h1[1])), pk2(siluf_(h1[2]), siluf_(h1[3]))});
#pragma unroll
      for (int dt = 0; dt < 4; ++dt) {
        const bf16x8 wf = ld8(W2 + (long)(dt * 16 + qi) * 256 + ksx * 32 + quad * 8);
        o[dt] = kv ? MFMA16(hf, wf, o[dt]) : MFMA16(wf, hf, o[dt]);
      }
    }
    const int bg = pair * 2 + (r16 >> 3);
    if (kv == 0) {
      const float* g = p.kng() + (layer * 3 + 0) * 64;
      const int b = bg >> 1, c = (r16 & 7) * 16 + qi;
      float ss = 0.f;
#pragma unroll
      for (int dt = 0; dt < 4; ++dt) ss += o[dt][0] * o[dt][0] + o[dt][1] * o[dt][1] + o[dt][2] * o[dt][2] + o[dt][3] * o[dt][3];
      ss += __shfl_xor(ss, 16); ss += __shfl_xor(ss, 32);
      const float rn = rsqrtf(ss * (1.f / 64.f) + NORM_EPS);
#pragma unroll
      for (int dt = 0; dt < 4; ++dt) { const f32x4 gg = *(const f32x4*)(g + dt * 16 + quad * 4); o[dt] = o[dt] * rn * gg; }
#pragma unroll
      for (int dt = 0; dt < 2; ++dt) {
        const long ti = ((long)b * 128 + c) * 32 + dt * 16 + quad * 4;
        const f32x4 cs = *(const f32x4*)(p.cosC() + ti), sn = *(const f32x4*)(p.sinC() + ti);
        const f32x4 x1 = o[dt], x2 = o[dt + 2];
        o[dt] = x1 * cs - x2 * sn; o[dt + 2] = x2 * cs + x1 * sn;
      }
      bf16_t* dst = p.kc() + ((long)bg * 128 + c) * 64 + quad * 4;
#pragma unroll
      for (int dt = 0; dt < 4; ++dt) {
        u32x2 ov = (u32x2){pk2(o[dt][0], o[dt][1]), pk2(o[dt][2], o[dt][3])};
        if (c >= NCMP) ov = (u32x2){0u, 0u};
        *(u32x2*)(dst + dt * 16) = ov;
      }
    } else {
#pragma unroll
      for (int dt = 0; dt < 4; ++dt) {
        const int c0 = (r16 & 7) * 16 + quad * 4;
        f32x4 v = o[dt];
        if (c0 + 3 >= NCMP) v[3] = 0.f;
        *(u32x2*)(p.vct() + ((long)bg * 64 + dt * 16 + qi) * 128 + c0) = (u32x2){pk2(v[0], v[1]), pk2(v[2], v[3])};
      }
    }
  }
  __syncthreads();
}

struct SbFrag { bf16x8 k[2][2]; bf16x8 v[4]; };
DI void sb_load(SbFrag& f, const bf16_t* __restrict__ kp0, const bf16_t* __restrict__ vp0, int kb) {
#pragma unroll
  for (int a = 0; a < 2; ++a) { f.k[a][0] = ld8(kp0 + (long)(kb + 4 * a) * 64); f.k[a][1] = ld8(kp0 + (long)(kb + 4 * a) * 64 + 32); }
#pragma unroll
  for (int dt = 0; dt < 4; ++dt) f.v[dt] = ld8(vp0 + (long)kb * 64 + dt * 16 * 32);
}
template <bool FULL>
DI void sb_chunk(const SbFrag& f, int kb, int t, int quad, const bf16x8 (&qf)[2], f32x4 (&o)[4], float& carry) {
  f32x4 s[2];
#pragma unroll
  for (int a = 0; a < 2; ++a) {
    s[a] = MFMA16(f.k[a][0], qf[0], ((f32x4){0.f, 0.f, 0.f, 0.f}));
    s[a] = MFMA16(f.k[a][1], qf[1], s[a]);
  }
  float L[8], ls[8]; bool val[8];
  float tot = 0.f;
#pragma unroll
  for (int idx = 0; idx < 8; ++idx) {
    const float z = s[idx >> 2][idx & 3] * (0.125f * 1.44269504089f);
    val[idx] = FULL ? true : (kb + 8 * quad + idx < t);
    const float sp = fmaxf(z, 0.f) + __builtin_amdgcn_logf(1.f + __builtin_amdgcn_exp2f(-fabsf(z)));
    L[idx] = val[idx] ? -sp : 0.f;
    ls[idx] = z - sp;
    tot += L[idx];
  }
  const float a1 = __shfl_xor(tot, 16), a2 = __shfl_xor(tot, 32), a3 = __shfl_xor(a1, 32);
  const float higher = ((quad ^ 1) > quad ? a1 : 0.f) + ((quad ^ 2) > quad ? a2 : 0.f) + ((quad ^ 3) > quad ? a3 : 0.f);
  float run = carry + higher;
  float wv[8];
#pragma unroll
  for (int idx = 7; idx >= 0; --idx) {
    const float e = __builtin_amdgcn_exp2f(ls[idx] + run);
    wv[idx] = val[idx] ? e : 0.f;
    run += L[idx];
  }
  carry += (tot + a1) + (a2 + a3);
  const bf16x8 pf = mk8((u32x4){pk2(wv[0], wv[1]), pk2(wv[2], wv[3]), pk2(wv[4], wv[5]), pk2(wv[6], wv[7])});
#pragma unroll
  for (int dt = 0; dt < 4; ++dt) o[dt] = MFMA16(f.v[dt], pf, o[dt]);
}

DI void sb_attn_wave(const Params& p, int b, int h, int t0, bf16_t* ybase) {
  const int lane = my_tid() & 63, qi = lane & 15, quad = lane >> 4;
  const bf16_t* Q = p.sbq() + (long)(b * 8 + h) * SEQ * 64;
  const bf16_t* K = p.sbk() + (long)(b * 8 + h) * SEQ * 64;
  const bf16_t* Vt = p.sbvt() + (long)(b * 8 + h) * 64 * SEQ;
  const int tA = t0 + qi, tB = t0 + 16 + qi;
  bf16x8 qa[2], qb[2];
  qa[0] = ld8(Q + (long)tA * 64 + quad * 8); qa[1] = ld8(Q + (long)tA * 64 + 32 + quad * 8);
  qb[0] = ld8(Q + (long)tB * 64 + quad * 8); qb[1] = ld8(Q + (long)tB * 64 + 32 + quad * 8);
  f32x4 oa[4], ob[4];
#pragma unroll
  for (int dt = 0; dt < 4; ++dt) { oa[dt] = (f32x4){0.f, 0.f, 0.f, 0.f}; ob[dt] = oa[dt]; }
  float ca = 0.f, cb = 0.f;
  const int krow = 8 * (qi >> 2) + (qi & 3);
  const bf16_t* kp0 = K + (long)krow * 64 + quad * 8;
  const bf16_t* vp0 = Vt + qi * 32 + 8 * quad;
  int kb = t0;
  SbFrag f0, f1, f2;
  sb_load(f0, kp0, vp0, kb); sb_load(f1, kp0, vp0, max(kb - 32, 0));
#define SB_STEP(F, KB) (((KB) + 32 <= t0) ? (sb_chunk<true>(F, KB, tA, quad, qa, oa, ca), sb_chunk<true>(F, KB, tB, quad, qb, ob, cb)) : (sb_chunk<false>(F, KB, tA, quad, qa, oa, ca), sb_chunk<false>(F, KB, tB, quad, qb, ob, cb)), __all(ca < -160.f && cb < -160.f))
  while (true) {
    sb_load(f2, kp0, vp0, max(kb - 64, 0));
    if (SB_STEP(f0, kb) || kb < 32) break;
    sb_load(f0, kp0, vp0, max(kb - 96, 0));
    if (SB_STEP(f1, kb - 32) || kb < 64) break;
    sb_load(f1, kp0, vp0, max(kb - 128, 0));
    if (SB_STEP(f2, kb - 64) || kb < 96) break;
    kb -= 96;
  }
#undef SB_STEP
#pragma unroll
  for (int half = 0; half < 2; ++half) {
    const long zo = ((long)b * SEQ + (half ? tB : tA)) * 512 + h * 64 + quad * 4;
    const bf16_t* zp = p.sbz() + zo; bf16_t* yp = ybase + zo;
#pragma unroll
    for (int dt = 0; dt < 4; ++dt) {
      const f32x4 o = half ? ob[dt] : oa[dt];
      const u32x2 zz = *(const u32x2*)(zp + dt * 16);
      *(u32x2*)(yp + dt * 16) = (u32x2){pk2(o[0] * bflo(zz[0]), o[1] * bfhi(zz[0])), pk2(o[2] * bflo(zz[1]), o[3] * bfhi(zz[1]))};
    }
  }
}

DI void phaseB(const Params& p0, int layer, unsigned char* lds, bool probe) {
  const int NITEM = 128 + BATCH * 8 * 8;
  for (int it = blockIdx.x; it < NITEM; it += gridDim.x) {
    const Params p = relaunder(p0);
    if (it < 128) { compress_partial(p, it, lds); continue; }
    const int i = it - 128, qt = 7 - (i >> 7), bh = i & 127;
    sb_attn_wave(p, bh >> 3, bh & 7, qt * 256 + (my_tid() >> 6) * 32, probe ? p.dummy() : p.sbz());
  }
}

constexpr int NSA_LO_BYTES = 8 * 8192;
constexpr int NSA_KROW = 144, NSA_VROW = 80;
constexpr int NSA_SLOT = 32 * NSA_KROW + 64 * NSA_VROW;
constexpr int NSA_SLOT0 = NSA_LO_BYTES, NSA_BLIST = NSA_SLOT0 + 2 * NSA_SLOT, NSA_UMW = NSA_BLIST + 64 * 4;

struct KVFrag { bf16x8 k[2][2]; bf16x8 v[4]; };
DI void nsa_ldsfrag(KVFrag& f, const unsigned char* slot, int qi, int quad) {
  const int krow = 8 * (qi >> 2) + (qi & 3);
#pragma unroll
  for (int a = 0; a < 2; ++a) { const unsigned char* kp = slot + (krow + 4 * a) * NSA_KROW + quad * 16; f.k[a][0] = mk8(*(const u32x4*)kp); f.k[a][1] = mk8(*(const u32x4*)(kp + 64)); }
#pragma unroll
  for (int dt = 0; dt < 4; ++dt) f.v[dt] = mk8(*(const u32x4*)(slot + 32 * NSA_KROW + (dt * 16 + qi) * NSA_VROW + quad * 16));
}
template <int MODE>
DI void nsa_chunk(const KVFrag& f, int kb, int t, bool selbit, const bf16x8 (&qf)[4][2], f32x4 (&O)[4][4], float (&m)[4], float (&l)[4], int quad, bool online) {
  const float SC = 0.125f * 1.44269504089f;
  bool val[8];
#pragma unroll
  for (int idx = 0; idx < 8; ++idx) {
    const int key = kb + 8 * quad + idx;
    val[idx] = MODE == 0 ? (selbit && key <= t) : (key <= t && key > t - 512);
  }
#pragma unroll
  for (int hh = 0; hh < 4; ++hh) {
    f32x4 s[2];
#pragma unroll
    for (int a = 0; a < 2; ++a) { s[a] = MFMA16(f.k[a][0], qf[hh][0], ((f32x4){0.f, 0.f, 0.f, 0.f})); s[a] = MFMA16(f.k[a][1], qf[hh][1], s[a]); }
    float mn = m[hh];
    if (online) {
      float cm = -1e30f;
#pragma unroll
      for (int idx = 0; idx < 8; ++idx) if (val[idx]) cm = fmaxf(cm, s[idx >> 2][idx & 3] * SC);
      cm = fmaxf(cm, __shfl_xor(cm, 16)); cm = fmaxf(cm, __shfl_xor(cm, 32));
      mn = fmaxf(mn, cm);
      const float alpha = __builtin_amdgcn_exp2f(m[hh] - mn);
      m[hh] = mn; l[hh] *= alpha;
#pragma unroll
      for (int dt = 0; dt < 4; ++dt) O[hh][dt] = O[hh][dt] * alpha;
    }
    float pv[8]; float ps = 0.f;
#pragma unroll
    for (int idx = 0; idx < 8; ++idx) { pv[idx] = val[idx] ? __builtin_amdgcn_exp2f(fmaf(s[idx >> 2][idx & 3], SC, -mn)) : 0.f; ps += pv[idx]; }
    l[hh] += ps;
    const bf16x8 pf = mk8((u32x4){pk2(pv[0], pv[1]), pk2(pv[2], pv[3]), pk2(pv[4], pv[5]), pk2(pv[6], pv[7])});
#pragma unroll
    for (int dt = 0; dt < 4; ++dt) O[hh][dt] = MFMA16(f.v[dt], pf, O[hh][dt]);
  }
}

template <int MODE>
DI void nsa_branch(const bf16_t* __restrict__ Kb, const bf16_t* __restrict__ Vtb, unsigned char* lds, int nb, int t, int cur, unsigned selmask, unsigned umall,
                   const bf16x8 (&qf)[4][2], f32x4 (&O)[4][4], float (&m)[4], float (&l)[4], bool online) {
  const int tid = my_tid(), lane = tid & 63, qi = lane & 15, quad = lane >> 4;
  const int* blist = (const int*)(lds + NSA_BLIST);
  const bool isv = tid >= 256;
  const int t2 = tid & 255;
  const bf16_t* gsrc = isv ? Vtb + (t2 >> 2) * 32 + (t2 & 3) * 8 : Kb + (long)(t2 >> 3) * 64 + (t2 & 7) * 8;
  const long gmul = 64;
  const int ldst = isv ? 32 * NSA_KROW + (t2 >> 2) * NSA_VROW + (t2 & 3) * 16 : (t2 >> 3) * NSA_KROW + (t2 & 7) * 16;
  unsigned char* slot0 = lds + NSA_SLOT0; unsigned char* slot1 = slot0 + NSA_SLOT;
  const int N = 2 * nb;
  auto kbof = [&](int n) { return blist[n >> 1] * 64 + (n & 1) * 32; };
  u32x4 ra = *(const u32x4*)(gsrc + (long)kbof(0) * gmul), rb = *(const u32x4*)(gsrc + (long)kbof(1) * gmul);
  *(u32x4*)(slot0 + ldst) = ra;
  __syncthreads();
#pragma unroll 1
  for (int n = 0; n < N; n += 2) {
    const int j = blist[n >> 1];
    const bool won = MODE == 0 ? ((umall >> j) & 1u) != 0 : (j >= cur - 8 && j <= cur);
    const bool bit = (selmask >> j) & 1u;
    ra = *(const u32x4*)(gsrc + (long)kbof(min(n + 2, N - 2)) * gmul);
    if (won) { KVFrag f; nsa_ldsfrag(f, slot0, qi, quad); nsa_chunk<MODE>(f, j * 64, t, bit, qf, O, m, l, quad, online); }
    *(u32x4*)(slot1 + ldst) = rb;
    __syncthreads();
    rb = *(const u32x4*)(gsrc + (long)kbof(min(n + 3, N - 1)) * gmul);
    if (won) { KVFrag f; nsa_ldsfrag(f, slot1, qi, quad); nsa_chunk<MODE>(f, j * 64 + 32, t, bit, qf, O, m, l, quad, online); }
    *(u32x4*)(slot0 + ldst) = ra;
    __syncthreads();
  }
}

template <bool LAST>
DI void nsa_finish(u32x2* lo, f32x4 (&O)[4][4], float (&m)[4], float (&l)[4], const float (&gate)[4], const bf16_t* zp, bf16_t* yp, float minit) {
#pragma unroll
  for (int hh = 0; hh < 4; ++hh) {
    float lt = l[hh]; lt += __shfl_xor(lt, 16); lt += __shfl_xor(lt, 32);
    const float f = lt > 0.f ? gate[hh] / lt : 0.f;
#pragma unroll
    for (int dt = 0; dt < 4; ++dt) {
      const u32x2 a = lo[(hh * 4 + dt) * 64];
      const f32x4 v = (f32x4){bflo(a[0]), bfhi(a[0]), bflo(a[1]), bfhi(a[1])} + O[hh][dt] * f;
      if (LAST) {
        const u32x2 zz = *(const u32x2*)(zp + hh * 64 + dt * 16);
        *(u32x2*)(yp + hh * 64 + dt * 16) = (u32x2){pk2(v[0] * bflo(zz[0]), v[1] * bfhi(zz[0])), pk2(v[2] * bflo(zz[1]), v[3] * bfhi(zz[1]))};
      } else {
        lo[(hh * 4 + dt) * 64] = (u32x2){pk2(v[0], v[1]), pk2(v[2], v[3])};
        O[hh][dt] = (f32x4){0.f, 0.f, 0.f, 0.f};
      }
    }
    m[hh] = minit; l[hh] = 0.f;
  }
}

DI void nsa_wave(const Params& p, int layer, int b, int g, int t0, unsigned char* lds, bf16_t* ybase) {
  const int lane = my_tid() & 63, qi = lane & 15, quad = lane >> 4;
  const int t = t0 + qi, cur = t0 >> 6;
  const long tok = (long)b * SEQ + t;
  const int bg = b * 2 + g;
  u32x2* lo = (u32x2*)lds + (my_tid() >> 6) * 1024 + lane;

  const float mf_c = p.mfix()[layer * 4 + 0], mf_s = p.mfix()[layer * 4 + 1], mf_w = p.mfix()[layer * 4 + 2];
  const bool on_c = mf_c > 60.f, on_s = mf_s > 60.f, on_w = mf_w > 60.f;
  const float SC = 0.125f * 1.44269504089f;
  const bf16_t* Kc = p.kc() + (long)bg * 128 * 64;
  const bf16_t* Vc = p.vct() + (long)bg * 64 * 128;
  f32x4 ph[8];
#pragma unroll
  for (int kt = 0; kt < 8; ++kt) ph[kt] = (f32x4){0.f, 0.f, 0.f, 0.f};
#pragma unroll 1
  for (int hh = 0; hh < 4; ++hh) {
    const bf16_t* qp0 = p.nq() + ((long)(b * 8 + g * 4 + hh) * SEQ + t) * 64 + quad * 8;
    const bf16x8 q0 = ld8(qp0), q1 = ld8(qp0 + 32); const float gt = p.ngate()[tok * 32 + g * 4 + hh];
    f32x4 sc[8];
    float mx = on_c ? -1e30f : mf_c;
#pragma unroll
    for (int kt = 0; kt < 8; ++kt) {
      const bf16_t* kp = Kc + (long)(kt * 16 + qi) * 64 + quad * 8;
      sc[kt] = MFMA16(ld8(kp), q0, ((f32x4){0.f, 0.f, 0.f, 0.f}));
      sc[kt] = MFMA16(ld8(kp + 32), q1, sc[kt]);
      sc[kt] = sc[kt] * SC;
    }
    if (on_c) {
#pragma unroll
      for (int kt = 0; kt < 8; ++kt)
#pragma unroll
        for (int r = 0; r < 4; ++r) { const int c = kt * 16 + quad * 4 + r; if (c < NCMP && 16 * c + 31 <= t) mx = fmaxf(mx, sc[kt][r]); }
      mx = fmaxf(mx, __shfl_xor(mx, 16)); mx = fmaxf(mx, __shfl_xor(mx, 32));
    }
    float sum = 0.f;
#pragma unroll
    for (int kt = 0; kt < 8; ++kt)
#pragma unroll
      for (int r = 0; r < 4; ++r) {
        const int c = kt * 16 + quad * 4 + r;
        const float e = (c < NCMP && 16 * c + 31 <= t) ? __builtin_amdgcn_exp2f(sc[kt][r] - mx) : 0.f;
        sc[kt][r] = e; sum += e;
      }
    sum += __shfl_xor(sum, 16); sum += __shfl_xor(sum, 32);
    const float inv = sum > 0.f ? 1.f / sum : 0.f;
#pragma unroll
    for (int kt = 0; kt < 8; ++kt) { sc[kt] = sc[kt] * inv; ph[kt] += sc[kt]; }
    f32x4 oc[4];
#pragma unroll
    for (int dt = 0; dt < 4; ++dt) oc[dt] = (f32x4){0.f, 0.f, 0.f, 0.f};
#pragma unroll
    for (int mm = 0; mm < 4; ++mm) {
      const bf16x8 pf = mk8((u32x4){pk2(sc[2 * mm][0], sc[2 * mm][1]), pk2(sc[2 * mm][2], sc[2 * mm][3]), pk2(sc[2 * mm + 1][0], sc[2 * mm + 1][1]), pk2(sc[2 * mm + 1][2], sc[2 * mm + 1][3])});
#pragma unroll
      for (int dt = 0; dt < 4; ++dt) {
        const bf16_t* vp = Vc + (long)(dt * 16 + qi) * 128 + 32 * mm + quad * 4;
        const u32x2 lo = *(const u32x2*)vp, hi = *(const u32x2*)(vp + 16);
        oc[dt] = MFMA16(mk8((u32x4){lo[0], lo[1], hi[0], hi[1]}), pf, oc[dt]);
      }
    }
#pragma unroll
    for (int dt = 0; dt < 4; ++dt) { const f32x4 v = oc[dt] * gt; lo[(hh * 4 + dt) * 64] = (u32x2){pk2(v[0], v[1]), pk2(v[2], v[3])}; }
  }
  float imp[8];
  {
    float rot[8];
#pragma unroll
    for (int kt = 0; kt < 8; ++kt) rot[kt] = __shfl(ph[kt][3], (lane + 48) & 63);
#pragma unroll
    for (int kt = 0; kt < 8; ++kt) {
      const float extra = quad > 0 ? rot[kt] : (kt > 0 ? rot[kt > 0 ? kt - 1 : 0] : 0.f);
      const float v = (ph[kt][0] + ph[kt][1]) + (ph[kt][2] + ph[kt][3]) + extra;
      const int j = 4 * kt + quad;
      const bool forced = j == 0 || j == cur || j == cur - 1;
      imp[kt] = j <= cur ? v + (forced ? 1e4f : 0.f) : -1e30f;
    }
  }
  unsigned selmask = 0;
  {
    int rank[8];
#pragma unroll
    for (int kt = 0; kt < 8; ++kt) rank[kt] = 0;
#pragma unroll 1
    for (int q2 = 0; q2 < 4; ++q2)
#pragma unroll
      for (int k2 = 0; k2 < 8; ++k2) {
        const float ov = __shfl(imp[k2], qi + 16 * q2);
#pragma unroll
        for (int kt = 0; kt < 8; ++kt) {
          const bool before = k2 < kt || (k2 == kt && q2 < quad);
          rank[kt] += (ov > imp[kt] || (ov == imp[kt] && before)) ? 1 : 0;
        }
      }
#pragma unroll
    for (int kt = 0; kt < 8; ++kt) if (rank[kt] < 8 && 4 * kt + quad <= cur) selmask |= 1u << (4 * kt + quad);
    selmask |= __shfl_xor(selmask, 16); selmask |= __shfl_xor(selmask, 32);
  }

  unsigned umall = selmask;
  umall |= __shfl_xor(umall, 1); umall |= __shfl_xor(umall, 2); umall |= __shfl_xor(umall, 4); umall |= __shfl_xor(umall, 8);
  umall = __builtin_amdgcn_readfirstlane(umall);
  const int wv = my_tid() >> 6;
  unsigned* umw = (unsigned*)(lds + NSA_UMW); int* blist = (int*)(lds + NSA_BLIST);
  if (lane == 0) umw[wv] = umall;
  bf16x8 qf[4][2];
#pragma unroll
  for (int hh = 0; hh < 4; ++hh) {
    const bf16_t* qp = p.nq() + ((long)(b * 8 + g * 4 + hh) * SEQ + t) * 64 + quad * 8;
    qf[hh][0] = ld8(qp); qf[hh][1] = ld8(qp + 32);
  }
  float gate[3][4];
#pragma unroll
  for (int br = 1; br < 3; ++br) { const f32x4 gv = *(const f32x4*)(p.ngate() + tok * 32 + br * 8 + g * 4); gate[br][0] = gv[0]; gate[br][1] = gv[1]; gate[br][2] = gv[2]; gate[br][3] = gv[3]; }
  f32x4 O[4][4]; float m[4], l[4];
#pragma unroll
  for (int hh = 0; hh < 4; ++hh) { m[hh] = on_s ? -1e30f : mf_s; l[hh] = 0.f;
#pragma unroll
    for (int dt = 0; dt < 4; ++dt) O[hh][dt] = (f32x4){0.f, 0.f, 0.f, 0.f}; }
  __syncthreads();
  int nb;
  {
    unsigned ub = 0;
#pragma unroll
    for (int i = 0; i < 8; ++i) ub |= umw[i];
    nb = __builtin_popcount(ub);
    if (my_tid() < 32) { if ((ub >> my_tid()) & 1u) blist[__builtin_popcount(ub & ((1u << my_tid()) - 1u))] = my_tid(); }
    __syncthreads();
    nsa_branch<0>(p.ks() + (long)bg * SEQ * 64, p.vst() + (long)bg * 64 * SEQ, lds, nb, t, cur, selmask, umall, qf, O, m, l, on_s);
    nsa_finish<false>(lo, O, m, l, gate[1], nullptr, nullptr, on_w ? -1e30f : mf_w);
  }
  {
    const int cur0 = (t0 >> 7) * 2, jlo = cur0 >= 8 ? cur0 - 8 : 0;
    nb = cur0 + 2 - jlo;
    if (my_tid() < nb) blist[my_tid()] = jlo + my_tid();
    __syncthreads();
    nsa_branch<1>(p.kw() + (long)bg * SEQ * 64, p.vwt() + (long)bg * 64 * SEQ, lds, nb, t, cur, selmask, umall, qf, O, m, l, on_w);
    nsa_finish<true>(lo, O, m, l, gate[2], p.nz() + tok * 512 + g * 256 + quad * 4, ybase + tok * 512 + g * 256 + quad * 4, 0.f);
  }
  __syncthreads();
}

DI void phaseC(const Params& p0, int layer, unsigned char* lds, bool probe) {
  const int NITEM = BATCH * 2 * 16;
  for (int it = blockIdx.x; it < NITEM; it += gridDim.x) {
    const Params p = relaunder(p0);
    const int qt = 15 - (it >> 5), bg = it & 31;
    nsa_wave(p, layer, bg >> 1, bg & 1, qt * 128 + (my_tid() >> 6) * 16, lds, probe ? p.dummy() : p.nz());
  }
}

DI void phaseD(const Params& p0, const Slot sl, int layer, unsigned char* lds) {
  const Params p = relaunder(p0);
  bf16_t* gl = (bf16_t*)lds;
  int mt, nt;
  for (int it = 0; tile_order(sl, it, 4, mt, nt); ++it) {
#pragma unroll 1
    for (int which = 0; which < 2; ++which) {
      const bf16_t* Wg = (which ? p.wupb_t() : p.wupa_t()) + ((long)nt * 256) * 512;
      const bf16_t* Yg = (which ? p.nz() : p.sbz()) + (long)mt * 256 * 512;
      const bf16_t* Gg = which ? p.gb() : p.ga();
      f32x4 acc[8][4]; zero_acc(acc);
      gemm_core(Wg, 512, Yg, 512, 512, gl, acc);
      const int tid = my_tid(), lane = tid & 63, w = tid >> 6, wa = w >> 2, wb = w & 3, qi = lane & 15, quad = lane >> 4;
#pragma unroll
      for (int j = 0; j < 4; ++j) {
        const long tok = (long)mt * 256 + wb * 64 + j * 16 + qi;
#pragma unroll
        for (int i = 0; i < 8; ++i) {
          const long off = tok * 1024 + nt * 256 + wa * 128 + i * 16 + quad * 4;
          const u32x2 xg = *(const u32x2*)(Gg + off);
          const f32x4 v = acc[i][j];
          float o0 = bflo(xg[0]) * v[0], o1 = bfhi(xg[0]) * v[1], o2 = bflo(xg[1]) * v[2], o3 = bfhi(xg[1]) * v[3];
          if (which) { const u32x2 a = *(const u32x2*)(p.merged() + off); o0 += bflo(a[0]); o1 += bfhi(a[0]); o2 += bflo(a[1]); o3 += bfhi(a[1]); }
          *(u32x2*)(p.merged() + off) = (u32x2){pk2(o0, o1), pk2(o2, o3)};
          if ((i & 3) == 3) asm volatile("" ::: "memory");
        }
      }
    }
  }
}

DI void phaseE(const Params& p0, const Slot sl, int layer, unsigned char* lds, const float* xsrc) {
  const Params p = relaunder(p0);
  bf16_t* gl = (bf16_t*)lds;
  int mt, nt;
  for (int it = 0; tile_order(sl, it, 4, mt, nt); ++it) {
    f32x4 acc[8][4]; zero_acc(acc);
    gemm_core(p.wout_t() + ((long)nt * 256) * 1024, 1024, p.merged() + (long)mt * 256 * 1024, 1024, 1024, gl, acc);
    const int tid = my_tid(), lane = tid & 63, w = tid >> 6, wa = w >> 2, wb = w & 3, qi = lane & 15, quad = lane >> 4;
#pragma unroll
    for (int j = 0; j < 4; ++j) {
      const long tok = (long)mt * 256 + wb * 64 + j * 16 + qi;
      float ss = 0.f;
#pragma unroll
      for (int i = 0; i < 8; ++i) {
        const long off = tok * 1024 + nt * 256 + wa * 128 + i * 16 + quad * 4;
        const f32x4 xo = *(const f32x4*)(xsrc + off);
        const f32x4 xn = xo + acc[i][j];
        *(f32x4*)(p.out + off) = xn;
        *(u32x2*)(p.xb() + off + tok * (LDX - D_MODEL)) = (u32x2){pk2(xn[0], xn[1]), pk2(xn[2], xn[3])};
        ss += xn[0] * xn[0] + xn[1] * xn[1] + xn[2] * xn[2] + xn[3] * xn[3];
      }
      ss += __shfl_xor(ss, 16); ss += __shfl_xor(ss, 32);
      if (quad == 0) p.part()[tok * 16 + nt * 2 + wa] = ss;
    }
  }
}

#ifndef STOP_AFTER
#define STOP_AFTER 0
#endif
constexpr int LDS_BYTES = LDS_GEMM_BYTES + 1024;

__global__ void __launch_bounds__(512) hybrid_megakernel(Params p) {
  extern __shared__ __attribute__((aligned(16))) unsigned char lds[];
  cg::grid_group grid = cg::this_grid();
  __shared__ int s_xcc, s_rank, s_ok;
  if (threadIdx.x == 0) {
    const unsigned xcc = (unsigned)__builtin_amdgcn_s_getreg((3 << 11) | 20) & 7u;
    s_xcc = (int)xcc; s_rank = (int)atomicAdd(p.ctl() + xcc, 1u);
  }
  phase_prologue(p, lds);
  grid.sync();
  if (threadIdx.x == 0) {
    int ok = 1;
    for (int i = 0; i < 8; ++i) ok &= (__hip_atomic_load(p.ctl() + i, __ATOMIC_RELAXED, __HIP_MEMORY_SCOPE_AGENT) == (gridDim.x >> 3));
    s_ok = ok;
  }
  __syncthreads();
  const Slot sl = {s_ok ? s_xcc : (int)(blockIdx.x & 7), s_ok ? s_rank : (int)(blockIdx.x >> 3)};
  for (int layer = 0; layer < DEPTH; ++layer) {
    if (layer > 0) convert_weights(p, layer, lds, 2);
    if (STOP_AFTER != 0 && STOP_AFTER == layer * 10) return;
    phaseA(p, sl, layer, lds);
    grid.sync();
#ifdef PROBE_A
    phaseA(p, sl, layer, lds, PROBE_A >= 2 ? PROBE_A : 0);
    grid.sync();
#endif
    if (STOP_AFTER == layer * 10 + 1) return;
#ifdef PROBE_B
    phaseB(p, layer, lds, true);
    grid.sync();
#endif
    phaseB(p, layer, lds, false);
    grid.sync();
    phaseB2(p, layer, lds);
    grid.sync();
    if (STOP_AFTER == layer * 10 + 2) return;
#ifdef PROBE_C
    phaseC(p, layer, lds, true);
    grid.sync();
#endif
    phaseC(p, layer, lds, false);
    grid.sync();
    if (STOP_AFTER == layer * 10 + 3) return;
    phaseD(p, sl, layer, lds);
    grid.sync();
#ifdef PROBE_D
    phaseD(p, sl, layer, lds);
    grid.sync();
#endif
    if (STOP_AFTER == layer * 10 + 4) return;
    if (layer == 0) phaseE(p, sl, layer, lds, p.x_in); else phaseE(p, sl, layer, lds, p.out);
    if (layer + 1 < DEPTH) convert_weights(p, layer + 1, lds, 1);
    if (layer + 1 < DEPTH) grid.sync();
    if (STOP_AFTER == layer * 10 + 5) return;
  }
}

extern "C" void kernel_launch(void* const* d_in, const int* in_sizes, int n_in, void* d_out, int out_size,
                              void* d_ws, size_t ws_size, hipStream_t stream) {
  static int grid_blocks = 0;
  if (!grid_blocks) {
    int dev = 0, cus = 0, per_cu = 0;
    (void)hipGetDevice(&dev);
    (void)hipDeviceGetAttribute(&cus, hipDeviceAttributeMultiprocessorCount, dev);
    if (hipFuncSetAttribute((const void*)hybrid_megakernel, hipFuncAttributeMaxDynamicSharedMemorySize, LDS_BYTES) != hipSuccess) fprintf(stderr, "hipFuncSetAttribute(max dynamic LDS) failed\n");
    (void)hipOccupancyMaxActiveBlocksPerMultiprocessor(&per_cu, hybrid_megakernel, NTHR, LDS_BYTES);
    (void)hipGetLastError();
    if (per_cu > 1) per_cu = 1;
    if (per_cu < 1) per_cu = 1;
    grid_blocks = (cus * per_cu) & ~7;
  }
  Params a{};
  a.x_in = (const float*)d_in[0]; a.pos = (const int*)d_in[1]; a.norm_g = (const float*)d_in[2]; a.w_in = (const float*)d_in[3];
  a.q_norm_g = (const float*)d_in[4]; a.k_norm_g = (const float*)d_in[5]; a.cmp_pe = (const float*)d_in[6]; a.cmp_w1 = (const float*)d_in[7];
  a.cmp_b1 = (const float*)d_in[8]; a.cmp_w2 = (const float*)d_in[9]; a.w_up_a = (const float*)d_in[10]; a.w_up_b = (const float*)d_in[11];
  a.w_out = (const float*)d_in[12];
  a.out = (float*)d_out; a.ws = (unsigned char*)d_ws;
  if (WS_NEED > ws_size) { fprintf(stderr, "workspace too small: need %zu have %zu\n", (size_t)WS_NEED, ws_size); return; }
  (void)hipMemsetAsync((unsigned char*)d_ws + OFF_CTL, 0, 256, stream);
  void* args[] = {&a};
  hipError_t e = hipLaunchCooperativeKernel((void*)hybrid_megakernel, dim3(grid_blocks), dim3(NTHR), args, LDS_BYTES, stream);
  if (e != hipSuccess) fprintf(stderr, "cooperative launch failed: %s (grid %d)\n", hipGetErrorString(e), grid_blocks);
}
```

```cpp
#include <hip/hip_runtime.h>
#include <hip/hip_cooperative_groups.h>
#include <cstdio>
#include <cstdint>
namespace cg = cooperative_groups;

typedef unsigned short bf16_t;
typedef short bf16x8 __attribute__((ext_vector_type(8)));
typedef float f32x4 __attribute__((ext_vector_type(4)));
typedef float f32x2 __attribute__((ext_vector_type(2)));
typedef unsigned u32x4 __attribute__((ext_vector_type(4)));
typedef unsigned u32x2 __attribute__((ext_vector_type(2)));
typedef __bf16 bf16x2_t __attribute__((ext_vector_type(2)));

#define DI __device__ __forceinline__
#define MFMA16(a, b, c) __builtin_amdgcn_mfma_f32_16x16x32_bf16((a), (b), (c), 0, 0, 0)

constexpr int D_MODEL = 1024, BATCH = 16, SEQ = 2048, DEPTH = 4, NTOK = BATCH * SEQ;
constexpr int N_IN = 5912, NP = 6144, NT_IN = 24;
constexpr int NTHR = 512;
constexpr int LDX = D_MODEL + 64;
constexpr int NCMP = 127;
constexpr float NORM_EPS = 1e-6f;

DI unsigned pk2(float lo, float hi) { f32x2 v = {lo, hi}; bf16x2_t b = __builtin_convertvector(v, bf16x2_t); return __builtin_bit_cast(unsigned, b); }
DI float bflo(unsigned u) { return __uint_as_float(u << 16); }
DI float bfhi(unsigned u) { return __uint_as_float(u & 0xffff0000u); }
DI float sigmoidf_(float x) { return __builtin_amdgcn_rcpf(1.f + __builtin_amdgcn_exp2f(-1.44269504089f * x)); }
DI float siluf_(float x) { return x * __builtin_amdgcn_rcpf(1.f + __builtin_amdgcn_exp2f(-1.44269504089f * x)); }
DI bf16x8 mk8(u32x4 v) { return __builtin_bit_cast(bf16x8, v); }
DI bf16x8 ld8(const bf16_t* p) { return __builtin_bit_cast(bf16x8, *(const u32x4*)p); }


DI void sincos_acc(float angf, float& sn, float& cs) {
  const double a = (double)angf;
  const double k = rint(a * 0.63661977236758134308);
  const double y = (a - k * 1.57079632679489655800) - k * 6.12323399573676603587e-17;
  const double y2 = y * y;
  const double sp = y * (1.0 + y2 * (-1.0 / 6 + y2 * (1.0 / 120 + y2 * (-1.0 / 5040 + y2 * (1.0 / 362880 + y2 * (-1.0 / 39916800 + y2 * (1.0 / 6227020800.0)))))));
  const double cp = 1.0 + y2 * (-0.5 + y2 * (1.0 / 24 + y2 * (-1.0 / 720 + y2 * (1.0 / 40320 + y2 * (-1.0 / 3628800 + y2 * (1.0 / 479001600.0))))));
  const int q = ((int)k) & 3;
  const double s_ = (q & 1) ? cp : sp, c_ = (q & 1) ? sp : cp;
  sn = (float)((q & 2) ? -s_ : s_);
  cs = (float)(((q + 1) & 2) ? -c_ : c_);
}
DI float inv_freq(int f) { return (float)exp(-(double)f * (9.21034037197618273607 / 32.0)); }

constexpr size_t al256(size_t x) { return (x + 255) & ~(size_t)255; }
constexpr size_t OFF_WT_IN = 0;
constexpr size_t OFF_W1T = OFF_WT_IN + al256((size_t)NP * LDX * 2);
constexpr size_t OFF_W2T = OFF_W1T + al256((size_t)2 * 256 * 2048 * 2);
constexpr size_t OFF_WUPA = OFF_W2T + al256((size_t)2 * 64 * 256 * 2);
constexpr size_t OFF_WUPB = OFF_WUPA + al256((size_t)1024 * 512 * 2);
constexpr size_t OFF_WOUT = OFF_WUPB + al256((size_t)1024 * 512 * 2);
constexpr size_t OFF_B1EFF = OFF_WOUT + al256((size_t)1024 * 1024 * 2);
constexpr size_t OFF_COST = OFF_B1EFF + al256((size_t)DEPTH * 2 * 16 * 256 * 4);
constexpr size_t OFF_SINT = OFF_COST + al256((size_t)NTOK * 32 * 4);
constexpr size_t OFF_COSC = OFF_SINT + al256((size_t)NTOK * 32 * 4);
constexpr size_t OFF_SINC = OFF_COSC + al256((size_t)BATCH * 128 * 32 * 4);
constexpr size_t OFF_XB = OFF_SINC + al256((size_t)BATCH * 128 * 32 * 4);
constexpr size_t OFF_PART = OFF_XB + al256((size_t)NTOK * LDX * 2);
constexpr size_t OFF_SBQ = OFF_PART + al256((size_t)NTOK * 16 * 4);
constexpr size_t OFF_SBK = OFF_SBQ + al256((size_t)NTOK * 512 * 2);
constexpr size_t OFF_SBVT = OFF_SBK + al256((size_t)NTOK * 512 * 2);
constexpr size_t OFF_SBZ = OFF_SBVT + al256((size_t)NTOK * 512 * 2);
constexpr size_t OFF_NQ = OFF_SBZ + al256((size_t)NTOK * 512 * 2);
constexpr size_t OFF_KCR = OFF_NQ + al256((size_t)NTOK * 512 * 2);
constexpr size_t OFF_VCR = OFF_KCR + al256((size_t)NTOK * 128 * 2);
constexpr size_t OFF_KS = OFF_VCR + al256((size_t)NTOK * 128 * 2);
constexpr size_t OFF_VST = OFF_KS + al256((size_t)NTOK * 128 * 2);
constexpr size_t OFF_KW = OFF_VST + al256((size_t)NTOK * 128 * 2);
constexpr size_t OFF_VWT = OFF_KW + al256((size_t)NTOK * 128 * 2);
constexpr size_t OFF_NGATE = OFF_VWT + al256((size_t)NTOK * 128 * 2);
constexpr size_t OFF_NZ = OFF_NGATE + al256((size_t)NTOK * 32 * 4);
constexpr size_t OFF_GA = OFF_NZ + al256((size_t)NTOK * 512 * 2);
constexpr size_t OFF_GB = OFF_GA + al256((size_t)NTOK * 1024 * 2);
constexpr size_t OFF_HID = OFF_GB + al256((size_t)NTOK * 1024 * 2);
constexpr size_t OFF_KC = OFF_HID + al256((size_t)4 * 32 * 256 * 256 * 4);
constexpr size_t OFF_VCT = OFF_KC + al256((size_t)BATCH * 2 * 128 * 64 * 2);
constexpr size_t OFF_QNG = OFF_VCT + al256((size_t)BATCH * 2 * 64 * 128 * 2);
constexpr size_t OFF_KNG = OFF_QNG + al256((size_t)DEPTH * 64 * 4);
constexpr size_t OFF_CTL = OFF_KNG + al256((size_t)DEPTH * 3 * 64 * 4);
constexpr size_t OFF_MFIX_BASE = OFF_CTL + 256;
constexpr size_t OFF_MFIX_OLD = OFF_KNG + al256((size_t)DEPTH * 3 * 64 * 4);
constexpr size_t OFF_MFIX = OFF_MFIX_BASE;
constexpr size_t OFF_DUMMY = OFF_MFIX + 256;
constexpr size_t WS_NEED = OFF_DUMMY + 256;

struct Params {
  const float* x_in; const int* pos; const float* norm_g; const float* w_in; const float* q_norm_g; const float* k_norm_g;
  const float* cmp_pe; const float* cmp_w1; const float* cmp_b1; const float* cmp_w2; const float* w_up_a; const float* w_up_b; const float* w_out;
  float* out; unsigned char* ws;
#define WSBUF(T, name, OFF) DI T* name() const { return (T*)(ws + (OFF)); }
  WSBUF(bf16_t, wt_in, OFF_WT_IN) WSBUF(bf16_t, w1t, OFF_W1T) WSBUF(bf16_t, w2t, OFF_W2T) WSBUF(bf16_t, wupa_t, OFF_WUPA) WSBUF(bf16_t, wupb_t, OFF_WUPB) WSBUF(bf16_t, wout_t, OFF_WOUT)
  WSBUF(float, b1eff, OFF_B1EFF) WSBUF(float, cosT, OFF_COST) WSBUF(float, sinT, OFF_SINT) WSBUF(float, cosC, OFF_COSC) WSBUF(float, sinC, OFF_SINC)
  WSBUF(bf16_t, xb, OFF_XB) WSBUF(float, part, OFF_PART) WSBUF(bf16_t, sbq, OFF_SBQ) WSBUF(bf16_t, sbk, OFF_SBK) WSBUF(bf16_t, sbvt, OFF_SBVT) WSBUF(bf16_t, sbz, OFF_SBZ)
  WSBUF(bf16_t, nq, OFF_NQ) WSBUF(bf16_t, kcr, OFF_KCR) WSBUF(bf16_t, vcr, OFF_VCR) WSBUF(bf16_t, ks, OFF_KS) WSBUF(bf16_t, vst, OFF_VST) WSBUF(bf16_t, kw, OFF_KW) WSBUF(bf16_t, vwt, OFF_VWT)
  WSBUF(float, ngate, OFF_NGATE) WSBUF(bf16_t, nz, OFF_NZ) WSBUF(bf16_t, ga, OFF_GA) WSBUF(bf16_t, gb, OFF_GB) WSBUF(float, hpre, OFF_HID) WSBUF(bf16_t, kc, OFF_KC) WSBUF(bf16_t, vct, OFF_VCT)
  WSBUF(bf16_t, merged, OFF_SBK)
  WSBUF(bf16_t, dummy, OFF_XB)     WSBUF(float, mfix, OFF_MFIX) WSBUF(unsigned, ctl, OFF_CTL)
  WSBUF(float, qng, OFF_QNG) WSBUF(float, kng, OFF_KNG)
};

DI int my_tid() { int t = threadIdx.x; asm volatile("" : "+v"(t)); return t; }
DI Params relaunder(const Params& p0) { Params p = p0; size_t z = 0; asm volatile("" : "+s"(z)); p.ws = p0.ws + z; return p; }

constexpr int TILE_B = 32 * 1024;
constexpr int STAGE_B = 2 * TILE_B;
constexpr int LDS_GEMM_BYTES = 2 * STAGE_B;
typedef __attribute__((address_space(3))) unsigned lds_u32;

DI void g_dma(const bf16_t* __restrict__ base, const unsigned (&off)[8], int ko, unsigned char* stage, int w) {
#pragma unroll
  for (int u = 0; u < 8; ++u)
    __builtin_amdgcn_global_load_lds((const unsigned*)(base + (off[u] + ko)), (lds_u32*)(stage + (w * 8 + u) * 1024), 16, 0, 0);
}
#define G_LDA(dst, ih, ks) _Pragma("unroll") for (int i = 0; i < 4; ++i) dst[i] = mk8(*(const u32x4*)(stage + ra + (((ih) * 4 + i) * 2 + (ks)) * 1024))
#define G_LDB(dst, ks) _Pragma("unroll") for (int j = 0; j < 4; ++j) dst[j] = mk8(*(const u32x4*)(stage + TILE_B + rb + (j * 2 + (ks)) * 1024))
#define G_MMA(ih, A, B) do { __builtin_amdgcn_s_setprio(1); _Pragma("unroll") for (int i = 0; i < 4; ++i) _Pragma("unroll") for (int j = 0; j < 4; ++j) acc[(ih) * 4 + i][j] = MFMA16(A[i], B[j], acc[(ih) * 4 + i][j]); __builtin_amdgcn_s_setprio(0); } while (0)
DI void g_compute(const unsigned char* stage, int ra, int rb, f32x4 (&acc)[8][4]) {
  bf16x8 b0[4], b1[4], a0[4], a1[4];
  G_LDB(b0, 0); G_LDA(a0, 0, 0);
  __builtin_amdgcn_sched_barrier(0);
  G_LDA(a1, 1, 0);
  G_MMA(0, a0, b0);
  __builtin_amdgcn_sched_barrier(0);
  G_LDB(b1, 1); G_LDA(a0, 0, 1);
  G_MMA(1, a1, b0);
  __builtin_amdgcn_sched_barrier(0);
  G_LDA(a1, 1, 1);
  G_MMA(0, a0, b1);
  __builtin_amdgcn_sched_barrier(0);
  G_MMA(1, a1, b1);
  __builtin_amdgcn_sched_barrier(0);
}

DI void gemm_core(const bf16_t* __restrict__ Ag, long lda, const bf16_t* __restrict__ Bg, long ldb, int K,
                  bf16_t* ldsb, f32x4 (&acc)[8][4], int kstep = 64, bool pre = false, const bf16_t* nAg = nullptr, const bf16_t* nBg = nullptr) {
  unsigned char* lds = (unsigned char*)ldsb;
  const int tid = my_tid(), lane = tid & 63, w = __builtin_amdgcn_readfirstlane(tid >> 6), wa = w >> 2, wb = w & 3, qi = lane & 15, quad = lane >> 4;
  const bf16_t* base = w >= 4 ? Bg : Ag; const int ld = (int)(w >= 4 ? ldb : lda);
  const bf16_t* nbase = nAg ? (w >= 4 ? nBg : nAg) : base;
  unsigned off[8];
#pragma unroll
  for (int u = 0; u < 8; ++u) { const int blk = (w & 3) * 8 + u, rg = blk >> 1, kh = blk & 1; off[u] = (unsigned)((rg * 16 + (lane >> 2)) * ld + kh * 32 + (lane & 3) * 8); }
  const int ra = (wa * 8) * 2 * 1024 + (qi * 4 + quad) * 16, rb = (wb * 4) * 2 * 1024 + (qi * 4 + quad) * 16;
  unsigned char* buf0 = lds; unsigned char* buf1 = lds + STAGE_B;
  const int KT = K >> 6;
  if (!pre) {
    g_dma(base, off, 0, buf0, w);
    asm volatile("s_waitcnt vmcnt(0)" ::: "memory");
    __syncthreads();
  }
  for (int kt = 0; kt < KT; kt += 2) {
    g_dma(base, off, (kt + 1) * kstep, buf1, w);
    g_compute(buf0, ra, rb, acc);
    asm volatile("s_waitcnt vmcnt(0)" ::: "memory");
    __syncthreads();
    const bool last = kt + 2 >= KT;
    g_dma(last ? nbase : base, off, last ? 0 : (kt + 2) * kstep, buf0, w);
    g_compute(buf1, ra, rb, acc);
    asm volatile("s_waitcnt vmcnt(0)" ::: "memory");
    __syncthreads();
  }
}

DI void zero_acc(f32x4 (&acc)[8][4]) {
#pragma unroll
  for (int i = 0; i < 8; ++i)
#pragma unroll
    for (int j = 0; j < 4; ++j) acc[i][j] = (f32x4){0.f, 0.f, 0.f, 0.f};
}

struct Slot { int xcd, slot; };
DI bool tile_order(const Slot sl, int it, int nN, int& mt, int& nt) {
  const int xcd = sl.xcd, slot = sl.slot, SL = gridDim.x >> 3;
  const int q = slot + it * SL, per = 8 * nN;
  if (q >= 2 * per) return false;
  const int mg = q / per, e = q - mg * per;
  nt = e >> 3; mt = xcd * 16 + mg * 8 + (e & 7);
  return true;
}

DI int inmap(int c) {
  if (c < 1024) return c;
  if (c < 1536) return c + 512;
  if (c < 2048) return c + 512;
  if (c < 2304) return c + 512;
  if (c < 2432) return c + 512;
  if (c < 2560) return c + 640;
  if (c < 3072) return c + 792;
  if (c < 4096) return c + 792;
  if (c < 5120) return c + 792;
  if (c < 5376) return c < 5144 ? c - 1792 : -1;
  if (c < 5888) return c - 4352;
  if (c < 6016) return c - 2944;
  return c - 2816;
}

DI void tr_tile(const float* __restrict__ src, int ld, int K, int k0, int n0, bool use_map, const float* __restrict__ scale, bf16_t* __restrict__ dst, int ldd, float* tile) {
  const int tid = my_tid();
  {
    const int nl = tid & 63, kk = tid >> 6;
    int n = n0 + nl; asm volatile("" : "+v"(n));
    const int sc = use_map ? inmap(n) : n;
#pragma unroll
    for (int r = 0; r < 8; ++r) {
      const int k = k0 + r * 8 + kk;
      float v = 0.f;
      if (sc >= 0) { v = src[(long)k * ld + sc]; if (scale) v *= scale[k]; }
      tile[(r * 8 + kk) * 65 + nl] = v;
    }
  }
  __syncthreads();
  {
    const int nl = tid >> 3, ks = tid & 7;
    unsigned o[4];
#pragma unroll
    for (int e = 0; e < 4; ++e) o[e] = pk2(tile[(ks * 8 + 2 * e) * 65 + nl], tile[(ks * 8 + 2 * e + 1) * 65 + nl]);
    *(u32x4*)(dst + (long)(n0 + nl) * ldd + k0 + ks * 8) = (u32x4){o[0], o[1], o[2], o[3]};
  }
  __syncthreads();
}

DI void tr_job(const float* src, int ld, int K, int N, bool use_map, const float* scale, bf16_t* dst, int ldd, float* tile) {
  const int nk = K >> 6, nn = N >> 6;
  for (int t = blockIdx.x; t < nk * nn; t += gridDim.x) tr_tile(src, ld, K, (t % nk) * 64, (t / nk) * 64, use_map, scale, dst, ldd, tile);
}

DI void convert_weights(const Params& p0, int l, unsigned char* lds, int which) {
  const Params p = relaunder(p0);
  float* tile = (float*)lds;
  if (which & 1) {
    tr_job(p.w_in + (long)l * D_MODEL * N_IN, N_IN, D_MODEL, NP, true, p.norm_g + l * D_MODEL, p.wt_in(), LDX, tile);
    for (int kv = 0; kv < 2; ++kv) {
      tr_job(p.cmp_w1 + (long)(l * 2 + kv) * 2048 * 256, 256, 2048, 256, false, nullptr, p.w1t() + (long)kv * 256 * 2048, 2048, tile);
      tr_job(p.cmp_w2 + (long)(l * 2 + kv) * 256 * 64, 64, 256, 64, false, nullptr, p.w2t() + (long)kv * 64 * 256, 256, tile);
    }
    tr_job(p.w_up_a + (long)l * 512 * 1024, 1024, 512, 1024, false, nullptr, p.wupa_t(), 512, tile);
    tr_job(p.w_up_b + (long)l * 512 * 1024, 1024, 512, 1024, false, nullptr, p.wupb_t(), 512, tile);
  }
  if (which & 2) tr_job(p.w_out + (long)l * 1024 * 1024, 1024, 1024, 1024, false, nullptr, p.wout_t(), 1024, tile);
}

DI void phase_prologue(const Params& p, unsigned char* lds) {
  const int tid = my_tid();
  convert_weights(p, 0, lds, 3);
  {
    const int lane = tid & 63;
    for (int wi = blockIdx.x * 8 + (tid >> 6); wi < DEPTH * 2 * 16 * 4; wi += gridDim.x * 8) {
      const int jq = wi & 3, kq = (wi >> 2) & 15, it = wi >> 6;
      const float* w1 = p.cmp_w1 + (long)it * 2048 * 256 + (long)kq * 128 * 256 + jq * 64 + lane; const float* pe = p.cmp_pe + (long)it * 2048 + kq * 128;
      float s0 = kq == 0 ? p.cmp_b1[it * 256 + jq * 64 + lane] : 0.f, s1 = 0.f, s2 = 0.f, s3 = 0.f;
#pragma unroll 4
      for (int k = 0; k < 128; k += 4) {
        s0 += pe[k] * w1[(long)k * 256]; s1 += pe[k + 1] * w1[(long)(k + 1) * 256]; s2 += pe[k + 2] * w1[(long)(k + 2) * 256]; s3 += pe[k + 3] * w1[(long)(k + 3) * 256];
      }
      p.b1eff()[(it * 16 + kq) * 256 + jq * 64 + lane] = (s0 + s1) + (s2 + s3);
    }
  }
  if (blockIdx.x == 1 && tid < DEPTH * 3) {
    const int l = tid / 3, br = tid % 3;
    float mq = 0.f, mk = 0.f;
    for (int d = 0; d < 64; ++d) { mq = fmaxf(mq, fabsf(p.q_norm_g[l * 64 + d])); mk = fmaxf(mk, fabsf(p.k_norm_g[(l * 3 + br) * 64 + d])); }
    p.mfix()[l * 4 + br] = 8.f * 1.44269504089f * mq * mk * 1.02f + 0.25f;
  }
  if (blockIdx.x == 0) { for (int i = tid; i < DEPTH * 64; i += NTHR) p.qng()[i] = p.q_norm_g[i]; for (int i = tid; i < DEPTH * 192; i += NTHR) p.kng()[i] = p.k_norm_g[i]; }
  const long gtid = (long)blockIdx.x * NTHR + tid, gn = (long)gridDim.x * NTHR;
  for (long i = gtid; i < (long)NTOK * 32; i += gn) {
    const int f = (int)(i & 31); const long tok = i >> 5;
    const float ang = (float)p.pos[tok] * inv_freq(f);
    float sn, cs; sincos_acc(ang, sn, cs);
    p.cosT()[i] = cs; p.sinT()[i] = sn;
  }
  for (long i = gtid; i < (long)BATCH * 128 * 32; i += gn) {
    const int f = (int)(i & 31); const int c = (int)((i >> 5) & 127); const int b = (int)(i >> 12);
    float cs = 1.f, sn = 0.f;
    if (c < NCMP) {
      float sum = 0.f;
      for (int k = 0; k < 32; ++k) sum += (float)p.pos[b * SEQ + c * 16 + k];
      const float ang = (sum * (1.f / 32.f)) * inv_freq(f);
      sincos_acc(ang, sn, cs);
    }
    p.cosC()[i] = cs; p.sinC()[i] = sn;
  }
  const int lane = tid & 63;
  for (long row = (long)blockIdx.x * 8 + (tid >> 6); row < NTOK; row += (long)gridDim.x * 8) {
    const float* xr = p.x_in + row * D_MODEL; bf16_t* xo = p.xb() + row * LDX;
    float ss = 0.f;
#pragma unroll
    for (int u = 0; u < 4; ++u) {
      const f32x4 v = *(const f32x4*)(xr + u * 256 + lane * 4);
      ss += v[0] * v[0] + v[1] * v[1] + v[2] * v[2] + v[3] * v[3];
      *(u32x2*)(xo + u * 256 + lane * 4) = (u32x2){pk2(v[0], v[1]), pk2(v[2], v[3])};
    }
#pragma unroll
    for (int o = 32; o >= 1; o >>= 1) ss += __shfl_xor(ss, o);
    if (lane < 8) p.part()[row * 16 + lane] = lane == 0 ? ss : 0.f;
  }
}

DI void phaseA_epilogue(const Params& p, int layer, int mt, int nt, const f32x4 (&acc)[8][4], const float* rs_s) {
  const int tid = my_tid(), lane = tid & 63, w = tid >> 6, wa = w >> 2, wb = w & 3, qi = lane & 15, quad = lane >> 4;
  if (nt >= 21) {
    bf16_t* dstb; int nh, head;
    if (nt < 23) { dstb = p.sbvt(); nh = 8; head = (nt - 21) * 4 + wb; } else if (wb < 2) { dstb = p.vst(); nh = 2; head = wb; } else { dstb = p.vwt(); nh = 2; head = wb - 2; }
    const int tok0 = mt * 256, b = tok0 >> 11, s0 = (tok0 & 2047) + wa * 128 + quad * 4;
#pragma unroll
    for (int i = 0; i < 8; ++i) {
      const int tl = wa * 128 + i * 16 + quad * 4;
      const float r0 = rs_s[tl], r1 = rs_s[tl + 1], r2 = rs_s[tl + 2], r3 = rs_s[tl + 3];
#pragma unroll
      for (int j = 0; j < 4; ++j) {
        const int d = j * 16 + qi;
        const f32x4 v = acc[i][j];
        const int sq = s0 + i * 16;
        bf16_t* dst = dstb + (long)(b * nh + head) * 64 * SEQ + (long)(sq >> 5) * 2048 + d * 32 + (sq & 31);
        *(u32x2*)dst = (u32x2){pk2(v[0] * r0, v[1] * r1), pk2(v[2] * r2, v[3] * r3)};
      }
    }
    return;
  }
  const bool headtype = nt < 4 || (nt >= 6 && nt < 10);
#pragma unroll
  for (int j = 0; j < 4; ++j) {
    const int tl = wb * 64 + j * 16 + qi; const long tok = (long)mt * 256 + tl; const int b = (int)(tok >> 11), sq = (int)(tok & 2047);
    const float rs = rs_s[tl];
    if (headtype) {
#pragma unroll
      for (int ih = 0; ih < 2; ++ih) {
        const int hit = wa * 2 + ih;
        f32x4 v[4];
#pragma unroll
        for (int i = 0; i < 4; ++i) v[i] = acc[ih * 4 + i][j] * rs;
        bf16_t* dstb; int nh, head; const float* g = nullptr;
        if (nt < 2) { dstb = p.sbq(); nh = 8; head = nt * 4 + hit; }
        else if (nt < 4) { dstb = p.sbk(); nh = 8; head = (nt - 2) * 4 + hit; }
        else if (nt < 8) { dstb = p.nq(); nh = 8; head = (nt - 6) * 4 + hit; g = p.qng() + layer * 64; }
        else if (nt == 8) { dstb = hit < 2 ? p.kcr() : p.vcr(); nh = 2; head = hit & 1; }
        else { dstb = hit < 2 ? p.ks() : p.kw(); nh = 2; head = hit & 1; g = p.kng() + (layer * 3 + (hit < 2 ? 1 : 2)) * 64; }
        if (g) {
          float ss = 0.f;
#pragma unroll
          for (int i = 0; i < 4; ++i) ss += v[i][0] * v[i][0] + v[i][1] * v[i][1] + v[i][2] * v[i][2] + v[i][3] * v[i][3];
          ss += __shfl_xor(ss, 16); ss += __shfl_xor(ss, 32);
          const float rn = rsqrtf(ss * (1.f / 64.f) + NORM_EPS);
#pragma unroll
          for (int i = 0; i < 4; ++i) { const f32x4 gg = *(const f32x4*)(g + i * 16 + quad * 4); v[i] = v[i] * rn * gg; }
#pragma unroll
          for (int i = 0; i < 2; ++i) {
            const f32x4 cs = *(const f32x4*)(p.cosT() + tok * 32 + i * 16 + quad * 4), sn = *(const f32x4*)(p.sinT() + tok * 32 + i * 16 + quad * 4);
            const f32x4 x1 = v[i], x2 = v[i + 2];
            v[i] = x1 * cs - x2 * sn; v[i + 2] = x2 * cs + x1 * sn;
          }
        }
        bf16_t* dst = dstb + ((long)(b * nh + head) * SEQ + sq) * 64 + quad * 4;
#pragma unroll
        for (int i = 0; i < 4; ++i) *(u32x2*)(dst + i * 16) = (u32x2){pk2(v[i][0], v[i][1]), pk2(v[i][2], v[i][3])};
        asm volatile("" ::: "memory");
      }
    } else if (nt == 20) {
      if (wa == 0) {
#pragma unroll
        for (int i = 0; i < 2; ++i) {
          const int f = i * 16 + quad * 4;
          const f32x4 v = acc[i][j] * rs;
          if (f < 24) { const f32x4 o = {sigmoidf_(v[0]), sigmoidf_(v[1]), sigmoidf_(v[2]), sigmoidf_(v[3])}; *(f32x4*)(p.ngate() + tok * 32 + f) = o; }
        }
      }
    } else {
      bf16_t* dstb; int ldd, c0; bool sil;
      if (nt < 6) { dstb = p.sbz(); ldd = 512; c0 = (nt - 4) * 256; sil = true; }
      else if (nt < 12) { dstb = p.nz(); ldd = 512; c0 = (nt - 10) * 256; sil = true; }
      else if (nt < 16) { dstb = p.ga(); ldd = 1024; c0 = (nt - 12) * 256; sil = false; }
      else { dstb = p.gb(); ldd = 1024; c0 = (nt - 16) * 256; sil = false; }
      bf16_t* dst = dstb + tok * ldd + c0 + wa * 128 + quad * 4;
#pragma unroll
      for (int i = 0; i < 8; ++i) {
        const f32x4 v = acc[i][j] * rs;
        f32x4 o;
#pragma unroll
        for (int r = 0; r < 4; ++r) o[r] = sil ? siluf_(v[r]) : sigmoidf_(v[r]);
        *(u32x2*)(dst + i * 16) = (u32x2){pk2(o[0], o[1]), pk2(o[2], o[3])};
      }
    }
    asm volatile("" ::: "memory");
  }
}

DI void phaseA(const Params& p0, const Slot sl, int layer, unsigned char* lds, int fake = 0) {
  const Params p = relaunder(p0);
  bf16_t* gl = (bf16_t*)lds; float* rs_s = (float*)(lds + LDS_GEMM_BYTES);
  const bf16_t* Wt = p.wt_in();
  int mt, nt;
  for (int it = 0; tile_order(sl, it, NT_IN, mt, nt); ++it) {
    if (my_tid() < 256) {
      const float* pp = p.part() + ((long)mt * 256 + my_tid()) * 16;
      const f32x4 v0 = *(const f32x4*)pp, v1 = *(const f32x4*)(pp + 4);
      const float s = ((v0[0] + v0[1]) + (v0[2] + v0[3])) + ((v1[0] + v1[1]) + (v1[2] + v1[3]));
      rs_s[my_tid()] = rsqrtf(s * (1.f / 1024.f) + NORM_EPS);
    }
    const int mtl = fake == 3 ? 0 : (fake == 4 ? sl.xcd * 16 + (sl.slot & 7) : mt), ntl = fake == 3 ? 0 : (fake == 4 ? (sl.slot >> 3) : nt);
    const bf16_t* Xg = p.xb() + (long)mtl * 256 * LDX; const bf16_t* Wg = Wt + (long)ntl * 256 * LDX;
    f32x4 acc[8][4]; zero_acc(acc);
    const int kstep = (fake == 1 || fake == 2) ? 0 : 64;
    int mt2, nt2;
    const bool more = !fake && tile_order(sl, it + 1, NT_IN, mt2, nt2);
    const bf16_t* Xn = more ? p.xb() + (long)mt2 * 256 * LDX : Xg; const bf16_t* Wn = more ? Wt + (long)nt2 * 256 * LDX : Wg;
    const bool vn = more ? nt2 >= 21 : nt >= 21;
    gemm_core(nt >= 21 ? Xg : Wg, LDX, nt >= 21 ? Wg : Xg, LDX, D_MODEL, gl, acc, kstep, !fake && it > 0, vn ? Xn : Wn, vn ? Wn : Xn);
    if (!fake) phaseA_epilogue(p, layer, mt, nt, acc, rs_s);
    else if (acc[0][0][0] == 123.456f && acc[7][3][3] == 5.f) p.dummy()[0] = 1;
    __syncthreads();
  }
}

DI void compress_partial(const Params& p, int ci, unsigned char* lds) {
  bf16_t* gl = (bf16_t*)lds;
  const int split = ci & 3, item = ci >> 2, kv = item & 1, pair = item >> 1;
  const bf16_t* src = (kv ? p.vcr() : p.kcr()) + (long)pair * 256 * 1024 + split * 512;
  const bf16_t* W1 = p.w1t() + (long)kv * 256 * 2048 + split * 512;
  f32x4 acc[8][4]; zero_acc(acc);
  gemm_core(W1, 2048, src, 1024, 512, gl, acc);
  const int tid = my_tid(), lane = tid & 63, w = tid >> 6, wa = w >> 2, wb = w & 3, qi = lane & 15, quad = lane >> 4;
  float* dst = p.hpre() + ((long)(split * 32 + item) * 256) * 256;
#pragma unroll
  for (int i = 0; i < 8; ++i)
#pragma unroll
    for (int j = 0; j < 4; ++j) *(f32x4*)(dst + (long)(wb * 64 + j * 16 + qi) * 256 + wa * 128 + i * 16 + quad * 4) = acc[i][j];
}

DI void phaseB2(const Params& p0, int layer, unsigned char* lds) {
  const Params p = relaunder(p0);
  const int tid = my_tid(), lane = tid & 63, w = tid >> 6, qi = lane & 15, quad = lane >> 4;
  float* bias_s = (float*)lds;
  {
    const float* b1 = p.b1eff() + (long)(layer * 2 + (tid >> 8)) * 16 * 256 + (tid & 255);
    float sacc = 0.f;
#pragma unroll
    for (int kq = 0; kq < 16; ++kq) sacc += b1[kq * 256];
    bias_s[tid] = sacc;
  }
  __syncthreads();
  const int wi = blockIdx.x * 2 + w;
  if (w < 2 && wi < 32 * 16) {
    const int item = wi >> 4, r16 = wi & 15, kv = item & 1, pair = item >> 1;
    const int row = r16 * 16 + qi;
    const bf16_t* W2 = p.w2t() + (long)kv * 64 * 256;
    const float* hp = p.hpre() + ((long)item * 256 + row) * 256 + quad * 8;
    f32x4 o[4];
#pragma unroll
    for (int dt = 0; dt < 4; ++dt) o[dt] = (f32x4){0.f, 0.f, 0.f, 0.f};
#pragma unroll 1
    for (int ksx = 0; ksx < 8; ++ksx) {
      f32x4 h0 = *(const f32x4*)(bias_s + kv * 256 + ksx * 32 + quad * 8), h1 = *(const f32x4*)(bias_s + kv * 256 + ksx * 32 + quad * 8 + 4);
#pragma unroll
      for (int sp = 0; sp < 4; ++sp) { const float* q = hp + (long)sp * 32 * 256 * 256 + ksx * 32; h0 += *(const f32x4*)q; h1 += *(const f32x4*)(q + 4); }
      const bf16x8 hf = mk8((u32x4){pk2(siluf_(h0[0]), siluf_(h0[1])), pk2(siluf_(h0[2]), siluf_(h0[3])), pk2(siluf_(h1[0]), siluf_(h1[1])), pk2(siluf_(h1[2]), siluf_(h1[3]))});
#pragma unroll
      for (int dt = 0; dt < 4; ++dt) {
        const bf16x8 wf = ld8(W2 + (long)(dt * 16 + qi) * 256 + ksx * 32 + quad * 8);
        o[dt] = kv ? MFMA16(hf, wf, o[dt]) : MFMA16(wf, hf, o[dt]);
      }
    }
    const int bg = pair * 2 + (r16 >> 3);
    if (kv == 0) {
      const float* g = p.kng() + (layer * 3 + 0) * 64;
      const int b = bg >> 1, c = (r16 & 7) * 16 + qi;
      float ss = 0.f;
#pragma unroll
      for (int dt = 0; dt < 4; ++dt) ss += o[dt][0] * o[dt][0] + o[dt][1] * o[dt][1] + o[dt][2] * o[dt][2] + o[dt][3] * o[dt][3];
      ss += __shfl_xor(ss, 16); ss += __shfl_xor(ss, 32);
      const float rn = rsqrtf(ss * (1.f / 64.f) + NORM_EPS);
#pragma unroll
      for (int dt = 0; dt < 4; ++dt) { const f32x4 gg = *(const f32x4*)(g + dt * 16 + quad * 4); o[dt] = o[dt] * rn * gg; }
#pragma unroll
      for (int dt = 0; dt < 2; ++dt) {
        const long ti = ((long)b * 128 + c) * 32 + dt * 16 + quad * 4;
        const f32x4 cs = *(const f32x4*)(p.cosC() + ti), sn = *(const f32x4*)(p.sinC() + ti);
        const f32x4 x1 = o[dt], x2 = o[dt + 2];
        o[dt] = x1 * cs - x2 * sn; o[dt + 2] = x2 * cs + x1 * sn;
      }
      bf16_t* dst = p.kc() + ((long)bg * 128 + c) * 64 + quad * 4;
#pragma unroll
      for (int dt = 0; dt < 4; ++dt) {
        u32x2 ov = (u32x2){pk2(o[dt][0], o[dt][1]), pk2(o[dt][2], o[dt][3])};
        if (c >= NCMP) ov = (u32x2){0u, 0u};
        *(u32x2*)(dst + dt * 16) = ov;
      }
    } else {
#pragma unroll
      for (int dt = 0; dt < 4; ++dt) {
        const int c0 = (r16 & 7) * 16 + quad * 4;
        f32x4 v = o[dt];
        if (c0 + 3 >= NCMP) v[3] = 0.f;
        *(u32x2*)(p.vct() + ((long)bg * 64 + dt * 16 + qi) * 128 + c0) = (u32x2){pk2(v[0], v[1]), pk2(v[2], v[3])};
      }
    }
  }
  __syncthreads();
}

struct SbFrag { bf16x8 k[2][2]; bf16x8 v[4]; };
DI void sb_load(SbFrag& f, const bf16_t* __restrict__ kp0, const bf16_t* __restrict__ vp0, int kb) {
#pragma unroll
  for (int a = 0; a < 2; ++a) { f.k[a][0] = ld8(kp0 + (long)(kb + 4 * a) * 64); f.k[a][1] = ld8(kp0 + (long)(kb + 4 * a) * 64 + 32); }
#pragma unroll
  for (int dt = 0; dt < 4; ++dt) f.v[dt] = ld8(vp0 + (long)kb * 64 + dt * 16 * 32);
}
template <bool FULL>
DI void sb_chunk(const SbFrag& f, int kb, int t, int quad, const bf16x8 (&qf)[2], f32x4 (&o)[4], float& carry) {
  f32x4 s[2];
#pragma unroll
  for (int a = 0; a < 2; ++a) {
    s[a] = MFMA16(f.k[a][0], qf[0], ((f32x4){0.f, 0.f, 0.f, 0.f}));
    s[a] = MFMA16(f.k[a][1], qf[1], s[a]);
  }
  float L[8], ls[8]; bool val[8];
  float tot = 0.f;
#pragma unroll
  for (int idx = 0; idx < 8; ++idx) {
    const float z = s[idx >> 2][idx & 3] * (0.125f * 1.44269504089f);
    val[idx] = FULL ? true : (kb + 8 * quad + idx < t);
    const float sp = fmaxf(z, 0.f) + __builtin_amdgcn_logf(1.f + __builtin_amdgcn_exp2f(-fabsf(z)));
    L[idx] = val[idx] ? -sp : 0.f;
    ls[idx] = z - sp;
    tot += L[idx];
  }
  const float a1 = __shfl_xor(tot, 16), a2 = __shfl_xor(tot, 32), a3 = __shfl_xor(a1, 32);
  const float higher = ((quad ^ 1) > quad ? a1 : 0.f) + ((quad ^ 2) > quad ? a2 : 0.f) + ((quad ^ 3) > quad ? a3 : 0.f);
  float run = carry + higher;
  float wv[8];
#pragma unroll
  for (int idx = 7; idx >= 0; --idx) {
    const float e = __builtin_amdgcn_exp2f(ls[idx] + run);
    wv[idx] = val[idx] ? e : 0.f;
    run += L[idx];
  }
  carry += (tot + a1) + (a2 + a3);
  const bf16x8 pf = mk8((u32x4){pk2(wv[0], wv[1]), pk2(wv[2], wv[3]), pk2(wv[4], wv[5]), pk2(wv[6], wv[7])});
#pragma unroll
  for (int dt = 0; dt < 4; ++dt) o[dt] = MFMA16(f.v[dt], pf, o[dt]);
}

DI void sb_attn_wave(const Params& p, int b, int h, int t0, bf16_t* ybase) {
  const int lane = my_tid() & 63, qi = lane & 15, quad = lane >> 4;
  const bf16_t* Q = p.sbq() + (long)(b * 8 + h) * SEQ * 64;
  const bf16_t* K = p.sbk() + (long)(b * 8 + h) * SEQ * 64;
  const bf16_t* Vt = p.sbvt() + (long)(b * 8 + h) * 64 * SEQ;
  const int tA = t0 + qi, tB = t0 + 16 + qi;
  bf16x8 qa[2], qb[2];
  qa[0] = ld8(Q + (long)tA * 64 + quad * 8); qa[1] = ld8(Q + (long)tA * 64 + 32 + quad * 8);
  qb[0] = ld8(Q + (long)tB * 64 + quad * 8); qb[1] = ld8(Q + (long)tB * 64 + 32 + quad * 8);
  f32x4 oa[4], ob[4];
#pragma unroll
  for (int dt = 0; dt < 4; ++dt) { oa[dt] = (f32x4){0.f, 0.f, 0.f, 0.f}; ob[dt] = oa[dt]; }
  float ca = 0.f, cb = 0.f;
  const int krow = 8 * (qi >> 2) + (qi & 3);
  const bf16_t* kp0 = K + (long)krow * 64 + quad * 8;
  const bf16_t* vp0 = Vt + qi * 32 + 8 * quad;
  int kb = t0;
  SbFrag f0, f1, f2;
  sb_load(f0, kp0, vp0, kb); sb_load(f1, kp0, vp0, max(kb - 32, 0));
#define SB_STEP(F, KB) (((KB) + 32 <= t0) ? (sb_chunk<true>(F, KB, tA, quad, qa, oa, ca), sb_chunk<true>(F, KB, tB, quad, qb, ob, cb)) : (sb_chunk<false>(F, KB, tA, quad, qa, oa, ca), sb_chunk<false>(F, KB, tB, quad, qb, ob, cb)), __all(ca < -160.f && cb < -160.f))
  while (true) {
    sb_load(f2, kp0, vp0, max(kb - 64, 0));
    if (SB_STEP(f0, kb) || kb < 32) break;
    sb_load(f0, kp0, vp0, max(kb - 96, 0));
    if (SB_STEP(f1, kb - 32) || kb < 64) break;
    sb_load(f1, kp0, vp0, max(kb - 128, 0));
    if (SB_STEP(f2, kb - 64) || kb < 96) break;
    kb -= 96;
  }
#undef SB_STEP
#pragma unroll
  for (int half = 0; half < 2; ++half) {
    const long zo = ((long)b * SEQ + (half ? tB : tA)) * 512 + h * 64 + quad * 4;
    const bf16_t* zp = p.sbz() + zo; bf16_t* yp = ybase + zo;
#pragma unroll
    for (int dt = 0; dt < 4; ++dt) {
      const f32x4 o = half ? ob[dt] : oa[dt];
      const u32x2 zz = *(const u32x2*)(zp + dt * 16);
      *(u32x2*)(yp + dt * 16) = (u32x2){pk2(o[0] * bflo(zz[0]), o[1] * bfhi(zz[0])), pk2(o[2] * bflo(zz[1]), o[3] * bfhi(zz[1]))};
    }
  }
}

DI void phaseB(const Params& p0, int layer, unsigned char* lds, bool probe) {
  const int NITEM = 128 + BATCH * 8 * 8;
  for (int it = blockIdx.x; it < NITEM; it += gridDim.x) {
    const Params p = relaunder(p0);
    if (it < 128) { compress_partial(p, it, lds); continue; }
    const int i = it - 128, qt = 7 - (i >> 7), bh = i & 127;
    sb_attn_wave(p, bh >> 3, bh & 7, qt * 256 + (my_tid() >> 6) * 32, probe ? p.dummy() : p.sbz());
  }
}

constexpr int NSA_LO_BYTES = 8 * 8192;
constexpr int NSA_KROW = 144, NSA_VROW = 80;
constexpr int NSA_SLOT = 32 * NSA_KROW + 64 * NSA_VROW;
constexpr int NSA_SLOT0 = NSA_LO_BYTES, NSA_BLIST = NSA_SLOT0 + 2 * NSA_SLOT, NSA_UMW = NSA_BLIST + 64 * 4;

struct KVFrag { bf16x8 k[2][2]; bf16x8 v[4]; };
DI void nsa_ldsfrag(KVFrag& f, const unsigned char* slot, int qi, int quad) {
  const int krow = 8 * (qi >> 2) + (qi & 3);
#pragma unroll
  for (int a = 0; a < 2; ++a) { const unsigned char* kp = slot + (krow + 4 * a) * NSA_KROW + quad * 16; f.k[a][0] = mk8(*(const u32x4*)kp); f.k[a][1] = mk8(*(const u32x4*)(kp + 64)); }
#pragma unroll
  for (int dt = 0; dt < 4; ++dt) f.v[dt] = mk8(*(const u32x4*)(slot + 32 * NSA_KROW + (dt * 16 + qi) * NSA_VROW + quad * 16));
}
template <int MODE>
DI void nsa_chunk(const KVFrag& f, int kb, int t, bool selbit, const bf16x8 (&qf)[4][2], f32x4 (&O)[4][4], float (&m)[4], float (&l)[4], int quad, bool online) {
  const float SC = 0.125f * 1.44269504089f;
  bool val[8];
#pragma unroll
  for (int idx = 0; idx < 8; ++idx) {
    const int key = kb + 8 * quad + idx;
    val[idx] = MODE == 0 ? (selbit && key <= t) : (key <= t && key > t - 512);
  }
#pragma unroll
  for (int hh = 0; hh < 4; ++hh) {
    f32x4 s[2];
#pragma unroll
    for (int a = 0; a < 2; ++a) { s[a] = MFMA16(f.k[a][0], qf[hh][0], ((f32x4){0.f, 0.f, 0.f, 0.f})); s[a] = MFMA16(f.k[a][1], qf[hh][1], s[a]); }
    float mn = m[hh];
    if (online) {
      float cm = -1e30f;
#pragma unroll
      for (int idx = 0; idx < 8; ++idx) if (val[idx]) cm = fmaxf(cm, s[idx >> 2][idx & 3] * SC);
      cm = fmaxf(cm, __shfl_xor(cm, 16)); cm = fmaxf(cm, __shfl_xor(cm, 32));
      mn = fmaxf(mn, cm);
      const float alpha = __builtin_amdgcn_exp2f(m[hh] - mn);
      m[hh] = mn; l[hh] *= alpha;
#pragma unroll
      for (int dt = 0; dt < 4; ++dt) O[hh][dt] = O[hh][dt] * alpha;
    }
    float pv[8]; float ps = 0.f;
#pragma unroll
    for (int idx = 0; idx < 8; ++idx) { pv[idx] = val[idx] ? __builtin_amdgcn_exp2f(fmaf(s[idx >> 2][idx & 3], SC, -mn)) : 0.f; ps += pv[idx]; }
    l[hh] += ps;
    const bf16x8 pf = mk8((u32x4){pk2(pv[0], pv[1]), pk2(pv[2], pv[3]), pk2(pv[4], pv[5]), pk2(pv[6], pv[7])});
#pragma unroll
    for (int dt = 0; dt < 4; ++dt) O[hh][dt] = MFMA16(f.v[dt], pf, O[hh][dt]);
  }
}

template <int MODE>
DI void nsa_branch(const bf16_t* __restrict__ Kb, const bf16_t* __restrict__ Vtb, unsigned char* lds, int nb, int t, int cur, unsigned selmask, unsigned umall,
                   const bf16x8 (&qf)[4][2], f32x4 (&O)[4][4], float (&m)[4], float (&l)[4], bool online) {
  const int tid = my_tid(), lane = tid & 63, qi = lane & 15, quad = lane >> 4;
  const int* blist = (const int*)(lds + NSA_BLIST);
  const bool isv = tid >= 256;
  const int t2 = tid & 255;
  const bf16_t* gsrc = isv ? Vtb + (t2 >> 2) * 32 + (t2 & 3) * 8 : Kb + (long)(t2 >> 3) * 64 + (t2 & 7) * 8;
  const long gmul = 64;
  const int ldst = isv ? 32 * NSA_KROW + (t2 >> 2) * NSA_VROW + (t2 & 3) * 16 : (t2 >> 3) * NSA_KROW + (t2 & 7) * 16;
  unsigned char* slot0 = lds + NSA_SLOT0; unsigned char* slot1 = slot0 + NSA_SLOT;
  const int N = 2 * nb;
  auto kbof = [&](int n) { return blist[n >> 1] * 64 + (n & 1) * 32; };
  u32x4 ra = *(const u32x4*)(gsrc + (long)kbof(0) * gmul), rb = *(const u32x4*)(gsrc + (long)kbof(1) * gmul);
  *(u32x4*)(slot0 + ldst) = ra;
  __syncthreads();
#pragma unroll 1
  for (int n = 0; n < N; n += 2) {
    const int j = blist[n >> 1];
    const bool won = MODE == 0 ? ((umall >> j) & 1u) != 0 : (j >= cur - 8 && j <= cur);
    const bool bit = (selmask >> j) & 1u;
    ra = *(const u32x4*)(gsrc + (long)kbof(min(n + 2, N - 2)) * gmul);
    if (won) { KVFrag f; nsa_ldsfrag(f, slot0, qi, quad); nsa_chunk<MODE>(f, j * 64, t, bit, qf, O, m, l, quad, online); }
    *(u32x4*)(slot1 + ldst) = rb;
    __syncthreads();
    rb = *(const u32x4*)(gsrc + (long)kbof(min(n + 3, N - 1)) * gmul);
    if (won) { KVFrag f; nsa_ldsfrag(f, slot1, qi, quad); nsa_chunk<MODE>(f, j * 64 + 32, t, bit, qf, O, m, l, quad, online); }
    *(u32x4*)(slot0 + ldst) = ra;
    __syncthreads();
  }
}

template <bool LAST>
DI void nsa_finish(u32x2* lo, f32x4 (&O)[4][4], float (&m)[4], float (&l)[4], const float (&gate)[4], const bf16_t* zp, bf16_t* yp, float minit) {
#pragma unroll
  for (int hh = 0; hh < 4; ++hh) {
    float lt = l[hh]; lt += __shfl_xor(lt, 16); lt += __shfl_xor(lt, 32);
    const float f = lt > 0.f ? gate[hh] / lt : 0.f;
#pragma unroll
    for (int dt = 0; dt < 4; ++dt) {
      const u32x2 a = lo[(hh * 4 + dt) * 64];
      const f32x4 v = (f32x4){bflo(a[0]), bfhi(a[0]), bflo(a[1]), bfhi(a[1])} + O[hh][dt] * f;
      if (LAST) {
        const u32x2 zz = *(const u32x2*)(zp + hh * 64 + dt * 16);
        *(u32x2*)(yp + hh * 64 + dt * 16) = (u32x2){pk2(v[0] * bflo(zz[0]), v[1] * bfhi(zz[0])), pk2(v[2] * bflo(zz[1]), v[3] * bfhi(zz[1]))};
      } else {
        lo[(hh * 4 + dt) * 64] = (u32x2){pk2(v[0], v[1]), pk2(v[2], v[3])};
        O[hh][dt] = (f32x4){0.f, 0.f, 0.f, 0.f};
      }
    }
    m[hh] = minit; l[hh] = 0.f;
  }
}

DI void nsa_wave(const Params& p, int layer, int b, int g, int t0, unsigned char* lds, bf16_t* ybase) {
  const int lane = my_tid() & 63, qi = lane & 15, quad = lane >> 4;
  const int t = t0 + qi, cur = t0 >> 6;
  const long tok = (long)b * SEQ + t;
  const int bg = b * 2 + g;
  u32x2* lo = (u32x2*)lds + (my_tid() >> 6) * 1024 + lane;

  const float mf_c = p.mfix()[layer * 4 + 0], mf_s = p.mfix()[layer * 4 + 1], mf_w = p.mfix()[layer * 4 + 2];
  const bool on_c = mf_c > 60.f, on_s = mf_s > 60.f, on_w = mf_w > 60.f;
  const float SC = 0.125f * 1.44269504089f;
  const bf16_t* Kc = p.kc() + (long)bg * 128 * 64;
  const bf16_t* Vc = p.vct() + (long)bg * 64 * 128;
  f32x4 ph[8];
#pragma unroll
  for (int kt = 0; kt < 8; ++kt) ph[kt] = (f32x4){0.f, 0.f, 0.f, 0.f};
#pragma unroll 1
  for (int hh = 0; hh < 4; ++hh) {
    const bf16_t* qp0 = p.nq() + ((long)(b * 8 + g * 4 + hh) * SEQ + t) * 64 + quad * 8;
    const bf16x8 q0 = ld8(qp0), q1 = ld8(qp0 + 32); const float gt = p.ngate()[tok * 32 + g * 4 + hh];
    f32x4 sc[8];
    float mx = on_c ? -1e30f : mf_c;
#pragma unroll
    for (int kt = 0; kt < 8; ++kt) {
      const bf16_t* kp = Kc + (long)(kt * 16 + qi) * 64 + quad * 8;
      sc[kt] = MFMA16(ld8(kp), q0, ((f32x4){0.f, 0.f, 0.f, 0.f}));
      sc[kt] = MFMA16(ld8(kp + 32), q1, sc[kt]);
      sc[kt] = sc[kt] * SC;
    }
    if (on_c) {
#pragma unroll
      for (int kt = 0; kt < 8; ++kt)
#pragma unroll
        for (int r = 0; r < 4; ++r) { const int c = kt * 16 + quad * 4 + r; if (c < NCMP && 16 * c + 31 <= t) mx = fmaxf(mx, sc[kt][r]); }
      mx = fmaxf(mx, __shfl_xor(mx, 16)); mx = fmaxf(mx, __shfl_xor(mx, 32));
    }
    float sum = 0.f;
#pragma unroll
    for (int kt = 0; kt < 8; ++kt)
#pragma unroll
      for (int r = 0; r < 4; ++r) {
        const int c = kt * 16 + quad * 4 + r;
        const float e = (c < NCMP && 16 * c + 31 <= t) ? __builtin_amdgcn_exp2f(sc[kt][r] - mx) : 0.f;
        sc[kt][r] = e; sum += e;
      }
    sum += __shfl_xor(sum, 16); sum += __shfl_xor(sum, 32);
    const float inv = sum > 0.f ? 1.f / sum : 0.f;
#pragma unroll
    for (int kt = 0; kt < 8; ++kt) { sc[kt] = sc[kt] * inv; ph[kt] += sc[kt]; }
    f32x4 oc[4];
#pragma unroll
    for (int dt = 0; dt < 4; ++dt) oc[dt] = (f32x4){0.f, 0.f, 0.f, 0.f};
#pragma unroll
    for (int mm = 0; mm < 4; ++mm) {
      const bf16x8 pf = mk8((u32x4){pk2(sc[2 * mm][0], sc[2 * mm][1]), pk2(sc[2 * mm][2], sc[2 * mm][3]), pk2(sc[2 * mm + 1][0], sc[2 * mm + 1][1]), pk2(sc[2 * mm + 1][2], sc[2 * mm + 1][3])});
#pragma unroll
      for (int dt = 0; dt < 4; ++dt) {
        const bf16_t* vp = Vc + (long)(dt * 16 + qi) * 128 + 32 * mm + quad * 4;
        const u32x2 lo = *(const u32x2*)vp, hi = *(const u32x2*)(vp + 16);
        oc[dt] = MFMA16(mk8((u32x4){lo[0], lo[1], hi[0], hi[1]}), pf, oc[dt]);
      }
    }
#pragma unroll
    for (int dt = 0; dt < 4; ++dt) { const f32x4 v = oc[dt] * gt; lo[(hh * 4 + dt) * 64] = (u32x2){pk2(v[0], v[1]), pk2(v[2], v[3])}; }
  }
  float imp[8];
  {
    float rot[8];
#pragma unroll
    for (int kt = 0; kt < 8; ++kt) rot[kt] = __shfl(ph[kt][3], (lane + 48) & 63);
#pragma unroll
    for (int kt = 0; kt < 8; ++kt) {
      const float extra = quad > 0 ? rot[kt] : (kt > 0 ? rot[kt > 0 ? kt - 1 : 0] : 0.f);
      const float v = (ph[kt][0] + ph[kt][1]) + (ph[kt][2] + ph[kt][3]) + extra;
      const int j = 4 * kt + quad;
      const bool forced = j == 0 || j == cur || j == cur - 1;
      imp[kt] = j <= cur ? v + (forced ? 1e4f : 0.f) : -1e30f;
    }
  }
  unsigned selmask = 0;
  {
    int rank[8];
#pragma unroll
    for (int kt = 0; kt < 8; ++kt) rank[kt] = 0;
#pragma unroll 1
    for (int q2 = 0; q2 < 4; ++q2)
#pragma unroll
      for (int k2 = 0; k2 < 8; ++k2) {
        const float ov = __shfl(imp[k2], qi + 16 * q2);
#pragma unroll
        for (int kt = 0; kt < 8; ++kt) {
          const bool before = k2 < kt || (k2 == kt && q2 < quad);
          rank[kt] += (ov > imp[kt] || (ov == imp[kt] && before)) ? 1 : 0;
        }
      }
#pragma unroll
    for (int kt = 0; kt < 8; ++kt) if (rank[kt] < 8 && 4 * kt + quad <= cur) selmask |= 1u << (4 * kt + quad);
    selmask |= __shfl_xor(selmask, 16); selmask |= __shfl_xor(selmask, 32);
  }

  unsigned umall = selmask;
  umall |= __shfl_xor(umall, 1); umall |= __shfl_xor(umall, 2); umall |= __shfl_xor(umall, 4); umall |= __shfl_xor(umall, 8);
  umall = __builtin_amdgcn_readfirstlane(umall);
  const int wv = my_tid() >> 6;
  unsigned* umw = (unsigned*)(lds + NSA_UMW); int* blist = (int*)(lds + NSA_BLIST);
  if (lane == 0) umw[wv] = umall;
  bf16x8 qf[4][2];
#pragma unroll
  for (int hh = 0; hh < 4; ++hh) {
    const bf16_t* qp = p.nq() + ((long)(b * 8 + g * 4 + hh) * SEQ + t) * 64 + quad * 8;
    qf[hh][0] = ld8(qp); qf[hh][1] = ld8(qp + 32);
  }
  float gate[3][4];
#pragma unroll
  for (int br = 1; br < 3; ++br) { const f32x4 gv = *(const f32x4*)(p.ngate() + tok * 32 + br * 8 + g * 4); gate[br][0] = gv[0]; gate[br][1] = gv[1]; gate[br][2] = gv[2]; gate[br][3] = gv[3]; }
  f32x4 O[4][4]; float m[4], l[4];
#pragma unroll
  for (int hh = 0; hh < 4; ++hh) { m[hh] = on_s ? -1e30f : mf_s; l[hh] = 0.f;
#pragma unroll
    for (int dt = 0; dt < 4; ++dt) O[hh][dt] = (f32x4){0.f, 0.f, 0.f, 0.f}; }
  __syncthreads();
  int nb;
  {
    unsigned ub = 0;
#pragma unroll
    for (int i = 0; i < 8; ++i) ub |= umw[i];
    nb = __builtin_popcount(ub);
    if (my_tid() < 32) { if ((ub >> my_tid()) & 1u) blist[__builtin_popcount(ub & ((1u << my_tid()) - 1u))] = my_tid(); }
    __syncthreads();
    nsa_branch<0>(p.ks() + (long)bg * SEQ * 64, p.vst() + (long)bg * 64 * SEQ, lds, nb, t, cur, selmask, umall, qf, O, m, l, on_s);
    nsa_finish<false>(lo, O, m, l, gate[1], nullptr, nullptr, on_w ? -1e30f : mf_w);
  }
  {
    const int cur0 = (t0 >> 7) * 2, jlo = cur0 >= 8 ? cur0 - 8 : 0;
    nb = cur0 + 2 - jlo;
    if (my_tid() < nb) blist[my_tid()] = jlo + my_tid();
    __syncthreads();
    nsa_branch<1>(p.kw() + (long)bg * SEQ * 64, p.vwt() + (long)bg * 64 * SEQ, lds, nb, t, cur, selmask, umall, qf, O, m, l, on_w);
    nsa_finish<true>(lo, O, m, l, gate[2], p.nz() + tok * 512 + g * 256 + quad * 4, ybase + tok * 512 + g * 256 + quad * 4, 0.f);
  }
  __syncthreads();
}

DI void phaseC(const Params& p0, int layer, unsigned char* lds, bool probe) {
  const int NITEM = BATCH * 2 * 16;
  for (int it = blockIdx.x; it < NITEM; it += gridDim.x) {
    const Params p = relaunder(p0);
    const int qt = 15 - (it >> 5), bg = it & 31;
    nsa_wave(p, layer, bg >> 1, bg & 1, qt * 128 + (my_tid() >> 6) * 16, lds, probe ? p.dummy() : p.nz());
  }
}

DI void phaseD(const Params& p0, const Slot sl, int layer, unsigned char* lds) {
  const Params p = relaunder(p0);
  bf16_t* gl = (bf16_t*)lds;
  int mt, nt;
  for (int it = 0; tile_order(sl, it, 4, mt, nt); ++it) {
#pragma unroll 1
    for (int which = 0; which < 2; ++which) {
      const bf16_t* Wg = (which ? p.wupb_t() : p.wupa_t()) + ((long)nt * 256) * 512;
      const bf16_t* Yg = (which ? p.nz() : p.sbz()) + (long)mt * 256 * 512;
      const bf16_t* Gg = which ? p.gb() : p.ga();
      int mt2 = mt, nt2 = nt; bool more = true;
      if (which) more = tile_order(sl, it + 1, 4, mt2, nt2);
      const bf16_t* Wn = more ? (which ? p.wupa_t() : p.wupb_t()) + ((long)nt2 * 256) * 512 : Wg;
      const bf16_t* Yn = more ? (which ? p.sbz() : p.nz()) + (long)mt2 * 256 * 512 : Yg;
      f32x4 acc[8][4]; zero_acc(acc);
      gemm_core(Wg, 512, Yg, 512, 512, gl, acc, 64, it > 0 || which, Wn, Yn);
      const int tid = my_tid(), lane = tid & 63, w = tid >> 6, wa = w >> 2, wb = w & 3, qi = lane & 15, quad = lane >> 4;
#pragma unroll
      for (int j = 0; j < 4; ++j) {
        const long tok = (long)mt * 256 + wb * 64 + j * 16 + qi;
#pragma unroll
        for (int i = 0; i < 8; ++i) {
          const long off = tok * 1024 + nt * 256 + wa * 128 + i * 16 + quad * 4;
          const u32x2 xg = *(const u32x2*)(Gg + off);
          const f32x4 v = acc[i][j];
          float o0 = bflo(xg[0]) * v[0], o1 = bfhi(xg[0]) * v[1], o2 = bflo(xg[1]) * v[2], o3 = bfhi(xg[1]) * v[3];
          if (which) { const u32x2 a = *(const u32x2*)(p.merged() + off); o0 += bflo(a[0]); o1 += bfhi(a[0]); o2 += bflo(a[1]); o3 += bfhi(a[1]); }
          *(u32x2*)(p.merged() + off) = (u32x2){pk2(o0, o1), pk2(o2, o3)};
          if ((i & 3) == 3) asm volatile("" ::: "memory");
        }
      }
    }
  }
}

DI void phaseE(const Params& p0, const Slot sl, int layer, unsigned char* lds, const float* xsrc) {
  const Params p = relaunder(p0);
  bf16_t* gl = (bf16_t*)lds;
  int mt, nt;
  for (int it = 0; tile_order(sl, it, 4, mt, nt); ++it) {
    f32x4 acc[8][4]; zero_acc(acc);
    int mt2, nt2;
    const bool more = tile_order(sl, it + 1, 4, mt2, nt2);
    const bf16_t* Wg = p.wout_t() + ((long)nt * 256) * 1024; const bf16_t* Mg = p.merged() + (long)mt * 256 * 1024;
    gemm_core(Wg, 1024, Mg, 1024, 1024, gl, acc, 64, it > 0, more ? p.wout_t() + ((long)nt2 * 256) * 1024 : Wg, more ? p.merged() + (long)mt2 * 256 * 1024 : Mg);
    const int tid = my_tid(), lane = tid & 63, w = tid >> 6, wa = w >> 2, wb = w & 3, qi = lane & 15, quad = lane >> 4;
#pragma unroll
    for (int j = 0; j < 4; ++j) {
      const long tok = (long)mt * 256 + wb * 64 + j * 16 + qi;
      float ss = 0.f;
#pragma unroll
      for (int i = 0; i < 8; ++i) {
        const long off = tok * 1024 + nt * 256 + wa * 128 + i * 16 + quad * 4;
        const f32x4 xo = *(const f32x4*)(xsrc + off);
        const f32x4 xn = xo + acc[i][j];
        *(f32x4*)(p.out + off) = xn;
        *(u32x2*)(p.xb() + off + tok * (LDX - D_MODEL)) = (u32x2){pk2(xn[0], xn[1]), pk2(xn[2], xn[3])};
        ss += xn[0] * xn[0] + xn[1] * xn[1] + xn[2] * xn[2] + xn[3] * xn[3];
      }
      ss += __shfl_xor(ss, 16); ss += __shfl_xor(ss, 32);
      if (quad == 0) p.part()[tok * 16 + nt * 2 + wa] = ss;
    }
  }
}

#ifndef STOP_AFTER
#define STOP_AFTER 0
#endif
constexpr int LDS_BYTES = LDS_GEMM_BYTES + 1024;

__global__ void __launch_bounds__(512) hybrid_megakernel(Params p) {
  extern __shared__ __attribute__((aligned(16))) unsigned char lds[];
  cg::grid_group grid = cg::this_grid();
  __shared__ int s_xcc, s_rank, s_ok;
  if (threadIdx.x == 0) {
    const unsigned xcc = (unsigned)__builtin_amdgcn_s_getreg((3 << 11) | 20) & 7u;
    s_xcc = (int)xcc; s_rank = (int)atomicAdd(p.ctl() + xcc, 1u);
  }
  phase_prologue(p, lds);
  grid.sync();
  if (threadIdx.x == 0) {
    int ok = 1;
    for (int i = 0; i < 8; ++i) ok &= (__hip_atomic_load(p.ctl() + i, __ATOMIC_RELAXED, __HIP_MEMORY_SCOPE_AGENT) == (gridDim.x >> 3));
    s_ok = ok;
  }
  __syncthreads();
  const Slot sl = {s_ok ? s_xcc : (int)(blockIdx.x & 7), s_ok ? s_rank : (int)(blockIdx.x >> 3)};
  for (int layer = 0; layer < DEPTH; ++layer) {
    if (layer > 0) convert_weights(p, layer, lds, 2);
    if (STOP_AFTER != 0 && STOP_AFTER == layer * 10) return;
    phaseA(p, sl, layer, lds);
    grid.sync();
#ifdef PROBE_A
    phaseA(p, sl, layer, lds, PROBE_A >= 2 ? PROBE_A : 0);
    grid.sync();
#endif
    if (STOP_AFTER == layer * 10 + 1) return;
#ifdef PROBE_B
    phaseB(p, layer, lds, true);
    grid.sync();
#endif
    phaseB(p, layer, lds, false);
    grid.sync();
    phaseB2(p, layer, lds);
    grid.sync();
    if (STOP_AFTER == layer * 10 + 2) return;
#ifdef PROBE_C
    phaseC(p, layer, lds, true);
    grid.sync();
#endif
    phaseC(p, layer, lds, false);
    grid.sync();
    if (STOP_AFTER == layer * 10 + 3) return;
    phaseD(p, sl, layer, lds);
    grid.sync();
#ifdef PROBE_D
    phaseD(p, sl, layer, lds);
    grid.sync();
#endif
    if (STOP_AFTER == layer * 10 + 4) return;
    if (layer == 0) phaseE(p, sl, layer, lds, p.x_in); else phaseE(p, sl, layer, lds, p.out);
    if (layer + 1 < DEPTH) convert_weights(p, layer + 1, lds, 1);
    if (layer + 1 < DEPTH) grid.sync();
    if (STOP_AFTER == layer * 10 + 5) return;
  }
}

extern "C" void kernel_launch(void* const* d_in, const int* in_sizes, int n_in, void* d_out, int out_size,
                              void* d_ws, size_t ws_size, hipStream_t stream) {
  static int grid_blocks = 0;
  if (!grid_blocks) {
    int dev = 0, cus = 0, per_cu = 0;
    (void)hipGetDevice(&dev);
    (void)hipDeviceGetAttribute(&cus, hipDeviceAttributeMultiprocessorCount, dev);
    if (hipFuncSetAttribute((const void*)hybrid_megakernel, hipFuncAttributeMaxDynamicSharedMemorySize, LDS_BYTES) != hipSuccess) fprintf(stderr, "hipFuncSetAttribute(max dynamic LDS) failed\n");
    (void)hipOccupancyMaxActiveBlocksPerMultiprocessor(&per_cu, hybrid_megakernel, NTHR, LDS_BYTES);
    (void)hipGetLastError();
    if (per_cu > 1) per_cu = 1;
    if (per_cu < 1) per_cu = 1;
    grid_blocks = (cus * per_cu) & ~7;
  }
  Params a{};
  a.x_in = (const float*)d_in[0]; a.pos = (const int*)d_in[1]; a.norm_g = (const float*)d_in[2]; a.w_in = (const float*)d_in[3];
  a.q_norm_g = (const float*)d_in[4]; a.k_norm_g = (const float*)d_in[5]; a.cmp_pe = (const float*)d_in[6]; a.cmp_w1 = (const float*)d_in[7];
  a.cmp_b1 = (const float*)d_in[8]; a.cmp_w2 = (const float*)d_in[9]; a.w_up_a = (const float*)d_in[10]; a.w_up_b = (const float*)d_in[11];
  a.w_out = (const float*)d_in[12];
  a.out = (float*)d_out; a.ws = (unsigned char*)d_ws;
  if (WS_NEED > ws_size) { fprintf(stderr, "workspace too small: need %zu have %zu\n", (size_t)WS_NEED, ws_size); return; }
  (void)hipMemsetAsync((unsigned char*)d_ws + OFF_CTL, 0, 256, stream);
  void* args[] = {&a};
  hipError_t e = hipLaunchCooperativeKernel((void*)hybrid_megakernel, dim3(grid_blocks), dim3(NTHR), args, LDS_BYTES, stream);
  if (e != hipSuccess) fprintf(stderr, "cooperative launch failed: %s (grid %d)\n", hipGetErrorString(e), grid_blocks);
}
```

```cpp
#include <hip/hip_runtime.h>
#include <hip/hip_cooperative_groups.h>
#include <cstdio>
#include <cstdint>
namespace cg = cooperative_groups;

typedef unsigned short bf16_t;
typedef short bf16x8 __attribute__((ext_vector_type(8)));
typedef float f32x4 __attribute__((ext_vector_type(4)));
typedef float f32x2 __attribute__((ext_vector_type(2)));
typedef unsigned u32x4 __attribute__((ext_vector_type(4)));
typedef unsigned u32x2 __attribute__((ext_vector_type(2)));
typedef __bf16 bf16x2_t __attribute__((ext_vector_type(2)));

#define DI __device__ __forceinline__
#define MFMA16(a, b, c) __builtin_amdgcn_mfma_f32_16x16x32_bf16((a), (b), (c), 0, 0, 0)

constexpr int D_MODEL = 1024, BATCH = 16, SEQ = 2048, DEPTH = 4, NTOK = BATCH * SEQ;
constexpr int N_IN = 5912, NP = 6144, NT_IN = 24;
constexpr int NTHR = 512;
constexpr int LDX = D_MODEL + 64;
constexpr int NCMP = 127;
constexpr float NORM_EPS = 1e-6f;

DI unsigned pk2(float lo, float hi) { f32x2 v = {lo, hi}; bf16x2_t b = __builtin_convertvector(v, bf16x2_t); return __builtin_bit_cast(unsigned, b); }
DI float bflo(unsigned u) { return __uint_as_float(u << 16); }
DI float bfhi(unsigned u) { return __uint_as_float(u & 0xffff0000u); }
DI float sigmoidf_(float x) { return __builtin_amdgcn_rcpf(1.f + __builtin_amdgcn_exp2f(-1.44269504089f * x)); }
DI float siluf_(float x) { return x * __builtin_amdgcn_rcpf(1.f + __builtin_amdgcn_exp2f(-1.44269504089f * x)); }
DI bf16x8 mk8(u32x4 v) { return __builtin_bit_cast(bf16x8, v); }
DI bf16x8 ld8(const bf16_t* p) { return __builtin_bit_cast(bf16x8, *(const u32x4*)p); }


DI void sincos_acc(float angf, float& sn, float& cs) {
  const double a = (double)angf;
  const double k = rint(a * 0.63661977236758134308);
  const double y = (a - k * 1.57079632679489655800) - k * 6.12323399573676603587e-17;
  const double y2 = y * y;
  const double sp = y * (1.0 + y2 * (-1.0 / 6 + y2 * (1.0 / 120 + y2 * (-1.0 / 5040 + y2 * (1.0 / 362880 + y2 * (-1.0 / 39916800 + y2 * (1.0 / 6227020800.0)))))));
  const double cp = 1.0 + y2 * (-0.5 + y2 * (1.0 / 24 + y2 * (-1.0 / 720 + y2 * (1.0 / 40320 + y2 * (-1.0 / 3628800 + y2 * (1.0 / 479001600.0))))));
  const int q = ((int)k) & 3;
  const double s_ = (q & 1) ? cp : sp, c_ = (q & 1) ? sp : cp;
  sn = (float)((q & 2) ? -s_ : s_);
  cs = (float)(((q + 1) & 2) ? -c_ : c_);
}
DI float inv_freq(int f) { return (float)exp(-(double)f * (9.21034037197618273607 / 32.0)); }

constexpr size_t al256(size_t x) { return (x + 255) & ~(size_t)255; }
constexpr size_t OFF_WT_IN = 0;
constexpr size_t OFF_W1T = OFF_WT_IN + al256((size_t)NP * LDX * 2);
constexpr size_t OFF_W2T = OFF_W1T + al256((size_t)2 * 256 * 2048 * 2);
constexpr size_t OFF_WUPA = OFF_W2T + al256((size_t)2 * 64 * 256 * 2);
constexpr size_t OFF_WUPB = OFF_WUPA + al256((size_t)1024 * 512 * 2);
constexpr size_t OFF_WOUT = OFF_WUPB + al256((size_t)1024 * 512 * 2);
constexpr size_t OFF_B1EFF = OFF_WOUT + al256((size_t)1024 * 1024 * 2);
constexpr size_t OFF_COST = OFF_B1EFF + al256((size_t)DEPTH * 2 * 16 * 256 * 4);
constexpr size_t OFF_SINT = OFF_COST + al256((size_t)NTOK * 32 * 4);
constexpr size_t OFF_COSC = OFF_SINT + al256((size_t)NTOK * 32 * 4);
constexpr size_t OFF_SINC = OFF_COSC + al256((size_t)BATCH * 128 * 32 * 4);
constexpr size_t OFF_XB = OFF_SINC + al256((size_t)BATCH * 128 * 32 * 4);
constexpr size_t OFF_PART = OFF_XB + al256((size_t)NTOK * LDX * 2);
constexpr size_t OFF_SBQ = OFF_PART + al256((size_t)NTOK * 16 * 4);
constexpr size_t OFF_SBK = OFF_SBQ + al256((size_t)NTOK * 512 * 2);
constexpr size_t OFF_SBVT = OFF_SBK + al256((size_t)NTOK * 512 * 2);
constexpr size_t OFF_SBZ = OFF_SBVT + al256((size_t)NTOK * 512 * 2);
constexpr size_t OFF_NQ = OFF_SBZ + al256((size_t)NTOK * 512 * 2);
constexpr size_t OFF_KCR = OFF_NQ + al256((size_t)NTOK * 512 * 2);
constexpr size_t OFF_VCR = OFF_KCR + al256((size_t)NTOK * 128 * 2);
constexpr size_t OFF_KS = OFF_VCR + al256((size_t)NTOK * 128 * 2);
constexpr size_t OFF_VST = OFF_KS + al256((size_t)NTOK * 128 * 2);
constexpr size_t OFF_KW = OFF_VST + al256((size_t)NTOK * 128 * 2);
constexpr size_t OFF_VWT = OFF_KW + al256((size_t)NTOK * 128 * 2);
constexpr size_t OFF_NGATE = OFF_VWT + al256((size_t)NTOK * 128 * 2);
constexpr size_t OFF_NZ = OFF_NGATE + al256((size_t)NTOK * 32 * 4);
constexpr size_t OFF_GA = OFF_NZ + al256((size_t)NTOK * 512 * 2);
constexpr size_t OFF_GB = OFF_GA + al256((size_t)NTOK * 1024 * 2);
constexpr size_t OFF_HID = OFF_GB + al256((size_t)NTOK * 1024 * 2);
constexpr size_t OFF_KC = OFF_HID + al256((size_t)4 * 32 * 256 * 256 * 4);
constexpr size_t OFF_VCT = OFF_KC + al256((size_t)BATCH * 2 * 128 * 64 * 2);
constexpr size_t OFF_QNG = OFF_VCT + al256((size_t)BATCH * 2 * 64 * 128 * 2);
constexpr size_t OFF_KNG = OFF_QNG + al256((size_t)DEPTH * 64 * 4);
constexpr size_t OFF_CTL = OFF_KNG + al256((size_t)DEPTH * 3 * 64 * 4);
constexpr size_t OFF_MFIX_BASE = OFF_CTL + 256;
constexpr size_t OFF_MFIX_OLD = OFF_KNG + al256((size_t)DEPTH * 3 * 64 * 4);
constexpr size_t OFF_MFIX = OFF_MFIX_BASE;
constexpr size_t OFF_DUMMY = OFF_MFIX + 256;
constexpr size_t WS_NEED = OFF_DUMMY + 256;

struct Params {
  const float* x_in; const int* pos; const float* norm_g; const float* w_in; const float* q_norm_g; const float* k_norm_g;
  const float* cmp_pe; const float* cmp_w1; const float* cmp_b1; const float* cmp_w2; const float* w_up_a; const float* w_up_b; const float* w_out;
  float* out; unsigned char* ws;
#define WSBUF(T, name, OFF) DI T* name() const { return (T*)(ws + (OFF)); }
  WSBUF(bf16_t, wt_in, OFF_WT_IN) WSBUF(bf16_t, w1t, OFF_W1T) WSBUF(bf16_t, w2t, OFF_W2T) WSBUF(bf16_t, wupa_t, OFF_WUPA) WSBUF(bf16_t, wupb_t, OFF_WUPB) WSBUF(bf16_t, wout_t, OFF_WOUT)
  WSBUF(float, b1eff, OFF_B1EFF) WSBUF(float, cosT, OFF_COST) WSBUF(float, sinT, OFF_SINT) WSBUF(float, cosC, OFF_COSC) WSBUF(float, sinC, OFF_SINC)
  WSBUF(bf16_t, xb, OFF_XB) WSBUF(float, part, OFF_PART) WSBUF(bf16_t, sbq, OFF_SBQ) WSBUF(bf16_t, sbk, OFF_SBK) WSBUF(bf16_t, sbvt, OFF_SBVT) WSBUF(bf16_t, sbz, OFF_SBZ)
  WSBUF(bf16_t, nq, OFF_NQ) WSBUF(bf16_t, kcr, OFF_KCR) WSBUF(bf16_t, vcr, OFF_VCR) WSBUF(bf16_t, ks, OFF_KS) WSBUF(bf16_t, vst, OFF_VST) WSBUF(bf16_t, kw, OFF_KW) WSBUF(bf16_t, vwt, OFF_VWT)
  WSBUF(float, ngate, OFF_NGATE) WSBUF(bf16_t, nz, OFF_NZ) WSBUF(bf16_t, ga, OFF_GA) WSBUF(bf16_t, gb, OFF_GB) WSBUF(float, hpre, OFF_HID) WSBUF(bf16_t, kc, OFF_KC) WSBUF(bf16_t, vct, OFF_VCT)
  WSBUF(bf16_t, merged, OFF_SBK)
  WSBUF(bf16_t, dummy, OFF_XB)     WSBUF(float, mfix, OFF_MFIX) WSBUF(unsigned, ctl, OFF_CTL)
  WSBUF(float, qng, OFF_QNG) WSBUF(float, kng, OFF_KNG)
};

DI int my_tid() { int t = threadIdx.x; asm volatile("" : "+v"(t)); return t; }
DI Params relaunder(const Params& p0) { Params p = p0; size_t z = 0; asm volatile("" : "+s"(z)); p.ws = p0.ws + z; return p; }

constexpr int TILE_B = 32 * 1024;
constexpr int STAGE_B = 2 * TILE_B;
constexpr int LDS_GEMM_BYTES = 2 * STAGE_B;
typedef __attribute__((address_space(3))) unsigned lds_u32;

DI void g_dma(const bf16_t* __restrict__ base, const unsigned (&off)[8], int ko, unsigned char* stage, int w) {
#pragma unroll
  for (int u = 0; u < 8; ++u)
    __builtin_amdgcn_global_load_lds((const unsigned*)(base + (off[u] + ko)), (lds_u32*)(stage + (w * 8 + u) * 1024), 16, 0, 0);
}
#define G_LDA(dst, ih, ks) _Pragma("unroll") for (int i = 0; i < 4; ++i) dst[i] = mk8(*(const u32x4*)(stage + ra + (((ih) * 4 + i) * 2 + (ks)) * 1024))
#define G_LDB(dst, ks) _Pragma("unroll") for (int j = 0; j < 4; ++j) dst[j] = mk8(*(const u32x4*)(stage + TILE_B + rb + (j * 2 + (ks)) * 1024))
#define G_MMA(ih, A, B) do { _Pragma("unroll") for (int i = 0; i < 4; ++i) _Pragma("unroll") for (int j = 0; j < 4; ++j) acc[(ih) * 4 + i][j] = MFMA16(A[i], B[j], acc[(ih) * 4 + i][j]); } while (0)
DI void g_compute(const unsigned char* stage, int ra, int rb, f32x4 (&acc)[8][4]) {
  bf16x8 b0[4], b1[4], a0[4], a1[4];
  G_LDB(b0, 0); G_LDA(a0, 0, 0);
  __builtin_amdgcn_sched_barrier(0);
  G_LDA(a1, 1, 0);
  G_MMA(0, a0, b0);
  __builtin_amdgcn_sched_barrier(0);
  G_LDB(b1, 1); G_LDA(a0, 0, 1);
  G_MMA(1, a1, b0);
  __builtin_amdgcn_sched_barrier(0);
  G_LDA(a1, 1, 1);
  G_MMA(0, a0, b1);
  __builtin_amdgcn_sched_barrier(0);
  G_MMA(1, a1, b1);
  __builtin_amdgcn_sched_barrier(0);
}

DI void gemm_core(const bf16_t* __restrict__ Ag, long lda, const bf16_t* __restrict__ Bg, long ldb, int K,
                  bf16_t* ldsb, f32x4 (&acc)[8][4], int kstep = 64, bool pre = false, const bf16_t* nAg = nullptr, const bf16_t* nBg = nullptr) {
  unsigned char* lds = (unsigned char*)ldsb;
  const int tid = my_tid(), lane = tid & 63, w = __builtin_amdgcn_readfirstlane(tid >> 6), wa = w >> 2, wb = w & 3, qi = lane & 15, quad = lane >> 4;
  const bf16_t* base = w >= 4 ? Bg : Ag; const int ld = (int)(w >= 4 ? ldb : lda);
  const bf16_t* nbase = nAg ? (w >= 4 ? nBg : nAg) : base;
  unsigned off[8];
#pragma unroll
  for (int u = 0; u < 8; ++u) { const int blk = (w & 3) * 8 + u, rg = blk >> 1, kh = blk & 1; off[u] = (unsigned)((rg * 16 + (lane >> 2)) * ld + kh * 32 + (lane & 3) * 8); }
  const int ra = (wa * 8) * 2 * 1024 + (qi * 4 + quad) * 16, rb = (wb * 4) * 2 * 1024 + (qi * 4 + quad) * 16;
  unsigned char* buf0 = lds; unsigned char* buf1 = lds + STAGE_B;
  const int KT = K >> 6;
  if (!pre) {
    g_dma(base, off, 0, buf0, w);
    asm volatile("s_waitcnt vmcnt(0)" ::: "memory");
    __syncthreads();
  }
  for (int kt = 0; kt < KT; kt += 2) {
    g_dma(base, off, (kt + 1) * kstep, buf1, w);
    g_compute(buf0, ra, rb, acc);
    asm volatile("s_waitcnt vmcnt(0)" ::: "memory");
    __syncthreads();
    const bool last = kt + 2 >= KT;
    g_dma(last ? nbase : base, off, last ? 0 : (kt + 2) * kstep, buf0, w);
    g_compute(buf1, ra, rb, acc);
    asm volatile("s_waitcnt vmcnt(0)" ::: "memory");
    __syncthreads();
  }
}

DI void zero_acc(f32x4 (&acc)[8][4]) {
#pragma unroll
  for (int i = 0; i < 8; ++i)
#pragma unroll
    for (int j = 0; j < 4; ++j) acc[i][j] = (f32x4){0.f, 0.f, 0.f, 0.f};
}

struct Slot { int xcd, slot; };
DI bool tile_order(const Slot sl, int it, int nN, int& mt, int& nt) {
  const int xcd = sl.xcd, slot = sl.slot, SL = gridDim.x >> 3;
  const int q = slot + it * SL, per = 8 * nN;
  if (q >= 2 * per) return false;
  const int mg = q / per, e = q - mg * per;
  nt = e >> 3; mt = xcd * 16 + mg * 8 + (e & 7);
  return true;
}

DI int inmap(int c) {
  if (c < 1024) return c;
  if (c < 1536) return c + 512;
  if (c < 2048) return c + 512;
  if (c < 2304) return c + 512;
  if (c < 2432) return c + 512;
  if (c < 2560) return c + 640;
  if (c < 3072) return c + 792;
  if (c < 4096) return c + 792;
  if (c < 5120) return c + 792;
  if (c < 5376) return c < 5144 ? c - 1792 : -1;
  if (c < 5888) return c - 4352;
  if (c < 6016) return c - 2944;
  return c - 2816;
}

DI void tr_tile(const float* __restrict__ src, int ld, int K, int k0, int n0, bool use_map, const float* __restrict__ scale, bf16_t* __restrict__ dst, int ldd, float* tile) {
  const int tid = my_tid();
  {
    const int nl = tid & 63, kk = tid >> 6;
    int n = n0 + nl; asm volatile("" : "+v"(n));
    const int sc = use_map ? inmap(n) : n;
#pragma unroll
    for (int r = 0; r < 8; ++r) {
      const int k = k0 + r * 8 + kk;
      float v = 0.f;
      if (sc >= 0) { v = src[(long)k * ld + sc]; if (scale) v *= scale[k]; }
      tile[(r * 8 + kk) * 65 + nl] = v;
    }
  }
  __syncthreads();
  {
    const int nl = tid >> 3, ks = tid & 7;
    unsigned o[4];
#pragma unroll
    for (int e = 0; e < 4; ++e) o[e] = pk2(tile[(ks * 8 + 2 * e) * 65 + nl], tile[(ks * 8 + 2 * e + 1) * 65 + nl]);
    *(u32x4*)(dst + (long)(n0 + nl) * ldd + k0 + ks * 8) = (u32x4){o[0], o[1], o[2], o[3]};
  }
  __syncthreads();
}

DI void tr_job(const float* src, int ld, int K, int N, bool use_map, const float* scale, bf16_t* dst, int ldd, float* tile) {
  const int nk = K >> 6, nn = N >> 6;
  for (int t = blockIdx.x; t < nk * nn; t += gridDim.x) tr_tile(src, ld, K, (t % nk) * 64, (t / nk) * 64, use_map, scale, dst, ldd, tile);
}

DI void convert_weights(const Params& p0, int l, unsigned char* lds, int which) {
  const Params p = relaunder(p0);
  float* tile = (float*)lds;
  if (which & 1) {
    tr_job(p.w_in + (long)l * D_MODEL * N_IN, N_IN, D_MODEL, NP, true, p.norm_g + l * D_MODEL, p.wt_in(), LDX, tile);
    for (int kv = 0; kv < 2; ++kv) {
      tr_job(p.cmp_w1 + (long)(l * 2 + kv) * 2048 * 256, 256, 2048, 256, false, nullptr, p.w1t() + (long)kv * 256 * 2048, 2048, tile);
      tr_job(p.cmp_w2 + (long)(l * 2 + kv) * 256 * 64, 64, 256, 64, false, nullptr, p.w2t() + (long)kv * 64 * 256, 256, tile);
    }
    tr_job(p.w_up_a + (long)l * 512 * 1024, 1024, 512, 1024, false, nullptr, p.wupa_t(), 512, tile);
    tr_job(p.w_up_b + (long)l * 512 * 1024, 1024, 512, 1024, false, nullptr, p.wupb_t(), 512, tile);
  }
  if (which & 2) tr_job(p.w_out + (long)l * 1024 * 1024, 1024, 1024, 1024, false, nullptr, p.wout_t(), 1024, tile);
}

DI void phase_prologue(const Params& p, unsigned char* lds) {
  const int tid = my_tid();
  convert_weights(p, 0, lds, 3);
  {
    const int lane = tid & 63;
    for (int wi = blockIdx.x * 8 + (tid >> 6); wi < DEPTH * 2 * 16 * 4; wi += gridDim.x * 8) {
      const int jq = wi & 3, kq = (wi >> 2) & 15, it = wi >> 6;
      const float* w1 = p.cmp_w1 + (long)it * 2048 * 256 + (long)kq * 128 * 256 + jq * 64 + lane; const float* pe = p.cmp_pe + (long)it * 2048 + kq * 128;
      float s0 = kq == 0 ? p.cmp_b1[it * 256 + jq * 64 + lane] : 0.f, s1 = 0.f, s2 = 0.f, s3 = 0.f;
#pragma unroll 4
      for (int k = 0; k < 128; k += 4) {
        s0 += pe[k] * w1[(long)k * 256]; s1 += pe[k + 1] * w1[(long)(k + 1) * 256]; s2 += pe[k + 2] * w1[(long)(k + 2) * 256]; s3 += pe[k + 3] * w1[(long)(k + 3) * 256];
      }
      p.b1eff()[(it * 16 + kq) * 256 + jq * 64 + lane] = (s0 + s1) + (s2 + s3);
    }
  }
  if (blockIdx.x == 1 && tid < DEPTH * 3) {
    const int l = tid / 3, br = tid % 3;
    float mq = 0.f, mk = 0.f;
    for (int d = 0; d < 64; ++d) { mq = fmaxf(mq, fabsf(p.q_norm_g[l * 64 + d])); mk = fmaxf(mk, fabsf(p.k_norm_g[(l * 3 + br) * 64 + d])); }
    p.mfix()[l * 4 + br] = 8.f * 1.44269504089f * mq * mk * 1.02f + 0.25f;
  }
  if (blockIdx.x == 0) { for (int i = tid; i < DEPTH * 64; i += NTHR) p.qng()[i] = p.q_norm_g[i]; for (int i = tid; i < DEPTH * 192; i += NTHR) p.kng()[i] = p.k_norm_g[i]; }
  const long gtid = (long)blockIdx.x * NTHR + tid, gn = (long)gridDim.x * NTHR;
  for (long i = gtid; i < (long)NTOK * 32; i += gn) {
    const int f = (int)(i & 31); const long tok = i >> 5;
    const float ang = (float)p.pos[tok] * inv_freq(f);
    float sn, cs; sincos_acc(ang, sn, cs);
    p.cosT()[i] = cs; p.sinT()[i] = sn;
  }
  for (long i = gtid; i < (long)BATCH * 128 * 32; i += gn) {
    const int f = (int)(i & 31); const int c = (int)((i >> 5) & 127); const int b = (int)(i >> 12);
    float cs = 1.f, sn = 0.f;
    if (c < NCMP) {
      float sum = 0.f;
      for (int k = 0; k < 32; ++k) sum += (float)p.pos[b * SEQ + c * 16 + k];
      const float ang = (sum * (1.f / 32.f)) * inv_freq(f);
      sincos_acc(ang, sn, cs);
    }
    p.cosC()[i] = cs; p.sinC()[i] = sn;
  }
  const int lane = tid & 63;
  for (long row = (long)blockIdx.x * 8 + (tid >> 6); row < NTOK; row += (long)gridDim.x * 8) {
    const float* xr = p.x_in + row * D_MODEL; bf16_t* xo = p.xb() + row * LDX;
    float ss = 0.f;
#pragma unroll
    for (int u = 0; u < 4; ++u) {
      const f32x4 v = *(const f32x4*)(xr + u * 256 + lane * 4);
      ss += v[0] * v[0] + v[1] * v[1] + v[2] * v[2] + v[3] * v[3];
      *(u32x2*)(xo + u * 256 + lane * 4) = (u32x2){pk2(v[0], v[1]), pk2(v[2], v[3])};
    }
#pragma unroll
    for (int o = 32; o >= 1; o >>= 1) ss += __shfl_xor(ss, o);
    if (lane < 8) p.part()[row * 16 + lane] = lane == 0 ? ss : 0.f;
  }
}

DI void phaseA_epilogue(const Params& p, int layer, int mt, int nt, const f32x4 (&acc)[8][4], const float* rs_s) {
  const int tid = my_tid(), lane = tid & 63, w = tid >> 6, wa = w >> 2, wb = w & 3, qi = lane & 15, quad = lane >> 4;
  if (nt >= 21) {
    bf16_t* dstb; int nh, head;
    if (nt < 23) { dstb = p.sbvt(); nh = 8; head = (nt - 21) * 4 + wb; } else if (wb < 2) { dstb = p.vst(); nh = 2; head = wb; } else { dstb = p.vwt(); nh = 2; head = wb - 2; }
    const int tok0 = mt * 256, b = tok0 >> 11, s0 = (tok0 & 2047) + wa * 128 + quad * 4;
#pragma unroll
    for (int i = 0; i < 8; ++i) {
      const int tl = wa * 128 + i * 16 + quad * 4;
      const float r0 = rs_s[tl], r1 = rs_s[tl + 1], r2 = rs_s[tl + 2], r3 = rs_s[tl + 3];
#pragma unroll
      for (int j = 0; j < 4; ++j) {
        const int d = j * 16 + qi;
        const f32x4 v = acc[i][j];
        const int sq = s0 + i * 16;
        bf16_t* dst = dstb + (long)(b * nh + head) * 64 * SEQ + (long)(sq >> 5) * 2048 + d * 32 + (sq & 31);
        *(u32x2*)dst = (u32x2){pk2(v[0] * r0, v[1] * r1), pk2(v[2] * r2, v[3] * r3)};
      }
    }
    return;
  }
  const bool headtype = nt < 4 || (nt >= 6 && nt < 10);
#pragma unroll
  for (int j = 0; j < 4; ++j) {
    const int tl = wb * 64 + j * 16 + qi; const long tok = (long)mt * 256 + tl; const int b = (int)(tok >> 11), sq = (int)(tok & 2047);
    const float rs = rs_s[tl];
    if (headtype) {
#pragma unroll
      for (int ih = 0; ih < 2; ++ih) {
        const int hit = wa * 2 + ih;
        f32x4 v[4];
#pragma unroll
        for (int i = 0; i < 4; ++i) v[i] = acc[ih * 4 + i][j] * rs;
        bf16_t* dstb; int nh, head; const float* g = nullptr;
        if (nt < 2) { dstb = p.sbq(); nh = 8; head = nt * 4 + hit; }
        else if (nt < 4) { dstb = p.sbk(); nh = 8; head = (nt - 2) * 4 + hit; }
        else if (nt < 8) { dstb = p.nq(); nh = 8; head = (nt - 6) * 4 + hit; g = p.qng() + layer * 64; }
        else if (nt == 8) { dstb = hit < 2 ? p.kcr() : p.vcr(); nh = 2; head = hit & 1; }
        else { dstb = hit < 2 ? p.ks() : p.kw(); nh = 2; head = hit & 1; g = p.kng() + (layer * 3 + (hit < 2 ? 1 : 2)) * 64; }
        if (g) {
          float ss = 0.f;
#pragma unroll
          for (int i = 0; i < 4; ++i) ss += v[i][0] * v[i][0] + v[i][1] * v[i][1] + v[i][2] * v[i][2] + v[i][3] * v[i][3];
          ss += __shfl_xor(ss, 16); ss += __shfl_xor(ss, 32);
          const float rn = rsqrtf(ss * (1.f / 64.f) + NORM_EPS);
#pragma unroll
          for (int i = 0; i < 4; ++i) { const f32x4 gg = *(const f32x4*)(g + i * 16 + quad * 4); v[i] = v[i] * rn * gg; }
#pragma unroll
          for (int i = 0; i < 2; ++i) {
            const f32x4 cs = *(const f32x4*)(p.cosT() + tok * 32 + i * 16 + quad * 4), sn = *(const f32x4*)(p.sinT() + tok * 32 + i * 16 + quad * 4);
            const f32x4 x1 = v[i], x2 = v[i + 2];
            v[i] = x1 * cs - x2 * sn; v[i + 2] = x2 * cs + x1 * sn;
          }
        }
        bf16_t* dst = dstb + ((long)(b * nh + head) * SEQ + sq) * 64 + quad * 4;
#pragma unroll
        for (int i = 0; i < 4; ++i) *(u32x2*)(dst + i * 16) = (u32x2){pk2(v[i][0], v[i][1]), pk2(v[i][2], v[i][3])};
        asm volatile("" ::: "memory");
      }
    } else if (nt == 20) {
      if (wa == 0) {
#pragma unroll
        for (int i = 0; i < 2; ++i) {
          const int f = i * 16 + quad * 4;
          const f32x4 v = acc[i][j] * rs;
          if (f < 24) { const f32x4 o = {sigmoidf_(v[0]), sigmoidf_(v[1]), sigmoidf_(v[2]), sigmoidf_(v[3])}; *(f32x4*)(p.ngate() + tok * 32 + f) = o; }
        }
      }
    } else {
      bf16_t* dstb; int ldd, c0; bool sil;
      if (nt < 6) { dstb = p.sbz(); ldd = 512; c0 = (nt - 4) * 256; sil = true; }
      else if (nt < 12) { dstb = p.nz(); ldd = 512; c0 = (nt - 10) * 256; sil = true; }
      else if (nt < 16) { dstb = p.ga(); ldd = 1024; c0 = (nt - 12) * 256; sil = false; }
      else { dstb = p.gb(); ldd = 1024; c0 = (nt - 16) * 256; sil = false; }
      bf16_t* dst = dstb + tok * ldd + c0 + wa * 128 + quad * 4;
#pragma unroll
      for (int i = 0; i < 8; ++i) {
        const f32x4 v = acc[i][j] * rs;
        f32x4 o;
#pragma unroll
        for (int r = 0; r < 4; ++r) o[r] = sil ? siluf_(v[r]) : sigmoidf_(v[r]);
        *(u32x2*)(dst + i * 16) = (u32x2){pk2(o[0], o[1]), pk2(o[2], o[3])};
      }
    }
    asm volatile("" ::: "memory");
  }
}

DI void phaseA(const Params& p0, const Slot sl, int layer, unsigned char* lds, int fake = 0) {
  const Params p = relaunder(p0);
  bf16_t* gl = (bf16_t*)lds; float* rs_s = (float*)(lds + LDS_GEMM_BYTES);
  const bf16_t* Wt = p.wt_in();
  int mt, nt;
  for (int it = 0; tile_order(sl, it, NT_IN, mt, nt); ++it) {
    if (my_tid() < 256) {
      const float* pp = p.part() + ((long)mt * 256 + my_tid()) * 16;
      const f32x4 v0 = *(const f32x4*)pp, v1 = *(const f32x4*)(pp + 4);
      const float s = ((v0[0] + v0[1]) + (v0[2] + v0[3])) + ((v1[0] + v1[1]) + (v1[2] + v1[3]));
      rs_s[my_tid()] = rsqrtf(s * (1.f / 1024.f) + NORM_EPS);
    }
    const int mtl = fake == 3 ? 0 : (fake == 4 ? sl.xcd * 16 + (sl.slot & 7) : mt), ntl = fake == 3 ? 0 : (fake == 4 ? (sl.slot >> 3) : nt);
    const bf16_t* Xg = p.xb() + (long)mtl * 256 * LDX; const bf16_t* Wg = Wt + (long)ntl * 256 * LDX;
    f32x4 acc[8][4]; zero_acc(acc);
    const int kstep = (fake == 1 || fake == 2) ? 0 : 64;
    int mt2, nt2;
    const bool more = !fake && tile_order(sl, it + 1, NT_IN, mt2, nt2);
    const bf16_t* Xn = more ? p.xb() + (long)mt2 * 256 * LDX : Xg; const bf16_t* Wn = more ? Wt + (long)nt2 * 256 * LDX : Wg;
    const bool vn = more ? nt2 >= 21 : nt >= 21;
    gemm_core(nt >= 21 ? Xg : Wg, LDX, nt >= 21 ? Wg : Xg, LDX, D_MODEL, gl, acc, kstep, !fake && it > 0, vn ? Xn : Wn, vn ? Wn : Xn);
    if (!fake) phaseA_epilogue(p, layer, mt, nt, acc, rs_s);
    else if (acc[0][0][0] == 123.456f && acc[7][3][3] == 5.f) p.dummy()[0] = 1;
    __syncthreads();
  }
}

DI void compress_partial(const Params& p, int ci, unsigned char* lds) {
  bf16_t* gl = (bf16_t*)lds;
  const int split = ci & 3, item = ci >> 2, kv = item & 1, pair = item >> 1;
  const bf16_t* src = (kv ? p.vcr() : p.kcr()) + (long)pair * 256 * 1024 + split * 512;
  const bf16_t* W1 = p.w1t() + (long)kv * 256 * 2048 + split * 512;
  f32x4 acc[8][4]; zero_acc(acc);
  gemm_core(W1, 2048, src, 1024, 512, gl, acc);
  const int tid = my_tid(), lane = tid & 63, w = tid >> 6, wa = w >> 2, wb = w & 3, qi = lane & 15, quad = lane >> 4;
  float* dst = p.hpre() + ((long)(split * 32 + item) * 256) * 256;
#pragma unroll
  for (int i = 0; i < 8; ++i)
#pragma unroll
    for (int j = 0; j < 4; ++j) *(f32x4*)(dst + (long)(wb * 64 + j * 16 + qi) * 256 + wa * 128 + i * 16 + quad * 4) = acc[i][j];
}

DI void phaseB2(const Params& p0, int layer, unsigned char* lds) {
  const Params p = relaunder(p0);
  const int tid = my_tid(), lane = tid & 63, w = tid >> 6, qi = lane & 15, quad = lane >> 4;
  float* bias_s = (float*)lds;
  {
    const float* b1 = p.b1eff() + (long)(layer * 2 + (tid >> 8)) * 16 * 256 + (tid & 255);
    float sacc = 0.f;
#pragma unroll
    for (int kq = 0; kq < 16; ++kq) sacc += b1[kq * 256];
    bias_s[tid] = sacc;
  }
  __syncthreads();
  if (w < 2)
  for (int wi = blockIdx.x * 2 + w; wi < 32 * 16; wi += gridDim.x * 2) {
    const int item = wi >> 4, r16 = wi & 15, kv = item & 1, pair = item >> 1;
    const int row = r16 * 16 + qi;
    const bf16_t* W2 = p.w2t() + (long)kv * 64 * 256;
    const float* hp = p.hpre() + ((long)item * 256 + row) * 256 + quad * 8;
    f32x4 o[4];
#pragma unroll
    for (int dt = 0; dt < 4; ++dt) o[dt] = (f32x4){0.f, 0.f, 0.f, 0.f};
#pragma unroll 1
    for (int ksx = 0; ksx < 8; ++ksx) {
      f32x4 h0 = *(const f32x4*)(bias_s + kv * 256 + ksx * 32 + quad * 8), h1 = *(const f32x4*)(bias_s + kv * 256 + ksx * 32 + quad * 8 + 4);
#pragma unroll
      for (int sp = 0; sp < 4; ++sp) { const float* q = hp + (long)sp * 32 * 256 * 256 + ksx * 32; h0 += *(const f32x4*)q; h1 += *(const f32x4*)(q + 4); }
      const bf16x8 hf = mk8((u32x4){pk2(siluf_(h0[0]), siluf_(h0[1])), pk2(siluf_(h0[2]), siluf_(h0[3])), pk2(siluf_(h1[0]), siluf_(h1[1])), pk2(siluf_(h1[2]), siluf_(h1[3]))});
#pragma unroll
      for (int dt = 0; dt < 4; ++dt) {
        const bf16x8 wf = ld8(W2 + (long)(dt * 16 + qi) * 256 + ksx * 32 + quad * 8);
        o[dt] = kv ? MFMA16(hf, wf, o[dt]) : MFMA16(wf, hf, o[dt]);
      }
    }
    const int bg = pair * 2 + (r16 >> 3);
    if (kv == 0) {
      const float* g = p.kng() + (layer * 3 + 0) * 64;
      const int b = bg >> 1, c = (r16 & 7) * 16 + qi;
      float ss = 0.f;
#pragma unroll
      for (int dt = 0; dt < 4; ++dt) ss += o[dt][0] * o[dt][0] + o[dt][1] * o[dt][1] + o[dt][2] * o[dt][2] + o[dt][3] * o[dt][3];
      ss += __shfl_xor(ss, 16); ss += __shfl_xor(ss, 32);
      const float rn = rsqrtf(ss * (1.f / 64.f) + NORM_EPS);
#pragma unroll
      for (int dt = 0; dt < 4; ++dt) { const f32x4 gg = *(const f32x4*)(g + dt * 16 + quad * 4); o[dt] = o[dt] * rn * gg; }
#pragma unroll
      for (int dt = 0; dt < 2; ++dt) {
        const long ti = ((long)b * 128 + c) * 32 + dt * 16 + quad * 4;
        const f32x4 cs = *(const f32x4*)(p.cosC() + ti), sn = *(const f32x4*)(p.sinC() + ti);
        const f32x4 x1 = o[dt], x2 = o[dt + 2];
        o[dt] = x1 * cs - x2 * sn; o[dt + 2] = x2 * cs + x1 * sn;
      }
      bf16_t* dst = p.kc() + ((long)bg * 128 + c) * 64 + quad * 4;
#pragma unroll
      for (int dt = 0; dt < 4; ++dt) {
        u32x2 ov = (u32x2){pk2(o[dt][0], o[dt][1]), pk2(o[dt][2], o[dt][3])};
        if (c >= NCMP) ov = (u32x2){0u, 0u};
        *(u32x2*)(dst + dt * 16) = ov;
      }
    } else {
#pragma unroll
      for (int dt = 0; dt < 4; ++dt) {
        const int c0 = (r16 & 7) * 16 + quad * 4;
        f32x4 v = o[dt];
        if (c0 + 3 >= NCMP) v[3] = 0.f;
        *(u32x2*)(p.vct() + ((long)bg * 64 + dt * 16 + qi) * 128 + c0) = (u32x2){pk2(v[0], v[1]), pk2(v[2], v[3])};
      }
    }
  }
  __syncthreads();
}

struct SbFrag { bf16x8 k[2][2]; bf16x8 v[4]; };
DI void sb_load(SbFrag& f, const bf16_t* __restrict__ kp0, const bf16_t* __restrict__ vp0, int kb) {
#pragma unroll
  for (int a = 0; a < 2; ++a) { f.k[a][0] = ld8(kp0 + (long)(kb + 4 * a) * 64); f.k[a][1] = ld8(kp0 + (long)(kb + 4 * a) * 64 + 32); }
#pragma unroll
  for (int dt = 0; dt < 4; ++dt) f.v[dt] = ld8(vp0 + (long)kb * 64 + dt * 16 * 32);
}
template <bool FULL>
DI void sb_chunk(const SbFrag& f, int kb, int t, int quad, const bf16x8 (&qf)[2], f32x4 (&o)[4], float& carry) {
  f32x4 s[2];
#pragma unroll
  for (int a = 0; a < 2; ++a) {
    s[a] = MFMA16(f.k[a][0], qf[0], ((f32x4){0.f, 0.f, 0.f, 0.f}));
    s[a] = MFMA16(f.k[a][1], qf[1], s[a]);
  }
  float L[8], ls[8]; bool val[8];
  float tot = 0.f;
#pragma unroll
  for (int idx = 0; idx < 8; ++idx) {
    const float z = s[idx >> 2][idx & 3] * (0.125f * 1.44269504089f);
    val[idx] = FULL ? true : (kb + 8 * quad + idx < t);
    const float sp = fmaxf(z, 0.f) + __builtin_amdgcn_logf(1.f + __builtin_amdgcn_exp2f(-fabsf(z)));
    L[idx] = val[idx] ? -sp : 0.f;
    ls[idx] = z - sp;
    tot += L[idx];
  }
  const float a1 = __shfl_xor(tot, 16), a2 = __shfl_xor(tot, 32), a3 = __shfl_xor(a1, 32);
  const float higher = ((quad ^ 1) > quad ? a1 : 0.f) + ((quad ^ 2) > quad ? a2 : 0.f) + ((quad ^ 3) > quad ? a3 : 0.f);
  float run = carry + higher;
  float wv[8];
#pragma unroll
  for (int idx = 7; idx >= 0; --idx) {
    const float e = __builtin_amdgcn_exp2f(ls[idx] + run);
    wv[idx] = val[idx] ? e : 0.f;
    run += L[idx];
  }
  carry += (tot + a1) + (a2 + a3);
  const bf16x8 pf = mk8((u32x4){pk2(wv[0], wv[1]), pk2(wv[2], wv[3]), pk2(wv[4], wv[5]), pk2(wv[6], wv[7])});
#pragma unroll
  for (int dt = 0; dt < 4; ++dt) o[dt] = MFMA16(f.v[dt], pf, o[dt]);
}

DI void sb_attn_wave(const Params& p, int b, int h, int t0, bf16_t* ybase) {
  const int lane = my_tid() & 63, qi = lane & 15, quad = lane >> 4;
  const bf16_t* Q = p.sbq() + (long)(b * 8 + h) * SEQ * 64;
  const bf16_t* K = p.sbk() + (long)(b * 8 + h) * SEQ * 64;
  const bf16_t* Vt = p.sbvt() + (long)(b * 8 + h) * 64 * SEQ;
  const int tA = t0 + qi, tB = t0 + 16 + qi;
  bf16x8 qa[2], qb[2];
  qa[0] = ld8(Q + (long)tA * 64 + quad * 8); qa[1] = ld8(Q + (long)tA * 64 + 32 + quad * 8);
  qb[0] = ld8(Q + (long)tB * 64 + quad * 8); qb[1] = ld8(Q + (long)tB * 64 + 32 + quad * 8);
  f32x4 oa[4], ob[4];
#pragma unroll
  for (int dt = 0; dt < 4; ++dt) { oa[dt] = (f32x4){0.f, 0.f, 0.f, 0.f}; ob[dt] = oa[dt]; }
  float ca = 0.f, cb = 0.f;
  const int krow = 8 * (qi >> 2) + (qi & 3);
  const bf16_t* kp0 = K + (long)krow * 64 + quad * 8;
  const bf16_t* vp0 = Vt + qi * 32 + 8 * quad;
  int kb = t0;
  SbFrag f0, f1, f2;
  sb_load(f0, kp0, vp0, kb); sb_load(f1, kp0, vp0, max(kb - 32, 0));
#define SB_STEP(F, KB) (((KB) + 32 <= t0) ? (sb_chunk<true>(F, KB, tA, quad, qa, oa, ca), sb_chunk<true>(F, KB, tB, quad, qb, ob, cb)) : (sb_chunk<false>(F, KB, tA, quad, qa, oa, ca), sb_chunk<false>(F, KB, tB, quad, qb, ob, cb)), __all(ca < -160.f && cb < -160.f))
  while (true) {
    sb_load(f2, kp0, vp0, max(kb - 64, 0));
    if (SB_STEP(f0, kb) || kb < 32) break;
    sb_load(f0, kp0, vp0, max(kb - 96, 0));
    if (SB_STEP(f1, kb - 32) || kb < 64) break;
    sb_load(f1, kp0, vp0, max(kb - 128, 0));
    if (SB_STEP(f2, kb - 64) || kb < 96) break;
    kb -= 96;
  }
#undef SB_STEP
#pragma unroll
  for (int half = 0; half < 2; ++half) {
    const long zo = ((long)b * SEQ + (half ? tB : tA)) * 512 + h * 64 + quad * 4;
    const bf16_t* zp = p.sbz() + zo; bf16_t* yp = ybase + zo;
#pragma unroll
    for (int dt = 0; dt < 4; ++dt) {
      const f32x4 o = half ? ob[dt] : oa[dt];
      const u32x2 zz = *(const u32x2*)(zp + dt * 16);
      *(u32x2*)(yp + dt * 16) = (u32x2){pk2(o[0] * bflo(zz[0]), o[1] * bfhi(zz[0])), pk2(o[2] * bflo(zz[1]), o[3] * bfhi(zz[1]))};
    }
  }
}

DI void phaseB(const Params& p0, int layer, unsigned char* lds, bool probe) {
  const int NITEM = 128 + BATCH * 8 * 8;
  for (int it = blockIdx.x; it < NITEM; it += gridDim.x) {
    const Params p = relaunder(p0);
    if (it < 128) { compress_partial(p, it, lds); continue; }
    const int i = it - 128, qt = 7 - (i >> 7), bh = i & 127;
    sb_attn_wave(p, bh >> 3, bh & 7, qt * 256 + (my_tid() >> 6) * 32, probe ? p.dummy() : p.sbz());
  }
}

constexpr int NSA_LO_BYTES = 8 * 8192;
constexpr int NSA_KROW = 144, NSA_VROW = 80;
constexpr int NSA_SLOT = 32 * NSA_KROW + 64 * NSA_VROW;
constexpr int NSA_SLOT0 = NSA_LO_BYTES, NSA_BLIST = NSA_SLOT0 + 2 * NSA_SLOT, NSA_UMW = NSA_BLIST + 64 * 4;

struct KVFrag { bf16x8 k[2][2]; bf16x8 v[4]; };
DI void nsa_ldsfrag(KVFrag& f, const unsigned char* slot, int qi, int quad) {
  const int krow = 8 * (qi >> 2) + (qi & 3);
#pragma unroll
  for (int a = 0; a < 2; ++a) { const unsigned char* kp = slot + (krow + 4 * a) * NSA_KROW + quad * 16; f.k[a][0] = mk8(*(const u32x4*)kp); f.k[a][1] = mk8(*(const u32x4*)(kp + 64)); }
#pragma unroll
  for (int dt = 0; dt < 4; ++dt) f.v[dt] = mk8(*(const u32x4*)(slot + 32 * NSA_KROW + (dt * 16 + qi) * NSA_VROW + quad * 16));
}
template <int MODE>
DI void nsa_chunk(const KVFrag& f, int kb, int t, bool selbit, const bf16x8 (&qf)[4][2], f32x4 (&O)[4][4], float (&m)[4], float (&l)[4], int quad, bool online) {
  const float SC = 0.125f * 1.44269504089f;
  bool val[8];
#pragma unroll
  for (int idx = 0; idx < 8; ++idx) {
    const int key = kb + 8 * quad + idx;
    val[idx] = MODE == 0 ? (selbit && key <= t) : (key <= t && key > t - 512);
  }
#pragma unroll
  for (int hh = 0; hh < 4; ++hh) {
    f32x4 s[2];
#pragma unroll
    for (int a = 0; a < 2; ++a) { s[a] = MFMA16(f.k[a][0], qf[hh][0], ((f32x4){0.f, 0.f, 0.f, 0.f})); s[a] = MFMA16(f.k[a][1], qf[hh][1], s[a]); }
    float mn = m[hh];
    if (online) {
      float cm = -1e30f;
#pragma unroll
      for (int idx = 0; idx < 8; ++idx) if (val[idx]) cm = fmaxf(cm, s[idx >> 2][idx & 3] * SC);
      cm = fmaxf(cm, __shfl_xor(cm, 16)); cm = fmaxf(cm, __shfl_xor(cm, 32));
      mn = fmaxf(mn, cm);
      const float alpha = __builtin_amdgcn_exp2f(m[hh] - mn);
      m[hh] = mn; l[hh] *= alpha;
#pragma unroll
      for (int dt = 0; dt < 4; ++dt) O[hh][dt] = O[hh][dt] * alpha;
    }
    float pv[8]; float ps = 0.f;
#pragma unroll
    for (int idx = 0; idx < 8; ++idx) { pv[idx] = val[idx] ? __builtin_amdgcn_exp2f(fmaf(s[idx >> 2][idx & 3], SC, -mn)) : 0.f; ps += pv[idx]; }
    l[hh] += ps;
    const bf16x8 pf = mk8((u32x4){pk2(pv[0], pv[1]), pk2(pv[2], pv[3]), pk2(pv[4], pv[5]), pk2(pv[6], pv[7])});
#pragma unroll
    for (int dt = 0; dt < 4; ++dt) O[hh][dt] = MFMA16(f.v[dt], pf, O[hh][dt]);
  }
}

template <int MODE>
DI void nsa_branch(const bf16_t* __restrict__ Kb, const bf16_t* __restrict__ Vtb, unsigned char* lds, int nb, int t, int cur, unsigned selmask, unsigned umall,
                   const bf16x8 (&qf)[4][2], f32x4 (&O)[4][4], float (&m)[4], float (&l)[4], bool online) {
  const int tid = my_tid(), lane = tid & 63, qi = lane & 15, quad = lane >> 4;
  const int* blist = (const int*)(lds + NSA_BLIST);
  const bool isv = tid >= 256;
  const int t2 = tid & 255;
  const bf16_t* gsrc = isv ? Vtb + (t2 >> 2) * 32 + (t2 & 3) * 8 : Kb + (long)(t2 >> 3) * 64 + (t2 & 7) * 8;
  const long gmul = 64;
  const int ldst = isv ? 32 * NSA_KROW + (t2 >> 2) * NSA_VROW + (t2 & 3) * 16 : (t2 >> 3) * NSA_KROW + (t2 & 7) * 16;
  unsigned char* slot0 = lds + NSA_SLOT0; unsigned char* slot1 = slot0 + NSA_SLOT;
  const int N = 2 * nb;
  auto kbof = [&](int n) { return blist[n >> 1] * 64 + (n & 1) * 32; };
  u32x4 ra = *(const u32x4*)(gsrc + (long)kbof(0) * gmul), rb = *(const u32x4*)(gsrc + (long)kbof(1) * gmul);
  *(u32x4*)(slot0 + ldst) = ra;
  __syncthreads();
#pragma unroll 1
  for (int n = 0; n < N; n += 2) {
    const int j = blist[n >> 1];
    const bool won = MODE == 0 ? ((umall >> j) & 1u) != 0 : (j >= cur - 8 && j <= cur);
    const bool bit = (selmask >> j) & 1u;
    ra = *(const u32x4*)(gsrc + (long)kbof(min(n + 2, N - 2)) * gmul);
    if (won) { KVFrag f; nsa_ldsfrag(f, slot0, qi, quad); nsa_chunk<MODE>(f, j * 64, t, bit, qf, O, m, l, quad, online); }
    *(u32x4*)(slot1 + ldst) = rb;
    __syncthreads();
    rb = *(const u32x4*)(gsrc + (long)kbof(min(n + 3, N - 1)) * gmul);
    if (won) { KVFrag f; nsa_ldsfrag(f, slot1, qi, quad); nsa_chunk<MODE>(f, j * 64 + 32, t, bit, qf, O, m, l, quad, online); }
    *(u32x4*)(slot0 + ldst) = ra;
    __syncthreads();
  }
}

template <bool LAST>
DI void nsa_finish(u32x2* lo, f32x4 (&O)[4][4], float (&m)[4], float (&l)[4], const float (&gate)[4], const bf16_t* zp, bf16_t* yp, float minit) {
#pragma unroll
  for (int hh = 0; hh < 4; ++hh) {
    float lt = l[hh]; lt += __shfl_xor(lt, 16); lt += __shfl_xor(lt, 32);
    const float f = lt > 0.f ? gate[hh] / lt : 0.f;
#pragma unroll
    for (int dt = 0; dt < 4; ++dt) {
      const u32x2 a = lo[(hh * 4 + dt) * 64];
      const f32x4 v = (f32x4){bflo(a[0]), bfhi(a[0]), bflo(a[1]), bfhi(a[1])} + O[hh][dt] * f;
      if (LAST) {
        const u32x2 zz = *(const u32x2*)(zp + hh * 64 + dt * 16);
        *(u32x2*)(yp + hh * 64 + dt * 16) = (u32x2){pk2(v[0] * bflo(zz[0]), v[1] * bfhi(zz[0])), pk2(v[2] * bflo(zz[1]), v[3] * bfhi(zz[1]))};
      } else {
        lo[(hh * 4 + dt) * 64] = (u32x2){pk2(v[0], v[1]), pk2(v[2], v[3])};
        O[hh][dt] = (f32x4){0.f, 0.f, 0.f, 0.f};
      }
    }
    m[hh] = minit; l[hh] = 0.f;
  }
}

DI void nsa_wave(const Params& p, int layer, int b, int g, int t0, unsigned char* lds, bf16_t* ybase) {
  const int lane = my_tid() & 63, qi = lane & 15, quad = lane >> 4;
  const int t = t0 + qi, cur = t0 >> 6;
  const long tok = (long)b * SEQ + t;
  const int bg = b * 2 + g;
  u32x2* lo = (u32x2*)lds + (my_tid() >> 6) * 1024 + lane;

  const float mf_c = p.mfix()[layer * 4 + 0], mf_s = p.mfix()[layer * 4 + 1], mf_w = p.mfix()[layer * 4 + 2];
  const bool on_c = mf_c > 60.f, on_s = mf_s > 60.f, on_w = mf_w > 60.f;
  const float SC = 0.125f * 1.44269504089f;
  const bf16_t* Kc = p.kc() + (long)bg * 128 * 64;
  const bf16_t* Vc = p.vct() + (long)bg * 64 * 128;
  f32x4 ph[8];
#pragma unroll
  for (int kt = 0; kt < 8; ++kt) ph[kt] = (f32x4){0.f, 0.f, 0.f, 0.f};
#pragma unroll 1
  for (int hh = 0; hh < 4; ++hh) {
    const bf16_t* qp0 = p.nq() + ((long)(b * 8 + g * 4 + hh) * SEQ + t) * 64 + quad * 8;
    const bf16x8 q0 = ld8(qp0), q1 = ld8(qp0 + 32); const float gt = p.ngate()[tok * 32 + g * 4 + hh];
    f32x4 sc[8];
    float mx = on_c ? -1e30f : mf_c;
#pragma unroll
    for (int kt = 0; kt < 8; ++kt) {
      const bf16_t* kp = Kc + (long)(kt * 16 + qi) * 64 + quad * 8;
      sc[kt] = MFMA16(ld8(kp), q0, ((f32x4){0.f, 0.f, 0.f, 0.f}));
      sc[kt] = MFMA16(ld8(kp + 32), q1, sc[kt]);
      sc[kt] = sc[kt] * SC;
    }
    if (on_c) {
#pragma unroll
      for (int kt = 0; kt < 8; ++kt)
#pragma unroll
        for (int r = 0; r < 4; ++r) { const int c = kt * 16 + quad * 4 + r; if (c < NCMP && 16 * c + 31 <= t) mx = fmaxf(mx, sc[kt][r]); }
      mx = fmaxf(mx, __shfl_xor(mx, 16)); mx = fmaxf(mx, __shfl_xor(mx, 32));
    }
    float sum = 0.f;
#pragma unroll
    for (int kt = 0; kt < 8; ++kt)
#pragma unroll
      for (int r = 0; r < 4; ++r) {
        const int c = kt * 16 + quad * 4 + r;
        const float e = (c < NCMP && 16 * c + 31 <= t) ? __builtin_amdgcn_exp2f(sc[kt][r] - mx) : 0.f;
        sc[kt][r] = e; sum += e;
      }
    sum += __shfl_xor(sum, 16); sum += __shfl_xor(sum, 32);
    const float inv = sum > 0.f ? 1.f / sum : 0.f;
#pragma unroll
    for (int kt = 0; kt < 8; ++kt) { sc[kt] = sc[kt] * inv; ph[kt] += sc[kt]; }
    f32x4 oc[4];
#pragma unroll
    for (int dt = 0; dt < 4; ++dt) oc[dt] = (f32x4){0.f, 0.f, 0.f, 0.f};
#pragma unroll
    for (int mm = 0; mm < 4; ++mm) {
      const bf16x8 pf = mk8((u32x4){pk2(sc[2 * mm][0], sc[2 * mm][1]), pk2(sc[2 * mm][2], sc[2 * mm][3]), pk2(sc[2 * mm + 1][0], sc[2 * mm + 1][1]), pk2(sc[2 * mm + 1][2], sc[2 * mm + 1][3])});
#pragma unroll
      for (int dt = 0; dt < 4; ++dt) {
        const bf16_t* vp = Vc + (long)(dt * 16 + qi) * 128 + 32 * mm + quad * 4;
        const u32x2 lo = *(const u32x2*)vp, hi = *(const u32x2*)(vp + 16);
        oc[dt] = MFMA16(mk8((u32x4){lo[0], lo[1], hi[0], hi[1]}), pf, oc[dt]);
      }
    }
#pragma unroll
    for (int dt = 0; dt < 4; ++dt) { const f32x4 v = oc[dt] * gt; lo[(hh * 4 + dt) * 64] = (u32x2){pk2(v[0], v[1]), pk2(v[2], v[3])}; }
  }
  float imp[8];
  {
    float rot[8];
#pragma unroll
    for (int kt = 0; kt < 8; ++kt) rot[kt] = __shfl(ph[kt][3], (lane + 48) & 63);
#pragma unroll
    for (int kt = 0; kt < 8; ++kt) {
      const float extra = quad > 0 ? rot[kt] : (kt > 0 ? rot[kt > 0 ? kt - 1 : 0] : 0.f);
      const float v = (ph[kt][0] + ph[kt][1]) + (ph[kt][2] + ph[kt][3]) + extra;
      const int j = 4 * kt + quad;
      const bool forced = j == 0 || j == cur || j == cur - 1;
      imp[kt] = j <= cur ? v + (forced ? 1e4f : 0.f) : -1e30f;
    }
  }
  unsigned selmask = 0;
  {
    int rank[8];
#pragma unroll
    for (int kt = 0; kt < 8; ++kt) rank[kt] = 0;
#pragma unroll 1
    for (int q2 = 0; q2 < 4; ++q2)
#pragma unroll
      for (int k2 = 0; k2 < 8; ++k2) {
        const float ov = __shfl(imp[k2], qi + 16 * q2);
#pragma unroll
        for (int kt = 0; kt < 8; ++kt) {
          const bool before = k2 < kt || (k2 == kt && q2 < quad);
          rank[kt] += (ov > imp[kt] || (ov == imp[kt] && before)) ? 1 : 0;
        }
      }
#pragma unroll
    for (int kt = 0; kt < 8; ++kt) if (rank[kt] < 8 && 4 * kt + quad <= cur) selmask |= 1u << (4 * kt + quad);
    selmask |= __shfl_xor(selmask, 16); selmask |= __shfl_xor(selmask, 32);
  }

  unsigned umall = selmask;
  umall |= __shfl_xor(umall, 1); umall |= __shfl_xor(umall, 2); umall |= __shfl_xor(umall, 4); umall |= __shfl_xor(umall, 8);
  umall = __builtin_amdgcn_readfirstlane(umall);
  const int wv = my_tid() >> 6;
  unsigned* umw = (unsigned*)(lds + NSA_UMW); int* blist = (int*)(lds + NSA_BLIST);
  if (lane == 0) umw[wv] = umall;
  bf16x8 qf[4][2];
#pragma unroll
  for (int hh = 0; hh < 4; ++hh) {
    const bf16_t* qp = p.nq() + ((long)(b * 8 + g * 4 + hh) * SEQ + t) * 64 + quad * 8;
    qf[hh][0] = ld8(qp); qf[hh][1] = ld8(qp + 32);
  }
  float gate[3][4];
#pragma unroll
  for (int br = 1; br < 3; ++br) { const f32x4 gv = *(const f32x4*)(p.ngate() + tok * 32 + br * 8 + g * 4); gate[br][0] = gv[0]; gate[br][1] = gv[1]; gate[br][2] = gv[2]; gate[br][3] = gv[3]; }
  f32x4 O[4][4]; float m[4], l[4];
#pragma unroll
  for (int hh = 0; hh < 4; ++hh) { m[hh] = on_s ? -1e30f : mf_s; l[hh] = 0.f;
#pragma unroll
    for (int dt = 0; dt < 4; ++dt) O[hh][dt] = (f32x4){0.f, 0.f, 0.f, 0.f}; }
  __syncthreads();
  int nb;
  {
    unsigned ub = 0;
#pragma unroll
    for (int i = 0; i < 8; ++i) ub |= umw[i];
    nb = __builtin_popcount(ub);
    if (my_tid() < 32) { if ((ub >> my_tid()) & 1u) blist[__builtin_popcount(ub & ((1u << my_tid()) - 1u))] = my_tid(); }
    __syncthreads();
    nsa_branch<0>(p.ks() + (long)bg * SEQ * 64, p.vst() + (long)bg * 64 * SEQ, lds, nb, t, cur, selmask, umall, qf, O, m, l, on_s);
    nsa_finish<false>(lo, O, m, l, gate[1], nullptr, nullptr, on_w ? -1e30f : mf_w);
  }
  {
    const int cur0 = (t0 >> 7) * 2, jlo = cur0 >= 8 ? cur0 - 8 : 0;
    nb = cur0 + 2 - jlo;
    if (my_tid() < nb) blist[my_tid()] = jlo + my_tid();
    __syncthreads();
    nsa_branch<1>(p.kw() + (long)bg * SEQ * 64, p.vwt() + (long)bg * 64 * SEQ, lds, nb, t, cur, selmask, umall, qf, O, m, l, on_w);
    nsa_finish<true>(lo, O, m, l, gate[2], p.nz() + tok * 512 + g * 256 + quad * 4, ybase + tok * 512 + g * 256 + quad * 4, 0.f);
  }
  __syncthreads();
}

DI void phaseC(const Params& p0, int layer, unsigned char* lds, bool probe) {
  const int NITEM = BATCH * 2 * 16;
  for (int it = blockIdx.x; it < NITEM; it += gridDim.x) {
    const Params p = relaunder(p0);
    const int qt = 15 - (it >> 5), bg = it & 31;
    nsa_wave(p, layer, bg >> 1, bg & 1, qt * 128 + (my_tid() >> 6) * 16, lds, probe ? p.dummy() : p.nz());
  }
}

DI void phaseD(const Params& p0, const Slot sl, int layer, unsigned char* lds) {
  const Params p = relaunder(p0);
  bf16_t* gl = (bf16_t*)lds;
  int mt, nt;
  for (int it = 0; tile_order(sl, it, 4, mt, nt); ++it) {
#pragma unroll 1
    for (int which = 0; which < 2; ++which) {
      const bf16_t* Wg = (which ? p.wupb_t() : p.wupa_t()) + ((long)nt * 256) * 512;
      const bf16_t* Yg = (which ? p.nz() : p.sbz()) + (long)mt * 256 * 512;
      const bf16_t* Gg = which ? p.gb() : p.ga();
      int mt2 = mt, nt2 = nt; bool more = true;
      if (which) more = tile_order(sl, it + 1, 4, mt2, nt2);
      const bf16_t* Wn = more ? (which ? p.wupa_t() : p.wupb_t()) + ((long)nt2 * 256) * 512 : Wg;
      const bf16_t* Yn = more ? (which ? p.sbz() : p.nz()) + (long)mt2 * 256 * 512 : Yg;
      f32x4 acc[8][4]; zero_acc(acc);
      gemm_core(Wg, 512, Yg, 512, 512, gl, acc, 64, it > 0 || which, Wn, Yn);
      const int tid = my_tid(), lane = tid & 63, w = tid >> 6, wa = w >> 2, wb = w & 3, qi = lane & 15, quad = lane >> 4;
#pragma unroll
      for (int j = 0; j < 4; ++j) {
        const long tok = (long)mt * 256 + wb * 64 + j * 16 + qi;
#pragma unroll
        for (int i = 0; i < 8; ++i) {
          const long off = tok * 1024 + nt * 256 + wa * 128 + i * 16 + quad * 4;
          const u32x2 xg = *(const u32x2*)(Gg + off);
          const f32x4 v = acc[i][j];
          float o0 = bflo(xg[0]) * v[0], o1 = bfhi(xg[0]) * v[1], o2 = bflo(xg[1]) * v[2], o3 = bfhi(xg[1]) * v[3];
          if (which) { const u32x2 a = *(const u32x2*)(p.merged() + off); o0 += bflo(a[0]); o1 += bfhi(a[0]); o2 += bflo(a[1]); o3 += bfhi(a[1]); }
          *(u32x2*)(p.merged() + off) = (u32x2){pk2(o0, o1), pk2(o2, o3)};
          if ((i & 3) == 3) asm volatile("" ::: "memory");
        }
      }
    }
  }
}

DI void phaseE(const Params& p0, const Slot sl, int layer, unsigned char* lds, const float* xsrc) {
  const Params p = relaunder(p0);
  bf16_t* gl = (bf16_t*)lds;
  int mt, nt;
  for (int it = 0; tile_order(sl, it, 4, mt, nt); ++it) {
    f32x4 acc[8][4]; zero_acc(acc);
    int mt2, nt2;
    const bool more = tile_order(sl, it + 1, 4, mt2, nt2);
    const bf16_t* Wg = p.wout_t() + ((long)nt * 256) * 1024; const bf16_t* Mg = p.merged() + (long)mt * 256 * 1024;
    gemm_core(Wg, 1024, Mg, 1024, 1024, gl, acc, 64, it > 0, more ? p.wout_t() + ((long)nt2 * 256) * 1024 : Wg, more ? p.merged() + (long)mt2 * 256 * 1024 : Mg);
    const int tid = my_tid(), lane = tid & 63, w = tid >> 6, wa = w >> 2, wb = w & 3, qi = lane & 15, quad = lane >> 4;
#pragma unroll
    for (int j = 0; j < 4; ++j) {
      const long tok = (long)mt * 256 + wb * 64 + j * 16 + qi;
      float ss = 0.f;
#pragma unroll
      for (int i = 0; i < 8; ++i) {
        const long off = tok * 1024 + nt * 256 + wa * 128 + i * 16 + quad * 4;
        const f32x4 xo = *(const f32x4*)(xsrc + off);
        const f32x4 xn = xo + acc[i][j];
        *(f32x4*)(p.out + off) = xn;
        *(u32x2*)(p.xb() + off + tok * (LDX - D_MODEL)) = (u32x2){pk2(xn[0], xn[1]), pk2(xn[2], xn[3])};
        ss += xn[0] * xn[0] + xn[1] * xn[1] + xn[2] * xn[2] + xn[3] * xn[3];
      }
      ss += __shfl_xor(ss, 16); ss += __shfl_xor(ss, 32);
      if (quad == 0) p.part()[tok * 16 + nt * 2 + wa] = ss;
    }
  }
}

#ifndef STOP_AFTER
#define STOP_AFTER 0
#endif
constexpr int LDS_BYTES = LDS_GEMM_BYTES + 1024;

__global__ void __launch_bounds__(512) hybrid_megakernel(Params p) {
  extern __shared__ __attribute__((aligned(16))) unsigned char lds[];
  cg::grid_group grid = cg::this_grid();
  __shared__ int s_xcc, s_rank, s_ok;
  if (threadIdx.x == 0) {
    const unsigned xcc = (unsigned)__builtin_amdgcn_s_getreg((3 << 11) | 20) & 7u;
    s_xcc = (int)xcc; s_rank = (int)atomicAdd(p.ctl() + xcc, 1u);
  }
  phase_prologue(p, lds);
  grid.sync();
  if (threadIdx.x == 0) {
    int ok = 1;
    for (int i = 0; i < 8; ++i) ok &= (__hip_atomic_load(p.ctl() + i, __ATOMIC_RELAXED, __HIP_MEMORY_SCOPE_AGENT) == (gridDim.x >> 3));
    s_ok = ok;
  }
  __syncthreads();
  const Slot sl = {s_ok ? s_xcc : (int)(blockIdx.x & 7), s_ok ? s_rank : (int)(blockIdx.x >> 3)};
  for (int layer = 0; layer < DEPTH; ++layer) {
    if (layer > 0) convert_weights(p, layer, lds, 2);
    if (STOP_AFTER != 0 && STOP_AFTER == layer * 10) return;
    phaseA(p, sl, layer, lds);
    grid.sync();
#ifdef PROBE_A
    phaseA(p, sl, layer, lds, PROBE_A >= 2 ? PROBE_A : 0);
    grid.sync();
#endif
    if (STOP_AFTER == layer * 10 + 1) return;
#ifdef PROBE_B
    phaseB(p, layer, lds, true);
    grid.sync();
#endif
    phaseB(p, layer, lds, false);
    grid.sync();
    phaseB2(p, layer, lds);
    grid.sync();
    if (STOP_AFTER == layer * 10 + 2) return;
#ifdef PROBE_C
    phaseC(p, layer, lds, true);
    grid.sync();
#endif
    phaseC(p, layer, lds, false);
    grid.sync();
    if (STOP_AFTER == layer * 10 + 3) return;
    phaseD(p, sl, layer, lds);
    grid.sync();
#ifdef PROBE_D
    phaseD(p, sl, layer, lds);
    grid.sync();
#endif
    if (STOP_AFTER == layer * 10 + 4) return;
    if (layer == 0) phaseE(p, sl, layer, lds, p.x_in); else phaseE(p, sl, layer, lds, p.out);
    if (layer + 1 < DEPTH) convert_weights(p, layer + 1, lds, 1);
    if (layer + 1 < DEPTH) grid.sync();
    if (STOP_AFTER == layer * 10 + 5) return;
  }
}

extern "C" void kernel_launch(void* const* d_in, const int* in_sizes, int n_in, void* d_out, int out_size,
                              void* d_ws, size_t ws_size, hipStream_t stream) {
  static int grid_blocks = 0;
  if (!grid_blocks) {
    int dev = 0, cus = 0, per_cu = 0;
    (void)hipGetDevice(&dev);
    (void)hipDeviceGetAttribute(&cus, hipDeviceAttributeMultiprocessorCount, dev);
    if (hipFuncSetAttribute((const void*)hybrid_megakernel, hipFuncAttributeMaxDynamicSharedMemorySize, LDS_BYTES) != hipSuccess) fprintf(stderr, "hipFuncSetAttribute(max dynamic LDS) failed\n");
    (void)hipOccupancyMaxActiveBlocksPerMultiprocessor(&per_cu, hybrid_megakernel, NTHR, LDS_BYTES);
    (void)hipGetLastError();
    if (per_cu > 1) per_cu = 1;
    if (per_cu < 1) per_cu = 1;
    grid_blocks = (cus * per_cu) & ~7;
  }
  Params a{};
  a.x_in = (const float*)d_in[0]; a.pos = (const int*)d_in[1]; a.norm_g = (const float*)d_in[2]; a.w_in = (const float*)d_in[3];
  a.q_norm_g = (const float*)d_in[4]; a.k_norm_g = (const float*)d_in[5]; a.cmp_pe = (const float*)d_in[6]; a.cmp_w1 = (const float*)d_in[7];
  a.cmp_b1 = (const float*)d_in[8]; a.cmp_w2 = (const float*)d_in[9]; a.w_up_a = (const float*)d_in[10]; a.w_up_b = (const float*)d_in[11];
  a.w_out = (const float*)d_in[12];
  a.out = (float*)d_out; a.ws = (unsigned char*)d_ws;
  if (WS_NEED > ws_size) { fprintf(stderr, "workspace too small: need %zu have %zu\n", (size_t)WS_NEED, ws_size); return; }
  (void)hipMemsetAsync((unsigned char*)d_ws + OFF_CTL, 0, 256, stream);
  void* args[] = {&a};
  hipError_t e = hipLaunchCooperativeKernel((void*)hybrid_megakernel, dim3(grid_blocks), dim3(NTHR), args, LDS_BYTES, stream);
  if (e != hipSuccess) fprintf(stderr, "cooperative launch failed: %s (grid %d)\n", hipGetErrorString(e), grid_blocks);
}
```

```cpp
#include <hip/hip_runtime.h>
#include <hip/hip_cooperative_groups.h>
#include <cstdio>
#include <cstdint>
namespace cg = cooperative_groups;

typedef unsigned short bf16_t;
typedef short bf16x8 __attribute__((ext_vector_type(8)));
typedef float f32x4 __attribute__((ext_vector_type(4)));
typedef float f32x2 __attribute__((ext_vector_type(2)));
typedef unsigned u32x4 __attribute__((ext_vector_type(4)));
typedef unsigned u32x2 __attribute__((ext_vector_type(2)));
typedef __bf16 bf16x2_t __attribute__((ext_vector_type(2)));

#define DI __device__ __forceinline__
#define MFMA16(a, b, c) __builtin_amdgcn_mfma_f32_16x16x32_bf16((a), (b), (c), 0, 0, 0)

constexpr int D_MODEL = 1024, BATCH = 16, SEQ = 2048, DEPTH = 4, NTOK = BATCH * SEQ;
constexpr int N_IN = 5912, NP = 6144, NT_IN = 24;
constexpr int NTHR = 512;
constexpr int LDX = D_MODEL + 64;
constexpr int NCMP = 127;
constexpr float NORM_EPS = 1e-6f;

DI unsigned pk2(float lo, float hi) { f32x2 v = {lo, hi}; bf16x2_t b = __builtin_convertvector(v, bf16x2_t); return __builtin_bit_cast(unsigned, b); }
DI float bflo(unsigned u) { return __uint_as_float(u << 16); }
DI float bfhi(unsigned u) { return __uint_as_float(u & 0xffff0000u); }
DI float sigmoidf_(float x) { return __builtin_amdgcn_rcpf(1.f + __builtin_amdgcn_exp2f(-1.44269504089f * x)); }
DI float siluf_(float x) { return x * __builtin_amdgcn_rcpf(1.f + __builtin_amdgcn_exp2f(-1.44269504089f * x)); }
DI bf16x8 mk8(u32x4 v) { return __builtin_bit_cast(bf16x8, v); }
DI bf16x8 ld8(const bf16_t* p) { return __builtin_bit_cast(bf16x8, *(const u32x4*)p); }


DI void sincos_acc(float angf, float& sn, float& cs) {
  const double a = (double)angf;
  const double k = rint(a * 0.63661977236758134308);
  const double y = (a - k * 1.57079632679489655800) - k * 6.12323399573676603587e-17;
  const double y2 = y * y;
  const double sp = y * (1.0 + y2 * (-1.0 / 6 + y2 * (1.0 / 120 + y2 * (-1.0 / 5040 + y2 * (1.0 / 362880 + y2 * (-1.0 / 39916800 + y2 * (1.0 / 6227020800.0)))))));
  const double cp = 1.0 + y2 * (-0.5 + y2 * (1.0 / 24 + y2 * (-1.0 / 720 + y2 * (1.0 / 40320 + y2 * (-1.0 / 3628800 + y2 * (1.0 / 479001600.0))))));
  const int q = ((int)k) & 3;
  const double s_ = (q & 1) ? cp : sp, c_ = (q & 1) ? sp : cp;
  sn = (float)((q & 2) ? -s_ : s_);
  cs = (float)(((q + 1) & 2) ? -c_ : c_);
}
DI float inv_freq(int f) { return (float)exp(-(double)f * (9.21034037197618273607 / 32.0)); }

constexpr size_t al256(size_t x) { return (x + 255) & ~(size_t)255; }
constexpr size_t OFF_WT_IN = 0;
constexpr size_t OFF_W1T = OFF_WT_IN + al256((size_t)NP * LDX * 2);
constexpr size_t OFF_W2T = OFF_W1T + al256((size_t)2 * 256 * 2048 * 2);
constexpr size_t OFF_WUPA = OFF_W2T + al256((size_t)2 * 64 * 256 * 2);
constexpr size_t OFF_WUPB = OFF_WUPA + al256((size_t)1024 * 512 * 2);
constexpr size_t OFF_WOUT = OFF_WUPB + al256((size_t)1024 * 512 * 2);
constexpr size_t OFF_B1EFF = OFF_WOUT + al256((size_t)1024 * 1024 * 2);
constexpr size_t OFF_COST = OFF_B1EFF + al256((size_t)DEPTH * 2 * 16 * 256 * 4);
constexpr size_t OFF_SINT = OFF_COST + al256((size_t)NTOK * 32 * 4);
constexpr size_t OFF_COSC = OFF_SINT + al256((size_t)NTOK * 32 * 4);
constexpr size_t OFF_SINC = OFF_COSC + al256((size_t)BATCH * 128 * 32 * 4);
constexpr size_t OFF_XB = OFF_SINC + al256((size_t)BATCH * 128 * 32 * 4);
constexpr size_t OFF_PART = OFF_XB + al256((size_t)NTOK * LDX * 2);
constexpr size_t OFF_SBQ = OFF_PART + al256((size_t)NTOK * 16 * 4);
constexpr size_t OFF_SBK = OFF_SBQ + al256((size_t)NTOK * 512 * 2);
constexpr size_t OFF_SBVT = OFF_SBK + al256((size_t)NTOK * 512 * 2);
constexpr size_t OFF_SBZ = OFF_SBVT + al256((size_t)NTOK * 512 * 2);
constexpr size_t OFF_NQ = OFF_SBZ + al256((size_t)NTOK * 512 * 2);
constexpr size_t OFF_KCR = OFF_NQ + al256((size_t)NTOK * 512 * 2);
constexpr size_t OFF_VCR = OFF_KCR + al256((size_t)NTOK * 128 * 2);
constexpr size_t OFF_KS = OFF_VCR + al256((size_t)NTOK * 128 * 2);
constexpr size_t OFF_VST = OFF_KS + al256((size_t)NTOK * 128 * 2);
constexpr size_t OFF_KW = OFF_VST + al256((size_t)NTOK * 128 * 2);
constexpr size_t OFF_VWT = OFF_KW + al256((size_t)NTOK * 128 * 2);
constexpr size_t OFF_NGATE = OFF_VWT + al256((size_t)NTOK * 128 * 2);
constexpr size_t OFF_NZ = OFF_NGATE + al256((size_t)NTOK * 32 * 4);
constexpr size_t OFF_GA = OFF_NZ + al256((size_t)NTOK * 512 * 2);
constexpr size_t OFF_GB = OFF_GA + al256((size_t)NTOK * 1024 * 2);
constexpr size_t OFF_HID = OFF_GB + al256((size_t)NTOK * 1024 * 2);
constexpr size_t OFF_KC = OFF_HID + al256((size_t)4 * 32 * 256 * 256 * 4);
constexpr size_t OFF_VCT = OFF_KC + al256((size_t)BATCH * 2 * 128 * 64 * 2);
constexpr size_t OFF_QNG = OFF_VCT + al256((size_t)BATCH * 2 * 64 * 128 * 2);
constexpr size_t OFF_KNG = OFF_QNG + al256((size_t)DEPTH * 64 * 4);
constexpr size_t OFF_CTL = OFF_KNG + al256((size_t)DEPTH * 3 * 64 * 4);
constexpr size_t OFF_MFIX_BASE = OFF_CTL + 256;
constexpr size_t OFF_MFIX_OLD = OFF_KNG + al256((size_t)DEPTH * 3 * 64 * 4);
constexpr size_t OFF_MFIX = OFF_MFIX_BASE;
constexpr size_t OFF_DUMMY = OFF_MFIX + 256;
constexpr size_t OFF_BAR = OFF_DUMMY + 256;
constexpr size_t WS_NEED = OFF_BAR + 3456 * 4;

struct Params {
  const float* x_in; const int* pos; const float* norm_g; const float* w_in; const float* q_norm_g; const float* k_norm_g;
  const float* cmp_pe; const float* cmp_w1; const float* cmp_b1; const float* cmp_w2; const float* w_up_a; const float* w_up_b; const float* w_out;
  float* out; unsigned char* ws;
#define WSBUF(T, name, OFF) DI T* name() const { return (T*)(ws + (OFF)); }
  WSBUF(bf16_t, wt_in, OFF_WT_IN) WSBUF(bf16_t, w1t, OFF_W1T) WSBUF(bf16_t, w2t, OFF_W2T) WSBUF(bf16_t, wupa_t, OFF_WUPA) WSBUF(bf16_t, wupb_t, OFF_WUPB) WSBUF(bf16_t, wout_t, OFF_WOUT)
  WSBUF(float, b1eff, OFF_B1EFF) WSBUF(float, cosT, OFF_COST) WSBUF(float, sinT, OFF_SINT) WSBUF(float, cosC, OFF_COSC) WSBUF(float, sinC, OFF_SINC)
  WSBUF(bf16_t, xb, OFF_XB) WSBUF(float, part, OFF_PART) WSBUF(bf16_t, sbq, OFF_SBQ) WSBUF(bf16_t, sbk, OFF_SBK) WSBUF(bf16_t, sbvt, OFF_SBVT) WSBUF(bf16_t, sbz, OFF_SBZ)
  WSBUF(bf16_t, nq, OFF_NQ) WSBUF(bf16_t, kcr, OFF_KCR) WSBUF(bf16_t, vcr, OFF_VCR) WSBUF(bf16_t, ks, OFF_KS) WSBUF(bf16_t, vst, OFF_VST) WSBUF(bf16_t, kw, OFF_KW) WSBUF(bf16_t, vwt, OFF_VWT)
  WSBUF(float, ngate, OFF_NGATE) WSBUF(bf16_t, nz, OFF_NZ) WSBUF(bf16_t, ga, OFF_GA) WSBUF(bf16_t, gb, OFF_GB) WSBUF(float, hpre, OFF_HID) WSBUF(bf16_t, kc, OFF_KC) WSBUF(bf16_t, vct, OFF_VCT)
  WSBUF(bf16_t, merged, OFF_SBK)
  WSBUF(bf16_t, dummy, OFF_XB)     WSBUF(float, mfix, OFF_MFIX) WSBUF(unsigned, ctl, OFF_CTL)
  WSBUF(float, qng, OFF_QNG) WSBUF(float, kng, OFF_KNG)
};

DI int my_tid() { int t = threadIdx.x; asm volatile("" : "+v"(t)); return t; }
DI Params relaunder(const Params& p0) { Params p = p0; size_t z = 0; asm volatile("" : "+s"(z)); p.ws = p0.ws + z; return p; }

constexpr int TILE_B = 32 * 1024;
constexpr int STAGE_B = 2 * TILE_B;
constexpr int LDS_GEMM_BYTES = 2 * STAGE_B;
typedef __attribute__((address_space(3))) unsigned lds_u32;

DI void g_dma(const bf16_t* __restrict__ base, const unsigned (&off)[8], int ko, unsigned char* stage, int w) {
#pragma unroll
  for (int u = 0; u < 8; ++u)
    __builtin_amdgcn_global_load_lds((const unsigned*)(base + (off[u] + ko)), (lds_u32*)(stage + (w * 8 + u) * 1024), 16, 0, 0);
}
#define G_LDA(dst, ih, ks) _Pragma("unroll") for (int i = 0; i < 4; ++i) dst[i] = mk8(*(const u32x4*)(stage + ra + (((ih) * 4 + i) * 2 + (ks)) * 1024))
#define G_LDB(dst, ks) _Pragma("unroll") for (int j = 0; j < 4; ++j) dst[j] = mk8(*(const u32x4*)(stage + TILE_B + rb + (j * 2 + (ks)) * 1024))
#define G_MMA(ih, A, B) do { _Pragma("unroll") for (int i = 0; i < 4; ++i) _Pragma("unroll") for (int j = 0; j < 4; ++j) acc[(ih) * 4 + i][j] = MFMA16(A[i], B[j], acc[(ih) * 4 + i][j]); } while (0)
DI void g_compute(const unsigned char* stage, int ra, int rb, f32x4 (&acc)[8][4]) {
  bf16x8 b0[4], b1[4], a0[4], a1[4];
  G_LDB(b0, 0); G_LDA(a0, 0, 0);
  __builtin_amdgcn_sched_barrier(0);
  G_LDA(a1, 1, 0);
  G_MMA(0, a0, b0);
  __builtin_amdgcn_sched_barrier(0);
  G_LDB(b1, 1); G_LDA(a0, 0, 1);
  G_MMA(1, a1, b0);
  __builtin_amdgcn_sched_barrier(0);
  G_LDA(a1, 1, 1);
  G_MMA(0, a0, b1);
  __builtin_amdgcn_sched_barrier(0);
  G_MMA(1, a1, b1);
  __builtin_amdgcn_sched_barrier(0);
}

DI void gemm_core(const bf16_t* __restrict__ Ag, long lda, const bf16_t* __restrict__ Bg, long ldb, int K,
                  bf16_t* ldsb, f32x4 (&acc)[8][4], int kstep = 64, bool pre = false, const bf16_t* nAg = nullptr, const bf16_t* nBg = nullptr) {
  unsigned char* lds = (unsigned char*)ldsb;
  const int tid = my_tid(), lane = tid & 63, w = __builtin_amdgcn_readfirstlane(tid >> 6), wa = w >> 2, wb = w & 3, qi = lane & 15, quad = lane >> 4;
  const bf16_t* base = w >= 4 ? Bg : Ag; const int ld = (int)(w >= 4 ? ldb : lda);
  const bf16_t* nbase = nAg ? (w >= 4 ? nBg : nAg) : base;
  unsigned off[8];
#pragma unroll
  for (int u = 0; u < 8; ++u) { const int blk = (w & 3) * 8 + u, rg = blk >> 1, kh = blk & 1; off[u] = (unsigned)((rg * 16 + (lane >> 2)) * ld + kh * 32 + (lane & 3) * 8); }
  const int ra = (wa * 8) * 2 * 1024 + (qi * 4 + quad) * 16, rb = (wb * 4) * 2 * 1024 + (qi * 4 + quad) * 16;
  unsigned char* buf0 = lds; unsigned char* buf1 = lds + STAGE_B;
  const int KT = K >> 6;
  if (!pre) {
    g_dma(base, off, 0, buf0, w);
    asm volatile("s_waitcnt vmcnt(0)" ::: "memory");
    __syncthreads();
  }
  for (int kt = 0; kt < KT; kt += 2) {
    g_dma(base, off, (kt + 1) * kstep, buf1, w);
    g_compute(buf0, ra, rb, acc);
    asm volatile("s_waitcnt vmcnt(0)" ::: "memory");
    __syncthreads();
    const bool last = kt + 2 >= KT;
    g_dma(last ? nbase : base, off, last ? 0 : (kt + 2) * kstep, buf0, w);
    g_compute(buf1, ra, rb, acc);
    asm volatile("s_waitcnt vmcnt(0)" ::: "memory");
    __syncthreads();
  }
}

DI void zero_acc(f32x4 (&acc)[8][4]) {
#pragma unroll
  for (int i = 0; i < 8; ++i)
#pragma unroll
    for (int j = 0; j < 4; ++j) acc[i][j] = (f32x4){0.f, 0.f, 0.f, 0.f};
}

struct Slot { int xcd, slot; };
DI bool tile_order(const Slot sl, int it, int nN, int& mt, int& nt) {
  const int xcd = sl.xcd, slot = sl.slot, SL = gridDim.x >> 3;
  const int q = slot + it * SL, per = 8 * nN;
  if (q >= 2 * per) return false;
  const int mg = q / per, e = q - mg * per;
  nt = e >> 3; mt = xcd * 16 + mg * 8 + (e & 7);
  return true;
}


#define XB_TMO      128
#define XB_XCNT(j)  (256  + 64 * (j))
#define XB_XSUB(j)  (1280 + 64 * (j))
#define XB_XGEN(j)  (2304 + 64 * (j))
#define XB_TOP      3328
#define XB_TOPGEN   3392
#define XCD_BAR_WORDS 3456
#define XB_SPIN_CAP (1u << 18)
#define LAS __attribute__((address_space(3)))
DI unsigned xb_ld(unsigned* p)              { return __hip_atomic_load(p, __ATOMIC_RELAXED, __HIP_MEMORY_SCOPE_AGENT); }
DI unsigned xb_add(unsigned* p, unsigned v) { return __hip_atomic_fetch_add(p, v, __ATOMIC_RELAXED, __HIP_MEMORY_SCOPE_AGENT); }
DI unsigned xb_xcc_id() { return (unsigned)__builtin_amdgcn_s_getreg((3 << 11) | 20) & 0xFu; }
#define XB_SPIN(cond, bar) do { unsigned _sp = 0; while (cond) { __builtin_amdgcn_s_sleep(1); \
    if ((++_sp & 255u) == 0u) { if (xb_ld(&(bar)[XB_TMO])) break; if (_sp > XB_SPIN_CAP) { atomicAdd(&(bar)[XB_TMO], 1u); break; } } } } while (0)
struct XcdBarrier { unsigned* bar; unsigned x; volatile LAS unsigned* st; };
DI XcdBarrier xcd_barrier_post(unsigned* bar, volatile LAS unsigned* st) {
  XcdBarrier b; b.bar = bar; b.x = xb_xcc_id(); b.st = st;
  if (threadIdx.x == 0) (void)xb_add(&bar[XB_XCNT(b.x)], 1u);
  return b;
}
DI void xcd_barrier_complete(unsigned* bar, unsigned x, unsigned& nloc, unsigned& nx) {
  const unsigned G = gridDim.x * gridDim.y * gridDim.z;
  unsigned sum, cnt, mine, sp = 0u;
  for (;;) {
    sum = 0u; cnt = 0u; mine = 0u;
#pragma unroll
    for (unsigned j = 0; j < 16; ++j) { const unsigned c = xb_ld(&bar[XB_XCNT(j)]); sum += c; cnt += (c > 0u) ? 1u : 0u; mine = (j == x) ? c : mine; }
    if (sum == G) break;
    __builtin_amdgcn_s_sleep(1);
    if ((++sp & 255u) == 0u) { if (xb_ld(&bar[XB_TMO])) break; if (sp > XB_SPIN_CAP) { atomicAdd(&bar[XB_TMO], 1u); break; } }
  }
  nloc = mine > 0u ? mine : 1u; nx = cnt > 0u ? cnt : 1u;
}
DI void xcd_barrier(const XcdBarrier& b) {
  asm volatile("s_waitcnt vmcnt(0)" ::: "memory");
  __syncthreads();
  if (threadIdx.x == 0) {
    unsigned* bar = b.bar;
    __builtin_amdgcn_s_waitcnt(0);
    unsigned nloc = b.st[0], nx = b.st[1];
    if (nloc == 0u) { xcd_barrier_complete(bar, b.x, nloc, nx); b.st[0] = nloc; b.st[1] = nx; }
    const unsigned old = xb_add(&bar[XB_XSUB(b.x)], 1u);
    const unsigned gen = old / nloc;
    if (old + 1u == (gen + 1u) * nloc) {
      __builtin_amdgcn_fence(__ATOMIC_RELEASE, "agent");
      asm volatile("s_waitcnt vmcnt(0)" ::: "memory");
      const unsigned og = xb_add(&bar[XB_TOP], 1u);
      const unsigned tg = og / nx;
      if (og + 1u == (tg + 1u) * nx) xb_add(&bar[XB_TOPGEN], 1u);
      else XB_SPIN(xb_ld(&bar[XB_TOPGEN]) == tg, bar);
      __builtin_amdgcn_fence(__ATOMIC_ACQUIRE, "agent");
      xb_add(&bar[XB_XGEN(b.x)], 1u);
      asm volatile("s_waitcnt vmcnt(0)" ::: "memory");
    } else {
      XB_SPIN(xb_ld(&bar[XB_XGEN(b.x)]) == gen, bar);
      __builtin_amdgcn_fence(__ATOMIC_ACQUIRE, "agent");
      asm volatile("s_waitcnt vmcnt(0)" ::: "memory");
    }
  }
  __syncthreads();
}

DI int inmap(int c) {
  if (c < 1024) return c;
  if (c < 1536) return c + 512;
  if (c < 2048) return c + 512;
  if (c < 2304) return c + 512;
  if (c < 2432) return c + 512;
  if (c < 2560) return c + 640;
  if (c < 3072) return c + 792;
  if (c < 4096) return c + 792;
  if (c < 5120) return c + 792;
  if (c < 5376) return c < 5144 ? c - 1792 : -1;
  if (c < 5888) return c - 4352;
  if (c < 6016) return c - 2944;
  return c - 2816;
}

DI void tr_tile(const float* __restrict__ src, int ld, int K, int k0, int n0, bool use_map, const float* __restrict__ scale, bf16_t* __restrict__ dst, int ldd, float* tile) {
  const int tid = my_tid();
  {
    const int nl = tid & 63, kk = tid >> 6;
    int n = n0 + nl; asm volatile("" : "+v"(n));
    const int sc = use_map ? inmap(n) : n;
#pragma unroll
    for (int r = 0; r < 8; ++r) {
      const int k = k0 + r * 8 + kk;
      float v = 0.f;
      if (sc >= 0) { v = src[(long)k * ld + sc]; if (scale) v *= scale[k]; }
      tile[(r * 8 + kk) * 65 + nl] = v;
    }
  }
  __syncthreads();
  {
    const int nl = tid >> 3, ks = tid & 7;
    unsigned o[4];
#pragma unroll
    for (int e = 0; e < 4; ++e) o[e] = pk2(tile[(ks * 8 + 2 * e) * 65 + nl], tile[(ks * 8 + 2 * e + 1) * 65 + nl]);
    *(u32x4*)(dst + (long)(n0 + nl) * ldd + k0 + ks * 8) = (u32x4){o[0], o[1], o[2], o[3]};
  }
  __syncthreads();
}

DI void tr_job(const float* src, int ld, int K, int N, bool use_map, const float* scale, bf16_t* dst, int ldd, float* tile) {
  const int nk = K >> 6, nn = N >> 6;
  for (int t = blockIdx.x; t < nk * nn; t += gridDim.x) tr_tile(src, ld, K, (t % nk) * 64, (t / nk) * 64, use_map, scale, dst, ldd, tile);
}

DI void convert_weights(const Params& p0, int l, unsigned char* lds, int which) {
  const Params p = relaunder(p0);
  float* tile = (float*)lds;
  if (which & 1) {
    tr_job(p.w_in + (long)l * D_MODEL * N_IN, N_IN, D_MODEL, NP, true, p.norm_g + l * D_MODEL, p.wt_in(), LDX, tile);
    for (int kv = 0; kv < 2; ++kv) {
      tr_job(p.cmp_w1 + (long)(l * 2 + kv) * 2048 * 256, 256, 2048, 256, false, nullptr, p.w1t() + (long)kv * 256 * 2048, 2048, tile);
      tr_job(p.cmp_w2 + (long)(l * 2 + kv) * 256 * 64, 64, 256, 64, false, nullptr, p.w2t() + (long)kv * 64 * 256, 256, tile);
    }
    tr_job(p.w_up_a + (long)l * 512 * 1024, 1024, 512, 1024, false, nullptr, p.wupa_t(), 512, tile);
    tr_job(p.w_up_b + (long)l * 512 * 1024, 1024, 512, 1024, false, nullptr, p.wupb_t(), 512, tile);
  }
  if (which & 2) tr_job(p.w_out + (long)l * 1024 * 1024, 1024, 1024, 1024, false, nullptr, p.wout_t(), 1024, tile);
}

DI void phase_prologue(const Params& p, unsigned char* lds) {
  const int tid = my_tid();
  convert_weights(p, 0, lds, 3);
  {
    const int lane = tid & 63;
    for (int wi = blockIdx.x * 8 + (tid >> 6); wi < DEPTH * 2 * 16 * 4; wi += gridDim.x * 8) {
      const int jq = wi & 3, kq = (wi >> 2) & 15, it = wi >> 6;
      const float* w1 = p.cmp_w1 + (long)it * 2048 * 256 + (long)kq * 128 * 256 + jq * 64 + lane; const float* pe = p.cmp_pe + (long)it * 2048 + kq * 128;
      float s0 = kq == 0 ? p.cmp_b1[it * 256 + jq * 64 + lane] : 0.f, s1 = 0.f, s2 = 0.f, s3 = 0.f;
#pragma unroll 4
      for (int k = 0; k < 128; k += 4) {
        s0 += pe[k] * w1[(long)k * 256]; s1 += pe[k + 1] * w1[(long)(k + 1) * 256]; s2 += pe[k + 2] * w1[(long)(k + 2) * 256]; s3 += pe[k + 3] * w1[(long)(k + 3) * 256];
      }
      p.b1eff()[(it * 16 + kq) * 256 + jq * 64 + lane] = (s0 + s1) + (s2 + s3);
    }
  }
  if (blockIdx.x == 1 && tid < DEPTH * 3) {
    const int l = tid / 3, br = tid % 3;
    float mq = 0.f, mk = 0.f;
    for (int d = 0; d < 64; ++d) { mq = fmaxf(mq, fabsf(p.q_norm_g[l * 64 + d])); mk = fmaxf(mk, fabsf(p.k_norm_g[(l * 3 + br) * 64 + d])); }
    p.mfix()[l * 4 + br] = 8.f * 1.44269504089f * mq * mk * 1.02f + 0.25f;
  }
  if (blockIdx.x == 0) { for (int i = tid; i < DEPTH * 64; i += NTHR) p.qng()[i] = p.q_norm_g[i]; for (int i = tid; i < DEPTH * 192; i += NTHR) p.kng()[i] = p.k_norm_g[i]; }
  const long gtid = (long)blockIdx.x * NTHR + tid, gn = (long)gridDim.x * NTHR;
  for (long i = gtid; i < (long)NTOK * 32; i += gn) {
    const int f = (int)(i & 31); const long tok = i >> 5;
    const float ang = (float)p.pos[tok] * inv_freq(f);
    float sn, cs; sincos_acc(ang, sn, cs);
    p.cosT()[i] = cs; p.sinT()[i] = sn;
  }
  for (long i = gtid; i < (long)BATCH * 128 * 32; i += gn) {
    const int f = (int)(i & 31); const int c = (int)((i >> 5) & 127); const int b = (int)(i >> 12);
    float cs = 1.f, sn = 0.f;
    if (c < NCMP) {
      float sum = 0.f;
      for (int k = 0; k < 32; ++k) sum += (float)p.pos[b * SEQ + c * 16 + k];
      const float ang = (sum * (1.f / 32.f)) * inv_freq(f);
      sincos_acc(ang, sn, cs);
    }
    p.cosC()[i] = cs; p.sinC()[i] = sn;
  }
  const int lane = tid & 63;
  for (long row = (long)blockIdx.x * 8 + (tid >> 6); row < NTOK; row += (long)gridDim.x * 8) {
    const float* xr = p.x_in + row * D_MODEL; bf16_t* xo = p.xb() + row * LDX;
    float ss = 0.f;
#pragma unroll
    for (int u = 0; u < 4; ++u) {
      const f32x4 v = *(const f32x4*)(xr + u * 256 + lane * 4);
      ss += v[0] * v[0] + v[1] * v[1] + v[2] * v[2] + v[3] * v[3];
      *(u32x2*)(xo + u * 256 + lane * 4) = (u32x2){pk2(v[0], v[1]), pk2(v[2], v[3])};
    }
#pragma unroll
    for (int o = 32; o >= 1; o >>= 1) ss += __shfl_xor(ss, o);
    if (lane < 8) p.part()[row * 16 + lane] = lane == 0 ? ss : 0.f;
  }
}

DI void phaseA_epilogue(const Params& p, int layer, int mt, int nt, const f32x4 (&acc)[8][4], const float* rs_s) {
  const int tid = my_tid(), lane = tid & 63, w = tid >> 6, wa = w >> 2, wb = w & 3, qi = lane & 15, quad = lane >> 4;
  if (nt >= 21) {
    bf16_t* dstb; int nh, head;
    if (nt < 23) { dstb = p.sbvt(); nh = 8; head = (nt - 21) * 4 + wb; } else if (wb < 2) { dstb = p.vst(); nh = 2; head = wb; } else { dstb = p.vwt(); nh = 2; head = wb - 2; }
    const int tok0 = mt * 256, b = tok0 >> 11, s0 = (tok0 & 2047) + wa * 128 + quad * 4;
#pragma unroll
    for (int i = 0; i < 8; ++i) {
      const int tl = wa * 128 + i * 16 + quad * 4;
      const float r0 = rs_s[tl], r1 = rs_s[tl + 1], r2 = rs_s[tl + 2], r3 = rs_s[tl + 3];
#pragma unroll
      for (int j = 0; j < 4; ++j) {
        const int d = j * 16 + qi;
        const f32x4 v = acc[i][j];
        const int sq = s0 + i * 16;
        bf16_t* dst = dstb + (long)(b * nh + head) * 64 * SEQ + (long)(sq >> 5) * 2048 + d * 32 + (sq & 31);
        *(u32x2*)dst = (u32x2){pk2(v[0] * r0, v[1] * r1), pk2(v[2] * r2, v[3] * r3)};
      }
    }
    return;
  }
  const bool headtype = nt < 4 || (nt >= 6 && nt < 10);
#pragma unroll
  for (int j = 0; j < 4; ++j) {
    const int tl = wb * 64 + j * 16 + qi; const long tok = (long)mt * 256 + tl; const int b = (int)(tok >> 11), sq = (int)(tok & 2047);
    const float rs = rs_s[tl];
    if (headtype) {
#pragma unroll
      for (int ih = 0; ih < 2; ++ih) {
        const int hit = wa * 2 + ih;
        f32x4 v[4];
#pragma unroll
        for (int i = 0; i < 4; ++i) v[i] = acc[ih * 4 + i][j] * rs;
        bf16_t* dstb; int nh, head; const float* g = nullptr;
        if (nt < 2) { dstb = p.sbq(); nh = 8; head = nt * 4 + hit; }
        else if (nt < 4) { dstb = p.sbk(); nh = 8; head = (nt - 2) * 4 + hit; }
        else if (nt < 8) { dstb = p.nq(); nh = 8; head = (nt - 6) * 4 + hit; g = p.qng() + layer * 64; }
        else if (nt == 8) { dstb = hit < 2 ? p.kcr() : p.vcr(); nh = 2; head = hit & 1; }
        else { dstb = hit < 2 ? p.ks() : p.kw(); nh = 2; head = hit & 1; g = p.kng() + (layer * 3 + (hit < 2 ? 1 : 2)) * 64; }
        if (g) {
          float ss = 0.f;
#pragma unroll
          for (int i = 0; i < 4; ++i) ss += v[i][0] * v[i][0] + v[i][1] * v[i][1] + v[i][2] * v[i][2] + v[i][3] * v[i][3];
          ss += __shfl_xor(ss, 16); ss += __shfl_xor(ss, 32);
          const float rn = rsqrtf(ss * (1.f / 64.f) + NORM_EPS);
#pragma unroll
          for (int i = 0; i < 4; ++i) { const f32x4 gg = *(const f32x4*)(g + i * 16 + quad * 4); v[i] = v[i] * rn * gg; }
#pragma unroll
          for (int i = 0; i < 2; ++i) {
            const f32x4 cs = *(const f32x4*)(p.cosT() + tok * 32 + i * 16 + quad * 4), sn = *(const f32x4*)(p.sinT() + tok * 32 + i * 16 + quad * 4);
            const f32x4 x1 = v[i], x2 = v[i + 2];
            v[i] = x1 * cs - x2 * sn; v[i + 2] = x2 * cs + x1 * sn;
          }
        }
        bf16_t* dst = dstb + ((long)(b * nh + head) * SEQ + sq) * 64 + quad * 4;
#pragma unroll
        for (int i = 0; i < 4; ++i) *(u32x2*)(dst + i * 16) = (u32x2){pk2(v[i][0], v[i][1]), pk2(v[i][2], v[i][3])};
        asm volatile("" ::: "memory");
      }
    } else if (nt == 20) {
      if (wa == 0) {
#pragma unroll
        for (int i = 0; i < 2; ++i) {
          const int f = i * 16 + quad * 4;
          const f32x4 v = acc[i][j] * rs;
          if (f < 24) { const f32x4 o = {sigmoidf_(v[0]), sigmoidf_(v[1]), sigmoidf_(v[2]), sigmoidf_(v[3])}; *(f32x4*)(p.ngate() + tok * 32 + f) = o; }
        }
      }
    } else {
      bf16_t* dstb; int ldd, c0; bool sil;
      if (nt < 6) { dstb = p.sbz(); ldd = 512; c0 = (nt - 4) * 256; sil = true; }
      else if (nt < 12) { dstb = p.nz(); ldd = 512; c0 = (nt - 10) * 256; sil = true; }
      else if (nt < 16) { dstb = p.ga(); ldd = 1024; c0 = (nt - 12) * 256; sil = false; }
      else { dstb = p.gb(); ldd = 1024; c0 = (nt - 16) * 256; sil = false; }
      bf16_t* dst = dstb + tok * ldd + c0 + wa * 128 + quad * 4;
#pragma unroll
      for (int i = 0; i < 8; ++i) {
        const f32x4 v = acc[i][j] * rs;
        f32x4 o;
#pragma unroll
        for (int r = 0; r < 4; ++r) o[r] = sil ? siluf_(v[r]) : sigmoidf_(v[r]);
        *(u32x2*)(dst + i * 16) = (u32x2){pk2(o[0], o[1]), pk2(o[2], o[3])};
      }
    }
    asm volatile("" ::: "memory");
  }
}

DI void phaseA(const Params& p0, const Slot sl, int layer, unsigned char* lds, int fake = 0) {
  const Params p = relaunder(p0);
  bf16_t* gl = (bf16_t*)lds; float* rs_s = (float*)(lds + LDS_GEMM_BYTES);
  const bf16_t* Wt = p.wt_in();
  int mt, nt;
  for (int it = 0; tile_order(sl, it, NT_IN, mt, nt); ++it) {
    if (my_tid() < 256) {
      const float* pp = p.part() + ((long)mt * 256 + my_tid()) * 16;
      const f32x4 v0 = *(const f32x4*)pp, v1 = *(const f32x4*)(pp + 4);
      const float s = ((v0[0] + v0[1]) + (v0[2] + v0[3])) + ((v1[0] + v1[1]) + (v1[2] + v1[3]));
      rs_s[my_tid()] = rsqrtf(s * (1.f / 1024.f) + NORM_EPS);
    }
    const int mtl = fake == 3 ? 0 : (fake == 4 ? sl.xcd * 16 + (sl.slot & 7) : mt), ntl = fake == 3 ? 0 : (fake == 4 ? (sl.slot >> 3) : nt);
    const bf16_t* Xg = p.xb() + (long)mtl * 256 * LDX; const bf16_t* Wg = Wt + (long)ntl * 256 * LDX;
    f32x4 acc[8][4]; zero_acc(acc);
    const int kstep = (fake == 1 || fake == 2) ? 0 : 64;
    int mt2, nt2;
    const bool more = !fake && tile_order(sl, it + 1, NT_IN, mt2, nt2);
    const bf16_t* Xn = more ? p.xb() + (long)mt2 * 256 * LDX : Xg; const bf16_t* Wn = more ? Wt + (long)nt2 * 256 * LDX : Wg;
    const bool vn = more ? nt2 >= 21 : nt >= 21;
    gemm_core(nt >= 21 ? Xg : Wg, LDX, nt >= 21 ? Wg : Xg, LDX, D_MODEL, gl, acc, kstep, !fake && it > 0, vn ? Xn : Wn, vn ? Wn : Xn);
    if (!fake) phaseA_epilogue(p, layer, mt, nt, acc, rs_s);
    else if (acc[0][0][0] == 123.456f && acc[7][3][3] == 5.f) p.dummy()[0] = 1;
    __syncthreads();
  }
}

DI void compress_partial(const Params& p, int ci, unsigned char* lds) {
  bf16_t* gl = (bf16_t*)lds;
  const int split = ci & 3, item = ci >> 2, kv = item & 1, pair = item >> 1;
  const bf16_t* src = (kv ? p.vcr() : p.kcr()) + (long)pair * 256 * 1024 + split * 512;
  const bf16_t* W1 = p.w1t() + (long)kv * 256 * 2048 + split * 512;
  f32x4 acc[8][4]; zero_acc(acc);
  gemm_core(W1, 2048, src, 1024, 512, gl, acc);
  const int tid = my_tid(), lane = tid & 63, w = tid >> 6, wa = w >> 2, wb = w & 3, qi = lane & 15, quad = lane >> 4;
  float* dst = p.hpre() + ((long)(split * 32 + item) * 256) * 256;
#pragma unroll
  for (int i = 0; i < 8; ++i)
#pragma unroll
    for (int j = 0; j < 4; ++j) *(f32x4*)(dst + (long)(wb * 64 + j * 16 + qi) * 256 + wa * 128 + i * 16 + quad * 4) = acc[i][j];
}

DI void phaseB2(const Params& p0, int layer, unsigned char* lds) {
  const Params p = relaunder(p0);
  const int tid = my_tid(), lane = tid & 63, w = tid >> 6, qi = lane & 15, quad = lane >> 4;
  float* bias_s = (float*)lds;
  {
    const float* b1 = p.b1eff() + (long)(layer * 2 + (tid >> 8)) * 16 * 256 + (tid & 255);
    float sacc = 0.f;
#pragma unroll
    for (int kq = 0; kq < 16; ++kq) sacc += b1[kq * 256];
    bias_s[tid] = sacc;
  }
  __syncthreads();
  if (w < 2)
  for (int wi = blockIdx.x * 2 + w; wi < 32 * 16; wi += gridDim.x * 2) {
    const int item = wi >> 4, r16 = wi & 15, kv = item & 1, pair = item >> 1;
    const int row = r16 * 16 + qi;
    const bf16_t* W2 = p.w2t() + (long)kv * 64 * 256;
    const float* hp = p.hpre() + ((long)item * 256 + row) * 256 + quad * 8;
    f32x4 o[4];
#pragma unroll
    for (int dt = 0; dt < 4; ++dt) o[dt] = (f32x4){0.f, 0.f, 0.f, 0.f};
#pragma unroll 1
    for (int ksx = 0; ksx < 8; ++ksx) {
      f32x4 h0 = *(const f32x4*)(bias_s + kv * 256 + ksx * 32 + quad * 8), h1 = *(const f32x4*)(bias_s + kv * 256 + ksx * 32 + quad * 8 + 4);
#pragma unroll
      for (int sp = 0; sp < 4; ++sp) { const float* q = hp + (long)sp * 32 * 256 * 256 + ksx * 32; h0 += *(const f32x4*)q; h1 += *(const f32x4*)(q + 4); }
      const bf16x8 hf = mk8((u32x4){pk2(siluf_(h0[0]), siluf_(h0[1])), pk2(siluf_(h0[2]), siluf_(h0[3])), pk2(siluf_(h1[0]), siluf_(h1[1])), pk2(siluf_(h1[2]), siluf_(h1[3]))});
#pragma unroll
      for (int dt = 0; dt < 4; ++dt) {
        const bf16x8 wf = ld8(W2 + (long)(dt * 16 + qi) * 256 + ksx * 32 + quad * 8);
        o[dt] = kv ? MFMA16(hf, wf, o[dt]) : MFMA16(wf, hf, o[dt]);
      }
    }
    const int bg = pair * 2 + (r16 >> 3);
    if (kv == 0) {
      const float* g = p.kng() + (layer * 3 + 0) * 64;
      const int b = bg >> 1, c = (r16 & 7) * 16 + qi;
      float ss = 0.f;
#pragma unroll
      for (int dt = 0; dt < 4; ++dt) ss += o[dt][0] * o[dt][0] + o[dt][1] * o[dt][1] + o[dt][2] * o[dt][2] + o[dt][3] * o[dt][3];
      ss += __shfl_xor(ss, 16); ss += __shfl_xor(ss, 32);
      const float rn = rsqrtf(ss * (1.f / 64.f) + NORM_EPS);
#pragma unroll
      for (int dt = 0; dt < 4; ++dt) { const f32x4 gg = *(const f32x4*)(g + dt * 16 + quad * 4); o[dt] = o[dt] * rn * gg; }
#pragma unroll
      for (int dt = 0; dt < 2; ++dt) {
        const long ti = ((long)b * 128 + c) * 32 + dt * 16 + quad * 4;
        const f32x4 cs = *(const f32x4*)(p.cosC() + ti), sn = *(const f32x4*)(p.sinC() + ti);
        const f32x4 x1 = o[dt], x2 = o[dt + 2];
        o[dt] = x1 * cs - x2 * sn; o[dt + 2] = x2 * cs + x1 * sn;
      }
      bf16_t* dst = p.kc() + ((long)bg * 128 + c) * 64 + quad * 4;
#pragma unroll
      for (int dt = 0; dt < 4; ++dt) {
        u32x2 ov = (u32x2){pk2(o[dt][0], o[dt][1]), pk2(o[dt][2], o[dt][3])};
        if (c >= NCMP) ov = (u32x2){0u, 0u};
        *(u32x2*)(dst + dt * 16) = ov;
      }
    } else {
#pragma unroll
      for (int dt = 0; dt < 4; ++dt) {
        const int c0 = (r16 & 7) * 16 + quad * 4;
        f32x4 v = o[dt];
        if (c0 + 3 >= NCMP) v[3] = 0.f;
        *(u32x2*)(p.vct() + ((long)bg * 64 + dt * 16 + qi) * 128 + c0) = (u32x2){pk2(v[0], v[1]), pk2(v[2], v[3])};
      }
    }
  }
  __syncthreads();
}

struct SbFrag { bf16x8 k[2][2]; bf16x8 v[4]; };
DI void sb_load(SbFrag& f, const bf16_t* __restrict__ kp0, const bf16_t* __restrict__ vp0, int kb) {
#pragma unroll
  for (int a = 0; a < 2; ++a) { f.k[a][0] = ld8(kp0 + (long)(kb + 4 * a) * 64); f.k[a][1] = ld8(kp0 + (long)(kb + 4 * a) * 64 + 32); }
#pragma unroll
  for (int dt = 0; dt < 4; ++dt) f.v[dt] = ld8(vp0 + (long)kb * 64 + dt * 16 * 32);
}
template <bool FULL>
DI void sb_chunk(const SbFrag& f, int kb, int t, int quad, const bf16x8 (&qf)[2], f32x4 (&o)[4], float& carry) {
  f32x4 s[2];
#pragma unroll
  for (int a = 0; a < 2; ++a) {
    s[a] = MFMA16(f.k[a][0], qf[0], ((f32x4){0.f, 0.f, 0.f, 0.f}));
    s[a] = MFMA16(f.k[a][1], qf[1], s[a]);
  }
  float L[8], ls[8]; bool val[8];
  float tot = 0.f;
#pragma unroll
  for (int idx = 0; idx < 8; ++idx) {
    const float z = s[idx >> 2][idx & 3] * (0.125f * 1.44269504089f);
    val[idx] = FULL ? true : (kb + 8 * quad + idx < t);
    const float sp = fmaxf(z, 0.f) + __builtin_amdgcn_logf(1.f + __builtin_amdgcn_exp2f(-fabsf(z)));
    L[idx] = val[idx] ? -sp : 0.f;
    ls[idx] = z - sp;
    tot += L[idx];
  }
  const float a1 = __shfl_xor(tot, 16), a2 = __shfl_xor(tot, 32), a3 = __shfl_xor(a1, 32);
  const float higher = ((quad ^ 1) > quad ? a1 : 0.f) + ((quad ^ 2) > quad ? a2 : 0.f) + ((quad ^ 3) > quad ? a3 : 0.f);
  float run = carry + higher;
  float wv[8];
#pragma unroll
  for (int idx = 7; idx >= 0; --idx) {
    const float e = __builtin_amdgcn_exp2f(ls[idx] + run);
    wv[idx] = val[idx] ? e : 0.f;
    run += L[idx];
  }
  carry += (tot + a1) + (a2 + a3);
  const bf16x8 pf = mk8((u32x4){pk2(wv[0], wv[1]), pk2(wv[2], wv[3]), pk2(wv[4], wv[5]), pk2(wv[6], wv[7])});
#pragma unroll
  for (int dt = 0; dt < 4; ++dt) o[dt] = MFMA16(f.v[dt], pf, o[dt]);
}

DI void sb_attn_wave(const Params& p, int b, int h, int t0, bf16_t* ybase) {
  const int lane = my_tid() & 63, qi = lane & 15, quad = lane >> 4;
  const bf16_t* Q = p.sbq() + (long)(b * 8 + h) * SEQ * 64;
  const bf16_t* K = p.sbk() + (long)(b * 8 + h) * SEQ * 64;
  const bf16_t* Vt = p.sbvt() + (long)(b * 8 + h) * 64 * SEQ;
  const int tA = t0 + qi, tB = t0 + 16 + qi;
  bf16x8 qa[2], qb[2];
  qa[0] = ld8(Q + (long)tA * 64 + quad * 8); qa[1] = ld8(Q + (long)tA * 64 + 32 + quad * 8);
  qb[0] = ld8(Q + (long)tB * 64 + quad * 8); qb[1] = ld8(Q + (long)tB * 64 + 32 + quad * 8);
  f32x4 oa[4], ob[4];
#pragma unroll
  for (int dt = 0; dt < 4; ++dt) { oa[dt] = (f32x4){0.f, 0.f, 0.f, 0.f}; ob[dt] = oa[dt]; }
  float ca = 0.f, cb = 0.f;
  const int krow = 8 * (qi >> 2) + (qi & 3);
  const bf16_t* kp0 = K + (long)krow * 64 + quad * 8;
  const bf16_t* vp0 = Vt + qi * 32 + 8 * quad;
  int kb = t0;
  SbFrag f0, f1, f2;
  sb_load(f0, kp0, vp0, kb); sb_load(f1, kp0, vp0, max(kb - 32, 0));
#define SB_STEP(F, KB) (((KB) + 32 <= t0) ? (sb_chunk<true>(F, KB, tA, quad, qa, oa, ca), sb_chunk<true>(F, KB, tB, quad, qb, ob, cb)) : (sb_chunk<false>(F, KB, tA, quad, qa, oa, ca), sb_chunk<false>(F, KB, tB, quad, qb, ob, cb)), __all(ca < -160.f && cb < -160.f))
  while (true) {
    sb_load(f2, kp0, vp0, max(kb - 64, 0));
    if (SB_STEP(f0, kb) || kb < 32) break;
    sb_load(f0, kp0, vp0, max(kb - 96, 0));
    if (SB_STEP(f1, kb - 32) || kb < 64) break;
    sb_load(f1, kp0, vp0, max(kb - 128, 0));
    if (SB_STEP(f2, kb - 64) || kb < 96) break;
    kb -= 96;
  }
#undef SB_STEP
#pragma unroll
  for (int half = 0; half < 2; ++half) {
    const long zo = ((long)b * SEQ + (half ? tB : tA)) * 512 + h * 64 + quad * 4;
    const bf16_t* zp = p.sbz() + zo; bf16_t* yp = ybase + zo;
#pragma unroll
    for (int dt = 0; dt < 4; ++dt) {
      const f32x4 o = half ? ob[dt] : oa[dt];
      const u32x2 zz = *(const u32x2*)(zp + dt * 16);
      *(u32x2*)(yp + dt * 16) = (u32x2){pk2(o[0] * bflo(zz[0]), o[1] * bfhi(zz[0])), pk2(o[2] * bflo(zz[1]), o[3] * bfhi(zz[1]))};
    }
  }
}

DI void phaseB(const Params& p0, int layer, unsigned char* lds, bool probe) {
  const int NITEM = 128 + BATCH * 8 * 8;
  for (int it = blockIdx.x; it < NITEM; it += gridDim.x) {
    const Params p = relaunder(p0);
    if (it < 128) { compress_partial(p, it, lds); continue; }
    const int i = it - 128, qt = 7 - (i >> 7), bh = i & 127;
    sb_attn_wave(p, bh >> 3, bh & 7, qt * 256 + (my_tid() >> 6) * 32, probe ? p.dummy() : p.sbz());
  }
}

constexpr int NSA_LO_BYTES = 8 * 8192;
constexpr int NSA_KROW = 144, NSA_VROW = 80;
constexpr int NSA_SLOT = 32 * NSA_KROW + 64 * NSA_VROW;
constexpr int NSA_SLOT0 = NSA_LO_BYTES, NSA_BLIST = NSA_SLOT0 + 2 * NSA_SLOT, NSA_UMW = NSA_BLIST + 64 * 4;

struct KVFrag { bf16x8 k[2][2]; bf16x8 v[4]; };
DI void nsa_ldsfrag(KVFrag& f, const unsigned char* slot, int qi, int quad) {
  const int krow = 8 * (qi >> 2) + (qi & 3);
#pragma unroll
  for (int a = 0; a < 2; ++a) { const unsigned char* kp = slot + (krow + 4 * a) * NSA_KROW + quad * 16; f.k[a][0] = mk8(*(const u32x4*)kp); f.k[a][1] = mk8(*(const u32x4*)(kp + 64)); }
#pragma unroll
  for (int dt = 0; dt < 4; ++dt) f.v[dt] = mk8(*(const u32x4*)(slot + 32 * NSA_KROW + (dt * 16 + qi) * NSA_VROW + quad * 16));
}
template <int MODE>
DI void nsa_chunk(const KVFrag& f, int kb, int t, bool selbit, const bf16x8 (&qf)[4][2], f32x4 (&O)[4][4], float (&m)[4], float (&l)[4], int quad, bool online) {
  const float SC = 0.125f * 1.44269504089f;
  bool val[8];
#pragma unroll
  for (int idx = 0; idx < 8; ++idx) {
    const int key = kb + 8 * quad + idx;
    val[idx] = MODE == 0 ? (selbit && key <= t) : (key <= t && key > t - 512);
  }
#pragma unroll
  for (int hh = 0; hh < 4; ++hh) {
    f32x4 s[2];
#pragma unroll
    for (int a = 0; a < 2; ++a) { s[a] = MFMA16(f.k[a][0], qf[hh][0], ((f32x4){0.f, 0.f, 0.f, 0.f})); s[a] = MFMA16(f.k[a][1], qf[hh][1], s[a]); }
    float mn = m[hh];
    if (online) {
      float cm = -1e30f;
#pragma unroll
      for (int idx = 0; idx < 8; ++idx) if (val[idx]) cm = fmaxf(cm, s[idx >> 2][idx & 3] * SC);
      cm = fmaxf(cm, __shfl_xor(cm, 16)); cm = fmaxf(cm, __shfl_xor(cm, 32));
      mn = fmaxf(mn, cm);
      const float alpha = __builtin_amdgcn_exp2f(m[hh] - mn);
      m[hh] = mn; l[hh] *= alpha;
#pragma unroll
      for (int dt = 0; dt < 4; ++dt) O[hh][dt] = O[hh][dt] * alpha;
    }
    float pv[8]; float ps = 0.f;
#pragma unroll
    for (int idx = 0; idx < 8; ++idx) { pv[idx] = val[idx] ? __builtin_amdgcn_exp2f(fmaf(s[idx >> 2][idx & 3], SC, -mn)) : 0.f; ps += pv[idx]; }
    l[hh] += ps;
    const bf16x8 pf = mk8((u32x4){pk2(pv[0], pv[1]), pk2(pv[2], pv[3]), pk2(pv[4], pv[5]), pk2(pv[6], pv[7])});
#pragma unroll
    for (int dt = 0; dt < 4; ++dt) O[hh][dt] = MFMA16(f.v[dt], pf, O[hh][dt]);
  }
}

template <int MODE>
DI void nsa_branch(const bf16_t* __restrict__ Kb, const bf16_t* __restrict__ Vtb, unsigned char* lds, int nb, int t, int cur, unsigned selmask, unsigned umall,
                   const bf16x8 (&qf)[4][2], f32x4 (&O)[4][4], float (&m)[4], float (&l)[4], bool online) {
  const int tid = my_tid(), lane = tid & 63, qi = lane & 15, quad = lane >> 4;
  const int* blist = (const int*)(lds + NSA_BLIST);
  const bool isv = tid >= 256;
  const int t2 = tid & 255;
  const bf16_t* gsrc = isv ? Vtb + (t2 >> 2) * 32 + (t2 & 3) * 8 : Kb + (long)(t2 >> 3) * 64 + (t2 & 7) * 8;
  const long gmul = 64;
  const int ldst = isv ? 32 * NSA_KROW + (t2 >> 2) * NSA_VROW + (t2 & 3) * 16 : (t2 >> 3) * NSA_KROW + (t2 & 7) * 16;
  unsigned char* slot0 = lds + NSA_SLOT0; unsigned char* slot1 = slot0 + NSA_SLOT;
  const int N = 2 * nb;
  auto kbof = [&](int n) { return blist[n >> 1] * 64 + (n & 1) * 32; };
  u32x4 ra = *(const u32x4*)(gsrc + (long)kbof(0) * gmul), rb = *(const u32x4*)(gsrc + (long)kbof(1) * gmul);
  *(u32x4*)(slot0 + ldst) = ra;
  __syncthreads();
#pragma unroll 1
  for (int n = 0; n < N; n += 2) {
    const int j = blist[n >> 1];
    const bool won = MODE == 0 ? ((umall >> j) & 1u) != 0 : (j >= cur - 8 && j <= cur);
    const bool bit = (selmask >> j) & 1u;
    ra = *(const u32x4*)(gsrc + (long)kbof(min(n + 2, N - 2)) * gmul);
    if (won) { KVFrag f; nsa_ldsfrag(f, slot0, qi, quad); nsa_chunk<MODE>(f, j * 64, t, bit, qf, O, m, l, quad, online); }
    *(u32x4*)(slot1 + ldst) = rb;
    __syncthreads();
    rb = *(const u32x4*)(gsrc + (long)kbof(min(n + 3, N - 1)) * gmul);
    if (won) { KVFrag f; nsa_ldsfrag(f, slot1, qi, quad); nsa_chunk<MODE>(f, j * 64 + 32, t, bit, qf, O, m, l, quad, online); }
    *(u32x4*)(slot0 + ldst) = ra;
    __syncthreads();
  }
}

template <bool LAST>
DI void nsa_finish(u32x2* lo, f32x4 (&O)[4][4], float (&m)[4], float (&l)[4], const float (&gate)[4], const bf16_t* zp, bf16_t* yp, float minit) {
#pragma unroll
  for (int hh = 0; hh < 4; ++hh) {
    float lt = l[hh]; lt += __shfl_xor(lt, 16); lt += __shfl_xor(lt, 32);
    const float f = lt > 0.f ? gate[hh] / lt : 0.f;
#pragma unroll
    for (int dt = 0; dt < 4; ++dt) {
      const u32x2 a = lo[(hh * 4 + dt) * 64];
      const f32x4 v = (f32x4){bflo(a[0]), bfhi(a[0]), bflo(a[1]), bfhi(a[1])} + O[hh][dt] * f;
      if (LAST) {
        const u32x2 zz = *(const u32x2*)(zp + hh * 64 + dt * 16);
        *(u32x2*)(yp + hh * 64 + dt * 16) = (u32x2){pk2(v[0] * bflo(zz[0]), v[1] * bfhi(zz[0])), pk2(v[2] * bflo(zz[1]), v[3] * bfhi(zz[1]))};
      } else {
        lo[(hh * 4 + dt) * 64] = (u32x2){pk2(v[0], v[1]), pk2(v[2], v[3])};
        O[hh][dt] = (f32x4){0.f, 0.f, 0.f, 0.f};
      }
    }
    m[hh] = minit; l[hh] = 0.f;
  }
}

DI void nsa_wave(const Params& p, int layer, int b, int g, int t0, unsigned char* lds, bf16_t* ybase) {
  const int lane = my_tid() & 63, qi = lane & 15, quad = lane >> 4;
  const int t = t0 + qi, cur = t0 >> 6;
  const long tok = (long)b * SEQ + t;
  const int bg = b * 2 + g;
  u32x2* lo = (u32x2*)lds + (my_tid() >> 6) * 1024 + lane;

  const float mf_c = p.mfix()[layer * 4 + 0], mf_s = p.mfix()[layer * 4 + 1], mf_w = p.mfix()[layer * 4 + 2];
  const bool on_c = mf_c > 60.f, on_s = mf_s > 60.f, on_w = mf_w > 60.f;
  const float SC = 0.125f * 1.44269504089f;
  const bf16_t* Kc = p.kc() + (long)bg * 128 * 64;
  const bf16_t* Vc = p.vct() + (long)bg * 64 * 128;
  f32x4 ph[8];
#pragma unroll
  for (int kt = 0; kt < 8; ++kt) ph[kt] = (f32x4){0.f, 0.f, 0.f, 0.f};
#pragma unroll 1
  for (int hh = 0; hh < 4; ++hh) {
    const bf16_t* qp0 = p.nq() + ((long)(b * 8 + g * 4 + hh) * SEQ + t) * 64 + quad * 8;
    const bf16x8 q0 = ld8(qp0), q1 = ld8(qp0 + 32); const float gt = p.ngate()[tok * 32 + g * 4 + hh];
    f32x4 sc[8];
    float mx = on_c ? -1e30f : mf_c;
#pragma unroll
    for (int kt = 0; kt < 8; ++kt) {
      const bf16_t* kp = Kc + (long)(kt * 16 + qi) * 64 + quad * 8;
      sc[kt] = MFMA16(ld8(kp), q0, ((f32x4){0.f, 0.f, 0.f, 0.f}));
      sc[kt] = MFMA16(ld8(kp + 32), q1, sc[kt]);
      sc[kt] = sc[kt] * SC;
    }
    if (on_c) {
#pragma unroll
      for (int kt = 0; kt < 8; ++kt)
#pragma unroll
        for (int r = 0; r < 4; ++r) { const int c = kt * 16 + quad * 4 + r; if (c < NCMP && 16 * c + 31 <= t) mx = fmaxf(mx, sc[kt][r]); }
      mx = fmaxf(mx, __shfl_xor(mx, 16)); mx = fmaxf(mx, __shfl_xor(mx, 32));
    }
    float sum = 0.f;
#pragma unroll
    for (int kt = 0; kt < 8; ++kt)
#pragma unroll
      for (int r = 0; r < 4; ++r) {
        const int c = kt * 16 + quad * 4 + r;
        const float e = (c < NCMP && 16 * c + 31 <= t) ? __builtin_amdgcn_exp2f(sc[kt][r] - mx) : 0.f;
        sc[kt][r] = e; sum += e;
      }
    sum += __shfl_xor(sum, 16); sum += __shfl_xor(sum, 32);
    const float inv = sum > 0.f ? 1.f / sum : 0.f;
#pragma unroll
    for (int kt = 0; kt < 8; ++kt) { sc[kt] = sc[kt] * inv; ph[kt] += sc[kt]; }
    f32x4 oc[4];
#pragma unroll
    for (int dt = 0; dt < 4; ++dt) oc[dt] = (f32x4){0.f, 0.f, 0.f, 0.f};
#pragma unroll
    for (int mm = 0; mm < 4; ++mm) {
      const bf16x8 pf = mk8((u32x4){pk2(sc[2 * mm][0], sc[2 * mm][1]), pk2(sc[2 * mm][2], sc[2 * mm][3]), pk2(sc[2 * mm + 1][0], sc[2 * mm + 1][1]), pk2(sc[2 * mm + 1][2], sc[2 * mm + 1][3])});
#pragma unroll
      for (int dt = 0; dt < 4; ++dt) {
        const bf16_t* vp = Vc + (long)(dt * 16 + qi) * 128 + 32 * mm + quad * 4;
        const u32x2 lo = *(const u32x2*)vp, hi = *(const u32x2*)(vp + 16);
        oc[dt] = MFMA16(mk8((u32x4){lo[0], lo[1], hi[0], hi[1]}), pf, oc[dt]);
      }
    }
#pragma unroll
    for (int dt = 0; dt < 4; ++dt) { const f32x4 v = oc[dt] * gt; lo[(hh * 4 + dt) * 64] = (u32x2){pk2(v[0], v[1]), pk2(v[2], v[3])}; }
  }
  float imp[8];
  {
    float rot[8];
#pragma unroll
    for (int kt = 0; kt < 8; ++kt) rot[kt] = __shfl(ph[kt][3], (lane + 48) & 63);
#pragma unroll
    for (int kt = 0; kt < 8; ++kt) {
      const float extra = quad > 0 ? rot[kt] : (kt > 0 ? rot[kt > 0 ? kt - 1 : 0] : 0.f);
      const float v = (ph[kt][0] + ph[kt][1]) + (ph[kt][2] + ph[kt][3]) + extra;
      const int j = 4 * kt + quad;
      const bool forced = j == 0 || j == cur || j == cur - 1;
      imp[kt] = j <= cur ? v + (forced ? 1e4f : 0.f) : -1e30f;
    }
  }
  unsigned selmask = 0;
  {
    int rank[8];
#pragma unroll
    for (int kt = 0; kt < 8; ++kt) rank[kt] = 0;
#pragma unroll 1
    for (int q2 = 0; q2 < 4; ++q2)
#pragma unroll
      for (int k2 = 0; k2 < 8; ++k2) {
        const float ov = __shfl(imp[k2], qi + 16 * q2);
#pragma unroll
        for (int kt = 0; kt < 8; ++kt) {
          const bool before = k2 < kt || (k2 == kt && q2 < quad);
          rank[kt] += (ov > imp[kt] || (ov == imp[kt] && before)) ? 1 : 0;
        }
      }
#pragma unroll
    for (int kt = 0; kt < 8; ++kt) if (rank[kt] < 8 && 4 * kt + quad <= cur) selmask |= 1u << (4 * kt + quad);
    selmask |= __shfl_xor(selmask, 16); selmask |= __shfl_xor(selmask, 32);
  }

  unsigned umall = selmask;
  umall |= __shfl_xor(umall, 1); umall |= __shfl_xor(umall, 2); umall |= __shfl_xor(umall, 4); umall |= __shfl_xor(umall, 8);
  umall = __builtin_amdgcn_readfirstlane(umall);
  const int wv = my_tid() >> 6;
  unsigned* umw = (unsigned*)(lds + NSA_UMW); int* blist = (int*)(lds + NSA_BLIST);
  if (lane == 0) umw[wv] = umall;
  bf16x8 qf[4][2];
#pragma unroll
  for (int hh = 0; hh < 4; ++hh) {
    const bf16_t* qp = p.nq() + ((long)(b * 8 + g * 4 + hh) * SEQ + t) * 64 + quad * 8;
    qf[hh][0] = ld8(qp); qf[hh][1] = ld8(qp + 32);
  }
  float gate[3][4];
#pragma unroll
  for (int br = 1; br < 3; ++br) { const f32x4 gv = *(const f32x4*)(p.ngate() + tok * 32 + br * 8 + g * 4); gate[br][0] = gv[0]; gate[br][1] = gv[1]; gate[br][2] = gv[2]; gate[br][3] = gv[3]; }
  f32x4 O[4][4]; float m[4], l[4];
#pragma unroll
  for (int hh = 0; hh < 4; ++hh) { m[hh] = on_s ? -1e30f : mf_s; l[hh] = 0.f;
#pragma unroll
    for (int dt = 0; dt < 4; ++dt) O[hh][dt] = (f32x4){0.f, 0.f, 0.f, 0.f}; }
  __syncthreads();
  int nb;
  {
    unsigned ub = 0;
#pragma unroll
    for (int i = 0; i < 8; ++i) ub |= umw[i];
    nb = __builtin_popcount(ub);
    if (my_tid() < 32) { if ((ub >> my_tid()) & 1u) blist[__builtin_popcount(ub & ((1u << my_tid()) - 1u))] = my_tid(); }
    __syncthreads();
    nsa_branch<0>(p.ks() + (long)bg * SEQ * 64, p.vst() + (long)bg * 64 * SEQ, lds, nb, t, cur, selmask, umall, qf, O, m, l, on_s);
    nsa_finish<false>(lo, O, m, l, gate[1], nullptr, nullptr, on_w ? -1e30f : mf_w);
  }
  {
    const int cur0 = (t0 >> 7) * 2, jlo = cur0 >= 8 ? cur0 - 8 : 0;
    nb = cur0 + 2 - jlo;
    if (my_tid() < nb) blist[my_tid()] = jlo + my_tid();
    __syncthreads();
    nsa_branch<1>(p.kw() + (long)bg * SEQ * 64, p.vwt() + (long)bg * 64 * SEQ, lds, nb, t, cur, selmask, umall, qf, O, m, l, on_w);
    nsa_finish<true>(lo, O, m, l, gate[2], p.nz() + tok * 512 + g * 256 + quad * 4, ybase + tok * 512 + g * 256 + quad * 4, 0.f);
  }
  __syncthreads();
}

DI void phaseC(const Params& p0, int layer, unsigned char* lds, bool probe) {
  const int NITEM = BATCH * 2 * 16;
  for (int it = blockIdx.x; it < NITEM; it += gridDim.x) {
    const Params p = relaunder(p0);
    const int qt = 15 - (it >> 5), bg = it & 31;
    nsa_wave(p, layer, bg >> 1, bg & 1, qt * 128 + (my_tid() >> 6) * 16, lds, probe ? p.dummy() : p.nz());
  }
}

DI void phaseD(const Params& p0, const Slot sl, int layer, unsigned char* lds) {
  const Params p = relaunder(p0);
  bf16_t* gl = (bf16_t*)lds;
  int mt, nt;
  for (int it = 0; tile_order(sl, it, 4, mt, nt); ++it) {
#pragma unroll 1
    for (int which = 0; which < 2; ++which) {
      const bf16_t* Wg = (which ? p.wupb_t() : p.wupa_t()) + ((long)nt * 256) * 512;
      const bf16_t* Yg = (which ? p.nz() : p.sbz()) + (long)mt * 256 * 512;
      const bf16_t* Gg = which ? p.gb() : p.ga();
      int mt2 = mt, nt2 = nt; bool more = true;
      if (which) more = tile_order(sl, it + 1, 4, mt2, nt2);
      const bf16_t* Wn = more ? (which ? p.wupa_t() : p.wupb_t()) + ((long)nt2 * 256) * 512 : Wg;
      const bf16_t* Yn = more ? (which ? p.sbz() : p.nz()) + (long)mt2 * 256 * 512 : Yg;
      f32x4 acc[8][4]; zero_acc(acc);
      gemm_core(Wg, 512, Yg, 512, 512, gl, acc, 64, it > 0 || which, Wn, Yn);
      const int tid = my_tid(), lane = tid & 63, w = tid >> 6, wa = w >> 2, wb = w & 3, qi = lane & 15, quad = lane >> 4;
#pragma unroll
      for (int j = 0; j < 4; ++j) {
        const long tok = (long)mt * 256 + wb * 64 + j * 16 + qi;
#pragma unroll
        for (int i = 0; i < 8; ++i) {
          const long off = tok * 1024 + nt * 256 + wa * 128 + i * 16 + quad * 4;
          const u32x2 xg = *(const u32x2*)(Gg + off);
          const f32x4 v = acc[i][j];
          float o0 = bflo(xg[0]) * v[0], o1 = bfhi(xg[0]) * v[1], o2 = bflo(xg[1]) * v[2], o3 = bfhi(xg[1]) * v[3];
          if (which) { const u32x2 a = *(const u32x2*)(p.merged() + off); o0 += bflo(a[0]); o1 += bfhi(a[0]); o2 += bflo(a[1]); o3 += bfhi(a[1]); }
          *(u32x2*)(p.merged() + off) = (u32x2){pk2(o0, o1), pk2(o2, o3)};
          if ((i & 3) == 3) asm volatile("" ::: "memory");
        }
      }
    }
  }
}

DI void phaseE(const Params& p0, const Slot sl, int layer, unsigned char* lds, const float* xsrc) {
  const Params p = relaunder(p0);
  bf16_t* gl = (bf16_t*)lds;
  int mt, nt;
  for (int it = 0; tile_order(sl, it, 4, mt, nt); ++it) {
    f32x4 acc[8][4]; zero_acc(acc);
    int mt2, nt2;
    const bool more = tile_order(sl, it + 1, 4, mt2, nt2);
    const bf16_t* Wg = p.wout_t() + ((long)nt * 256) * 1024; const bf16_t* Mg = p.merged() + (long)mt * 256 * 1024;
    gemm_core(Wg, 1024, Mg, 1024, 1024, gl, acc, 64, it > 0, more ? p.wout_t() + ((long)nt2 * 256) * 1024 : Wg, more ? p.merged() + (long)mt2 * 256 * 1024 : Mg);
    const int tid = my_tid(), lane = tid & 63, w = tid >> 6, wa = w >> 2, wb = w & 3, qi = lane & 15, quad = lane >> 4;
#pragma unroll
    for (int j = 0; j < 4; ++j) {
      const long tok = (long)mt * 256 + wb * 64 + j * 16 + qi;
      float ss = 0.f;
#pragma unroll
      for (int i = 0; i < 8; ++i) {
        const long off = tok * 1024 + nt * 256 + wa * 128 + i * 16 + quad * 4;
        const f32x4 xo = *(const f32x4*)(xsrc + off);
        const f32x4 xn = xo + acc[i][j];
        *(f32x4*)(p.out + off) = xn;
        *(u32x2*)(p.xb() + off + tok * (LDX - D_MODEL)) = (u32x2){pk2(xn[0], xn[1]), pk2(xn[2], xn[3])};
        ss += xn[0] * xn[0] + xn[1] * xn[1] + xn[2] * xn[2] + xn[3] * xn[3];
      }
      ss += __shfl_xor(ss, 16); ss += __shfl_xor(ss, 32);
      if (quad == 0) p.part()[tok * 16 + nt * 2 + wa] = ss;
    }
  }
}

#ifndef STOP_AFTER
#define STOP_AFTER 0
#endif
constexpr int LDS_BYTES = LDS_GEMM_BYTES + 1024;

__global__ void __launch_bounds__(512) hybrid_megakernel(Params p) {
  extern __shared__ __attribute__((aligned(16))) unsigned char lds[];
  cg::grid_group grid = cg::this_grid();
  __shared__ int s_xcc, s_rank, s_ok;
  __shared__ unsigned s_bar[4];
  if (threadIdx.x == 0) { s_bar[0] = 0u; s_bar[1] = 0u; }
  __syncthreads();
  const XcdBarrier xb = xcd_barrier_post((unsigned*)(p.ws + OFF_BAR), (volatile LAS unsigned*)s_bar);
  if (threadIdx.x == 0) {
    const unsigned xcc = (unsigned)__builtin_amdgcn_s_getreg((3 << 11) | 20) & 7u;
    s_xcc = (int)xcc; s_rank = (int)atomicAdd(p.ctl() + xcc, 1u);
  }
  phase_prologue(p, lds);
  grid.sync();
  if (threadIdx.x == 0) {
    int ok = 1;
    for (int i = 0; i < 8; ++i) ok &= (__hip_atomic_load(p.ctl() + i, __ATOMIC_RELAXED, __HIP_MEMORY_SCOPE_AGENT) == (gridDim.x >> 3));
    s_ok = ok;
  }
  __syncthreads();
  const Slot sl = {s_ok ? s_xcc : (int)(blockIdx.x & 7), s_ok ? s_rank : (int)(blockIdx.x >> 3)};
  for (int layer = 0; layer < DEPTH; ++layer) {
    if (layer > 0) convert_weights(p, layer, lds, 2);
    if (STOP_AFTER != 0 && STOP_AFTER == layer * 10) return;
    phaseA(p, sl, layer, lds);
    xcd_barrier(xb);
#ifdef PROBE_A
    phaseA(p, sl, layer, lds, PROBE_A >= 2 ? PROBE_A : 0);
    xcd_barrier(xb);
#endif
    if (STOP_AFTER == layer * 10 + 1) return;
#ifdef PROBE_B
    phaseB(p, layer, lds, true);
    xcd_barrier(xb);
#endif
    phaseB(p, layer, lds, false);
    xcd_barrier(xb);
    phaseB2(p, layer, lds);
    xcd_barrier(xb);
    if (STOP_AFTER == layer * 10 + 2) return;
#ifdef PROBE_C
    phaseC(p, layer, lds, true);
    xcd_barrier(xb);
#endif
    phaseC(p, layer, lds, false);
    xcd_barrier(xb);
    if (STOP_AFTER == layer * 10 + 3) return;
    phaseD(p, sl, layer, lds);
    xcd_barrier(xb);
#ifdef PROBE_D
    phaseD(p, sl, layer, lds);
    xcd_barrier(xb);
#endif
    if (STOP_AFTER == layer * 10 + 4) return;
    if (layer == 0) phaseE(p, sl, layer, lds, p.x_in); else phaseE(p, sl, layer, lds, p.out);
    if (layer + 1 < DEPTH) convert_weights(p, layer + 1, lds, 1);
    if (layer + 1 < DEPTH) xcd_barrier(xb);
    if (STOP_AFTER == layer * 10 + 5) return;
  }
}

extern "C" void kernel_launch(void* const* d_in, const int* in_sizes, int n_in, void* d_out, int out_size,
                              void* d_ws, size_t ws_size, hipStream_t stream) {
  static int grid_blocks = 0;
  if (!grid_blocks) {
    int dev = 0, cus = 0, per_cu = 0;
    (void)hipGetDevice(&dev);
    (void)hipDeviceGetAttribute(&cus, hipDeviceAttributeMultiprocessorCount, dev);
    if (hipFuncSetAttribute((const void*)hybrid_megakernel, hipFuncAttributeMaxDynamicSharedMemorySize, LDS_BYTES) != hipSuccess) fprintf(stderr, "hipFuncSetAttribute(max dynamic LDS) failed\n");
    (void)hipOccupancyMaxActiveBlocksPerMultiprocessor(&per_cu, hybrid_megakernel, NTHR, LDS_BYTES);
    (void)hipGetLastError();
    if (per_cu > 1) per_cu = 1;
    if (per_cu < 1) per_cu = 1;
    grid_blocks = (cus * per_cu) & ~7;
  }
  Params a{};
  a.x_in = (const float*)d_in[0]; a.pos = (const int*)d_in[1]; a.norm_g = (const float*)d_in[2]; a.w_in = (const float*)d_in[3];
  a.q_norm_g = (const float*)d_in[4]; a.k_norm_g = (const float*)d_in[5]; a.cmp_pe = (const float*)d_in[6]; a.cmp_w1 = (const float*)d_in[7];
  a.cmp_b1 = (const float*)d_in[8]; a.cmp_w2 = (const float*)d_in[9]; a.w_up_a = (const float*)d_in[10]; a.w_up_b = (const float*)d_in[11];
  a.w_out = (const float*)d_in[12];
  a.out = (float*)d_out; a.ws = (unsigned char*)d_ws;
  if (WS_NEED > ws_size) { fprintf(stderr, "workspace too small: need %zu have %zu\n", (size_t)WS_NEED, ws_size); return; }
  (void)hipMemsetAsync((unsigned char*)d_ws + OFF_CTL, 0, 256, stream);
  (void)hipMemsetAsync((unsigned char*)d_ws + OFF_BAR, 0, 3456 * 4, stream);
  void* args[] = {&a};
  hipError_t e = hipLaunchCooperativeKernel((void*)hybrid_megakernel, dim3(grid_blocks), dim3(NTHR), args, LDS_BYTES, stream);
  if (e != hipSuccess) fprintf(stderr, "cooperative launch failed: %s (grid %d)\n", hipGetErrorString(e), grid_blocks);
}
```

```cpp
#include <hip/hip_runtime.h>
#include <hip/hip_cooperative_groups.h>
#include <cstdio>
#include <cstdint>
namespace cg = cooperative_groups;

typedef unsigned short bf16_t;
typedef short bf16x8 __attribute__((ext_vector_type(8)));
typedef float f32x4 __attribute__((ext_vector_type(4)));
typedef float f32x2 __attribute__((ext_vector_type(2)));
typedef unsigned u32x4 __attribute__((ext_vector_type(4)));
typedef unsigned u32x2 __attribute__((ext_vector_type(2)));
typedef __bf16 bf16x2_t __attribute__((ext_vector_type(2)));

#define DI __device__ __forceinline__
#define MFMA16(a, b, c) __builtin_amdgcn_mfma_f32_16x16x32_bf16((a), (b), (c), 0, 0, 0)

constexpr int D_MODEL = 1024, BATCH = 16, SEQ = 2048, DEPTH = 4, NTOK = BATCH * SEQ;
constexpr int N_IN = 5912, NP = 6144, NT_IN = 24;
constexpr int NTHR = 512;
constexpr int LDX = D_MODEL + 64;
constexpr int NCMP = 127;
constexpr float NORM_EPS = 1e-6f;

DI unsigned pk2(float lo, float hi) { f32x2 v = {lo, hi}; bf16x2_t b = __builtin_convertvector(v, bf16x2_t); return __builtin_bit_cast(unsigned, b); }
DI float bflo(unsigned u) { return __uint_as_float(u << 16); }
DI float bfhi(unsigned u) { return __uint_as_float(u & 0xffff0000u); }
DI float sigmoidf_(float x) { return __builtin_amdgcn_rcpf(1.f + __builtin_amdgcn_exp2f(-1.44269504089f * x)); }
DI float siluf_(float x) { return x * __builtin_amdgcn_rcpf(1.f + __builtin_amdgcn_exp2f(-1.44269504089f * x)); }
DI bf16x8 mk8(u32x4 v) { return __builtin_bit_cast(bf16x8, v); }
DI bf16x8 ld8(const bf16_t* p) { return __builtin_bit_cast(bf16x8, *(const u32x4*)p); }


DI void sincos_acc(float angf, float& sn, float& cs) {
  const double a = (double)angf;
  const double k = rint(a * 0.63661977236758134308);
  const double y = (a - k * 1.57079632679489655800) - k * 6.12323399573676603587e-17;
  const double y2 = y * y;
  const double sp = y * (1.0 + y2 * (-1.0 / 6 + y2 * (1.0 / 120 + y2 * (-1.0 / 5040 + y2 * (1.0 / 362880 + y2 * (-1.0 / 39916800 + y2 * (1.0 / 6227020800.0)))))));
  const double cp = 1.0 + y2 * (-0.5 + y2 * (1.0 / 24 + y2 * (-1.0 / 720 + y2 * (1.0 / 40320 + y2 * (-1.0 / 3628800 + y2 * (1.0 / 479001600.0))))));
  const int q = ((int)k) & 3;
  const double s_ = (q & 1) ? cp : sp, c_ = (q & 1) ? sp : cp;
  sn = (float)((q & 2) ? -s_ : s_);
  cs = (float)(((q + 1) & 2) ? -c_ : c_);
}
DI float inv_freq(int f) { return (float)exp(-(double)f * (9.21034037197618273607 / 32.0)); }

constexpr size_t al256(size_t x) { return (x + 255) & ~(size_t)255; }
constexpr size_t OFF_WT_IN = 0;
constexpr size_t OFF_W1T = OFF_WT_IN + al256((size_t)NP * LDX * 2);
constexpr size_t OFF_W2T = OFF_W1T + al256((size_t)2 * 256 * 2048 * 2);
constexpr size_t OFF_WUPA = OFF_W2T + al256((size_t)2 * 64 * 256 * 2);
constexpr size_t OFF_WUPB = OFF_WUPA + al256((size_t)1024 * 512 * 2);
constexpr size_t OFF_WOUT = OFF_WUPB + al256((size_t)1024 * 512 * 2);
constexpr size_t OFF_B1EFF = OFF_WOUT + al256((size_t)1024 * 1024 * 2);
constexpr size_t OFF_COST = OFF_B1EFF + al256((size_t)DEPTH * 2 * 16 * 256 * 4);
constexpr size_t OFF_SINT = OFF_COST + al256((size_t)NTOK * 32 * 4);
constexpr size_t OFF_COSC = OFF_SINT + al256((size_t)NTOK * 32 * 4);
constexpr size_t OFF_SINC = OFF_COSC + al256((size_t)BATCH * 128 * 32 * 4);
constexpr size_t OFF_XB = OFF_SINC + al256((size_t)BATCH * 128 * 32 * 4);
constexpr size_t OFF_PART = OFF_XB + al256((size_t)NTOK * LDX * 2);
constexpr size_t OFF_SBQ = OFF_PART + al256((size_t)NTOK * 16 * 4);
constexpr size_t OFF_SBK = OFF_SBQ + al256((size_t)NTOK * 512 * 2);
constexpr size_t OFF_SBVT = OFF_SBK + al256((size_t)NTOK * 512 * 2);
constexpr size_t OFF_SBZ = OFF_SBVT + al256((size_t)NTOK * 512 * 2);
constexpr size_t OFF_NQ = OFF_SBZ + al256((size_t)NTOK * 512 * 2);
constexpr size_t OFF_KCR = OFF_NQ + al256((size_t)NTOK * 512 * 2);
constexpr size_t OFF_VCR = OFF_KCR + al256((size_t)NTOK * 128 * 2);
constexpr size_t OFF_KS = OFF_VCR + al256((size_t)NTOK * 128 * 2);
constexpr size_t OFF_VST = OFF_KS + al256((size_t)NTOK * 128 * 2);
constexpr size_t OFF_KW = OFF_VST + al256((size_t)NTOK * 128 * 2);
constexpr size_t OFF_VWT = OFF_KW + al256((size_t)NTOK * 128 * 2);
constexpr size_t OFF_NGATE = OFF_VWT + al256((size_t)NTOK * 128 * 2);
constexpr size_t OFF_NZ = OFF_NGATE + al256((size_t)NTOK * 32 * 4);
constexpr size_t OFF_GA = OFF_NZ + al256((size_t)NTOK * 512 * 2);
constexpr size_t OFF_GB = OFF_GA + al256((size_t)NTOK * 1024 * 2);
constexpr size_t OFF_HID = OFF_GB + al256((size_t)NTOK * 1024 * 2);
constexpr size_t OFF_KC = OFF_HID + al256((size_t)4 * 32 * 256 * 256 * 4);
constexpr size_t OFF_VCT = OFF_KC + al256((size_t)BATCH * 2 * 128 * 64 * 2);
constexpr size_t OFF_QNG = OFF_VCT + al256((size_t)BATCH * 2 * 64 * 128 * 2);
constexpr size_t OFF_KNG = OFF_QNG + al256((size_t)DEPTH * 64 * 4);
constexpr size_t OFF_CTL = OFF_KNG + al256((size_t)DEPTH * 3 * 64 * 4);
constexpr size_t OFF_MFIX_BASE = OFF_CTL + 256;
constexpr size_t OFF_MFIX_OLD = OFF_KNG + al256((size_t)DEPTH * 3 * 64 * 4);
constexpr size_t OFF_MFIX = OFF_MFIX_BASE;
constexpr size_t OFF_DUMMY = OFF_MFIX + 256;
constexpr size_t OFF_BAR = OFF_DUMMY + 256;
constexpr size_t WS_NEED = OFF_BAR + 3456 * 4;

struct Params {
  const float* x_in; const int* pos; const float* norm_g; const float* w_in; const float* q_norm_g; const float* k_norm_g;
  const float* cmp_pe; const float* cmp_w1; const float* cmp_b1; const float* cmp_w2; const float* w_up_a; const float* w_up_b; const float* w_out;
  float* out; unsigned char* ws;
#define WSBUF(T, name, OFF) DI T* name() const { return (T*)(ws + (OFF)); }
  WSBUF(bf16_t, wt_in, OFF_WT_IN) WSBUF(bf16_t, w1t, OFF_W1T) WSBUF(bf16_t, w2t, OFF_W2T) WSBUF(bf16_t, wupa_t, OFF_WUPA) WSBUF(bf16_t, wupb_t, OFF_WUPB) WSBUF(bf16_t, wout_t, OFF_WOUT)
  WSBUF(float, b1eff, OFF_B1EFF) WSBUF(float, cosT, OFF_COST) WSBUF(float, sinT, OFF_SINT) WSBUF(float, cosC, OFF_COSC) WSBUF(float, sinC, OFF_SINC)
  WSBUF(bf16_t, xb, OFF_XB) WSBUF(float, part, OFF_PART) WSBUF(bf16_t, sbq, OFF_SBQ) WSBUF(bf16_t, sbk, OFF_SBK) WSBUF(bf16_t, sbvt, OFF_SBVT) WSBUF(bf16_t, sbz, OFF_SBZ)
  WSBUF(bf16_t, nq, OFF_NQ) WSBUF(bf16_t, kcr, OFF_KCR) WSBUF(bf16_t, vcr, OFF_VCR) WSBUF(bf16_t, ks, OFF_KS) WSBUF(bf16_t, vst, OFF_VST) WSBUF(bf16_t, kw, OFF_KW) WSBUF(bf16_t, vwt, OFF_VWT)
  WSBUF(float, ngate, OFF_NGATE) WSBUF(bf16_t, nz, OFF_NZ) WSBUF(bf16_t, ga, OFF_GA) WSBUF(bf16_t, gb, OFF_GB) WSBUF(float, hpre, OFF_HID) WSBUF(bf16_t, kc, OFF_KC) WSBUF(bf16_t, vct, OFF_VCT)
  WSBUF(bf16_t, merged, OFF_SBK)
  WSBUF(bf16_t, dummy, OFF_XB)     WSBUF(float, mfix, OFF_MFIX) WSBUF(unsigned, ctl, OFF_CTL)
  WSBUF(float, qng, OFF_QNG) WSBUF(float, kng, OFF_KNG)
};

DI int my_tid() { int t = threadIdx.x; asm volatile("" : "+v"(t)); return t; }
DI Params relaunder(const Params& p0) { Params p = p0; size_t z = 0; asm volatile("" : "+s"(z)); p.ws = p0.ws + z; return p; }

constexpr int TILE_B = 32 * 1024;
constexpr int STAGE_B = 2 * TILE_B;
constexpr int LDS_GEMM_BYTES = 2 * STAGE_B;
typedef __attribute__((address_space(3))) unsigned lds_u32;

DI void g_dma(const bf16_t* __restrict__ base, const unsigned (&off)[8], int ko, unsigned char* stage, int w) {
#pragma unroll
  for (int u = 0; u < 8; ++u)
    __builtin_amdgcn_global_load_lds((const unsigned*)(base + (off[u] + ko)), (lds_u32*)(stage + (w * 8 + u) * 1024), 16, 0, 0);
}
#define G_LDA(dst, ih, ks) _Pragma("unroll") for (int i = 0; i < 4; ++i) dst[i] = mk8(*(const u32x4*)(stage + ra + (((ih) * 4 + i) * 2 + (ks)) * 1024))
#define G_LDB(dst, ks) _Pragma("unroll") for (int j = 0; j < 4; ++j) dst[j] = mk8(*(const u32x4*)(stage + TILE_B + rb + (j * 2 + (ks)) * 1024))
#define G_MMA(ih, A, B) do { _Pragma("unroll") for (int i = 0; i < 4; ++i) _Pragma("unroll") for (int j = 0; j < 4; ++j) acc[(ih) * 4 + i][j] = MFMA16(A[i], B[j], acc[(ih) * 4 + i][j]); } while (0)
DI void g_compute(const unsigned char* stage, int ra, int rb, f32x4 (&acc)[8][4]) {
  bf16x8 b0[4], b1[4], a0[4], a1[4];
  G_LDB(b0, 0); G_LDA(a0, 0, 0);
  __builtin_amdgcn_sched_barrier(0);
  G_LDA(a1, 1, 0);
  G_MMA(0, a0, b0);
  __builtin_amdgcn_sched_barrier(0);
  G_LDB(b1, 1); G_LDA(a0, 0, 1);
  G_MMA(1, a1, b0);
  __builtin_amdgcn_sched_barrier(0);
  G_LDA(a1, 1, 1);
  G_MMA(0, a0, b1);
  __builtin_amdgcn_sched_barrier(0);
  G_MMA(1, a1, b1);
  __builtin_amdgcn_sched_barrier(0);
}

DI void gemm_core(const bf16_t* __restrict__ Ag, long lda, const bf16_t* __restrict__ Bg, long ldb, int K,
                  bf16_t* ldsb, f32x4 (&acc)[8][4], int kstep = 64, bool pre = false, const bf16_t* nAg = nullptr, const bf16_t* nBg = nullptr, bool perm = false) {
  unsigned char* lds = (unsigned char*)ldsb;
  const int tid = my_tid(), lane = tid & 63, w = __builtin_amdgcn_readfirstlane(tid >> 6), wa = w >> 2, wb = w & 3, qi = lane & 15, quad = lane >> 4;
  const bf16_t* base = w >= 4 ? Bg : Ag; const int ld = (int)(w >= 4 ? ldb : lda);
  const bf16_t* nbase = nAg ? (w >= 4 ? nBg : nAg) : base;
  unsigned off[8];
#pragma unroll
  for (int u = 0; u < 8; ++u) {
    const int blk = (w & 3) * 8 + u, rg = blk >> 1, kh = blk & 1;
    int R = rg * 16 + (lane >> 2);
    if (perm) { const int rho = R & 31; R = (R & ~31) + ((rho >> 2) & 3) * 8 + (rho >> 4) * 4 + (rho & 3); }
    off[u] = (unsigned)(R * ld + kh * 32 + (lane & 3) * 8);
  }
  const int ra = (wa * 8) * 2 * 1024 + (qi * 4 + quad) * 16, rb = (wb * 4) * 2 * 1024 + (qi * 4 + quad) * 16;
  unsigned char* buf0 = lds; unsigned char* buf1 = lds + STAGE_B;
  const int KT = K >> 6;
  if (!pre) {
    g_dma(base, off, 0, buf0, w);
    asm volatile("s_waitcnt vmcnt(0)" ::: "memory");
    __syncthreads();
  }
  for (int kt = 0; kt < KT; kt += 2) {
    g_dma(base, off, (kt + 1) * kstep, buf1, w);
    g_compute(buf0, ra, rb, acc);
    asm volatile("s_waitcnt vmcnt(0)" ::: "memory");
    __syncthreads();
    const bool last = kt + 2 >= KT;
    g_dma(last ? nbase : base, off, last ? 0 : (kt + 2) * kstep, buf0, w);
    g_compute(buf1, ra, rb, acc);
    asm volatile("s_waitcnt vmcnt(0)" ::: "memory");
    __syncthreads();
  }
}

DI void zero_acc(f32x4 (&acc)[8][4]) {
#pragma unroll
  for (int i = 0; i < 8; ++i)
#pragma unroll
    for (int j = 0; j < 4; ++j) acc[i][j] = (f32x4){0.f, 0.f, 0.f, 0.f};
}

struct Slot { int xcd, slot; };
DI bool tile_order(const Slot sl, int it, int nN, int& mt, int& nt) {
  const int xcd = sl.xcd, slot = sl.slot, SL = gridDim.x >> 3;
  const int q = slot + it * SL, per = 8 * nN;
  if (q >= 2 * per) return false;
  const int mg = q / per, e = q - mg * per;
  nt = e >> 3; mt = xcd * 16 + mg * 8 + (e & 7);
  return true;
}


#define XB_TMO      128
#define XB_XCNT(j)  (256  + 64 * (j))
#define XB_XSUB(j)  (1280 + 64 * (j))
#define XB_XGEN(j)  (2304 + 64 * (j))
#define XB_TOP      3328
#define XB_TOPGEN   3392
#define XCD_BAR_WORDS 3456
#define XB_SPIN_CAP (1u << 21)
#define LAS __attribute__((address_space(3)))
DI unsigned xb_ld(unsigned* p)              { return __hip_atomic_load(p, __ATOMIC_RELAXED, __HIP_MEMORY_SCOPE_AGENT); }
DI unsigned xb_add(unsigned* p, unsigned v) { return __hip_atomic_fetch_add(p, v, __ATOMIC_RELAXED, __HIP_MEMORY_SCOPE_AGENT); }
DI unsigned xb_xcc_id() { return (unsigned)__builtin_amdgcn_s_getreg((3 << 11) | 20) & 0xFu; }
#define XB_SPIN(cond, bar) do { unsigned _sp = 0; while (cond) { __builtin_amdgcn_s_sleep(1); \
    if ((++_sp & 255u) == 0u) { if (xb_ld(&(bar)[XB_TMO])) break; if (_sp > XB_SPIN_CAP) { atomicAdd(&(bar)[XB_TMO], 1u); break; } } } } while (0)
struct XcdBarrier { unsigned* bar; unsigned x; volatile LAS unsigned* st; };
DI XcdBarrier xcd_barrier_post(unsigned* bar, volatile LAS unsigned* st) {
  XcdBarrier b; b.bar = bar; b.x = xb_xcc_id(); b.st = st;
  if (threadIdx.x == 0) (void)xb_add(&bar[XB_XCNT(b.x)], 1u);
  return b;
}
DI void xcd_barrier_complete(unsigned* bar, unsigned x, unsigned& nloc, unsigned& nx) {
  const unsigned G = gridDim.x * gridDim.y * gridDim.z;
  unsigned sum, cnt, mine, sp = 0u;
  for (;;) {
    sum = 0u; cnt = 0u; mine = 0u;
#pragma unroll
    for (unsigned j = 0; j < 16; ++j) { const unsigned c = xb_ld(&bar[XB_XCNT(j)]); sum += c; cnt += (c > 0u) ? 1u : 0u; mine = (j == x) ? c : mine; }
    if (sum == G) break;
    __builtin_amdgcn_s_sleep(1);
    if ((++sp & 255u) == 0u) { if (xb_ld(&bar[XB_TMO])) break; if (sp > XB_SPIN_CAP) { atomicAdd(&bar[XB_TMO], 1u); break; } }
  }
  nloc = mine > 0u ? mine : 1u; nx = cnt > 0u ? cnt : 1u;
}
DI void xcd_barrier(const XcdBarrier& b) {
  asm volatile("s_waitcnt vmcnt(0)" ::: "memory");
  __syncthreads();
  if (threadIdx.x == 0) {
    unsigned* bar = b.bar;
    __builtin_amdgcn_s_waitcnt(0);
    unsigned nloc = b.st[0], nx = b.st[1];
    if (nloc == 0u) { xcd_barrier_complete(bar, b.x, nloc, nx); b.st[0] = nloc; b.st[1] = nx; }
    const unsigned old = xb_add(&bar[XB_XSUB(b.x)], 1u);
    const unsigned gen = old / nloc;
    if (old + 1u == (gen + 1u) * nloc) {
      __builtin_amdgcn_fence(__ATOMIC_RELEASE, "agent");
      asm volatile("s_waitcnt vmcnt(0)" ::: "memory");
      const unsigned og = xb_add(&bar[XB_TOP], 1u);
      const unsigned tg = og / nx;
      if (og + 1u == (tg + 1u) * nx) xb_add(&bar[XB_TOPGEN], 1u);
      else XB_SPIN(xb_ld(&bar[XB_TOPGEN]) == tg, bar);
      __builtin_amdgcn_fence(__ATOMIC_ACQUIRE, "agent");
      xb_add(&bar[XB_XGEN(b.x)], 1u);
      asm volatile("s_waitcnt vmcnt(0)" ::: "memory");
    } else {
      XB_SPIN(xb_ld(&bar[XB_XGEN(b.x)]) == gen, bar);
      __builtin_amdgcn_fence(__ATOMIC_ACQUIRE, "agent");
      asm volatile("s_waitcnt vmcnt(0)" ::: "memory");
    }
  }
  __syncthreads();
}

DI int inmap(int c) {
  if (c < 1024) return c;
  if (c < 1536) return c + 512;
  if (c < 2048) return c + 512;
  if (c < 2304) return c + 512;
  if (c < 2432) return c + 512;
  if (c < 2560) return c + 640;
  if (c < 3072) return c + 792;
  if (c < 4096) return c + 792;
  if (c < 5120) return c + 792;
  if (c < 5376) return c < 5144 ? c - 1792 : -1;
  if (c < 5888) return c - 4352;
  if (c < 6016) return c - 2944;
  return c - 2816;
}

DI void tr_tile(const float* __restrict__ src, int ld, int K, int k0, int n0, bool use_map, const float* __restrict__ scale, bf16_t* __restrict__ dst, int ldd, float* tile) {
  const int tid = my_tid();
  {
    const int nl = tid & 63, kk = tid >> 6;
    int n = n0 + nl; asm volatile("" : "+v"(n));
    const int sc = use_map ? inmap(n) : n;
#pragma unroll
    for (int r = 0; r < 8; ++r) {
      const int k = k0 + r * 8 + kk;
      float v = 0.f;
      if (sc >= 0) { v = src[(long)k * ld + sc]; if (scale) v *= scale[k]; }
      tile[(r * 8 + kk) * 65 + nl] = v;
    }
  }
  __syncthreads();
  {
    const int nl = tid >> 3, ks = tid & 7;
    unsigned o[4];
#pragma unroll
    for (int e = 0; e < 4; ++e) o[e] = pk2(tile[(ks * 8 + 2 * e) * 65 + nl], tile[(ks * 8 + 2 * e + 1) * 65 + nl]);
    *(u32x4*)(dst + (long)(n0 + nl) * ldd + k0 + ks * 8) = (u32x4){o[0], o[1], o[2], o[3]};
  }
  __syncthreads();
}

DI void tr_job(const float* src, int ld, int K, int N, bool use_map, const float* scale, bf16_t* dst, int ldd, float* tile) {
  const int nk = K >> 6, nn = N >> 6;
  for (int t = blockIdx.x; t < nk * nn; t += gridDim.x) tr_tile(src, ld, K, (t % nk) * 64, (t / nk) * 64, use_map, scale, dst, ldd, tile);
}

DI void convert_weights(const Params& p0, int l, unsigned char* lds, int which) {
  const Params p = relaunder(p0);
  float* tile = (float*)lds;
  if (which & 1) {
    tr_job(p.w_in + (long)l * D_MODEL * N_IN, N_IN, D_MODEL, NP, true, p.norm_g + l * D_MODEL, p.wt_in(), LDX, tile);
    for (int kv = 0; kv < 2; ++kv) {
      tr_job(p.cmp_w1 + (long)(l * 2 + kv) * 2048 * 256, 256, 2048, 256, false, nullptr, p.w1t() + (long)kv * 256 * 2048, 2048, tile);
      tr_job(p.cmp_w2 + (long)(l * 2 + kv) * 256 * 64, 64, 256, 64, false, nullptr, p.w2t() + (long)kv * 64 * 256, 256, tile);
    }
    tr_job(p.w_up_a + (long)l * 512 * 1024, 1024, 512, 1024, false, nullptr, p.wupa_t(), 512, tile);
    tr_job(p.w_up_b + (long)l * 512 * 1024, 1024, 512, 1024, false, nullptr, p.wupb_t(), 512, tile);
  }
  if (which & 2) tr_job(p.w_out + (long)l * 1024 * 1024, 1024, 1024, 1024, false, nullptr, p.wout_t(), 1024, tile);
}

DI void phase_prologue(const Params& p, unsigned char* lds) {
  const int tid = my_tid();
  convert_weights(p, 0, lds, 3);
  {
    const int lane = tid & 63;
    for (int wi = blockIdx.x * 8 + (tid >> 6); wi < DEPTH * 2 * 16 * 4; wi += gridDim.x * 8) {
      const int jq = wi & 3, kq = (wi >> 2) & 15, it = wi >> 6;
      const float* w1 = p.cmp_w1 + (long)it * 2048 * 256 + (long)kq * 128 * 256 + jq * 64 + lane; const float* pe = p.cmp_pe + (long)it * 2048 + kq * 128;
      float s0 = kq == 0 ? p.cmp_b1[it * 256 + jq * 64 + lane] : 0.f, s1 = 0.f, s2 = 0.f, s3 = 0.f;
#pragma unroll 4
      for (int k = 0; k < 128; k += 4) {
        s0 += pe[k] * w1[(long)k * 256]; s1 += pe[k + 1] * w1[(long)(k + 1) * 256]; s2 += pe[k + 2] * w1[(long)(k + 2) * 256]; s3 += pe[k + 3] * w1[(long)(k + 3) * 256];
      }
      p.b1eff()[(it * 16 + kq) * 256 + jq * 64 + lane] = (s0 + s1) + (s2 + s3);
    }
  }
  if (blockIdx.x == 1 && tid < DEPTH * 3) {
    const int l = tid / 3, br = tid % 3;
    float mq = 0.f, mk = 0.f;
    for (int d = 0; d < 64; ++d) { mq = fmaxf(mq, fabsf(p.q_norm_g[l * 64 + d])); mk = fmaxf(mk, fabsf(p.k_norm_g[(l * 3 + br) * 64 + d])); }
    p.mfix()[l * 4 + br] = 8.f * 1.44269504089f * mq * mk * 1.02f + 0.25f;
  }
  if (blockIdx.x == 0) { for (int i = tid; i < DEPTH * 64; i += NTHR) p.qng()[i] = p.q_norm_g[i]; for (int i = tid; i < DEPTH * 192; i += NTHR) p.kng()[i] = p.k_norm_g[i]; }
  const long gtid = (long)blockIdx.x * NTHR + tid, gn = (long)gridDim.x * NTHR;
  for (long i = gtid; i < (long)NTOK * 32; i += gn) {
    const int f = (int)(i & 31); const long tok = i >> 5;
    const float ang = (float)p.pos[tok] * inv_freq(f);
    float sn, cs; sincos_acc(ang, sn, cs);
    p.cosT()[i] = cs; p.sinT()[i] = sn;
  }
  for (long i = gtid; i < (long)BATCH * 128 * 32; i += gn) {
    const int f = (int)(i & 31); const int c = (int)((i >> 5) & 127); const int b = (int)(i >> 12);
    float cs = 1.f, sn = 0.f;
    if (c < NCMP) {
      float sum = 0.f;
      for (int k = 0; k < 32; ++k) sum += (float)p.pos[b * SEQ + c * 16 + k];
      const float ang = (sum * (1.f / 32.f)) * inv_freq(f);
      sincos_acc(ang, sn, cs);
    }
    p.cosC()[i] = cs; p.sinC()[i] = sn;
  }
  const int lane = tid & 63;
  for (long row = (long)blockIdx.x * 8 + (tid >> 6); row < NTOK; row += (long)gridDim.x * 8) {
    const float* xr = p.x_in + row * D_MODEL; bf16_t* xo = p.xb() + row * LDX;
    float ss = 0.f;
#pragma unroll
    for (int u = 0; u < 4; ++u) {
      const f32x4 v = *(const f32x4*)(xr + u * 256 + lane * 4);
      ss += v[0] * v[0] + v[1] * v[1] + v[2] * v[2] + v[3] * v[3];
      *(u32x2*)(xo + u * 256 + lane * 4) = (u32x2){pk2(v[0], v[1]), pk2(v[2], v[3])};
    }
#pragma unroll
    for (int o = 32; o >= 1; o >>= 1) ss += __shfl_xor(ss, o);
    if (lane < 8) p.part()[row * 16 + lane] = lane == 0 ? ss : 0.f;
  }
}

DI void phaseA_epilogue(const Params& p, int layer, int mt, int nt, const f32x4 (&acc)[8][4], const float* rs_s) {
  const int tid = my_tid(), lane = tid & 63, w = tid >> 6, wa = w >> 2, wb = w & 3, qi = lane & 15, quad = lane >> 4;
  if (nt >= 21) {
    bf16_t* dstb; int nh, head;
    if (nt < 23) { dstb = p.sbvt(); nh = 8; head = (nt - 21) * 4 + wb; } else if (wb < 2) { dstb = p.vst(); nh = 2; head = wb; } else { dstb = p.vwt(); nh = 2; head = wb - 2; }
    const int tok0 = mt * 256, b = tok0 >> 11;
#pragma unroll
    for (int ip = 0; ip < 4; ++ip) {
      const int tl = wa * 128 + ip * 32 + quad * 8;
      const f32x4 ra = *(const f32x4*)(rs_s + tl), rb2 = *(const f32x4*)(rs_s + tl + 4);
      const int sq = (tok0 & 2047) + tl;
#pragma unroll
      for (int j = 0; j < 4; ++j) {
        const int d = (j >> 1) * 32 + (qi >> 2) * 8 + (j & 1) * 4 + (qi & 3);
        const f32x4 v0 = acc[2 * ip][j] * ra, v1 = acc[2 * ip + 1][j] * rb2;
        bf16_t* dst = dstb + (long)(b * nh + head) * 64 * SEQ + (long)(sq >> 5) * 2048 + d * 32 + (sq & 31);
        *(u32x4*)dst = (u32x4){pk2(v0[0], v0[1]), pk2(v0[2], v0[3]), pk2(v1[0], v1[1]), pk2(v1[2], v1[3])};
      }
    }
    return;
  }
  const bool headtype = nt < 4 || (nt >= 6 && nt < 10);
#pragma unroll
  for (int j = 0; j < 4; ++j) {
    const int tl = wb * 64 + (j >> 1) * 32 + (qi >> 2) * 8 + (j & 1) * 4 + (qi & 3); const long tok = (long)mt * 256 + tl; const int b = (int)(tok >> 11), sq = (int)(tok & 2047);
    const float rs = rs_s[tl];
    if (headtype) {
#pragma unroll
      for (int ih = 0; ih < 2; ++ih) {
        const int hit = wa * 2 + ih;
        f32x4 v[4];
#pragma unroll
        for (int i = 0; i < 4; ++i) v[i] = acc[ih * 4 + i][j] * rs;
        bf16_t* dstb; int nh, head; const float* g = nullptr;
        if (nt < 2) { dstb = p.sbq(); nh = 8; head = nt * 4 + hit; }
        else if (nt < 4) { dstb = p.sbk(); nh = 8; head = (nt - 2) * 4 + hit; }
        else if (nt < 8) { dstb = p.nq(); nh = 8; head = (nt - 6) * 4 + hit; g = p.qng() + layer * 64; }
        else if (nt == 8) { dstb = hit < 2 ? p.kcr() : p.vcr(); nh = 2; head = hit & 1; }
        else { dstb = hit < 2 ? p.ks() : p.kw(); nh = 2; head = hit & 1; g = p.kng() + (layer * 3 + (hit < 2 ? 1 : 2)) * 64; }
        if (g) {
          float ss = 0.f;
#pragma unroll
          for (int i = 0; i < 4; ++i) ss += v[i][0] * v[i][0] + v[i][1] * v[i][1] + v[i][2] * v[i][2] + v[i][3] * v[i][3];
          ss += __shfl_xor(ss, 16); ss += __shfl_xor(ss, 32);
          const float rn = rsqrtf(ss * (1.f / 64.f) + NORM_EPS);
#pragma unroll
          for (int i = 0; i < 4; ++i) { const f32x4 gg = *(const f32x4*)(g + (i >> 1) * 32 + quad * 8 + (i & 1) * 4); v[i] = v[i] * rn * gg; }
#pragma unroll
          for (int i = 0; i < 2; ++i) {
            const f32x4 cs = *(const f32x4*)(p.cosT() + tok * 32 + quad * 8 + i * 4), sn = *(const f32x4*)(p.sinT() + tok * 32 + quad * 8 + i * 4);
            const f32x4 x1 = v[i], x2 = v[i + 2];
            v[i] = x1 * cs - x2 * sn; v[i + 2] = x2 * cs + x1 * sn;
          }
        }
        bf16_t* dst = dstb + ((long)(b * nh + head) * SEQ + sq) * 64 + quad * 8;
#pragma unroll
        for (int ip = 0; ip < 2; ++ip)
          *(u32x4*)(dst + ip * 32) = (u32x4){pk2(v[2 * ip][0], v[2 * ip][1]), pk2(v[2 * ip][2], v[2 * ip][3]), pk2(v[2 * ip + 1][0], v[2 * ip + 1][1]), pk2(v[2 * ip + 1][2], v[2 * ip + 1][3])};
        asm volatile("" ::: "memory");
      }
    } else if (nt == 20) {
      if (wa == 0 && quad < 3) {
#pragma unroll
        for (int i = 0; i < 2; ++i) {
          const f32x4 v = acc[i][j] * rs;
          const f32x4 o = {sigmoidf_(v[0]), sigmoidf_(v[1]), sigmoidf_(v[2]), sigmoidf_(v[3])};
          *(f32x4*)(p.ngate() + tok * 32 + quad * 8 + i * 4) = o;
        }
      }
    } else {
      bf16_t* dstb; int ldd, c0; bool sil;
      if (nt < 6) { dstb = p.sbz(); ldd = 512; c0 = (nt - 4) * 256; sil = true; }
      else if (nt < 12) { dstb = p.nz(); ldd = 512; c0 = (nt - 10) * 256; sil = true; }
      else if (nt < 16) { dstb = p.ga(); ldd = 1024; c0 = (nt - 12) * 256; sil = false; }
      else { dstb = p.gb(); ldd = 1024; c0 = (nt - 16) * 256; sil = false; }
      bf16_t* dst = dstb + tok * ldd + c0 + wa * 128 + quad * 8;
#pragma unroll
      for (int ip = 0; ip < 4; ++ip) {
        const f32x4 v0 = acc[2 * ip][j] * rs, v1 = acc[2 * ip + 1][j] * rs;
        f32x4 o0, o1;
#pragma unroll
        for (int r = 0; r < 4; ++r) { o0[r] = sil ? siluf_(v0[r]) : sigmoidf_(v0[r]); o1[r] = sil ? siluf_(v1[r]) : sigmoidf_(v1[r]); }
        *(u32x4*)(dst + ip * 32) = (u32x4){pk2(o0[0], o0[1]), pk2(o0[2], o0[3]), pk2(o1[0], o1[1]), pk2(o1[2], o1[3])};
      }
    }
    asm volatile("" ::: "memory");
  }
}

DI void phaseA(const Params& p0, const Slot sl, int layer, unsigned char* lds, int fake = 0) {
  const Params p = relaunder(p0);
  bf16_t* gl = (bf16_t*)lds; float* rs_s = (float*)(lds + LDS_GEMM_BYTES);
  const bf16_t* Wt = p.wt_in();
  int mt, nt;
  for (int it = 0; tile_order(sl, it, NT_IN, mt, nt); ++it) {
    if (my_tid() < 256) {
      const float* pp = p.part() + ((long)mt * 256 + my_tid()) * 16;
      const f32x4 v0 = *(const f32x4*)pp, v1 = *(const f32x4*)(pp + 4);
      const float s = ((v0[0] + v0[1]) + (v0[2] + v0[3])) + ((v1[0] + v1[1]) + (v1[2] + v1[3]));
      rs_s[my_tid()] = rsqrtf(s * (1.f / 1024.f) + NORM_EPS);
    }
    const int mtl = fake == 3 ? 0 : (fake == 4 ? sl.xcd * 16 + (sl.slot & 7) : mt), ntl = fake == 3 ? 0 : (fake == 4 ? (sl.slot >> 3) : nt);
    const bf16_t* Xg = p.xb() + (long)mtl * 256 * LDX; const bf16_t* Wg = Wt + (long)ntl * 256 * LDX;
    f32x4 acc[8][4]; zero_acc(acc);
    const int kstep = (fake == 1 || fake == 2) ? 0 : 64;
    int mt2, nt2;
    const bool more = !fake && tile_order(sl, it + 1, NT_IN, mt2, nt2);
    const bf16_t* Xn = more ? p.xb() + (long)mt2 * 256 * LDX : Xg; const bf16_t* Wn = more ? Wt + (long)nt2 * 256 * LDX : Wg;
    const bool vn = more ? nt2 >= 21 : nt >= 21;
    gemm_core(nt >= 21 ? Xg : Wg, LDX, nt >= 21 ? Wg : Xg, LDX, D_MODEL, gl, acc, kstep, !fake && it > 0, vn ? Xn : Wn, vn ? Wn : Xn, true);
    if (!fake) phaseA_epilogue(p, layer, mt, nt, acc, rs_s);
    else if (acc[0][0][0] == 123.456f && acc[7][3][3] == 5.f) p.dummy()[0] = 1;
    __syncthreads();
  }
}

DI void compress_partial(const Params& p, int ci, unsigned char* lds) {
  bf16_t* gl = (bf16_t*)lds;
  const int split = ci & 3, item = ci >> 2, kv = item & 1, pair = item >> 1;
  const bf16_t* src = (kv ? p.vcr() : p.kcr()) + (long)pair * 256 * 1024 + split * 512;
  const bf16_t* W1 = p.w1t() + (long)kv * 256 * 2048 + split * 512;
  f32x4 acc[8][4]; zero_acc(acc);
  gemm_core(W1, 2048, src, 1024, 512, gl, acc);
  const int tid = my_tid(), lane = tid & 63, w = tid >> 6, wa = w >> 2, wb = w & 3, qi = lane & 15, quad = lane >> 4;
  float* dst = p.hpre() + ((long)(split * 32 + item) * 256) * 256;
#pragma unroll
  for (int i = 0; i < 8; ++i)
#pragma unroll
    for (int j = 0; j < 4; ++j) *(f32x4*)(dst + (long)(wb * 64 + j * 16 + qi) * 256 + wa * 128 + i * 16 + quad * 4) = acc[i][j];
}

DI void phaseB2(const Params& p0, int layer, unsigned char* lds) {
  const Params p = relaunder(p0);
  const int tid = my_tid(), lane = tid & 63, w = tid >> 6, qi = lane & 15, quad = lane >> 4;
  float* bias_s = (float*)lds;
  {
    const float* b1 = p.b1eff() + (long)(layer * 2 + (tid >> 8)) * 16 * 256 + (tid & 255);
    float sacc = 0.f;
#pragma unroll
    for (int kq = 0; kq < 16; ++kq) sacc += b1[kq * 256];
    bias_s[tid] = sacc;
  }
  __syncthreads();
  if (w < 2)
  for (int wi = blockIdx.x * 2 + w; wi < 32 * 16; wi += gridDim.x * 2) {
    const int item = wi >> 4, r16 = wi & 15, kv = item & 1, pair = item >> 1;
    const int row = r16 * 16 + qi;
    const bf16_t* W2 = p.w2t() + (long)kv * 64 * 256;
    const float* hp = p.hpre() + ((long)item * 256 + row) * 256 + quad * 8;
    f32x4 o[4];
#pragma unroll
    for (int dt = 0; dt < 4; ++dt) o[dt] = (f32x4){0.f, 0.f, 0.f, 0.f};
#pragma unroll 1
    for (int ksx = 0; ksx < 8; ++ksx) {
      f32x4 h0 = *(const f32x4*)(bias_s + kv * 256 + ksx * 32 + quad * 8), h1 = *(const f32x4*)(bias_s + kv * 256 + ksx * 32 + quad * 8 + 4);
#pragma unroll
      for (int sp = 0; sp < 4; ++sp) { const float* q = hp + (long)sp * 32 * 256 * 256 + ksx * 32; h0 += *(const f32x4*)q; h1 += *(const f32x4*)(q + 4); }
      const bf16x8 hf = mk8((u32x4){pk2(siluf_(h0[0]), siluf_(h0[1])), pk2(siluf_(h0[2]), siluf_(h0[3])), pk2(siluf_(h1[0]), siluf_(h1[1])), pk2(siluf_(h1[2]), siluf_(h1[3]))});
#pragma unroll
      for (int dt = 0; dt < 4; ++dt) {
        const bf16x8 wf = ld8(W2 + (long)(dt * 16 + qi) * 256 + ksx * 32 + quad * 8);
        o[dt] = kv ? MFMA16(hf, wf, o[dt]) : MFMA16(wf, hf, o[dt]);
      }
    }
    const int bg = pair * 2 + (r16 >> 3);
    if (kv == 0) {
      const float* g = p.kng() + (layer * 3 + 0) * 64;
      const int b = bg >> 1, c = (r16 & 7) * 16 + qi;
      float ss = 0.f;
#pragma unroll
      for (int dt = 0; dt < 4; ++dt) ss += o[dt][0] * o[dt][0] + o[dt][1] * o[dt][1] + o[dt][2] * o[dt][2] + o[dt][3] * o[dt][3];
      ss += __shfl_xor(ss, 16); ss += __shfl_xor(ss, 32);
      const float rn = rsqrtf(ss * (1.f / 64.f) + NORM_EPS);
#pragma unroll
      for (int dt = 0; dt < 4; ++dt) { const f32x4 gg = *(const f32x4*)(g + dt * 16 + quad * 4); o[dt] = o[dt] * rn * gg; }
#pragma unroll
      for (int dt = 0; dt < 2; ++dt) {
        const long ti = ((long)b * 128 + c) * 32 + dt * 16 + quad * 4;
        const f32x4 cs = *(const f32x4*)(p.cosC() + ti), sn = *(const f32x4*)(p.sinC() + ti);
        const f32x4 x1 = o[dt], x2 = o[dt + 2];
        o[dt] = x1 * cs - x2 * sn; o[dt + 2] = x2 * cs + x1 * sn;
      }
      bf16_t* dst = p.kc() + ((long)bg * 128 + c) * 64 + quad * 4;
#pragma unroll
      for (int dt = 0; dt < 4; ++dt) {
        u32x2 ov = (u32x2){pk2(o[dt][0], o[dt][1]), pk2(o[dt][2], o[dt][3])};
        if (c >= NCMP) ov = (u32x2){0u, 0u};
        *(u32x2*)(dst + dt * 16) = ov;
      }
    } else {
#pragma unroll
      for (int dt = 0; dt < 4; ++dt) {
        const int c0 = (r16 & 7) * 16 + quad * 4;
        f32x4 v = o[dt];
        if (c0 + 3 >= NCMP) v[3] = 0.f;
        *(u32x2*)(p.vct() + ((long)bg * 64 + dt * 16 + qi) * 128 + c0) = (u32x2){pk2(v[0], v[1]), pk2(v[2], v[3])};
      }
    }
  }
  __syncthreads();
}

struct SbFrag { bf16x8 k[2][2]; bf16x8 v[4]; };
DI void sb_load(SbFrag& f, const bf16_t* __restrict__ kp0, const bf16_t* __restrict__ vp0, int kb) {
#pragma unroll
  for (int a = 0; a < 2; ++a) { f.k[a][0] = ld8(kp0 + (long)(kb + 4 * a) * 64); f.k[a][1] = ld8(kp0 + (long)(kb + 4 * a) * 64 + 32); }
#pragma unroll
  for (int dt = 0; dt < 4; ++dt) f.v[dt] = ld8(vp0 + (long)kb * 64 + dt * 16 * 32);
}
template <bool FULL>
DI void sb_chunk(const SbFrag& f, int kb, int t, int quad, const bf16x8 (&qf)[2], f32x4 (&o)[4], float& carry) {
  f32x4 s[2];
#pragma unroll
  for (int a = 0; a < 2; ++a) {
    s[a] = MFMA16(f.k[a][0], qf[0], ((f32x4){0.f, 0.f, 0.f, 0.f}));
    s[a] = MFMA16(f.k[a][1], qf[1], s[a]);
  }
  float L[8], ls[8]; bool val[8];
  float tot = 0.f;
#pragma unroll
  for (int idx = 0; idx < 8; ++idx) {
    const float z = s[idx >> 2][idx & 3] * (0.125f * 1.44269504089f);
    val[idx] = FULL ? true : (kb + 8 * quad + idx < t);
    const float sp = fmaxf(z, 0.f) + __builtin_amdgcn_logf(1.f + __builtin_amdgcn_exp2f(-fabsf(z)));
    L[idx] = val[idx] ? -sp : 0.f;
    ls[idx] = z - sp;
    tot += L[idx];
  }
  const float a1 = __shfl_xor(tot, 16), a2 = __shfl_xor(tot, 32), a3 = __shfl_xor(a1, 32);
  const float higher = ((quad ^ 1) > quad ? a1 : 0.f) + ((quad ^ 2) > quad ? a2 : 0.f) + ((quad ^ 3) > quad ? a3 : 0.f);
  float run = carry + higher;
  float wv[8];
#pragma unroll
  for (int idx = 7; idx >= 0; --idx) {
    const float e = __builtin_amdgcn_exp2f(ls[idx] + run);
    wv[idx] = val[idx] ? e : 0.f;
    run += L[idx];
  }
  carry += (tot + a1) + (a2 + a3);
  const bf16x8 pf = mk8((u32x4){pk2(wv[0], wv[1]), pk2(wv[2], wv[3]), pk2(wv[4], wv[5]), pk2(wv[6], wv[7])});
#pragma unroll
  for (int dt = 0; dt < 4; ++dt) o[dt] = MFMA16(f.v[dt], pf, o[dt]);
}

DI void sb_attn_wave(const Params& p, int b, int h, int t0, bf16_t* ybase) {
  const int lane = my_tid() & 63, qi = lane & 15, quad = lane >> 4;
  const bf16_t* Q = p.sbq() + (long)(b * 8 + h) * SEQ * 64;
  const bf16_t* K = p.sbk() + (long)(b * 8 + h) * SEQ * 64;
  const bf16_t* Vt = p.sbvt() + (long)(b * 8 + h) * 64 * SEQ;
  const int tA = t0 + qi, tB = t0 + 16 + qi;
  bf16x8 qa[2], qb[2];
  qa[0] = ld8(Q + (long)tA * 64 + quad * 8); qa[1] = ld8(Q + (long)tA * 64 + 32 + quad * 8);
  qb[0] = ld8(Q + (long)tB * 64 + quad * 8); qb[1] = ld8(Q + (long)tB * 64 + 32 + quad * 8);
  f32x4 oa[4], ob[4];
#pragma unroll
  for (int dt = 0; dt < 4; ++dt) { oa[dt] = (f32x4){0.f, 0.f, 0.f, 0.f}; ob[dt] = oa[dt]; }
  float ca = 0.f, cb = 0.f;
  const int krow = 8 * (qi >> 2) + (qi & 3);
  const bf16_t* kp0 = K + (long)krow * 64 + quad * 8;
  const bf16_t* vp0 = Vt + qi * 32 + 8 * quad;
  int kb = t0;
  SbFrag f0, f1, f2;
  sb_load(f0, kp0, vp0, kb); sb_load(f1, kp0, vp0, max(kb - 32, 0));
#define SB_STEP(F, KB) (((KB) + 32 <= t0) ? (sb_chunk<true>(F, KB, tA, quad, qa, oa, ca), sb_chunk<true>(F, KB, tB, quad, qb, ob, cb)) : (sb_chunk<false>(F, KB, tA, quad, qa, oa, ca), sb_chunk<false>(F, KB, tB, quad, qb, ob, cb)), __all(ca < -160.f && cb < -160.f))
  while (true) {
    sb_load(f2, kp0, vp0, max(kb - 64, 0));
    if (SB_STEP(f0, kb) || kb < 32) break;
    sb_load(f0, kp0, vp0, max(kb - 96, 0));
    if (SB_STEP(f1, kb - 32) || kb < 64) break;
    sb_load(f1, kp0, vp0, max(kb - 128, 0));
    if (SB_STEP(f2, kb - 64) || kb < 96) break;
    kb -= 96;
  }
#undef SB_STEP
#pragma unroll
  for (int half = 0; half < 2; ++half) {
    const long zo = ((long)b * SEQ + (half ? tB : tA)) * 512 + h * 64 + quad * 4;
    const bf16_t* zp = p.sbz() + zo; bf16_t* yp = ybase + zo;
#pragma unroll
    for (int dt = 0; dt < 4; ++dt) {
      const f32x4 o = half ? ob[dt] : oa[dt];
      const u32x2 zz = *(const u32x2*)(zp + dt * 16);
      *(u32x2*)(yp + dt * 16) = (u32x2){pk2(o[0] * bflo(zz[0]), o[1] * bfhi(zz[0])), pk2(o[2] * bflo(zz[1]), o[3] * bfhi(zz[1]))};
    }
  }
}

DI void phaseB(const Params& p0, int layer, unsigned char* lds, bool probe) {
  const int NITEM = 128 + BATCH * 8 * 8;
  for (int it = blockIdx.x; it < NITEM; it += gridDim.x) {
    const Params p = relaunder(p0);
    if (it < 128) { compress_partial(p, it, lds); continue; }
    const int i = it - 128, qt = 7 - (i >> 7), bh = i & 127;
    sb_attn_wave(p, bh >> 3, bh & 7, qt * 256 + (my_tid() >> 6) * 32, probe ? p.dummy() : p.sbz());
  }
}

constexpr int NSA_LO_BYTES = 8 * 8192;
constexpr int NSA_KROW = 144, NSA_VROW = 80;
constexpr int NSA_SLOT = 32 * NSA_KROW + 64 * NSA_VROW;
constexpr int NSA_SLOT0 = NSA_LO_BYTES, NSA_BLIST = NSA_SLOT0 + 2 * NSA_SLOT, NSA_UMW = NSA_BLIST + 64 * 4;

struct KVFrag { bf16x8 k[2][2]; bf16x8 v[4]; };
DI void nsa_ldsfrag(KVFrag& f, const unsigned char* slot, int qi, int quad) {
  const int krow = 8 * (qi >> 2) + (qi & 3);
#pragma unroll
  for (int a = 0; a < 2; ++a) { const unsigned char* kp = slot + (krow + 4 * a) * NSA_KROW + quad * 16; f.k[a][0] = mk8(*(const u32x4*)kp); f.k[a][1] = mk8(*(const u32x4*)(kp + 64)); }
#pragma unroll
  for (int dt = 0; dt < 4; ++dt) f.v[dt] = mk8(*(const u32x4*)(slot + 32 * NSA_KROW + (dt * 16 + qi) * NSA_VROW + quad * 16));
}
template <int MODE>
DI void nsa_chunk(const KVFrag& f, int kb, int t, bool selbit, const bf16x8 (&qf)[4][2], f32x4 (&O)[4][4], float (&m)[4], float (&l)[4], int quad, bool online) {
  const float SC = 0.125f * 1.44269504089f;
  bool val[8];
#pragma unroll
  for (int idx = 0; idx < 8; ++idx) {
    const int key = kb + 8 * quad + idx;
    val[idx] = MODE == 0 ? (selbit && key <= t) : (key <= t && key > t - 512);
  }
#pragma unroll
  for (int hh = 0; hh < 4; ++hh) {
    f32x4 s[2];
#pragma unroll
    for (int a = 0; a < 2; ++a) { s[a] = MFMA16(f.k[a][0], qf[hh][0], ((f32x4){0.f, 0.f, 0.f, 0.f})); s[a] = MFMA16(f.k[a][1], qf[hh][1], s[a]); }
    float mn = m[hh];
    if (online) {
      float cm = -1e30f;
#pragma unroll
      for (int idx = 0; idx < 8; ++idx) if (val[idx]) cm = fmaxf(cm, s[idx >> 2][idx & 3] * SC);
      cm = fmaxf(cm, __shfl_xor(cm, 16)); cm = fmaxf(cm, __shfl_xor(cm, 32));
      mn = fmaxf(mn, cm);
      const float alpha = __builtin_amdgcn_exp2f(m[hh] - mn);
      m[hh] = mn; l[hh] *= alpha;
#pragma unroll
      for (int dt = 0; dt < 4; ++dt) O[hh][dt] = O[hh][dt] * alpha;
    }
    float pv[8]; float ps = 0.f;
#pragma unroll
    for (int idx = 0; idx < 8; ++idx) { pv[idx] = val[idx] ? __builtin_amdgcn_exp2f(fmaf(s[idx >> 2][idx & 3], SC, -mn)) : 0.f; ps += pv[idx]; }
    l[hh] += ps;
    const bf16x8 pf = mk8((u32x4){pk2(pv[0], pv[1]), pk2(pv[2], pv[3]), pk2(pv[4], pv[5]), pk2(pv[6], pv[7])});
#pragma unroll
    for (int dt = 0; dt < 4; ++dt) O[hh][dt] = MFMA16(f.v[dt], pf, O[hh][dt]);
  }
}

template <int MODE>
DI void nsa_branch(const bf16_t* __restrict__ Kb, const bf16_t* __restrict__ Vtb, unsigned char* lds, int nb, int t, int cur, unsigned selmask, unsigned umall,
                   const bf16x8 (&qf)[4][2], f32x4 (&O)[4][4], float (&m)[4], float (&l)[4], bool online) {
  const int tid = my_tid(), lane = tid & 63, qi = lane & 15, quad = lane >> 4;
  const int* blist = (const int*)(lds + NSA_BLIST);
  const bool isv = tid >= 256;
  const int t2 = tid & 255;
  const bf16_t* gsrc = isv ? Vtb + (t2 >> 2) * 32 + (t2 & 3) * 8 : Kb + (long)(t2 >> 3) * 64 + (t2 & 7) * 8;
  const long gmul = 64;
  const int ldst = isv ? 32 * NSA_KROW + (t2 >> 2) * NSA_VROW + (t2 & 3) * 16 : (t2 >> 3) * NSA_KROW + (t2 & 7) * 16;
  unsigned char* slot0 = lds + NSA_SLOT0; unsigned char* slot1 = slot0 + NSA_SLOT;
  const int N = 2 * nb;
  auto kbof = [&](int n) { return blist[n >> 1] * 64 + (n & 1) * 32; };
  u32x4 ra = *(const u32x4*)(gsrc + (long)kbof(0) * gmul), rb = *(const u32x4*)(gsrc + (long)kbof(1) * gmul);
  *(u32x4*)(slot0 + ldst) = ra;
  __syncthreads();
#pragma unroll 1
  for (int n = 0; n < N; n += 2) {
    const int j = blist[n >> 1];
    const bool won = MODE == 0 ? ((umall >> j) & 1u) != 0 : (j >= cur - 8 && j <= cur);
    const bool bit = (selmask >> j) & 1u;
    ra = *(const u32x4*)(gsrc + (long)kbof(min(n + 2, N - 2)) * gmul);
    if (won) { KVFrag f; nsa_ldsfrag(f, slot0, qi, quad); nsa_chunk<MODE>(f, j * 64, t, bit, qf, O, m, l, quad, online); }
    *(u32x4*)(slot1 + ldst) = rb;
    __syncthreads();
    rb = *(const u32x4*)(gsrc + (long)kbof(min(n + 3, N - 1)) * gmul);
    if (won) { KVFrag f; nsa_ldsfrag(f, slot1, qi, quad); nsa_chunk<MODE>(f, j * 64 + 32, t, bit, qf, O, m, l, quad, online); }
    *(u32x4*)(slot0 + ldst) = ra;
    __syncthreads();
  }
}

template <bool LAST>
DI void nsa_finish(u32x2* lo, f32x4 (&O)[4][4], float (&m)[4], float (&l)[4], const float (&gate)[4], const bf16_t* zp, bf16_t* yp, float minit) {
#pragma unroll
  for (int hh = 0; hh < 4; ++hh) {
    float lt = l[hh]; lt += __shfl_xor(lt, 16); lt += __shfl_xor(lt, 32);
    const float f = lt > 0.f ? gate[hh] / lt : 0.f;
#pragma unroll
    for (int dt = 0; dt < 4; ++dt) {
      const u32x2 a = lo[(hh * 4 + dt) * 64];
      const f32x4 v = (f32x4){bflo(a[0]), bfhi(a[0]), bflo(a[1]), bfhi(a[1])} + O[hh][dt] * f;
      if (LAST) {
        const u32x2 zz = *(const u32x2*)(zp + hh * 64 + dt * 16);
        *(u32x2*)(yp + hh * 64 + dt * 16) = (u32x2){pk2(v[0] * bflo(zz[0]), v[1] * bfhi(zz[0])), pk2(v[2] * bflo(zz[1]), v[3] * bfhi(zz[1]))};
      } else {
        lo[(hh * 4 + dt) * 64] = (u32x2){pk2(v[0], v[1]), pk2(v[2], v[3])};
        O[hh][dt] = (f32x4){0.f, 0.f, 0.f, 0.f};
      }
    }
    m[hh] = minit; l[hh] = 0.f;
  }
}

DI void nsa_wave(const Params& p, int layer, int b, int g, int t0, unsigned char* lds, bf16_t* ybase) {
  const int lane = my_tid() & 63, qi = lane & 15, quad = lane >> 4;
  const int t = t0 + qi, cur = t0 >> 6;
  const long tok = (long)b * SEQ + t;
  const int bg = b * 2 + g;
  u32x2* lo = (u32x2*)lds + (my_tid() >> 6) * 1024 + lane;

  const float mf_c = p.mfix()[layer * 4 + 0], mf_s = p.mfix()[layer * 4 + 1], mf_w = p.mfix()[layer * 4 + 2];
  const bool on_c = mf_c > 60.f, on_s = mf_s > 60.f, on_w = mf_w > 60.f;
  const float SC = 0.125f * 1.44269504089f;
  const bf16_t* Kc = p.kc() + (long)bg * 128 * 64;
  const bf16_t* Vc = p.vct() + (long)bg * 64 * 128;
  f32x4 ph[8];
#pragma unroll
  for (int kt = 0; kt < 8; ++kt) ph[kt] = (f32x4){0.f, 0.f, 0.f, 0.f};
#pragma unroll 1
  for (int hh = 0; hh < 4; ++hh) {
    const bf16_t* qp0 = p.nq() + ((long)(b * 8 + g * 4 + hh) * SEQ + t) * 64 + quad * 8;
    const bf16x8 q0 = ld8(qp0), q1 = ld8(qp0 + 32); const float gt = p.ngate()[tok * 32 + g * 4 + hh];
    f32x4 sc[8];
    float mx = on_c ? -1e30f : mf_c;
#pragma unroll
    for (int kt = 0; kt < 8; ++kt) {
      const bf16_t* kp = Kc + (long)(kt * 16 + qi) * 64 + quad * 8;
      sc[kt] = MFMA16(ld8(kp), q0, ((f32x4){0.f, 0.f, 0.f, 0.f}));
      sc[kt] = MFMA16(ld8(kp + 32), q1, sc[kt]);
      sc[kt] = sc[kt] * SC;
    }
    if (on_c) {
#pragma unroll
      for (int kt = 0; kt < 8; ++kt)
#pragma unroll
        for (int r = 0; r < 4; ++r) { const int c = kt * 16 + quad * 4 + r; if (c < NCMP && 16 * c + 31 <= t) mx = fmaxf(mx, sc[kt][r]); }
      mx = fmaxf(mx, __shfl_xor(mx, 16)); mx = fmaxf(mx, __shfl_xor(mx, 32));
    }
    float sum = 0.f;
#pragma unroll
    for (int kt = 0; kt < 8; ++kt)
#pragma unroll
      for (int r = 0; r < 4; ++r) {
        const int c = kt * 16 + quad * 4 + r;
        const float e = (c < NCMP && 16 * c + 31 <= t) ? __builtin_amdgcn_exp2f(sc[kt][r] - mx) : 0.f;
        sc[kt][r] = e; sum += e;
      }
    sum += __shfl_xor(sum, 16); sum += __shfl_xor(sum, 32);
    const float inv = sum > 0.f ? 1.f / sum : 0.f;
#pragma unroll
    for (int kt = 0; kt < 8; ++kt) { sc[kt] = sc[kt] * inv; ph[kt] += sc[kt]; }
    f32x4 oc[4];
#pragma unroll
    for (int dt = 0; dt < 4; ++dt) oc[dt] = (f32x4){0.f, 0.f, 0.f, 0.f};
#pragma unroll
    for (int mm = 0; mm < 4; ++mm) {
      const bf16x8 pf = mk8((u32x4){pk2(sc[2 * mm][0], sc[2 * mm][1]), pk2(sc[2 * mm][2], sc[2 * mm][3]), pk2(sc[2 * mm + 1][0], sc[2 * mm + 1][1]), pk2(sc[2 * mm + 1][2], sc[2 * mm + 1][3])});
#pragma unroll
      for (int dt = 0; dt < 4; ++dt) {
        const bf16_t* vp = Vc + (long)(dt * 16 + qi) * 128 + 32 * mm + quad * 4;
        const u32x2 lo = *(const u32x2*)vp, hi = *(const u32x2*)(vp + 16);
        oc[dt] = MFMA16(mk8((u32x4){lo[0], lo[1], hi[0], hi[1]}), pf, oc[dt]);
      }
    }
#pragma unroll
    for (int dt = 0; dt < 4; ++dt) { const f32x4 v = oc[dt] * gt; lo[(hh * 4 + dt) * 64] = (u32x2){pk2(v[0], v[1]), pk2(v[2], v[3])}; }
  }
  float imp[8];
  {
    float rot[8];
#pragma unroll
    for (int kt = 0; kt < 8; ++kt) rot[kt] = __shfl(ph[kt][3], (lane + 48) & 63);
#pragma unroll
    for (int kt = 0; kt < 8; ++kt) {
      const float extra = quad > 0 ? rot[kt] : (kt > 0 ? rot[kt > 0 ? kt - 1 : 0] : 0.f);
      const float v = (ph[kt][0] + ph[kt][1]) + (ph[kt][2] + ph[kt][3]) + extra;
      const int j = 4 * kt + quad;
      const bool forced = j == 0 || j == cur || j == cur - 1;
      imp[kt] = j <= cur ? v + (forced ? 1e4f : 0.f) : -1e30f;
    }
  }
  unsigned selmask = 0;
  {
    int rank[8];
#pragma unroll
    for (int kt = 0; kt < 8; ++kt) rank[kt] = 0;
#pragma unroll 1
    for (int q2 = 0; q2 < 4; ++q2)
#pragma unroll
      for (int k2 = 0; k2 < 8; ++k2) {
        const float ov = __shfl(imp[k2], qi + 16 * q2);
#pragma unroll
        for (int kt = 0; kt < 8; ++kt) {
          const bool before = k2 < kt || (k2 == kt && q2 < quad);
          rank[kt] += (ov > imp[kt] || (ov == imp[kt] && before)) ? 1 : 0;
        }
      }
#pragma unroll
    for (int kt = 0; kt < 8; ++kt) if (rank[kt] < 8 && 4 * kt + quad <= cur) selmask |= 1u << (4 * kt + quad);
    selmask |= __shfl_xor(selmask, 16); selmask |= __shfl_xor(selmask, 32);
  }

  unsigned umall = selmask;
  umall |= __shfl_xor(umall, 1); umall |= __shfl_xor(umall, 2); umall |= __shfl_xor(umall, 4); umall |= __shfl_xor(umall, 8);
  umall = __builtin_amdgcn_readfirstlane(umall);
  const int wv = my_tid() >> 6;
  unsigned* umw = (unsigned*)(lds + NSA_UMW); int* blist = (int*)(lds + NSA_BLIST);
  if (lane == 0) umw[wv] = umall;
  bf16x8 qf[4][2];
#pragma unroll
  for (int hh = 0; hh < 4; ++hh) {
    const bf16_t* qp = p.nq() + ((long)(b * 8 + g * 4 + hh) * SEQ + t) * 64 + quad * 8;
    qf[hh][0] = ld8(qp); qf[hh][1] = ld8(qp + 32);
  }
  float gate[3][4];
#pragma unroll
  for (int br = 1; br < 3; ++br) { const f32x4 gv = *(const f32x4*)(p.ngate() + tok * 32 + br * 8 + g * 4); gate[br][0] = gv[0]; gate[br][1] = gv[1]; gate[br][2] = gv[2]; gate[br][3] = gv[3]; }
  f32x4 O[4][4]; float m[4], l[4];
#pragma unroll
  for (int hh = 0; hh < 4; ++hh) { m[hh] = on_s ? -1e30f : mf_s; l[hh] = 0.f;
#pragma unroll
    for (int dt = 0; dt < 4; ++dt) O[hh][dt] = (f32x4){0.f, 0.f, 0.f, 0.f}; }
  __syncthreads();
  int nb;
  {
    unsigned ub = 0;
#pragma unroll
    for (int i = 0; i < 8; ++i) ub |= umw[i];
    nb = __builtin_popcount(ub);
    if (my_tid() < 32) { if ((ub >> my_tid()) & 1u) blist[__builtin_popcount(ub & ((1u << my_tid()) - 1u))] = my_tid(); }
    __syncthreads();
    nsa_branch<0>(p.ks() + (long)bg * SEQ * 64, p.vst() + (long)bg * 64 * SEQ, lds, nb, t, cur, selmask, umall, qf, O, m, l, on_s);
    nsa_finish<false>(lo, O, m, l, gate[1], nullptr, nullptr, on_w ? -1e30f : mf_w);
  }
  {
    const int cur0 = (t0 >> 7) * 2, jlo = cur0 >= 8 ? cur0 - 8 : 0;
    nb = cur0 + 2 - jlo;
    if (my_tid() < nb) blist[my_tid()] = jlo + my_tid();
    __syncthreads();
    nsa_branch<1>(p.kw() + (long)bg * SEQ * 64, p.vwt() + (long)bg * 64 * SEQ, lds, nb, t, cur, selmask, umall, qf, O, m, l, on_w);
    nsa_finish<true>(lo, O, m, l, gate[2], p.nz() + tok * 512 + g * 256 + quad * 4, ybase + tok * 512 + g * 256 + quad * 4, 0.f);
  }
  __syncthreads();
}

DI void phaseC(const Params& p0, int layer, unsigned char* lds, bool probe) {
  const int NITEM = BATCH * 2 * 16;
  for (int it = blockIdx.x; it < NITEM; it += gridDim.x) {
    const Params p = relaunder(p0);
    const int qt = 15 - (it >> 5), bg = it & 31;
    nsa_wave(p, layer, bg >> 1, bg & 1, qt * 128 + (my_tid() >> 6) * 16, lds, probe ? p.dummy() : p.nz());
  }
}

DI void phaseD(const Params& p0, const Slot sl, int layer, unsigned char* lds) {
  const Params p = relaunder(p0);
  bf16_t* gl = (bf16_t*)lds;
  int mt, nt;
  for (int it = 0; tile_order(sl, it, 4, mt, nt); ++it) {
#pragma unroll 1
    for (int which = 0; which < 2; ++which) {
      const bf16_t* Wg = (which ? p.wupb_t() : p.wupa_t()) + ((long)nt * 256) * 512;
      const bf16_t* Yg = (which ? p.nz() : p.sbz()) + (long)mt * 256 * 512;
      const bf16_t* Gg = which ? p.gb() : p.ga();
      int mt2 = mt, nt2 = nt; bool more = true;
      if (which) more = tile_order(sl, it + 1, 4, mt2, nt2);
      const bf16_t* Wn = more ? (which ? p.wupa_t() : p.wupb_t()) + ((long)nt2 * 256) * 512 : Wg;
      const bf16_t* Yn = more ? (which ? p.sbz() : p.nz()) + (long)mt2 * 256 * 512 : Yg;
      f32x4 acc[8][4]; zero_acc(acc);
      gemm_core(Wg, 512, Yg, 512, 512, gl, acc, 64, it > 0 || which, Wn, Yn);
      const int tid = my_tid(), lane = tid & 63, w = tid >> 6, wa = w >> 2, wb = w & 3, qi = lane & 15, quad = lane >> 4;
#pragma unroll
      for (int j = 0; j < 4; ++j) {
        const long tok = (long)mt * 256 + wb * 64 + j * 16 + qi;
#pragma unroll
        for (int i = 0; i < 8; ++i) {
          const long off = tok * 1024 + nt * 256 + wa * 128 + i * 16 + quad * 4;
          const u32x2 xg = *(const u32x2*)(Gg + off);
          const f32x4 v = acc[i][j];
          float o0 = bflo(xg[0]) * v[0], o1 = bfhi(xg[0]) * v[1], o2 = bflo(xg[1]) * v[2], o3 = bfhi(xg[1]) * v[3];
          if (which) { const u32x2 a = *(const u32x2*)(p.merged() + off); o0 += bflo(a[0]); o1 += bfhi(a[0]); o2 += bflo(a[1]); o3 += bfhi(a[1]); }
          *(u32x2*)(p.merged() + off) = (u32x2){pk2(o0, o1), pk2(o2, o3)};
          if ((i & 3) == 3) asm volatile("" ::: "memory");
        }
      }
    }
  }
}

DI void phaseE(const Params& p0, const Slot sl, int layer, unsigned char* lds, const float* xsrc) {
  const Params p = relaunder(p0);
  bf16_t* gl = (bf16_t*)lds;
  int mt, nt;
  for (int it = 0; tile_order(sl, it, 4, mt, nt); ++it) {
    f32x4 acc[8][4]; zero_acc(acc);
    int mt2, nt2;
    const bool more = tile_order(sl, it + 1, 4, mt2, nt2);
    const bf16_t* Wg = p.wout_t() + ((long)nt * 256) * 1024; const bf16_t* Mg = p.merged() + (long)mt * 256 * 1024;
    gemm_core(Wg, 1024, Mg, 1024, 1024, gl, acc, 64, it > 0, more ? p.wout_t() + ((long)nt2 * 256) * 1024 : Wg, more ? p.merged() + (long)mt2 * 256 * 1024 : Mg);
    const int tid = my_tid(), lane = tid & 63, w = tid >> 6, wa = w >> 2, wb = w & 3, qi = lane & 15, quad = lane >> 4;
#pragma unroll
    for (int j = 0; j < 4; ++j) {
      const long tok = (long)mt * 256 + wb * 64 + j * 16 + qi;
      float ss = 0.f;
#pragma unroll
      for (int i = 0; i < 8; ++i) {
        const long off = tok * 1024 + nt * 256 + wa * 128 + i * 16 + quad * 4;
        const f32x4 xo = *(const f32x4*)(xsrc + off);
        const f32x4 xn = xo + acc[i][j];
        *(f32x4*)(p.out + off) = xn;
        *(u32x2*)(p.xb() + off + tok * (LDX - D_MODEL)) = (u32x2){pk2(xn[0], xn[1]), pk2(xn[2], xn[3])};
        ss += xn[0] * xn[0] + xn[1] * xn[1] + xn[2] * xn[2] + xn[3] * xn[3];
      }
      ss += __shfl_xor(ss, 16); ss += __shfl_xor(ss, 32);
      if (quad == 0) p.part()[tok * 16 + nt * 2 + wa] = ss;
    }
  }
}

#ifndef STOP_AFTER
#define STOP_AFTER 0
#endif
constexpr int LDS_BYTES = LDS_GEMM_BYTES + 1024;

__global__ void __launch_bounds__(512) hybrid_megakernel(Params p) {
  extern __shared__ __attribute__((aligned(16))) unsigned char lds[];
  cg::grid_group grid = cg::this_grid();
  __shared__ int s_xcc, s_rank, s_ok;
  __shared__ unsigned s_bar[4];
  if (threadIdx.x == 0) { s_bar[0] = 0u; s_bar[1] = 0u; }
  __syncthreads();
  const XcdBarrier xb = xcd_barrier_post((unsigned*)(p.ws + OFF_BAR), (volatile LAS unsigned*)s_bar);
  if (threadIdx.x == 0) {
    const unsigned xcc = (unsigned)__builtin_amdgcn_s_getreg((3 << 11) | 20) & 7u;
    s_xcc = (int)xcc; s_rank = (int)atomicAdd(p.ctl() + xcc, 1u);
  }
  phase_prologue(p, lds);
  grid.sync();
  if (threadIdx.x == 0) {
    int ok = 1;
    for (int i = 0; i < 8; ++i) ok &= (__hip_atomic_load(p.ctl() + i, __ATOMIC_RELAXED, __HIP_MEMORY_SCOPE_AGENT) == (gridDim.x >> 3));
    s_ok = ok;
  }
  __syncthreads();
  const Slot sl = {s_ok ? s_xcc : (int)(blockIdx.x & 7), s_ok ? s_rank : (int)(blockIdx.x >> 3)};
  for (int layer = 0; layer < DEPTH; ++layer) {
    if (layer > 0) convert_weights(p, layer, lds, 2);
    if (STOP_AFTER != 0 && STOP_AFTER == layer * 10) return;
    phaseA(p, sl, layer, lds);
    xcd_barrier(xb);
#ifdef PROBE_A
    phaseA(p, sl, layer, lds, PROBE_A >= 2 ? PROBE_A : 0);
    xcd_barrier(xb);
#endif
    if (STOP_AFTER == layer * 10 + 1) return;
#ifdef PROBE_B
    phaseB(p, layer, lds, true);
    xcd_barrier(xb);
#endif
    phaseB(p, layer, lds, false);
    xcd_barrier(xb);
    phaseB2(p, layer, lds);
    xcd_barrier(xb);
    if (STOP_AFTER == layer * 10 + 2) return;
#ifdef PROBE_C
    phaseC(p, layer, lds, true);
    xcd_barrier(xb);
#endif
    phaseC(p, layer, lds, false);
    xcd_barrier(xb);
    if (STOP_AFTER == layer * 10 + 3) return;
    phaseD(p, sl, layer, lds);
    xcd_barrier(xb);
#ifdef PROBE_D
    phaseD(p, sl, layer, lds);
    xcd_barrier(xb);
#endif
    if (STOP_AFTER == layer * 10 + 4) return;
    if (layer == 0) phaseE(p, sl, layer, lds, p.x_in); else phaseE(p, sl, layer, lds, p.out);
    if (layer + 1 < DEPTH) convert_weights(p, layer + 1, lds, 1);
    if (layer + 1 < DEPTH) xcd_barrier(xb);
    if (STOP_AFTER == layer * 10 + 5) return;
  }
}

extern "C" void kernel_launch(void* const* d_in, const int* in_sizes, int n_in, void* d_out, int out_size,
                              void* d_ws, size_t ws_size, hipStream_t stream) {
  static int grid_blocks = 0;
  if (!grid_blocks) {
    int dev = 0, cus = 0, per_cu = 0;
    (void)hipGetDevice(&dev);
    (void)hipDeviceGetAttribute(&cus, hipDeviceAttributeMultiprocessorCount, dev);
    if (hipFuncSetAttribute((const void*)hybrid_megakernel, hipFuncAttributeMaxDynamicSharedMemorySize, LDS_BYTES) != hipSuccess) fprintf(stderr, "hipFuncSetAttribute(max dynamic LDS) failed\n");
    (void)hipOccupancyMaxActiveBlocksPerMultiprocessor(&per_cu, hybrid_megakernel, NTHR, LDS_BYTES);
    (void)hipGetLastError();
    if (per_cu > 1) per_cu = 1;
    if (per_cu < 1) per_cu = 1;
    grid_blocks = (cus * per_cu) & ~7;
  }
  Params a{};
  a.x_in = (const float*)d_in[0]; a.pos = (const int*)d_in[1]; a.norm_g = (const float*)d_in[2]; a.w_in = (const float*)d_in[3];
  a.q_norm_g = (const float*)d_in[4]; a.k_norm_g = (const float*)d_in[5]; a.cmp_pe = (const float*)d_in[6]; a.cmp_w1 = (const float*)d_in[7];
  a.cmp_b1 = (const float*)d_in[8]; a.cmp_w2 = (const float*)d_in[9]; a.w_up_a = (const float*)d_in[10]; a.w_up_b = (const float*)d_in[11];
  a.w_out = (const float*)d_in[12];
  a.out = (float*)d_out; a.ws = (unsigned char*)d_ws;
  if (WS_NEED > ws_size) { fprintf(stderr, "workspace too small: need %zu have %zu\n", (size_t)WS_NEED, ws_size); return; }
  (void)hipMemsetAsync((unsigned char*)d_ws + OFF_CTL, 0, 256, stream);
  (void)hipMemsetAsync((unsigned char*)d_ws + OFF_BAR, 0, 3456 * 4, stream);
  void* args[] = {&a};
  hipError_t e = hipLaunchCooperativeKernel((void*)hybrid_megakernel, dim3(grid_blocks), dim3(NTHR), args, LDS_BYTES, stream);
  if (e != hipSuccess) fprintf(stderr, "cooperative launch failed: %s (grid %d)\n", hipGetErrorString(e), grid_blocks);
}
```

```cpp
#include <hip/hip_runtime.h>
#include <hip/hip_cooperative_groups.h>
#include <cstdio>
#include <cstdint>
namespace cg = cooperative_groups;

typedef unsigned short bf16_t;
typedef short bf16x8 __attribute__((ext_vector_type(8)));
typedef float f32x4 __attribute__((ext_vector_type(4)));
typedef float f32x2 __attribute__((ext_vector_type(2)));
typedef unsigned u32x4 __attribute__((ext_vector_type(4)));
typedef unsigned u32x2 __attribute__((ext_vector_type(2)));
typedef __bf16 bf16x2_t __attribute__((ext_vector_type(2)));

#define DI __device__ __forceinline__
#define MFMA16(a, b, c) __builtin_amdgcn_mfma_f32_16x16x32_bf16((a), (b), (c), 0, 0, 0)

constexpr int D_MODEL = 1024, BATCH = 16, SEQ = 2048, DEPTH = 4, NTOK = BATCH * SEQ;
constexpr int N_IN = 5912, NP = 6144, NT_IN = 24;
constexpr int NTHR = 512;
constexpr int LDX = D_MODEL + 64;
constexpr int NCMP = 127;
constexpr float NORM_EPS = 1e-6f;

DI unsigned pk2(float lo, float hi) { f32x2 v = {lo, hi}; bf16x2_t b = __builtin_convertvector(v, bf16x2_t); return __builtin_bit_cast(unsigned, b); }
DI float bflo(unsigned u) { return __uint_as_float(u << 16); }
DI float bfhi(unsigned u) { return __uint_as_float(u & 0xffff0000u); }
DI float sigmoidf_(float x) { return __builtin_amdgcn_rcpf(1.f + __builtin_amdgcn_exp2f(-1.44269504089f * x)); }
DI float siluf_(float x) { return x * __builtin_amdgcn_rcpf(1.f + __builtin_amdgcn_exp2f(-1.44269504089f * x)); }
DI bf16x8 mk8(u32x4 v) { return __builtin_bit_cast(bf16x8, v); }
DI bf16x8 ld8(const bf16_t* p) { return __builtin_bit_cast(bf16x8, *(const u32x4*)p); }


DI void sincos_acc(float angf, float& sn, float& cs) {
  const double a = (double)angf;
  const double k = rint(a * 0.63661977236758134308);
  const double y = (a - k * 1.57079632679489655800) - k * 6.12323399573676603587e-17;
  const double y2 = y * y;
  const double sp = y * (1.0 + y2 * (-1.0 / 6 + y2 * (1.0 / 120 + y2 * (-1.0 / 5040 + y2 * (1.0 / 362880 + y2 * (-1.0 / 39916800 + y2 * (1.0 / 6227020800.0)))))));
  const double cp = 1.0 + y2 * (-0.5 + y2 * (1.0 / 24 + y2 * (-1.0 / 720 + y2 * (1.0 / 40320 + y2 * (-1.0 / 3628800 + y2 * (1.0 / 479001600.0))))));
  const int q = ((int)k) & 3;
  const double s_ = (q & 1) ? cp : sp, c_ = (q & 1) ? sp : cp;
  sn = (float)((q & 2) ? -s_ : s_);
  cs = (float)(((q + 1) & 2) ? -c_ : c_);
}
DI float inv_freq(int f) { return (float)exp(-(double)f * (9.21034037197618273607 / 32.0)); }

constexpr size_t al256(size_t x) { return (x + 255) & ~(size_t)255; }
constexpr size_t OFF_WT_IN = 0;
constexpr size_t OFF_W1T = OFF_WT_IN + al256((size_t)NP * LDX * 2);
constexpr size_t OFF_W2T = OFF_W1T + al256((size_t)2 * 256 * 2048 * 2);
constexpr size_t OFF_WUPA = OFF_W2T + al256((size_t)2 * 64 * 256 * 2);
constexpr size_t OFF_WUPB = OFF_WUPA + al256((size_t)1024 * 512 * 2);
constexpr size_t OFF_WOUT = OFF_WUPB + al256((size_t)1024 * 512 * 2);
constexpr size_t OFF_B1EFF = OFF_WOUT + al256((size_t)1024 * 1024 * 2);
constexpr size_t OFF_COST = OFF_B1EFF + al256((size_t)DEPTH * 2 * 16 * 256 * 4);
constexpr size_t OFF_SINT = OFF_COST + al256((size_t)NTOK * 32 * 4);
constexpr size_t OFF_COSC = OFF_SINT + al256((size_t)NTOK * 32 * 4);
constexpr size_t OFF_SINC = OFF_COSC + al256((size_t)BATCH * 128 * 32 * 4);
constexpr size_t OFF_XB = OFF_SINC + al256((size_t)BATCH * 128 * 32 * 4);
constexpr size_t OFF_PART = OFF_XB + al256((size_t)NTOK * LDX * 2);
constexpr size_t OFF_SBQ = OFF_PART + al256((size_t)NTOK * 16 * 4);
constexpr size_t OFF_SBK = OFF_SBQ + al256((size_t)NTOK * 512 * 2);
constexpr size_t OFF_SBVT = OFF_SBK + al256((size_t)NTOK * 512 * 2);
constexpr size_t OFF_SBZ = OFF_SBVT + al256((size_t)NTOK * 512 * 2);
constexpr size_t OFF_NQ = OFF_SBZ + al256((size_t)NTOK * 512 * 2);
constexpr size_t OFF_KCR = OFF_NQ + al256((size_t)NTOK * 512 * 2);
constexpr size_t OFF_VCR = OFF_KCR + al256((size_t)NTOK * 128 * 2);
constexpr size_t OFF_KS = OFF_VCR + al256((size_t)NTOK * 128 * 2);
constexpr size_t OFF_VST = OFF_KS + al256((size_t)NTOK * 128 * 2);
constexpr size_t OFF_KW = OFF_VST + al256((size_t)NTOK * 128 * 2);
constexpr size_t OFF_VWT = OFF_KW + al256((size_t)NTOK * 128 * 2);
constexpr size_t OFF_NGATE = OFF_VWT + al256((size_t)NTOK * 128 * 2);
constexpr size_t OFF_NZ = OFF_NGATE + al256((size_t)NTOK * 32 * 4);
constexpr size_t OFF_GA = OFF_NZ + al256((size_t)NTOK * 512 * 2);
constexpr size_t OFF_GB = OFF_GA + al256((size_t)NTOK * 1024 * 2);
constexpr size_t OFF_HID = OFF_GB + al256((size_t)NTOK * 1024 * 2);
constexpr size_t OFF_KC = OFF_HID + al256((size_t)4 * 32 * 256 * 256 * 4);
constexpr size_t OFF_VCT = OFF_KC + al256((size_t)BATCH * 2 * 128 * 64 * 2);
constexpr size_t OFF_QNG = OFF_VCT + al256((size_t)BATCH * 2 * 64 * 128 * 2);
constexpr size_t OFF_KNG = OFF_QNG + al256((size_t)DEPTH * 64 * 4);
constexpr size_t OFF_CTL = OFF_KNG + al256((size_t)DEPTH * 3 * 64 * 4);
constexpr size_t OFF_MFIX_BASE = OFF_CTL + 256;
constexpr size_t OFF_MFIX_OLD = OFF_KNG + al256((size_t)DEPTH * 3 * 64 * 4);
constexpr size_t OFF_MFIX = OFF_MFIX_BASE;
constexpr size_t OFF_DUMMY = OFF_MFIX + 256;
constexpr size_t OFF_BAR = OFF_DUMMY + 256;
constexpr size_t WS_NEED = OFF_BAR + 3456 * 4;

struct Params {
  const float* x_in; const int* pos; const float* norm_g; const float* w_in; const float* q_norm_g; const float* k_norm_g;
  const float* cmp_pe; const float* cmp_w1; const float* cmp_b1; const float* cmp_w2; const float* w_up_a; const float* w_up_b; const float* w_out;
  float* out; unsigned char* ws;
#define WSBUF(T, name, OFF) DI T* name() const { return (T*)(ws + (OFF)); }
  WSBUF(bf16_t, wt_in, OFF_WT_IN) WSBUF(bf16_t, w1t, OFF_W1T) WSBUF(bf16_t, w2t, OFF_W2T) WSBUF(bf16_t, wupa_t, OFF_WUPA) WSBUF(bf16_t, wupb_t, OFF_WUPB) WSBUF(bf16_t, wout_t, OFF_WOUT)
  WSBUF(float, b1eff, OFF_B1EFF) WSBUF(float, cosT, OFF_COST) WSBUF(float, sinT, OFF_SINT) WSBUF(float, cosC, OFF_COSC) WSBUF(float, sinC, OFF_SINC)
  WSBUF(bf16_t, xb, OFF_XB) WSBUF(float, part, OFF_PART) WSBUF(bf16_t, sbq, OFF_SBQ) WSBUF(bf16_t, sbk, OFF_SBK) WSBUF(bf16_t, sbvt, OFF_SBVT) WSBUF(bf16_t, sbz, OFF_SBZ)
  WSBUF(bf16_t, nq, OFF_NQ) WSBUF(bf16_t, kcr, OFF_KCR) WSBUF(bf16_t, vcr, OFF_VCR) WSBUF(bf16_t, ks, OFF_KS) WSBUF(bf16_t, vst, OFF_VST) WSBUF(bf16_t, kw, OFF_KW) WSBUF(bf16_t, vwt, OFF_VWT)
  WSBUF(float, ngate, OFF_NGATE) WSBUF(bf16_t, nz, OFF_NZ) WSBUF(bf16_t, ga, OFF_GA) WSBUF(bf16_t, gb, OFF_GB) WSBUF(float, hpre, OFF_HID) WSBUF(bf16_t, kc, OFF_KC) WSBUF(bf16_t, vct, OFF_VCT)
  WSBUF(bf16_t, merged, OFF_SBK)
  WSBUF(bf16_t, dummy, OFF_XB)     WSBUF(float, mfix, OFF_MFIX) WSBUF(unsigned, ctl, OFF_CTL)
  WSBUF(float, qng, OFF_QNG) WSBUF(float, kng, OFF_KNG)
};

DI int my_tid() { int t = threadIdx.x; asm volatile("" : "+v"(t)); return t; }
DI Params relaunder(const Params& p0) { Params p = p0; size_t z = 0; asm volatile("" : "+s"(z)); p.ws = p0.ws + z; return p; }

constexpr int TILE_B = 32 * 1024;
constexpr int STAGE_B = 2 * TILE_B;
constexpr int LDS_GEMM_BYTES = 2 * STAGE_B;
typedef __attribute__((address_space(3))) unsigned lds_u32;

DI void g_dma(const bf16_t* __restrict__ base, const unsigned (&off)[8], int ko, unsigned char* stage, int w) {
#pragma unroll
  for (int u = 0; u < 8; ++u)
    __builtin_amdgcn_global_load_lds((const unsigned*)(base + (off[u] + ko)), (lds_u32*)(stage + (w * 8 + u) * 1024), 16, 0, 0);
}
#define G_LDA(dst, ih, ks) _Pragma("unroll") for (int i = 0; i < 4; ++i) dst[i] = mk8(*(const u32x4*)(stage + ra + (((ih) * 4 + i) * 2 + (ks)) * 1024))
#define G_LDB(dst, ks) _Pragma("unroll") for (int j = 0; j < 4; ++j) dst[j] = mk8(*(const u32x4*)(stage + TILE_B + rb + (j * 2 + (ks)) * 1024))
#define G_MMA(ih, A, B) do { _Pragma("unroll") for (int i = 0; i < 4; ++i) _Pragma("unroll") for (int j = 0; j < 4; ++j) acc[(ih) * 4 + i][j] = MFMA16(A[i], B[j], acc[(ih) * 4 + i][j]); } while (0)
DI void g_compute(const unsigned char* stage, int ra, int rb, f32x4 (&acc)[8][4]) {
  bf16x8 b0[4], b1[4], a0[4], a1[4];
  G_LDB(b0, 0); G_LDA(a0, 0, 0);
  __builtin_amdgcn_sched_barrier(0);
  G_LDA(a1, 1, 0);
  G_MMA(0, a0, b0);
  __builtin_amdgcn_sched_barrier(0);
  G_LDB(b1, 1); G_LDA(a0, 0, 1);
  G_MMA(1, a1, b0);
  __builtin_amdgcn_sched_barrier(0);
  G_LDA(a1, 1, 1);
  G_MMA(0, a0, b1);
  __builtin_amdgcn_sched_barrier(0);
  G_MMA(1, a1, b1);
  __builtin_amdgcn_sched_barrier(0);
}

DI void gemm_core(const bf16_t* __restrict__ Ag, long lda, const bf16_t* __restrict__ Bg, long ldb, int K,
                  bf16_t* ldsb, f32x4 (&acc)[8][4], int kstep = 64, bool pre = false, const bf16_t* nAg = nullptr, const bf16_t* nBg = nullptr, bool perm = false) {
  unsigned char* lds = (unsigned char*)ldsb;
  const int tid = my_tid(), lane = tid & 63, w = __builtin_amdgcn_readfirstlane(tid >> 6), wa = w >> 2, wb = w & 3, qi = lane & 15, quad = lane >> 4;
  const bf16_t* base = w >= 4 ? Bg : Ag; const int ld = (int)(w >= 4 ? ldb : lda);
  const bf16_t* nbase = nAg ? (w >= 4 ? nBg : nAg) : base;
  unsigned off[8];
#pragma unroll
  for (int u = 0; u < 8; ++u) {
    const int blk = (w & 3) * 8 + u, rg = blk >> 1, kh = blk & 1;
    int R = rg * 16 + (lane >> 2);
    if (perm) { const int rho = R & 31; R = (R & ~31) + ((rho >> 2) & 3) * 8 + (rho >> 4) * 4 + (rho & 3); }
    off[u] = (unsigned)(R * ld + kh * 32 + (lane & 3) * 8);
  }
  const int ra = (wa * 8) * 2 * 1024 + (qi * 4 + quad) * 16, rb = (wb * 4) * 2 * 1024 + (qi * 4 + quad) * 16;
  unsigned char* buf0 = lds; unsigned char* buf1 = lds + STAGE_B;
  const int KT = K >> 6;
  if (!pre) {
    g_dma(base, off, 0, buf0, w);
    asm volatile("s_waitcnt vmcnt(0)" ::: "memory");
    __syncthreads();
  }
  for (int kt = 0; kt < KT; kt += 2) {
    g_dma(base, off, (kt + 1) * kstep, buf1, w);
    g_compute(buf0, ra, rb, acc);
    asm volatile("s_waitcnt vmcnt(0)" ::: "memory");
    __syncthreads();
    const bool last = kt + 2 >= KT;
    g_dma(last ? nbase : base, off, last ? 0 : (kt + 2) * kstep, buf0, w);
    g_compute(buf1, ra, rb, acc);
    asm volatile("s_waitcnt vmcnt(0)" ::: "memory");
    __syncthreads();
  }
}

DI void zero_acc(f32x4 (&acc)[8][4]) {
#pragma unroll
  for (int i = 0; i < 8; ++i)
#pragma unroll
    for (int j = 0; j < 4; ++j) acc[i][j] = (f32x4){0.f, 0.f, 0.f, 0.f};
}

struct Slot { int xcd, slot; };
DI bool tile_order(const Slot sl, int it, int nN, int& mt, int& nt) {
  const int xcd = sl.xcd, slot = sl.slot, SL = gridDim.x >> 3;
  const int q = slot + it * SL, per = 8 * nN;
  if (q >= 2 * per) return false;
  const int mg = q / per, e = q - mg * per;
  nt = e >> 3; mt = xcd * 16 + mg * 8 + (e & 7);
  return true;
}


#define XB_TMO      128
#define XB_XCNT(j)  (256  + 64 * (j))
#define XB_XSUB(j)  (1280 + 64 * (j))
#define XB_XGEN(j)  (2304 + 64 * (j))
#define XB_TOP      3328
#define XB_TOPGEN   3392
#define XCD_BAR_WORDS 3456
#define XB_SPIN_CAP (1u << 21)
#define LAS __attribute__((address_space(3)))
DI unsigned xb_ld(unsigned* p)              { return __hip_atomic_load(p, __ATOMIC_RELAXED, __HIP_MEMORY_SCOPE_AGENT); }
DI unsigned xb_add(unsigned* p, unsigned v) { return __hip_atomic_fetch_add(p, v, __ATOMIC_RELAXED, __HIP_MEMORY_SCOPE_AGENT); }
DI unsigned xb_xcc_id() { return (unsigned)__builtin_amdgcn_s_getreg((3 << 11) | 20) & 0xFu; }
#define XB_SPIN(cond, bar) do { unsigned _sp = 0; while (cond) { __builtin_amdgcn_s_sleep(1); \
    if ((++_sp & 255u) == 0u) { if (xb_ld(&(bar)[XB_TMO])) break; if (_sp > XB_SPIN_CAP) { atomicAdd(&(bar)[XB_TMO], 1u); break; } } } } while (0)
struct XcdBarrier { unsigned* bar; unsigned x; volatile LAS unsigned* st; };
DI XcdBarrier xcd_barrier_post(unsigned* bar, volatile LAS unsigned* st) {
  XcdBarrier b; b.bar = bar; b.x = xb_xcc_id(); b.st = st;
  if (threadIdx.x == 0) (void)xb_add(&bar[XB_XCNT(b.x)], 1u);
  return b;
}
DI void xcd_barrier_complete(unsigned* bar, unsigned x, unsigned& nloc, unsigned& nx) {
  const unsigned G = gridDim.x * gridDim.y * gridDim.z;
  unsigned sum, cnt, mine, sp = 0u;
  for (;;) {
    sum = 0u; cnt = 0u; mine = 0u;
#pragma unroll
    for (unsigned j = 0; j < 16; ++j) { const unsigned c = xb_ld(&bar[XB_XCNT(j)]); sum += c; cnt += (c > 0u) ? 1u : 0u; mine = (j == x) ? c : mine; }
    if (sum == G) break;
    __builtin_amdgcn_s_sleep(1);
    if ((++sp & 255u) == 0u) { if (xb_ld(&bar[XB_TMO])) break; if (sp > XB_SPIN_CAP) { atomicAdd(&bar[XB_TMO], 1u); break; } }
  }
  nloc = mine > 0u ? mine : 1u; nx = cnt > 0u ? cnt : 1u;
}
DI void xcd_barrier(const XcdBarrier& b) {
  asm volatile("s_waitcnt vmcnt(0)" ::: "memory");
  __syncthreads();
  if (threadIdx.x == 0) {
    unsigned* bar = b.bar;
    __builtin_amdgcn_s_waitcnt(0);
    unsigned nloc = b.st[0], nx = b.st[1];
    if (nloc == 0u) { xcd_barrier_complete(bar, b.x, nloc, nx); b.st[0] = nloc; b.st[1] = nx; }
    const unsigned old = xb_add(&bar[XB_XSUB(b.x)], 1u);
    const unsigned gen = old / nloc;
    if (old + 1u == (gen + 1u) * nloc) {
      __builtin_amdgcn_fence(__ATOMIC_RELEASE, "agent");
      asm volatile("s_waitcnt vmcnt(0)" ::: "memory");
      const unsigned og = xb_add(&bar[XB_TOP], 1u);
      const unsigned tg = og / nx;
      if (og + 1u == (tg + 1u) * nx) xb_add(&bar[XB_TOPGEN], 1u);
      else XB_SPIN(xb_ld(&bar[XB_TOPGEN]) == tg, bar);
      __builtin_amdgcn_fence(__ATOMIC_ACQUIRE, "agent");
      xb_add(&bar[XB_XGEN(b.x)], 1u);
      asm volatile("s_waitcnt vmcnt(0)" ::: "memory");
    } else {
      XB_SPIN(xb_ld(&bar[XB_XGEN(b.x)]) == gen, bar);
      __builtin_amdgcn_fence(__ATOMIC_ACQUIRE, "agent");
      asm volatile("s_waitcnt vmcnt(0)" ::: "memory");
    }
  }
  __syncthreads();
}

DI int inmap(int c) {
  if (c < 1024) return c;
  if (c < 1536) return c + 512;
  if (c < 2048) return c + 512;
  if (c < 2304) return c + 512;
  if (c < 2432) return c + 512;
  if (c < 2560) return c + 640;
  if (c < 3072) return c + 792;
  if (c < 4096) return c + 792;
  if (c < 5120) return c + 792;
  if (c < 5376) return c < 5144 ? c - 1792 : -1;
  if (c < 5888) return c - 4352;
  if (c < 6016) return c - 2944;
  return c - 2816;
}

DI void tr_tile(const float* __restrict__ src, int ld, int K, int k0, int n0, bool use_map, const float* __restrict__ scale, bf16_t* __restrict__ dst, int ldd, float* tile) {
  const int tid = my_tid();
  {
    const int nl = tid & 63, kk = tid >> 6;
    int n = n0 + nl; asm volatile("" : "+v"(n));
    const int sc = use_map ? inmap(n) : n;
#pragma unroll
    for (int r = 0; r < 8; ++r) {
      const int k = k0 + r * 8 + kk;
      float v = 0.f;
      if (sc >= 0) { v = src[(long)k * ld + sc]; if (scale) v *= scale[k]; }
      tile[(r * 8 + kk) * 65 + nl] = v;
    }
  }
  __syncthreads();
  {
    const int nl = tid >> 3, ks = tid & 7;
    unsigned o[4];
#pragma unroll
    for (int e = 0; e < 4; ++e) o[e] = pk2(tile[(ks * 8 + 2 * e) * 65 + nl], tile[(ks * 8 + 2 * e + 1) * 65 + nl]);
    *(u32x4*)(dst + (long)(n0 + nl) * ldd + k0 + ks * 8) = (u32x4){o[0], o[1], o[2], o[3]};
  }
  __syncthreads();
}

DI void tr_job(const float* src, int ld, int K, int N, bool use_map, const float* scale, bf16_t* dst, int ldd, float* tile) {
  const int nk = K >> 6, nn = N >> 6;
  for (int t = blockIdx.x; t < nk * nn; t += gridDim.x) tr_tile(src, ld, K, (t % nk) * 64, (t / nk) * 64, use_map, scale, dst, ldd, tile);
}

DI void convert_weights(const Params& p0, int l, unsigned char* lds, int which) {
  const Params p = relaunder(p0);
  float* tile = (float*)lds;
  if (which & 1) {
    tr_job(p.w_in + (long)l * D_MODEL * N_IN, N_IN, D_MODEL, NP, true, p.norm_g + l * D_MODEL, p.wt_in(), LDX, tile);
    for (int kv = 0; kv < 2; ++kv) {
      tr_job(p.cmp_w1 + (long)(l * 2 + kv) * 2048 * 256, 256, 2048, 256, false, nullptr, p.w1t() + (long)kv * 256 * 2048, 2048, tile);
      tr_job(p.cmp_w2 + (long)(l * 2 + kv) * 256 * 64, 64, 256, 64, false, nullptr, p.w2t() + (long)kv * 64 * 256, 256, tile);
    }
    tr_job(p.w_up_a + (long)l * 512 * 1024, 1024, 512, 1024, false, nullptr, p.wupa_t(), 512, tile);
    tr_job(p.w_up_b + (long)l * 512 * 1024, 1024, 512, 1024, false, nullptr, p.wupb_t(), 512, tile);
  }
  if (which & 2) tr_job(p.w_out + (long)l * 1024 * 1024, 1024, 1024, 1024, false, nullptr, p.wout_t(), 1024, tile);
}

DI void phase_prologue(const Params& p, unsigned char* lds) {
  const int tid = my_tid();
  convert_weights(p, 0, lds, 3);
  {
    const int lane = tid & 63;
    for (int wi = blockIdx.x * 8 + (tid >> 6); wi < DEPTH * 2 * 16 * 4; wi += gridDim.x * 8) {
      const int jq = wi & 3, kq = (wi >> 2) & 15, it = wi >> 6;
      const float* w1 = p.cmp_w1 + (long)it * 2048 * 256 + (long)kq * 128 * 256 + jq * 64 + lane; const float* pe = p.cmp_pe + (long)it * 2048 + kq * 128;
      float s0 = kq == 0 ? p.cmp_b1[it * 256 + jq * 64 + lane] : 0.f, s1 = 0.f, s2 = 0.f, s3 = 0.f;
#pragma unroll 4
      for (int k = 0; k < 128; k += 4) {
        s0 += pe[k] * w1[(long)k * 256]; s1 += pe[k + 1] * w1[(long)(k + 1) * 256]; s2 += pe[k + 2] * w1[(long)(k + 2) * 256]; s3 += pe[k + 3] * w1[(long)(k + 3) * 256];
      }
      p.b1eff()[(it * 16 + kq) * 256 + jq * 64 + lane] = (s0 + s1) + (s2 + s3);
    }
  }
  if (blockIdx.x == 1 && tid < DEPTH * 3) {
    const int l = tid / 3, br = tid % 3;
    float mq = 0.f, mk = 0.f;
    for (int d = 0; d < 64; ++d) { mq = fmaxf(mq, fabsf(p.q_norm_g[l * 64 + d])); mk = fmaxf(mk, fabsf(p.k_norm_g[(l * 3 + br) * 64 + d])); }
    p.mfix()[l * 4 + br] = 8.f * 1.44269504089f * mq * mk * 1.02f + 0.25f;
  }
  if (blockIdx.x == 0) { for (int i = tid; i < DEPTH * 64; i += NTHR) p.qng()[i] = p.q_norm_g[i]; for (int i = tid; i < DEPTH * 192; i += NTHR) p.kng()[i] = p.k_norm_g[i]; }
  const long gtid = (long)blockIdx.x * NTHR + tid, gn = (long)gridDim.x * NTHR;
  for (long i = gtid; i < (long)NTOK * 32; i += gn) {
    const int f = (int)(i & 31); const long tok = i >> 5;
    const float ang = (float)p.pos[tok] * inv_freq(f);
    float sn, cs; sincos_acc(ang, sn, cs);
    p.cosT()[i] = cs; p.sinT()[i] = sn;
  }
  for (long i = gtid; i < (long)BATCH * 128 * 32; i += gn) {
    const int f = (int)(i & 31); const int c = (int)((i >> 5) & 127); const int b = (int)(i >> 12);
    float cs = 1.f, sn = 0.f;
    if (c < NCMP) {
      float sum = 0.f;
      for (int k = 0; k < 32; ++k) sum += (float)p.pos[b * SEQ + c * 16 + k];
      const float ang = (sum * (1.f / 32.f)) * inv_freq(f);
      sincos_acc(ang, sn, cs);
    }
    p.cosC()[i] = cs; p.sinC()[i] = sn;
  }
  const int lane = tid & 63;
  for (long row = (long)blockIdx.x * 8 + (tid >> 6); row < NTOK; row += (long)gridDim.x * 8) {
    const float* xr = p.x_in + row * D_MODEL; bf16_t* xo = p.xb() + row * LDX;
    float ss = 0.f;
#pragma unroll
    for (int u = 0; u < 4; ++u) {
      const f32x4 v = *(const f32x4*)(xr + u * 256 + lane * 4);
      ss += v[0] * v[0] + v[1] * v[1] + v[2] * v[2] + v[3] * v[3];
      *(u32x2*)(xo + u * 256 + lane * 4) = (u32x2){pk2(v[0], v[1]), pk2(v[2], v[3])};
    }
#pragma unroll
    for (int o = 32; o >= 1; o >>= 1) ss += __shfl_xor(ss, o);
    if (lane < 8) p.part()[row * 16 + lane] = lane == 0 ? ss : 0.f;
  }
}

DI void phaseA_epilogue(const Params& p, int layer, int mt, int nt, const f32x4 (&acc)[8][4], const float* rs_s) {
  const int tid = my_tid(), lane = tid & 63, w = tid >> 6, wa = w >> 2, wb = w & 3, qi = lane & 15, quad = lane >> 4;
  if (nt >= 21) {
    bf16_t* dstb; int nh, head;
    if (nt < 23) { dstb = p.sbvt(); nh = 8; head = (nt - 21) * 4 + wb; } else if (wb < 2) { dstb = p.vst(); nh = 2; head = wb; } else { dstb = p.vwt(); nh = 2; head = wb - 2; }
    const int tok0 = mt * 256, b = tok0 >> 11;
#pragma unroll
    for (int ip = 0; ip < 4; ++ip) {
      const int tl = wa * 128 + ip * 32 + quad * 8;
      const f32x4 ra = *(const f32x4*)(rs_s + tl), rb2 = *(const f32x4*)(rs_s + tl + 4);
      const int sq = (tok0 & 2047) + tl;
#pragma unroll
      for (int j = 0; j < 4; ++j) {
        const int d = (j >> 1) * 32 + (qi >> 2) * 8 + (j & 1) * 4 + (qi & 3);
        const f32x4 v0 = acc[2 * ip][j] * ra, v1 = acc[2 * ip + 1][j] * rb2;
        bf16_t* dst = dstb + (long)(b * nh + head) * 64 * SEQ + (long)(sq >> 5) * 2048 + d * 32 + (sq & 31);
        *(u32x4*)dst = (u32x4){pk2(v0[0], v0[1]), pk2(v0[2], v0[3]), pk2(v1[0], v1[1]), pk2(v1[2], v1[3])};
      }
    }
    return;
  }
  const bool headtype = nt < 4 || (nt >= 6 && nt < 10);
#pragma unroll
  for (int j = 0; j < 4; ++j) {
    const int tl = wb * 64 + (j >> 1) * 32 + (qi >> 2) * 8 + (j & 1) * 4 + (qi & 3); const long tok = (long)mt * 256 + tl; const int b = (int)(tok >> 11), sq = (int)(tok & 2047);
    const float rs = rs_s[tl];
    if (headtype) {
#pragma unroll
      for (int ih = 0; ih < 2; ++ih) {
        const int hit = wa * 2 + ih;
        f32x4 v[4];
#pragma unroll
        for (int i = 0; i < 4; ++i) v[i] = acc[ih * 4 + i][j] * rs;
        bf16_t* dstb; int nh, head; const float* g = nullptr;
        if (nt < 2) { dstb = p.sbq(); nh = 8; head = nt * 4 + hit; }
        else if (nt < 4) { dstb = p.sbk(); nh = 8; head = (nt - 2) * 4 + hit; }
        else if (nt < 8) { dstb = p.nq(); nh = 8; head = (nt - 6) * 4 + hit; g = p.qng() + layer * 64; }
        else if (nt == 8) { dstb = hit < 2 ? p.kcr() : p.vcr(); nh = 2; head = hit & 1; }
        else { dstb = hit < 2 ? p.ks() : p.kw(); nh = 2; head = hit & 1; g = p.kng() + (layer * 3 + (hit < 2 ? 1 : 2)) * 64; }
        if (g) {
          float ss = 0.f;
#pragma unroll
          for (int i = 0; i < 4; ++i) ss += v[i][0] * v[i][0] + v[i][1] * v[i][1] + v[i][2] * v[i][2] + v[i][3] * v[i][3];
          ss += __shfl_xor(ss, 16); ss += __shfl_xor(ss, 32);
          const float rn = rsqrtf(ss * (1.f / 64.f) + NORM_EPS);
#pragma unroll
          for (int i = 0; i < 4; ++i) { const f32x4 gg = *(const f32x4*)(g + (i >> 1) * 32 + quad * 8 + (i & 1) * 4); v[i] = v[i] * rn * gg; }
#pragma unroll
          for (int i = 0; i < 2; ++i) {
            const f32x4 cs = *(const f32x4*)(p.cosT() + tok * 32 + quad * 8 + i * 4), sn = *(const f32x4*)(p.sinT() + tok * 32 + quad * 8 + i * 4);
            const f32x4 x1 = v[i], x2 = v[i + 2];
            v[i] = x1 * cs - x2 * sn; v[i + 2] = x2 * cs + x1 * sn;
          }
        }
        bf16_t* dst = dstb + ((long)(b * nh + head) * SEQ + sq) * 64 + quad * 8;
#pragma unroll
        for (int ip = 0; ip < 2; ++ip)
          *(u32x4*)(dst + ip * 32) = (u32x4){pk2(v[2 * ip][0], v[2 * ip][1]), pk2(v[2 * ip][2], v[2 * ip][3]), pk2(v[2 * ip + 1][0], v[2 * ip + 1][1]), pk2(v[2 * ip + 1][2], v[2 * ip + 1][3])};
        asm volatile("" ::: "memory");
      }
    } else if (nt == 20) {
      if (wa == 0 && quad < 3) {
#pragma unroll
        for (int i = 0; i < 2; ++i) {
          const f32x4 v = acc[i][j] * rs;
          const f32x4 o = {sigmoidf_(v[0]), sigmoidf_(v[1]), sigmoidf_(v[2]), sigmoidf_(v[3])};
          *(f32x4*)(p.ngate() + tok * 32 + quad * 8 + i * 4) = o;
        }
      }
    } else {
      bf16_t* dstb; int ldd, c0; bool sil;
      if (nt < 6) { dstb = p.sbz(); ldd = 512; c0 = (nt - 4) * 256; sil = true; }
      else if (nt < 12) { dstb = p.nz(); ldd = 512; c0 = (nt - 10) * 256; sil = true; }
      else if (nt < 16) { dstb = p.ga(); ldd = 1024; c0 = (nt - 12) * 256; sil = false; }
      else { dstb = p.gb(); ldd = 1024; c0 = (nt - 16) * 256; sil = false; }
      bf16_t* dst = dstb + tok * ldd + c0 + wa * 128 + quad * 8;
#pragma unroll
      for (int ip = 0; ip < 4; ++ip) {
        const f32x4 v0 = acc[2 * ip][j] * rs, v1 = acc[2 * ip + 1][j] * rs;
        f32x4 o0, o1;
#pragma unroll
        for (int r = 0; r < 4; ++r) { o0[r] = sil ? siluf_(v0[r]) : sigmoidf_(v0[r]); o1[r] = sil ? siluf_(v1[r]) : sigmoidf_(v1[r]); }
        *(u32x4*)(dst + ip * 32) = (u32x4){pk2(o0[0], o0[1]), pk2(o0[2], o0[3]), pk2(o1[0], o1[1]), pk2(o1[2], o1[3])};
      }
    }
    asm volatile("" ::: "memory");
  }
}

DI void phaseA(const Params& p0, const Slot sl, int layer, unsigned char* lds, int fake = 0) {
  const Params p = relaunder(p0);
  bf16_t* gl = (bf16_t*)lds; float* rs_s = (float*)(lds + LDS_GEMM_BYTES);
  const bf16_t* Wt = p.wt_in();
  int mt, nt;
  for (int it = 0; tile_order(sl, it, NT_IN, mt, nt); ++it) {
    if (my_tid() < 256) {
      const float* pp = p.part() + ((long)mt * 256 + my_tid()) * 16;
      const f32x4 v0 = *(const f32x4*)pp, v1 = *(const f32x4*)(pp + 4);
      const float s = ((v0[0] + v0[1]) + (v0[2] + v0[3])) + ((v1[0] + v1[1]) + (v1[2] + v1[3]));
      rs_s[my_tid()] = rsqrtf(s * (1.f / 1024.f) + NORM_EPS);
    }
    const int mtl = fake == 3 ? 0 : (fake == 4 ? sl.xcd * 16 + (sl.slot & 7) : mt), ntl = fake == 3 ? 0 : (fake == 4 ? (sl.slot >> 3) : nt);
    const bf16_t* Xg = p.xb() + (long)mtl * 256 * LDX; const bf16_t* Wg = Wt + (long)ntl * 256 * LDX;
    f32x4 acc[8][4]; zero_acc(acc);
    const int kstep = (fake == 1 || fake == 2) ? 0 : 64;
    int mt2, nt2;
    const bool more = !fake && tile_order(sl, it + 1, NT_IN, mt2, nt2);
    const bf16_t* Xn = more ? p.xb() + (long)mt2 * 256 * LDX : Xg; const bf16_t* Wn = more ? Wt + (long)nt2 * 256 * LDX : Wg;
    const bool vn = more ? nt2 >= 21 : nt >= 21;
    gemm_core(nt >= 21 ? Xg : Wg, LDX, nt >= 21 ? Wg : Xg, LDX, D_MODEL, gl, acc, kstep, !fake && it > 0, vn ? Xn : Wn, vn ? Wn : Xn, true);
    if (!fake) phaseA_epilogue(p, layer, mt, nt, acc, rs_s);
    else if (acc[0][0][0] == 123.456f && acc[7][3][3] == 5.f) p.dummy()[0] = 1;
    __syncthreads();
  }
}

DI void compress_partial(const Params& p, int ci, unsigned char* lds) {
  bf16_t* gl = (bf16_t*)lds;
  const int split = ci & 3, item = ci >> 2, kv = item & 1, pair = item >> 1;
  const bf16_t* src = (kv ? p.vcr() : p.kcr()) + (long)pair * 256 * 1024 + split * 512;
  const bf16_t* W1 = p.w1t() + (long)kv * 256 * 2048 + split * 512;
  f32x4 acc[8][4]; zero_acc(acc);
  gemm_core(W1, 2048, src, 1024, 512, gl, acc);
  const int tid = my_tid(), lane = tid & 63, w = tid >> 6, wa = w >> 2, wb = w & 3, qi = lane & 15, quad = lane >> 4;
  float* dst = p.hpre() + ((long)(split * 32 + item) * 256) * 256;
#pragma unroll
  for (int i = 0; i < 8; ++i)
#pragma unroll
    for (int j = 0; j < 4; ++j) *(f32x4*)(dst + (long)(wb * 64 + j * 16 + qi) * 256 + wa * 128 + i * 16 + quad * 4) = acc[i][j];
}

DI void phaseB2(const Params& p0, int layer, unsigned char* lds) {
  const Params p = relaunder(p0);
  const int tid = my_tid(), lane = tid & 63, w = tid >> 6, qi = lane & 15, quad = lane >> 4;
  float* bias_s = (float*)lds;
  {
    const float* b1 = p.b1eff() + (long)(layer * 2 + (tid >> 8)) * 16 * 256 + (tid & 255);
    float sacc = 0.f;
#pragma unroll
    for (int kq = 0; kq < 16; ++kq) sacc += b1[kq * 256];
    bias_s[tid] = sacc;
  }
  __syncthreads();
  if (w < 2)
  for (int wi = blockIdx.x * 2 + w; wi < 32 * 16; wi += gridDim.x * 2) {
    const int item = wi >> 4, r16 = wi & 15, kv = item & 1, pair = item >> 1;
    const int row = r16 * 16 + qi;
    const bf16_t* W2 = p.w2t() + (long)kv * 64 * 256;
    const float* hp = p.hpre() + ((long)item * 256 + row) * 256 + quad * 8;
    f32x4 o[4];
#pragma unroll
    for (int dt = 0; dt < 4; ++dt) o[dt] = (f32x4){0.f, 0.f, 0.f, 0.f};
#pragma unroll 1
    for (int ksx = 0; ksx < 8; ++ksx) {
      f32x4 h0 = *(const f32x4*)(bias_s + kv * 256 + ksx * 32 + quad * 8), h1 = *(const f32x4*)(bias_s + kv * 256 + ksx * 32 + quad * 8 + 4);
#pragma unroll
      for (int sp = 0; sp < 4; ++sp) { const float* q = hp + (long)sp * 32 * 256 * 256 + ksx * 32; h0 += *(const f32x4*)q; h1 += *(const f32x4*)(q + 4); }
      const bf16x8 hf = mk8((u32x4){pk2(siluf_(h0[0]), siluf_(h0[1])), pk2(siluf_(h0[2]), siluf_(h0[3])), pk2(siluf_(h1[0]), siluf_(h1[1])), pk2(siluf_(h1[2]), siluf_(h1[3]))});
#pragma unroll
      for (int dt = 0; dt < 4; ++dt) {
        const bf16x8 wf = ld8(W2 + (long)(dt * 16 + qi) * 256 + ksx * 32 + quad * 8);
        o[dt] = kv ? MFMA16(hf, wf, o[dt]) : MFMA16(wf, hf, o[dt]);
      }
    }
    const int bg = pair * 2 + (r16 >> 3);
    if (kv == 0) {
      const float* g = p.kng() + (layer * 3 + 0) * 64;
      const int b = bg >> 1, c = (r16 & 7) * 16 + qi;
      float ss = 0.f;
#pragma unroll
      for (int dt = 0; dt < 4; ++dt) ss += o[dt][0] * o[dt][0] + o[dt][1] * o[dt][1] + o[dt][2] * o[dt][2] + o[dt][3] * o[dt][3];
      ss += __shfl_xor(ss, 16); ss += __shfl_xor(ss, 32);
      const float rn = rsqrtf(ss * (1.f / 64.f) + NORM_EPS);
#pragma unroll
      for (int dt = 0; dt < 4; ++dt) { const f32x4 gg = *(const f32x4*)(g + dt * 16 + quad * 4); o[dt] = o[dt] * rn * gg; }
#pragma unroll
      for (int dt = 0; dt < 2; ++dt) {
        const long ti = ((long)b * 128 + c) * 32 + dt * 16 + quad * 4;
        const f32x4 cs = *(const f32x4*)(p.cosC() + ti), sn = *(const f32x4*)(p.sinC() + ti);
        const f32x4 x1 = o[dt], x2 = o[dt + 2];
        o[dt] = x1 * cs - x2 * sn; o[dt + 2] = x2 * cs + x1 * sn;
      }
      bf16_t* dst = p.kc() + ((long)bg * 128 + c) * 64 + quad * 4;
#pragma unroll
      for (int dt = 0; dt < 4; ++dt) {
        u32x2 ov = (u32x2){pk2(o[dt][0], o[dt][1]), pk2(o[dt][2], o[dt][3])};
        if (c >= NCMP) ov = (u32x2){0u, 0u};
        *(u32x2*)(dst + dt * 16) = ov;
      }
    } else {
#pragma unroll
      for (int dt = 0; dt < 4; ++dt) {
        const int c0 = (r16 & 7) * 16 + quad * 4;
        f32x4 v = o[dt];
        if (c0 + 3 >= NCMP) v[3] = 0.f;
        *(u32x2*)(p.vct() + ((long)bg * 64 + dt * 16 + qi) * 128 + c0) = (u32x2){pk2(v[0], v[1]), pk2(v[2], v[3])};
      }
    }
  }
  __syncthreads();
}

struct SbFrag { bf16x8 k[2][2]; bf16x8 v[4]; };
DI void sb_load(SbFrag& f, const bf16_t* __restrict__ kp0, const bf16_t* __restrict__ vp0, int kb) {
#pragma unroll
  for (int a = 0; a < 2; ++a) { f.k[a][0] = ld8(kp0 + (long)(kb + 4 * a) * 64); f.k[a][1] = ld8(kp0 + (long)(kb + 4 * a) * 64 + 32); }
#pragma unroll
  for (int dt = 0; dt < 4; ++dt) f.v[dt] = ld8(vp0 + (long)kb * 64 + dt * 16 * 32);
}
template <bool FULL>
DI void sb_chunk(const SbFrag& f, int kb, int t, int quad, const bf16x8 (&qf)[2], f32x4 (&o)[4], float& carry) {
  f32x4 s[2];
#pragma unroll
  for (int a = 0; a < 2; ++a) {
    s[a] = MFMA16(f.k[a][0], qf[0], ((f32x4){0.f, 0.f, 0.f, 0.f}));
    s[a] = MFMA16(f.k[a][1], qf[1], s[a]);
  }
  float beta[8], om[8];
  float prod = 1.f;
#pragma unroll
  for (int idx = 0; idx < 8; ++idx) {
    const float z2 = fminf(s[idx >> 2][idx & 3] * (0.125f * 1.44269504089f), 60.f);
    const float e = __builtin_amdgcn_exp2f(z2);
    const float r = __builtin_amdgcn_rcpf(1.f + e);
    const bool val = FULL ? true : (kb + 8 * quad + idx < t);
    om[idx] = val ? r : 1.f;
    beta[idx] = val ? e * r : 0.f;
    prod *= om[idx];
  }
  const float a1 = __shfl_xor(prod, 16), a2 = __shfl_xor(prod, 32), a3 = __shfl_xor(a1, 32);
  const float higher = ((quad ^ 1) > quad ? a1 : 1.f) * ((quad ^ 2) > quad ? a2 : 1.f) * ((quad ^ 3) > quad ? a3 : 1.f);
  float q = __builtin_amdgcn_exp2f(carry) * higher;
  float wv[8];
#pragma unroll
  for (int idx = 7; idx >= 0; --idx) { wv[idx] = beta[idx] * q; q *= om[idx]; }
  carry += __builtin_amdgcn_logf((prod * a1) * (a2 * a3));
  const bf16x8 pf = mk8((u32x4){pk2(wv[0], wv[1]), pk2(wv[2], wv[3]), pk2(wv[4], wv[5]), pk2(wv[6], wv[7])});
#pragma unroll
  for (int dt = 0; dt < 4; ++dt) o[dt] = MFMA16(f.v[dt], pf, o[dt]);
}

DI void sb_attn_wave(const Params& p, int b, int h, int t0, bf16_t* ybase) {
  const int lane = my_tid() & 63, qi = lane & 15, quad = lane >> 4;
  const bf16_t* Q = p.sbq() + (long)(b * 8 + h) * SEQ * 64;
  const bf16_t* K = p.sbk() + (long)(b * 8 + h) * SEQ * 64;
  const bf16_t* Vt = p.sbvt() + (long)(b * 8 + h) * 64 * SEQ;
  const int tA = t0 + qi, tB = t0 + 16 + qi;
  bf16x8 qa[2], qb[2];
  qa[0] = ld8(Q + (long)tA * 64 + quad * 8); qa[1] = ld8(Q + (long)tA * 64 + 32 + quad * 8);
  qb[0] = ld8(Q + (long)tB * 64 + quad * 8); qb[1] = ld8(Q + (long)tB * 64 + 32 + quad * 8);
  f32x4 oa[4], ob[4];
#pragma unroll
  for (int dt = 0; dt < 4; ++dt) { oa[dt] = (f32x4){0.f, 0.f, 0.f, 0.f}; ob[dt] = oa[dt]; }
  float ca = 0.f, cb = 0.f;
  const int krow = 8 * (qi >> 2) + (qi & 3);
  const bf16_t* kp0 = K + (long)krow * 64 + quad * 8;
  const bf16_t* vp0 = Vt + qi * 32 + 8 * quad;
  int kb = t0;
  SbFrag f0, f1, f2;
  sb_load(f0, kp0, vp0, kb); sb_load(f1, kp0, vp0, max(kb - 32, 0));
#define SB_STEP(F, KB) (((KB) + 32 <= t0) ? (sb_chunk<true>(F, KB, tA, quad, qa, oa, ca), sb_chunk<true>(F, KB, tB, quad, qb, ob, cb)) : (sb_chunk<false>(F, KB, tA, quad, qa, oa, ca), sb_chunk<false>(F, KB, tB, quad, qb, ob, cb)), __all(ca < -160.f && cb < -160.f))
  while (true) {
    sb_load(f2, kp0, vp0, max(kb - 64, 0));
    if (SB_STEP(f0, kb) || kb < 32) break;
    sb_load(f0, kp0, vp0, max(kb - 96, 0));
    if (SB_STEP(f1, kb - 32) || kb < 64) break;
    sb_load(f1, kp0, vp0, max(kb - 128, 0));
    if (SB_STEP(f2, kb - 64) || kb < 96) break;
    kb -= 96;
  }
#undef SB_STEP
#pragma unroll
  for (int half = 0; half < 2; ++half) {
    const long zo = ((long)b * SEQ + (half ? tB : tA)) * 512 + h * 64 + quad * 4;
    const bf16_t* zp = p.sbz() + zo; bf16_t* yp = ybase + zo;
#pragma unroll
    for (int dt = 0; dt < 4; ++dt) {
      const f32x4 o = half ? ob[dt] : oa[dt];
      const u32x2 zz = *(const u32x2*)(zp + dt * 16);
      *(u32x2*)(yp + dt * 16) = (u32x2){pk2(o[0] * bflo(zz[0]), o[1] * bfhi(zz[0])), pk2(o[2] * bflo(zz[1]), o[3] * bfhi(zz[1]))};
    }
  }
}

DI void phaseB(const Params& p0, int layer, unsigned char* lds, bool probe) {
  const int NITEM = 128 + BATCH * 8 * 8;
  for (int it = blockIdx.x; it < NITEM; it += gridDim.x) {
    const Params p = relaunder(p0);
    if (it < 128) { compress_partial(p, it, lds); continue; }
    const int i = it - 128, qt = 7 - (i >> 7), bh = i & 127;
    sb_attn_wave(p, bh >> 3, bh & 7, qt * 256 + (my_tid() >> 6) * 32, probe ? p.dummy() : p.sbz());
  }
}

constexpr int NSA_LO_BYTES = 8 * 8192;
constexpr int NSA_KROW = 144, NSA_VROW = 80;
constexpr int NSA_SLOT = 32 * NSA_KROW + 64 * NSA_VROW;
constexpr int NSA_SLOT0 = NSA_LO_BYTES, NSA_BLIST = NSA_SLOT0 + 2 * NSA_SLOT, NSA_UMW = NSA_BLIST + 64 * 4;

struct KVFrag { bf16x8 k[2][2]; bf16x8 v[4]; };
DI void nsa_ldsfrag(KVFrag& f, const unsigned char* slot, int qi, int quad) {
  const int krow = 8 * (qi >> 2) + (qi & 3);
#pragma unroll
  for (int a = 0; a < 2; ++a) { const unsigned char* kp = slot + (krow + 4 * a) * NSA_KROW + quad * 16; f.k[a][0] = mk8(*(const u32x4*)kp); f.k[a][1] = mk8(*(const u32x4*)(kp + 64)); }
#pragma unroll
  for (int dt = 0; dt < 4; ++dt) f.v[dt] = mk8(*(const u32x4*)(slot + 32 * NSA_KROW + (dt * 16 + qi) * NSA_VROW + quad * 16));
}
template <int MODE>
DI void nsa_chunk(const KVFrag& f, int kb, int t, bool selbit, const bf16x8 (&qf)[4][2], f32x4 (&O)[4][4], float (&m)[4], float (&l)[4], int quad, bool online) {
  const float SC = 0.125f * 1.44269504089f;
  bool val[8];
#pragma unroll
  for (int idx = 0; idx < 8; ++idx) {
    const int key = kb + 8 * quad + idx;
    val[idx] = MODE == 0 ? (selbit && key <= t) : (key <= t && key > t - 512);
  }
#pragma unroll
  for (int hh = 0; hh < 4; ++hh) {
    f32x4 s[2];
#pragma unroll
    for (int a = 0; a < 2; ++a) { s[a] = MFMA16(f.k[a][0], qf[hh][0], ((f32x4){0.f, 0.f, 0.f, 0.f})); s[a] = MFMA16(f.k[a][1], qf[hh][1], s[a]); }
    float mn = m[hh];
    if (online) {
      float cm = -1e30f;
#pragma unroll
      for (int idx = 0; idx < 8; ++idx) if (val[idx]) cm = fmaxf(cm, s[idx >> 2][idx & 3] * SC);
      cm = fmaxf(cm, __shfl_xor(cm, 16)); cm = fmaxf(cm, __shfl_xor(cm, 32));
      mn = fmaxf(mn, cm);
      const float alpha = __builtin_amdgcn_exp2f(m[hh] - mn);
      m[hh] = mn; l[hh] *= alpha;
#pragma unroll
      for (int dt = 0; dt < 4; ++dt) O[hh][dt] = O[hh][dt] * alpha;
    }
    float pv[8]; float ps = 0.f;
#pragma unroll
    for (int idx = 0; idx < 8; ++idx) { pv[idx] = val[idx] ? __builtin_amdgcn_exp2f(fmaf(s[idx >> 2][idx & 3], SC, -mn)) : 0.f; ps += pv[idx]; }
    l[hh] += ps;
    const bf16x8 pf = mk8((u32x4){pk2(pv[0], pv[1]), pk2(pv[2], pv[3]), pk2(pv[4], pv[5]), pk2(pv[6], pv[7])});
#pragma unroll
    for (int dt = 0; dt < 4; ++dt) O[hh][dt] = MFMA16(f.v[dt], pf, O[hh][dt]);
  }
}

template <int MODE>
DI void nsa_branch(const bf16_t* __restrict__ Kb, const bf16_t* __restrict__ Vtb, unsigned char* lds, int nb, int t, int cur, unsigned selmask, unsigned umall,
                   const bf16x8 (&qf)[4][2], f32x4 (&O)[4][4], float (&m)[4], float (&l)[4], bool online) {
  const int tid = my_tid(), lane = tid & 63, qi = lane & 15, quad = lane >> 4;
  const int* blist = (const int*)(lds + NSA_BLIST);
  const bool isv = tid >= 256;
  const int t2 = tid & 255;
  const bf16_t* gsrc = isv ? Vtb + (t2 >> 2) * 32 + (t2 & 3) * 8 : Kb + (long)(t2 >> 3) * 64 + (t2 & 7) * 8;
  const long gmul = 64;
  const int ldst = isv ? 32 * NSA_KROW + (t2 >> 2) * NSA_VROW + (t2 & 3) * 16 : (t2 >> 3) * NSA_KROW + (t2 & 7) * 16;
  unsigned char* slot0 = lds + NSA_SLOT0; unsigned char* slot1 = slot0 + NSA_SLOT;
  const int N = 2 * nb;
  auto kbof = [&](int n) { return blist[n >> 1] * 64 + (n & 1) * 32; };
  u32x4 ra = *(const u32x4*)(gsrc + (long)kbof(0) * gmul), rb = *(const u32x4*)(gsrc + (long)kbof(1) * gmul);
  *(u32x4*)(slot0 + ldst) = ra;
  __syncthreads();
#pragma unroll 1
  for (int n = 0; n < N; n += 2) {
    const int j = blist[n >> 1];
    const bool won = MODE == 0 ? ((umall >> j) & 1u) != 0 : (j >= cur - 8 && j <= cur);
    const bool bit = (selmask >> j) & 1u;
    ra = *(const u32x4*)(gsrc + (long)kbof(min(n + 2, N - 2)) * gmul);
    if (won) { KVFrag f; nsa_ldsfrag(f, slot0, qi, quad); nsa_chunk<MODE>(f, j * 64, t, bit, qf, O, m, l, quad, online); }
    *(u32x4*)(slot1 + ldst) = rb;
    __syncthreads();
    rb = *(const u32x4*)(gsrc + (long)kbof(min(n + 3, N - 1)) * gmul);
    if (won) { KVFrag f; nsa_ldsfrag(f, slot1, qi, quad); nsa_chunk<MODE>(f, j * 64 + 32, t, bit, qf, O, m, l, quad, online); }
    *(u32x4*)(slot0 + ldst) = ra;
    __syncthreads();
  }
}

template <bool LAST>
DI void nsa_finish(u32x2* lo, f32x4 (&O)[4][4], float (&m)[4], float (&l)[4], const float (&gate)[4], const bf16_t* zp, bf16_t* yp, float minit) {
#pragma unroll
  for (int hh = 0; hh < 4; ++hh) {
    float lt = l[hh]; lt += __shfl_xor(lt, 16); lt += __shfl_xor(lt, 32);
    const float f = lt > 0.f ? gate[hh] / lt : 0.f;
#pragma unroll
    for (int dt = 0; dt < 4; ++dt) {
      const u32x2 a = lo[(hh * 4 + dt) * 64];
      const f32x4 v = (f32x4){bflo(a[0]), bfhi(a[0]), bflo(a[1]), bfhi(a[1])} + O[hh][dt] * f;
      if (LAST) {
        const u32x2 zz = *(const u32x2*)(zp + hh * 64 + dt * 16);
        *(u32x2*)(yp + hh * 64 + dt * 16) = (u32x2){pk2(v[0] * bflo(zz[0]), v[1] * bfhi(zz[0])), pk2(v[2] * bflo(zz[1]), v[3] * bfhi(zz[1]))};
      } else {
        lo[(hh * 4 + dt) * 64] = (u32x2){pk2(v[0], v[1]), pk2(v[2], v[3])};
        O[hh][dt] = (f32x4){0.f, 0.f, 0.f, 0.f};
      }
    }
    m[hh] = minit; l[hh] = 0.f;
  }
}

DI void nsa_wave(const Params& p, int layer, int b, int g, int t0, unsigned char* lds, bf16_t* ybase) {
  const int lane = my_tid() & 63, qi = lane & 15, quad = lane >> 4;
  const int t = t0 + qi, cur = t0 >> 6;
  const long tok = (long)b * SEQ + t;
  const int bg = b * 2 + g;
  u32x2* lo = (u32x2*)lds + (my_tid() >> 6) * 1024 + lane;

  const float mf_c = p.mfix()[layer * 4 + 0], mf_s = p.mfix()[layer * 4 + 1], mf_w = p.mfix()[layer * 4 + 2];
  const bool on_c = mf_c > 60.f, on_s = mf_s > 60.f, on_w = mf_w > 60.f;
  const float SC = 0.125f * 1.44269504089f;
  const bf16_t* Kc = p.kc() + (long)bg * 128 * 64;
  const bf16_t* Vc = p.vct() + (long)bg * 64 * 128;
  f32x4 ph[8];
#pragma unroll
  for (int kt = 0; kt < 8; ++kt) ph[kt] = (f32x4){0.f, 0.f, 0.f, 0.f};
#pragma unroll 1
  for (int hh = 0; hh < 4; ++hh) {
    const bf16_t* qp0 = p.nq() + ((long)(b * 8 + g * 4 + hh) * SEQ + t) * 64 + quad * 8;
    const bf16x8 q0 = ld8(qp0), q1 = ld8(qp0 + 32); const float gt = p.ngate()[tok * 32 + g * 4 + hh];
    f32x4 sc[8];
    float mx = on_c ? -1e30f : mf_c;
#pragma unroll
    for (int kt = 0; kt < 8; ++kt) {
      const bf16_t* kp = Kc + (long)(kt * 16 + qi) * 64 + quad * 8;
      sc[kt] = MFMA16(ld8(kp), q0, ((f32x4){0.f, 0.f, 0.f, 0.f}));
      sc[kt] = MFMA16(ld8(kp + 32), q1, sc[kt]);
      sc[kt] = sc[kt] * SC;
    }
    if (on_c) {
#pragma unroll
      for (int kt = 0; kt < 8; ++kt)
#pragma unroll
        for (int r = 0; r < 4; ++r) { const int c = kt * 16 + quad * 4 + r; if (c < NCMP && 16 * c + 31 <= t) mx = fmaxf(mx, sc[kt][r]); }
      mx = fmaxf(mx, __shfl_xor(mx, 16)); mx = fmaxf(mx, __shfl_xor(mx, 32));
    }
    float sum = 0.f;
#pragma unroll
    for (int kt = 0; kt < 8; ++kt)
#pragma unroll
      for (int r = 0; r < 4; ++r) {
        const int c = kt * 16 + quad * 4 + r;
        const float e = (c < NCMP && 16 * c + 31 <= t) ? __builtin_amdgcn_exp2f(sc[kt][r] - mx) : 0.f;
        sc[kt][r] = e; sum += e;
      }
    sum += __shfl_xor(sum, 16); sum += __shfl_xor(sum, 32);
    const float inv = sum > 0.f ? 1.f / sum : 0.f;
#pragma unroll
    for (int kt = 0; kt < 8; ++kt) { sc[kt] = sc[kt] * inv; ph[kt] += sc[kt]; }
    f32x4 oc[4];
#pragma unroll
    for (int dt = 0; dt < 4; ++dt) oc[dt] = (f32x4){0.f, 0.f, 0.f, 0.f};
#pragma unroll
    for (int mm = 0; mm < 4; ++mm) {
      const bf16x8 pf = mk8((u32x4){pk2(sc[2 * mm][0], sc[2 * mm][1]), pk2(sc[2 * mm][2], sc[2 * mm][3]), pk2(sc[2 * mm + 1][0], sc[2 * mm + 1][1]), pk2(sc[2 * mm + 1][2], sc[2 * mm + 1][3])});
#pragma unroll
      for (int dt = 0; dt < 4; ++dt) {
        const bf16_t* vp = Vc + (long)(dt * 16 + qi) * 128 + 32 * mm + quad * 4;
        const u32x2 lo = *(const u32x2*)vp, hi = *(const u32x2*)(vp + 16);
        oc[dt] = MFMA16(mk8((u32x4){lo[0], lo[1], hi[0], hi[1]}), pf, oc[dt]);
      }
    }
#pragma unroll
    for (int dt = 0; dt < 4; ++dt) { const f32x4 v = oc[dt] * gt; lo[(hh * 4 + dt) * 64] = (u32x2){pk2(v[0], v[1]), pk2(v[2], v[3])}; }
  }
  float imp[8];
  {
    float rot[8];
#pragma unroll
    for (int kt = 0; kt < 8; ++kt) rot[kt] = __shfl(ph[kt][3], (lane + 48) & 63);
#pragma unroll
    for (int kt = 0; kt < 8; ++kt) {
      const float extra = quad > 0 ? rot[kt] : (kt > 0 ? rot[kt > 0 ? kt - 1 : 0] : 0.f);
      const float v = (ph[kt][0] + ph[kt][1]) + (ph[kt][2] + ph[kt][3]) + extra;
      const int j = 4 * kt + quad;
      const bool forced = j == 0 || j == cur || j == cur - 1;
      imp[kt] = j <= cur ? v + (forced ? 1e4f : 0.f) : -1e30f;
    }
  }
  unsigned selmask = 0;
  {
    int rank[8];
#pragma unroll
    for (int kt = 0; kt < 8; ++kt) rank[kt] = 0;
#pragma unroll 1
    for (int q2 = 0; q2 < 4; ++q2)
#pragma unroll
      for (int k2 = 0; k2 < 8; ++k2) {
        const float ov = __shfl(imp[k2], qi + 16 * q2);
#pragma unroll
        for (int kt = 0; kt < 8; ++kt) {
          const bool before = k2 < kt || (k2 == kt && q2 < quad);
          rank[kt] += (ov > imp[kt] || (ov == imp[kt] && before)) ? 1 : 0;
        }
      }
#pragma unroll
    for (int kt = 0; kt < 8; ++kt) if (rank[kt] < 8 && 4 * kt + quad <= cur) selmask |= 1u << (4 * kt + quad);
    selmask |= __shfl_xor(selmask, 16); selmask |= __shfl_xor(selmask, 32);
  }

  unsigned umall = selmask;
  umall |= __shfl_xor(umall, 1); umall |= __shfl_xor(umall, 2); umall |= __shfl_xor(umall, 4); umall |= __shfl_xor(umall, 8);
  umall = __builtin_amdgcn_readfirstlane(umall);
  const int wv = my_tid() >> 6;
  unsigned* umw = (unsigned*)(lds + NSA_UMW); int* blist = (int*)(lds + NSA_BLIST);
  if (lane == 0) umw[wv] = umall;
  bf16x8 qf[4][2];
#pragma unroll
  for (int hh = 0; hh < 4; ++hh) {
    const bf16_t* qp = p.nq() + ((long)(b * 8 + g * 4 + hh) * SEQ + t) * 64 + quad * 8;
    qf[hh][0] = ld8(qp); qf[hh][1] = ld8(qp + 32);
  }
  float gate[3][4];
#pragma unroll
  for (int br = 1; br < 3; ++br) { const f32x4 gv = *(const f32x4*)(p.ngate() + tok * 32 + br * 8 + g * 4); gate[br][0] = gv[0]; gate[br][1] = gv[1]; gate[br][2] = gv[2]; gate[br][3] = gv[3]; }
  f32x4 O[4][4]; float m[4], l[4];
#pragma unroll
  for (int hh = 0; hh < 4; ++hh) { m[hh] = on_s ? -1e30f : mf_s; l[hh] = 0.f;
#pragma unroll
    for (int dt = 0; dt < 4; ++dt) O[hh][dt] = (f32x4){0.f, 0.f, 0.f, 0.f}; }
  __syncthreads();
  int nb;
  {
    unsigned ub = 0;
#pragma unroll
    for (int i = 0; i < 8; ++i) ub |= umw[i];
    nb = __builtin_popcount(ub);
    if (my_tid() < 32) { if ((ub >> my_tid()) & 1u) blist[__builtin_popcount(ub & ((1u << my_tid()) - 1u))] = my_tid(); }
    __syncthreads();
    nsa_branch<0>(p.ks() + (long)bg * SEQ * 64, p.vst() + (long)bg * 64 * SEQ, lds, nb, t, cur, selmask, umall, qf, O, m, l, on_s);
    nsa_finish<false>(lo, O, m, l, gate[1], nullptr, nullptr, on_w ? -1e30f : mf_w);
  }
  {
    const int cur0 = (t0 >> 7) * 2, jlo = cur0 >= 8 ? cur0 - 8 : 0;
    nb = cur0 + 2 - jlo;
    if (my_tid() < nb) blist[my_tid()] = jlo + my_tid();
    __syncthreads();
    nsa_branch<1>(p.kw() + (long)bg * SEQ * 64, p.vwt() + (long)bg * 64 * SEQ, lds, nb, t, cur, selmask, umall, qf, O, m, l, on_w);
    nsa_finish<true>(lo, O, m, l, gate[2], p.nz() + tok * 512 + g * 256 + quad * 4, ybase + tok * 512 + g * 256 + quad * 4, 0.f);
  }
  __syncthreads();
}

DI void phaseC(const Params& p0, int layer, unsigned char* lds, bool probe) {
  const int NITEM = BATCH * 2 * 16;
  for (int it = blockIdx.x; it < NITEM; it += gridDim.x) {
    const Params p = relaunder(p0);
    const int qt = 15 - (it >> 5), bg = it & 31;
    nsa_wave(p, layer, bg >> 1, bg & 1, qt * 128 + (my_tid() >> 6) * 16, lds, probe ? p.dummy() : p.nz());
  }
}

DI void phaseD(const Params& p0, const Slot sl, int layer, unsigned char* lds) {
  const Params p = relaunder(p0);
  bf16_t* gl = (bf16_t*)lds;
  int mt, nt;
  for (int it = 0; tile_order(sl, it, 4, mt, nt); ++it) {
#pragma unroll 1
    for (int which = 0; which < 2; ++which) {
      const bf16_t* Wg = (which ? p.wupb_t() : p.wupa_t()) + ((long)nt * 256) * 512;
      const bf16_t* Yg = (which ? p.nz() : p.sbz()) + (long)mt * 256 * 512;
      const bf16_t* Gg = which ? p.gb() : p.ga();
      int mt2 = mt, nt2 = nt; bool more = true;
      if (which) more = tile_order(sl, it + 1, 4, mt2, nt2);
      const bf16_t* Wn = more ? (which ? p.wupa_t() : p.wupb_t()) + ((long)nt2 * 256) * 512 : Wg;
      const bf16_t* Yn = more ? (which ? p.sbz() : p.nz()) + (long)mt2 * 256 * 512 : Yg;
      f32x4 acc[8][4]; zero_acc(acc);
      gemm_core(Wg, 512, Yg, 512, 512, gl, acc, 64, it > 0 || which, Wn, Yn);
      const int tid = my_tid(), lane = tid & 63, w = tid >> 6, wa = w >> 2, wb = w & 3, qi = lane & 15, quad = lane >> 4;
#pragma unroll
      for (int j = 0; j < 4; ++j) {
        const long tok = (long)mt * 256 + wb * 64 + j * 16 + qi;
#pragma unroll
        for (int i = 0; i < 8; ++i) {
          const long off = tok * 1024 + nt * 256 + wa * 128 + i * 16 + quad * 4;
          const u32x2 xg = *(const u32x2*)(Gg + off);
          const f32x4 v = acc[i][j];
          float o0 = bflo(xg[0]) * v[0], o1 = bfhi(xg[0]) * v[1], o2 = bflo(xg[1]) * v[2], o3 = bfhi(xg[1]) * v[3];
          if (which) { const u32x2 a = *(const u32x2*)(p.merged() + off); o0 += bflo(a[0]); o1 += bfhi(a[0]); o2 += bflo(a[1]); o3 += bfhi(a[1]); }
          *(u32x2*)(p.merged() + off) = (u32x2){pk2(o0, o1), pk2(o2, o3)};
          if ((i & 3) == 3) asm volatile("" ::: "memory");
        }
      }
    }
  }
}

DI void phaseE(const Params& p0, const Slot sl, int layer, unsigned char* lds, const float* xsrc) {
  const Params p = relaunder(p0);
  bf16_t* gl = (bf16_t*)lds;
  int mt, nt;
  for (int it = 0; tile_order(sl, it, 4, mt, nt); ++it) {
    f32x4 acc[8][4]; zero_acc(acc);
    int mt2, nt2;
    const bool more = tile_order(sl, it + 1, 4, mt2, nt2);
    const bf16_t* Wg = p.wout_t() + ((long)nt * 256) * 1024; const bf16_t* Mg = p.merged() + (long)mt * 256 * 1024;
    gemm_core(Wg, 1024, Mg, 1024, 1024, gl, acc, 64, it > 0, more ? p.wout_t() + ((long)nt2 * 256) * 1024 : Wg, more ? p.merged() + (long)mt2 * 256 * 1024 : Mg);
    const int tid = my_tid(), lane = tid & 63, w = tid >> 6, wa = w >> 2, wb = w & 3, qi = lane & 15, quad = lane >> 4;
#pragma unroll
    for (int j = 0; j < 4; ++j) {
      const long tok = (long)mt * 256 + wb * 64 + j * 16 + qi;
      float ss = 0.f;
#pragma unroll
      for (int i = 0; i < 8; ++i) {
        const long off = tok * 1024 + nt * 256 + wa * 128 + i * 16 + quad * 4;
        const f32x4 xo = *(const f32x4*)(xsrc + off);
        const f32x4 xn = xo + acc[i][j];
        *(f32x4*)(p.out + off) = xn;
        *(u32x2*)(p.xb() + off + tok * (LDX - D_MODEL)) = (u32x2){pk2(xn[0], xn[1]), pk2(xn[2], xn[3])};
        ss += xn[0] * xn[0] + xn[1] * xn[1] + xn[2] * xn[2] + xn[3] * xn[3];
      }
      ss += __shfl_xor(ss, 16); ss += __shfl_xor(ss, 32);
      if (quad == 0) p.part()[tok * 16 + nt * 2 + wa] = ss;
    }
  }
}

#ifndef STOP_AFTER
#define STOP_AFTER 0
#endif
constexpr int LDS_BYTES = LDS_GEMM_BYTES + 1024;

__global__ void __launch_bounds__(512) hybrid_megakernel(Params p) {
  extern __shared__ __attribute__((aligned(16))) unsigned char lds[];
  cg::grid_group grid = cg::this_grid();
  __shared__ int s_xcc, s_rank, s_ok;
  __shared__ unsigned s_bar[4];
  if (threadIdx.x == 0) { s_bar[0] = 0u; s_bar[1] = 0u; }
  __syncthreads();
  const XcdBarrier xb = xcd_barrier_post((unsigned*)(p.ws + OFF_BAR), (volatile LAS unsigned*)s_bar);
  if (threadIdx.x == 0) {
    const unsigned xcc = (unsigned)__builtin_amdgcn_s_getreg((3 << 11) | 20) & 7u;
    s_xcc = (int)xcc; s_rank = (int)atomicAdd(p.ctl() + xcc, 1u);
  }
  phase_prologue(p, lds);
  grid.sync();
  if (threadIdx.x == 0) {
    int ok = 1;
    for (int i = 0; i < 8; ++i) ok &= (__hip_atomic_load(p.ctl() + i, __ATOMIC_RELAXED, __HIP_MEMORY_SCOPE_AGENT) == (gridDim.x >> 3));
    s_ok = ok;
  }
  __syncthreads();
  const Slot sl = {s_ok ? s_xcc : (int)(blockIdx.x & 7), s_ok ? s_rank : (int)(blockIdx.x >> 3)};
  for (int layer = 0; layer < DEPTH; ++layer) {
    if (layer > 0) convert_weights(p, layer, lds, 2);
    if (STOP_AFTER != 0 && STOP_AFTER == layer * 10) return;
    phaseA(p, sl, layer, lds);
    xcd_barrier(xb);
#ifdef PROBE_A
    phaseA(p, sl, layer, lds, PROBE_A >= 2 ? PROBE_A : 0);
    xcd_barrier(xb);
#endif
    if (STOP_AFTER == layer * 10 + 1) return;
#ifdef PROBE_B
    phaseB(p, layer, lds, true);
    xcd_barrier(xb);
#endif
    phaseB(p, layer, lds, false);
    xcd_barrier(xb);
    phaseB2(p, layer, lds);
    xcd_barrier(xb);
    if (STOP_AFTER == layer * 10 + 2) return;
#ifdef PROBE_C
    phaseC(p, layer, lds, true);
    xcd_barrier(xb);
#endif
    phaseC(p, layer, lds, false);
    xcd_barrier(xb);
    if (STOP_AFTER == layer * 10 + 3) return;
    phaseD(p, sl, layer, lds);
    xcd_barrier(xb);
#ifdef PROBE_D
    phaseD(p, sl, layer, lds);
    xcd_barrier(xb);
#endif
    if (STOP_AFTER == layer * 10 + 4) return;
    if (layer == 0) phaseE(p, sl, layer, lds, p.x_in); else phaseE(p, sl, layer, lds, p.out);
    if (layer + 1 < DEPTH) convert_weights(p, layer + 1, lds, 1);
    if (layer + 1 < DEPTH) xcd_barrier(xb);
    if (STOP_AFTER == layer * 10 + 5) return;
  }
}

extern "C" void kernel_launch(void* const* d_in, const int* in_sizes, int n_in, void* d_out, int out_size,
                              void* d_ws, size_t ws_size, hipStream_t stream) {
  static int grid_blocks = 0;
  if (!grid_blocks) {
    int dev = 0, cus = 0, per_cu = 0;
    (void)hipGetDevice(&dev);
    (void)hipDeviceGetAttribute(&cus, hipDeviceAttributeMultiprocessorCount, dev);
    if (hipFuncSetAttribute((const void*)hybrid_megakernel, hipFuncAttributeMaxDynamicSharedMemorySize, LDS_BYTES) != hipSuccess) fprintf(stderr, "hipFuncSetAttribute(max dynamic LDS) failed\n");
    (void)hipOccupancyMaxActiveBlocksPerMultiprocessor(&per_cu, hybrid_megakernel, NTHR, LDS_BYTES);
    (void)hipGetLastError();
    if (per_cu > 1) per_cu = 1;
    if (per_cu < 1) per_cu = 1;
    grid_blocks = (cus * per_cu) & ~7;
  }
  Params a{};
  a.x_in = (const float*)d_in[0]; a.pos = (const int*)d_in[1]; a.norm_g = (const float*)d_in[2]; a.w_in = (const float*)d_in[3];
  a.q_norm_g = (const float*)d_in[4]; a.k_norm_g = (const float*)d_in[5]; a.cmp_pe = (const float*)d_in[6]; a.cmp_w1 = (const float*)d_in[7];
  a.cmp_b1 = (const float*)d_in[8]; a.cmp_w2 = (const float*)d_in[9]; a.w_up_a = (const float*)d_in[10]; a.w_up_b = (const float*)d_in[11];
  a.w_out = (const float*)d_in[12];
  a.out = (float*)d_out; a.ws = (unsigned char*)d_ws;
  if (WS_NEED > ws_size) { fprintf(stderr, "workspace too small: need %zu have %zu\n", (size_t)WS_NEED, ws_size); return; }
  (void)hipMemsetAsync((unsigned char*)d_ws + OFF_CTL, 0, 256, stream);
  (void)hipMemsetAsync((unsigned char*)d_ws + OFF_BAR, 0, 3456 * 4, stream);
  void* args[] = {&a};
  hipError_t e = hipLaunchCooperativeKernel((void*)hybrid_megakernel, dim3(grid_blocks), dim3(NTHR), args, LDS_BYTES, stream);
  if (e != hipSuccess) fprintf(stderr, "cooperative launch failed: %s (grid %d)\n", hipGetErrorString(e), grid_blocks);
}
```

```cpp
#include <hip/hip_runtime.h>
#include <hip/hip_cooperative_groups.h>
#include <cstdio>
#include <cstdint>
namespace cg = cooperative_groups;

typedef unsigned short bf16_t;
typedef short bf16x8 __attribute__((ext_vector_type(8)));
typedef float f32x4 __attribute__((ext_vector_type(4)));
typedef float f32x2 __attribute__((ext_vector_type(2)));
typedef unsigned u32x4 __attribute__((ext_vector_type(4)));
typedef unsigned u32x2 __attribute__((ext_vector_type(2)));
typedef __bf16 bf16x2_t __attribute__((ext_vector_type(2)));

#define DI __device__ __forceinline__
#define MFMA16(a, b, c) __builtin_amdgcn_mfma_f32_16x16x32_bf16((a), (b), (c), 0, 0, 0)

constexpr int D_MODEL = 1024, BATCH = 16, SEQ = 2048, DEPTH = 4, NTOK = BATCH * SEQ;
constexpr int N_IN = 5912, NP = 6144, NT_IN = 24;
constexpr int NTHR = 512;
constexpr int LDX = D_MODEL + 64;
constexpr int NCMP = 127;
constexpr float NORM_EPS = 1e-6f;

DI unsigned pk2(float lo, float hi) { f32x2 v = {lo, hi}; bf16x2_t b = __builtin_convertvector(v, bf16x2_t); return __builtin_bit_cast(unsigned, b); }
DI float bflo(unsigned u) { return __uint_as_float(u << 16); }
DI float bfhi(unsigned u) { return __uint_as_float(u & 0xffff0000u); }
DI float sigmoidf_(float x) { return __builtin_amdgcn_rcpf(1.f + __builtin_amdgcn_exp2f(-1.44269504089f * x)); }
DI float siluf_(float x) { return x * __builtin_amdgcn_rcpf(1.f + __builtin_amdgcn_exp2f(-1.44269504089f * x)); }
DI bf16x8 mk8(u32x4 v) { return __builtin_bit_cast(bf16x8, v); }
DI bf16x8 ld8(const bf16_t* p) { return __builtin_bit_cast(bf16x8, *(const u32x4*)p); }


DI void sincos_acc(float angf, float& sn, float& cs) {
  const double a = (double)angf;
  const double k = rint(a * 0.63661977236758134308);
  const double y = (a - k * 1.57079632679489655800) - k * 6.12323399573676603587e-17;
  const double y2 = y * y;
  const double sp = y * (1.0 + y2 * (-1.0 / 6 + y2 * (1.0 / 120 + y2 * (-1.0 / 5040 + y2 * (1.0 / 362880 + y2 * (-1.0 / 39916800 + y2 * (1.0 / 6227020800.0)))))));
  const double cp = 1.0 + y2 * (-0.5 + y2 * (1.0 / 24 + y2 * (-1.0 / 720 + y2 * (1.0 / 40320 + y2 * (-1.0 / 3628800 + y2 * (1.0 / 479001600.0))))));
  const int q = ((int)k) & 3;
  const double s_ = (q & 1) ? cp : sp, c_ = (q & 1) ? sp : cp;
  sn = (float)((q & 2) ? -s_ : s_);
  cs = (float)(((q + 1) & 2) ? -c_ : c_);
}
DI float inv_freq(int f) { return (float)exp(-(double)f * (9.21034037197618273607 / 32.0)); }

constexpr size_t al256(size_t x) { return (x + 255) & ~(size_t)255; }
constexpr size_t OFF_WT_IN = 0;
constexpr size_t OFF_W1T = OFF_WT_IN + al256((size_t)NP * LDX * 2);
constexpr size_t OFF_W2T = OFF_W1T + al256((size_t)2 * 256 * 2048 * 2);
constexpr size_t OFF_WUPA = OFF_W2T + al256((size_t)2 * 64 * 256 * 2);
constexpr size_t OFF_WUPB = OFF_WUPA + al256((size_t)1024 * 512 * 2);
constexpr size_t OFF_WOUT = OFF_WUPB + al256((size_t)1024 * 512 * 2);
constexpr size_t OFF_B1EFF = OFF_WOUT + al256((size_t)1024 * 1024 * 2);
constexpr size_t OFF_COST = OFF_B1EFF + al256((size_t)DEPTH * 2 * 16 * 256 * 4);
constexpr size_t OFF_SINT = OFF_COST + al256((size_t)NTOK * 32 * 4);
constexpr size_t OFF_COSC = OFF_SINT + al256((size_t)NTOK * 32 * 4);
constexpr size_t OFF_SINC = OFF_COSC + al256((size_t)BATCH * 128 * 32 * 4);
constexpr size_t OFF_XB = OFF_SINC + al256((size_t)BATCH * 128 * 32 * 4);
constexpr size_t OFF_PART = OFF_XB + al256((size_t)NTOK * LDX * 2);
constexpr size_t OFF_SBQ = OFF_PART + al256((size_t)NTOK * 16 * 4);
constexpr size_t OFF_SBK = OFF_SBQ + al256((size_t)NTOK * 512 * 2);
constexpr size_t OFF_SBVT = OFF_SBK + al256((size_t)NTOK * 512 * 2);
constexpr size_t OFF_SBZ = OFF_SBVT + al256((size_t)NTOK * 512 * 2);
constexpr size_t OFF_NQ = OFF_SBZ + al256((size_t)NTOK * 512 * 2);
constexpr size_t OFF_KCR = OFF_NQ + al256((size_t)NTOK * 512 * 2);
constexpr size_t OFF_VCR = OFF_KCR + al256((size_t)NTOK * 128 * 2);
constexpr size_t OFF_KS = OFF_VCR + al256((size_t)NTOK * 128 * 2);
constexpr size_t OFF_VST = OFF_KS + al256((size_t)NTOK * 128 * 2);
constexpr size_t OFF_KW = OFF_VST + al256((size_t)NTOK * 128 * 2);
constexpr size_t OFF_VWT = OFF_KW + al256((size_t)NTOK * 128 * 2);
constexpr size_t OFF_NGATE = OFF_VWT + al256((size_t)NTOK * 128 * 2);
constexpr size_t OFF_NZ = OFF_NGATE + al256((size_t)NTOK * 32 * 4);
constexpr size_t OFF_GA = OFF_NZ + al256((size_t)NTOK * 512 * 2);
constexpr size_t OFF_GB = OFF_GA + al256((size_t)NTOK * 1024 * 2);
constexpr size_t OFF_HID = OFF_GB + al256((size_t)NTOK * 1024 * 2);
constexpr size_t OFF_KC = OFF_HID + al256((size_t)4 * 32 * 256 * 256 * 4);
constexpr size_t OFF_VCT = OFF_KC + al256((size_t)BATCH * 2 * 128 * 64 * 2);
constexpr size_t OFF_QNG = OFF_VCT + al256((size_t)BATCH * 2 * 64 * 128 * 2);
constexpr size_t OFF_KNG = OFF_QNG + al256((size_t)DEPTH * 64 * 4);
constexpr size_t OFF_CTL = OFF_KNG + al256((size_t)DEPTH * 3 * 64 * 4);
constexpr size_t OFF_MFIX_BASE = OFF_CTL + 256;
constexpr size_t OFF_MFIX_OLD = OFF_KNG + al256((size_t)DEPTH * 3 * 64 * 4);
constexpr size_t OFF_MFIX = OFF_MFIX_BASE;
constexpr size_t OFF_DUMMY = OFF_MFIX + 256;
constexpr size_t OFF_BAR = OFF_DUMMY + 256;
constexpr size_t WS_NEED = OFF_BAR + 3456 * 4;

struct Params {
  const float* x_in; const int* pos; const float* norm_g; const float* w_in; const float* q_norm_g; const float* k_norm_g;
  const float* cmp_pe; const float* cmp_w1; const float* cmp_b1; const float* cmp_w2; const float* w_up_a; const float* w_up_b; const float* w_out;
  float* out; unsigned char* ws;
#define WSBUF(T, name, OFF) DI T* name() const { return (T*)(ws + (OFF)); }
  WSBUF(bf16_t, wt_in, OFF_WT_IN) WSBUF(bf16_t, w1t, OFF_W1T) WSBUF(bf16_t, w2t, OFF_W2T) WSBUF(bf16_t, wupa_t, OFF_WUPA) WSBUF(bf16_t, wupb_t, OFF_WUPB) WSBUF(bf16_t, wout_t, OFF_WOUT)
  WSBUF(float, b1eff, OFF_B1EFF) WSBUF(float, cosT, OFF_COST) WSBUF(float, sinT, OFF_SINT) WSBUF(float, cosC, OFF_COSC) WSBUF(float, sinC, OFF_SINC)
  WSBUF(bf16_t, xb, OFF_XB) WSBUF(float, part, OFF_PART) WSBUF(bf16_t, sbq, OFF_SBQ) WSBUF(bf16_t, sbk, OFF_SBK) WSBUF(bf16_t, sbvt, OFF_SBVT) WSBUF(bf16_t, sbz, OFF_SBZ)
  WSBUF(bf16_t, nq, OFF_NQ) WSBUF(bf16_t, kcr, OFF_KCR) WSBUF(bf16_t, vcr, OFF_VCR) WSBUF(bf16_t, ks, OFF_KS) WSBUF(bf16_t, vst, OFF_VST) WSBUF(bf16_t, kw, OFF_KW) WSBUF(bf16_t, vwt, OFF_VWT)
  WSBUF(float, ngate, OFF_NGATE) WSBUF(bf16_t, nz, OFF_NZ) WSBUF(bf16_t, ga, OFF_GA) WSBUF(bf16_t, gb, OFF_GB) WSBUF(float, hpre, OFF_HID) WSBUF(bf16_t, kc, OFF_KC) WSBUF(bf16_t, vct, OFF_VCT)
  WSBUF(bf16_t, merged, OFF_SBK)
  WSBUF(bf16_t, dummy, OFF_XB)     WSBUF(float, mfix, OFF_MFIX) WSBUF(unsigned, ctl, OFF_CTL)
  WSBUF(float, qng, OFF_QNG) WSBUF(float, kng, OFF_KNG)
};

DI int my_tid() { int t = threadIdx.x; asm volatile("" : "+v"(t)); return t; }
DI Params relaunder(const Params& p0) { Params p = p0; size_t z = 0; asm volatile("" : "+s"(z)); p.ws = p0.ws + z; return p; }

constexpr int TILE_B = 32 * 1024;
constexpr int STAGE_B = 2 * TILE_B;
constexpr int LDS_GEMM_BYTES = 2 * STAGE_B;
typedef __attribute__((address_space(3))) unsigned lds_u32;

DI void g_dma(const bf16_t* __restrict__ base, const unsigned (&off)[8], int ko, unsigned char* stage, int w) {
#pragma unroll
  for (int u = 0; u < 8; ++u)
    __builtin_amdgcn_global_load_lds((const unsigned*)(base + (off[u] + ko)), (lds_u32*)(stage + (w * 8 + u) * 1024), 16, 0, 0);
}
#define G_LDA(dst, ih, ks) _Pragma("unroll") for (int i = 0; i < 4; ++i) dst[i] = mk8(*(const u32x4*)(stage + ra + (((ih) * 4 + i) * 2 + (ks)) * 1024))
#define G_LDB(dst, ks) _Pragma("unroll") for (int j = 0; j < 4; ++j) dst[j] = mk8(*(const u32x4*)(stage + TILE_B + rb + (j * 2 + (ks)) * 1024))
#define G_MMA(ih, A, B) do { _Pragma("unroll") for (int i = 0; i < 4; ++i) _Pragma("unroll") for (int j = 0; j < 4; ++j) acc[(ih) * 4 + i][j] = MFMA16(A[i], B[j], acc[(ih) * 4 + i][j]); } while (0)
DI void g_compute(const unsigned char* stage, int ra, int rb, f32x4 (&acc)[8][4]) {
  bf16x8 b0[4], b1[4], a0[4], a1[4];
  G_LDB(b0, 0); G_LDA(a0, 0, 0);
  __builtin_amdgcn_sched_barrier(0);
  G_LDA(a1, 1, 0);
  G_MMA(0, a0, b0);
  __builtin_amdgcn_sched_barrier(0);
  G_LDB(b1, 1); G_LDA(a0, 0, 1);
  G_MMA(1, a1, b0);
  __builtin_amdgcn_sched_barrier(0);
  G_LDA(a1, 1, 1);
  G_MMA(0, a0, b1);
  __builtin_amdgcn_sched_barrier(0);
  G_MMA(1, a1, b1);
  __builtin_amdgcn_sched_barrier(0);
}

DI void gemm_core(const bf16_t* __restrict__ Ag, long lda, const bf16_t* __restrict__ Bg, long ldb, int K,
                  bf16_t* ldsb, f32x4 (&acc)[8][4], int kstep = 64, bool pre = false, const bf16_t* nAg = nullptr, const bf16_t* nBg = nullptr, bool perm = false) {
  unsigned char* lds = (unsigned char*)ldsb;
  const int tid = my_tid(), lane = tid & 63, w = __builtin_amdgcn_readfirstlane(tid >> 6), wa = w >> 2, wb = w & 3, qi = lane & 15, quad = lane >> 4;
  const bf16_t* base = w >= 4 ? Bg : Ag; const int ld = (int)(w >= 4 ? ldb : lda);
  const bf16_t* nbase = nAg ? (w >= 4 ? nBg : nAg) : base;
  unsigned off[8];
#pragma unroll
  for (int u = 0; u < 8; ++u) {
    const int blk = (w & 3) * 8 + u, rg = blk >> 1, kh = blk & 1;
    int R = rg * 16 + (lane >> 2);
    if (perm) { const int rho = R & 31; R = (R & ~31) + ((rho >> 2) & 3) * 8 + (rho >> 4) * 4 + (rho & 3); }
    off[u] = (unsigned)(R * ld + kh * 32 + (lane & 3) * 8);
  }
  const int ra = (wa * 8) * 2 * 1024 + (qi * 4 + quad) * 16, rb = (wb * 4) * 2 * 1024 + (qi * 4 + quad) * 16;
  unsigned char* buf0 = lds; unsigned char* buf1 = lds + STAGE_B;
  const int KT = K >> 6;
  if (!pre) {
    g_dma(base, off, 0, buf0, w);
    asm volatile("s_waitcnt vmcnt(0)" ::: "memory");
    __syncthreads();
  }
  for (int kt = 0; kt < KT; kt += 2) {
    g_dma(base, off, (kt + 1) * kstep, buf1, w);
    g_compute(buf0, ra, rb, acc);
    asm volatile("s_waitcnt vmcnt(0)" ::: "memory");
    __syncthreads();
    const bool last = kt + 2 >= KT;
    g_dma(last ? nbase : base, off, last ? 0 : (kt + 2) * kstep, buf0, w);
    g_compute(buf1, ra, rb, acc);
    asm volatile("s_waitcnt vmcnt(0)" ::: "memory");
    __syncthreads();
  }
}

DI void zero_acc(f32x4 (&acc)[8][4]) {
#pragma unroll
  for (int i = 0; i < 8; ++i)
#pragma unroll
    for (int j = 0; j < 4; ++j) acc[i][j] = (f32x4){0.f, 0.f, 0.f, 0.f};
}

struct Slot { int xcd, slot; };
DI bool tile_order(const Slot sl, int it, int nN, int& mt, int& nt) {
  const int xcd = sl.xcd, slot = sl.slot, SL = gridDim.x >> 3;
  const int q = slot + it * SL, per = 8 * nN;
  if (q >= 2 * per) return false;
  const int mg = q / per, e = q - mg * per;
  nt = e >> 3; mt = xcd * 16 + mg * 8 + (e & 7);
  return true;
}


#define XB_TMO      128
#define XB_XCNT(j)  (256  + 64 * (j))
#define XB_XSUB(j)  (1280 + 64 * (j))
#define XB_XGEN(j)  (2304 + 64 * (j))
#define XB_TOP      3328
#define XB_TOPGEN   3392
#define XCD_BAR_WORDS 3456
#define XB_SPIN_CAP (1u << 21)
#define LAS __attribute__((address_space(3)))
DI unsigned xb_ld(unsigned* p)              { return __hip_atomic_load(p, __ATOMIC_RELAXED, __HIP_MEMORY_SCOPE_AGENT); }
DI unsigned xb_add(unsigned* p, unsigned v) { return __hip_atomic_fetch_add(p, v, __ATOMIC_RELAXED, __HIP_MEMORY_SCOPE_AGENT); }
DI unsigned xb_xcc_id() { return (unsigned)__builtin_amdgcn_s_getreg((3 << 11) | 20) & 0xFu; }
#define XB_SPIN(cond, bar) do { unsigned _sp = 0; while (cond) { __builtin_amdgcn_s_sleep(1); \
    if ((++_sp & 255u) == 0u) { if (xb_ld(&(bar)[XB_TMO])) break; if (_sp > XB_SPIN_CAP) { atomicAdd(&(bar)[XB_TMO], 1u); break; } } } } while (0)
struct XcdBarrier { unsigned* bar; unsigned x; volatile LAS unsigned* st; };
DI XcdBarrier xcd_barrier_post(unsigned* bar, volatile LAS unsigned* st) {
  XcdBarrier b; b.bar = bar; b.x = xb_xcc_id(); b.st = st;
  if (threadIdx.x == 0) (void)xb_add(&bar[XB_XCNT(b.x)], 1u);
  return b;
}
DI void xcd_barrier_complete(unsigned* bar, unsigned x, unsigned& nloc, unsigned& nx) {
  const unsigned G = gridDim.x * gridDim.y * gridDim.z;
  unsigned sum, cnt, mine, sp = 0u;
  for (;;) {
    sum = 0u; cnt = 0u; mine = 0u;
#pragma unroll
    for (unsigned j = 0; j < 16; ++j) { const unsigned c = xb_ld(&bar[XB_XCNT(j)]); sum += c; cnt += (c > 0u) ? 1u : 0u; mine = (j == x) ? c : mine; }
    if (sum == G) break;
    __builtin_amdgcn_s_sleep(1);
    if ((++sp & 255u) == 0u) { if (xb_ld(&bar[XB_TMO])) break; if (sp > XB_SPIN_CAP) { atomicAdd(&bar[XB_TMO], 1u); break; } }
  }
  nloc = mine > 0u ? mine : 1u; nx = cnt > 0u ? cnt : 1u;
}
DI void xcd_barrier(const XcdBarrier& b) {
  asm volatile("s_waitcnt vmcnt(0)" ::: "memory");
  __syncthreads();
  if (threadIdx.x == 0) {
    unsigned* bar = b.bar;
    __builtin_amdgcn_s_waitcnt(0);
    unsigned nloc = b.st[0], nx = b.st[1];
    if (nloc == 0u) { xcd_barrier_complete(bar, b.x, nloc, nx); b.st[0] = nloc; b.st[1] = nx; }
    const unsigned old = xb_add(&bar[XB_XSUB(b.x)], 1u);
    const unsigned gen = old / nloc;
    if (old + 1u == (gen + 1u) * nloc) {
      __builtin_amdgcn_fence(__ATOMIC_RELEASE, "agent");
      asm volatile("s_waitcnt vmcnt(0)" ::: "memory");
      const unsigned og = xb_add(&bar[XB_TOP], 1u);
      const unsigned tg = og / nx;
      if (og + 1u == (tg + 1u) * nx) xb_add(&bar[XB_TOPGEN], 1u);
      else XB_SPIN(xb_ld(&bar[XB_TOPGEN]) == tg, bar);
      __builtin_amdgcn_fence(__ATOMIC_ACQUIRE, "agent");
      xb_add(&bar[XB_XGEN(b.x)], 1u);
      asm volatile("s_waitcnt vmcnt(0)" ::: "memory");
    } else {
      XB_SPIN(xb_ld(&bar[XB_XGEN(b.x)]) == gen, bar);
      __builtin_amdgcn_fence(__ATOMIC_ACQUIRE, "agent");
      asm volatile("s_waitcnt vmcnt(0)" ::: "memory");
    }
  }
  __syncthreads();
}

DI int inmap(int c) {
  if (c < 1024) return c;
  if (c < 1536) return c + 512;
  if (c < 2048) return c + 512;
  if (c < 2304) return c + 512;
  if (c < 2432) return c + 512;
  if (c < 2560) return c + 640;
  if (c < 3072) return c + 792;
  if (c < 4096) return c + 792;
  if (c < 5120) return c + 792;
  if (c < 5376) return c < 5144 ? c - 1792 : -1;
  if (c < 5888) return c - 4352;
  if (c < 6016) return c - 2944;
  return c - 2816;
}

DI void tr_tile(const float* __restrict__ src, int ld, int K, int k0, int n0, bool use_map, const float* __restrict__ scale, bf16_t* __restrict__ dst, int ldd, float* tile) {
  const int tid = my_tid();
  {
    const int nl = tid & 63, kk = tid >> 6;
    int n = n0 + nl; asm volatile("" : "+v"(n));
    const int sc = use_map ? inmap(n) : n;
#pragma unroll
    for (int r = 0; r < 8; ++r) {
      const int k = k0 + r * 8 + kk;
      float v = 0.f;
      if (sc >= 0) { v = src[(long)k * ld + sc]; if (scale) v *= scale[k]; }
      tile[(r * 8 + kk) * 65 + nl] = v;
    }
  }
  __syncthreads();
  {
    const int nl = tid >> 3, ks = tid & 7;
    unsigned o[4];
#pragma unroll
    for (int e = 0; e < 4; ++e) o[e] = pk2(tile[(ks * 8 + 2 * e) * 65 + nl], tile[(ks * 8 + 2 * e + 1) * 65 + nl]);
    *(u32x4*)(dst + (long)(n0 + nl) * ldd + k0 + ks * 8) = (u32x4){o[0], o[1], o[2], o[3]};
  }
  __syncthreads();
}

DI void tr_job(const float* src, int ld, int K, int N, bool use_map, const float* scale, bf16_t* dst, int ldd, float* tile) {
  const int nk = K >> 6, nn = N >> 6;
  for (int t = blockIdx.x; t < nk * nn; t += gridDim.x) tr_tile(src, ld, K, (t % nk) * 64, (t / nk) * 64, use_map, scale, dst, ldd, tile);
}

DI void convert_weights(const Params& p0, int l, unsigned char* lds, int which) {
  const Params p = relaunder(p0);
  float* tile = (float*)lds;
  if (which & 1) {
    tr_job(p.w_in + (long)l * D_MODEL * N_IN, N_IN, D_MODEL, NP, true, p.norm_g + l * D_MODEL, p.wt_in(), LDX, tile);
    for (int kv = 0; kv < 2; ++kv) {
      tr_job(p.cmp_w1 + (long)(l * 2 + kv) * 2048 * 256, 256, 2048, 256, false, nullptr, p.w1t() + (long)kv * 256 * 2048, 2048, tile);
      tr_job(p.cmp_w2 + (long)(l * 2 + kv) * 256 * 64, 64, 256, 64, false, nullptr, p.w2t() + (long)kv * 64 * 256, 256, tile);
    }
    tr_job(p.w_up_a + (long)l * 512 * 1024, 1024, 512, 1024, false, nullptr, p.wupa_t(), 512, tile);
    tr_job(p.w_up_b + (long)l * 512 * 1024, 1024, 512, 1024, false, nullptr, p.wupb_t(), 512, tile);
  }
  if (which & 2) tr_job(p.w_out + (long)l * 1024 * 1024, 1024, 1024, 1024, false, nullptr, p.wout_t(), 1024, tile);
}

DI void phase_prologue(const Params& p, unsigned char* lds) {
  const int tid = my_tid();
  convert_weights(p, 0, lds, 3);
  {
    const int lane = tid & 63;
    for (int wi = blockIdx.x * 8 + (tid >> 6); wi < DEPTH * 2 * 16 * 4; wi += gridDim.x * 8) {
      const int jq = wi & 3, kq = (wi >> 2) & 15, it = wi >> 6;
      const float* w1 = p.cmp_w1 + (long)it * 2048 * 256 + (long)kq * 128 * 256 + jq * 64 + lane; const float* pe = p.cmp_pe + (long)it * 2048 + kq * 128;
      float s0 = kq == 0 ? p.cmp_b1[it * 256 + jq * 64 + lane] : 0.f, s1 = 0.f, s2 = 0.f, s3 = 0.f;
#pragma unroll 4
      for (int k = 0; k < 128; k += 4) {
        s0 += pe[k] * w1[(long)k * 256]; s1 += pe[k + 1] * w1[(long)(k + 1) * 256]; s2 += pe[k + 2] * w1[(long)(k + 2) * 256]; s3 += pe[k + 3] * w1[(long)(k + 3) * 256];
      }
      p.b1eff()[(it * 16 + kq) * 256 + jq * 64 + lane] = (s0 + s1) + (s2 + s3);
    }
  }
  if (blockIdx.x == 1 && tid < DEPTH * 3) {
    const int l = tid / 3, br = tid % 3;
    float mq = 0.f, mk = 0.f;
    for (int d = 0; d < 64; ++d) { mq = fmaxf(mq, fabsf(p.q_norm_g[l * 64 + d])); mk = fmaxf(mk, fabsf(p.k_norm_g[(l * 3 + br) * 64 + d])); }
    p.mfix()[l * 4 + br] = 8.f * 1.44269504089f * mq * mk * 1.02f + 0.25f;
  }
  if (blockIdx.x == 0) { for (int i = tid; i < DEPTH * 64; i += NTHR) p.qng()[i] = p.q_norm_g[i]; for (int i = tid; i < DEPTH * 192; i += NTHR) p.kng()[i] = p.k_norm_g[i]; }
  const long gtid = (long)blockIdx.x * NTHR + tid, gn = (long)gridDim.x * NTHR;
  for (long i = gtid; i < (long)NTOK * 32; i += gn) {
    const int f = (int)(i & 31); const long tok = i >> 5;
    const float ang = (float)p.pos[tok] * inv_freq(f);
    float sn, cs; sincos_acc(ang, sn, cs);
    p.cosT()[i] = cs; p.sinT()[i] = sn;
  }
  for (long i = gtid; i < (long)BATCH * 128 * 32; i += gn) {
    const int f = (int)(i & 31); const int c = (int)((i >> 5) & 127); const int b = (int)(i >> 12);
    float cs = 1.f, sn = 0.f;
    if (c < NCMP) {
      float sum = 0.f;
      for (int k = 0; k < 32; ++k) sum += (float)p.pos[b * SEQ + c * 16 + k];
      const float ang = (sum * (1.f / 32.f)) * inv_freq(f);
      sincos_acc(ang, sn, cs);
    }
    p.cosC()[i] = cs; p.sinC()[i] = sn;
  }
  const int lane = tid & 63;
  for (long row = (long)blockIdx.x * 8 + (tid >> 6); row < NTOK; row += (long)gridDim.x * 8) {
    const float* xr = p.x_in + row * D_MODEL; bf16_t* xo = p.xb() + row * LDX;
    float ss = 0.f;
#pragma unroll
    for (int u = 0; u < 4; ++u) {
      const f32x4 v = *(const f32x4*)(xr + u * 256 + lane * 4);
      ss += v[0] * v[0] + v[1] * v[1] + v[2] * v[2] + v[3] * v[3];
      *(u32x2*)(xo + u * 256 + lane * 4) = (u32x2){pk2(v[0], v[1]), pk2(v[2], v[3])};
    }
#pragma unroll
    for (int o = 32; o >= 1; o >>= 1) ss += __shfl_xor(ss, o);
    if (lane < 8) p.part()[row * 16 + lane] = lane == 0 ? ss : 0.f;
  }
}

DI void phaseA_epilogue(const Params& p, int layer, int mt, int nt, const f32x4 (&acc)[8][4], const float* rs_s) {
  const int tid = my_tid(), lane = tid & 63, w = tid >> 6, wa = w >> 2, wb = w & 3, qi = lane & 15, quad = lane >> 4;
  if (nt >= 21) {
    bf16_t* dstb; int nh, head;
    if (nt < 23) { dstb = p.sbvt(); nh = 8; head = (nt - 21) * 4 + wb; } else if (wb < 2) { dstb = p.vst(); nh = 2; head = wb; } else { dstb = p.vwt(); nh = 2; head = wb - 2; }
    const int tok0 = mt * 256, b = tok0 >> 11;
#pragma unroll
    for (int ip = 0; ip < 4; ++ip) {
      const int tl = wa * 128 + ip * 32 + quad * 8;
      const f32x4 ra = *(const f32x4*)(rs_s + tl), rb2 = *(const f32x4*)(rs_s + tl + 4);
      const int sq = (tok0 & 2047) + tl;
#pragma unroll
      for (int j = 0; j < 4; ++j) {
        const int d = (j >> 1) * 32 + (qi >> 2) * 8 + (j & 1) * 4 + (qi & 3);
        const f32x4 v0 = acc[2 * ip][j] * ra, v1 = acc[2 * ip + 1][j] * rb2;
        bf16_t* dst = dstb + (long)(b * nh + head) * 64 * SEQ + (long)(sq >> 5) * 2048 + d * 32 + (sq & 31);
        *(u32x4*)dst = (u32x4){pk2(v0[0], v0[1]), pk2(v0[2], v0[3]), pk2(v1[0], v1[1]), pk2(v1[2], v1[3])};
      }
    }
    return;
  }
  const bool headtype = nt < 4 || (nt >= 6 && nt < 10);
#pragma unroll
  for (int j = 0; j < 4; ++j) {
    const int tl = wb * 64 + (j >> 1) * 32 + (qi >> 2) * 8 + (j & 1) * 4 + (qi & 3); const long tok = (long)mt * 256 + tl; const int b = (int)(tok >> 11), sq = (int)(tok & 2047);
    const float rs = rs_s[tl];
    if (headtype) {
#pragma unroll
      for (int ih = 0; ih < 2; ++ih) {
        const int hit = wa * 2 + ih;
        f32x4 v[4];
#pragma unroll
        for (int i = 0; i < 4; ++i) v[i] = acc[ih * 4 + i][j] * rs;
        bf16_t* dstb; int nh, head; const float* g = nullptr;
        if (nt < 2) { dstb = p.sbq(); nh = 8; head = nt * 4 + hit; }
        else if (nt < 4) { dstb = p.sbk(); nh = 8; head = (nt - 2) * 4 + hit; }
        else if (nt < 8) { dstb = p.nq(); nh = 8; head = (nt - 6) * 4 + hit; g = p.qng() + layer * 64; }
        else if (nt == 8) { dstb = hit < 2 ? p.kcr() : p.vcr(); nh = 2; head = hit & 1; }
        else { dstb = hit < 2 ? p.ks() : p.kw(); nh = 2; head = hit & 1; g = p.kng() + (layer * 3 + (hit < 2 ? 1 : 2)) * 64; }
        if (g) {
          float ss = 0.f;
#pragma unroll
          for (int i = 0; i < 4; ++i) ss += v[i][0] * v[i][0] + v[i][1] * v[i][1] + v[i][2] * v[i][2] + v[i][3] * v[i][3];
          ss += __shfl_xor(ss, 16); ss += __shfl_xor(ss, 32);
          const float rn = rsqrtf(ss * (1.f / 64.f) + NORM_EPS);
#pragma unroll
          for (int i = 0; i < 4; ++i) { const f32x4 gg = *(const f32x4*)(g + (i >> 1) * 32 + quad * 8 + (i & 1) * 4); v[i] = v[i] * rn * gg; }
#pragma unroll
          for (int i = 0; i < 2; ++i) {
            const f32x4 cs = *(const f32x4*)(p.cosT() + tok * 32 + quad * 8 + i * 4), sn = *(const f32x4*)(p.sinT() + tok * 32 + quad * 8 + i * 4);
            const f32x4 x1 = v[i], x2 = v[i + 2];
            v[i] = x1 * cs - x2 * sn; v[i + 2] = x2 * cs + x1 * sn;
          }
        }
        bf16_t* dst = dstb + ((long)(b * nh + head) * SEQ + sq) * 64 + quad * 8;
#pragma unroll
        for (int ip = 0; ip < 2; ++ip)
          *(u32x4*)(dst + ip * 32) = (u32x4){pk2(v[2 * ip][0], v[2 * ip][1]), pk2(v[2 * ip][2], v[2 * ip][3]), pk2(v[2 * ip + 1][0], v[2 * ip + 1][1]), pk2(v[2 * ip + 1][2], v[2 * ip + 1][3])};
        asm volatile("" ::: "memory");
      }
    } else if (nt == 20) {
      if (wa == 0 && quad < 3) {
#pragma unroll
        for (int i = 0; i < 2; ++i) {
          const f32x4 v = acc[i][j] * rs;
          const f32x4 o = {sigmoidf_(v[0]), sigmoidf_(v[1]), sigmoidf_(v[2]), sigmoidf_(v[3])};
          *(f32x4*)(p.ngate() + tok * 32 + quad * 8 + i * 4) = o;
        }
      }
    } else {
      bf16_t* dstb; int ldd, c0; bool sil;
      if (nt < 6) { dstb = p.sbz(); ldd = 512; c0 = (nt - 4) * 256; sil = true; }
      else if (nt < 12) { dstb = p.nz(); ldd = 512; c0 = (nt - 10) * 256; sil = true; }
      else if (nt < 16) { dstb = p.ga(); ldd = 1024; c0 = (nt - 12) * 256; sil = false; }
      else { dstb = p.gb(); ldd = 1024; c0 = (nt - 16) * 256; sil = false; }
      bf16_t* dst = dstb + tok * ldd + c0 + wa * 128 + quad * 8;
#pragma unroll
      for (int ip = 0; ip < 4; ++ip) {
        const f32x4 v0 = acc[2 * ip][j] * rs, v1 = acc[2 * ip + 1][j] * rs;
        f32x4 o0, o1;
#pragma unroll
        for (int r = 0; r < 4; ++r) { o0[r] = sil ? siluf_(v0[r]) : sigmoidf_(v0[r]); o1[r] = sil ? siluf_(v1[r]) : sigmoidf_(v1[r]); }
        *(u32x4*)(dst + ip * 32) = (u32x4){pk2(o0[0], o0[1]), pk2(o0[2], o0[3]), pk2(o1[0], o1[1]), pk2(o1[2], o1[3])};
      }
    }
    asm volatile("" ::: "memory");
  }
}

DI void phaseA(const Params& p0, const Slot sl, int layer, unsigned char* lds, int fake = 0) {
  const Params p = relaunder(p0);
  bf16_t* gl = (bf16_t*)lds; float* rs_s = (float*)(lds + LDS_GEMM_BYTES);
  const bf16_t* Wt = p.wt_in();
  int mt, nt;
  for (int it = 0; tile_order(sl, it, NT_IN, mt, nt); ++it) {
    if (my_tid() < 256) {
      const float* pp = p.part() + ((long)mt * 256 + my_tid()) * 16;
      const f32x4 v0 = *(const f32x4*)pp, v1 = *(const f32x4*)(pp + 4);
      const float s = ((v0[0] + v0[1]) + (v0[2] + v0[3])) + ((v1[0] + v1[1]) + (v1[2] + v1[3]));
      rs_s[my_tid()] = rsqrtf(s * (1.f / 1024.f) + NORM_EPS);
    }
    const int mtl = fake == 3 ? 0 : (fake == 4 ? sl.xcd * 16 + (sl.slot & 7) : mt), ntl = fake == 3 ? 0 : (fake == 4 ? (sl.slot >> 3) : nt);
    const bf16_t* Xg = p.xb() + (long)mtl * 256 * LDX; const bf16_t* Wg = Wt + (long)ntl * 256 * LDX;
    f32x4 acc[8][4]; zero_acc(acc);
    const int kstep = (fake == 1 || fake == 2) ? 0 : 64;
    int mt2, nt2;
    const bool more = !fake && tile_order(sl, it + 1, NT_IN, mt2, nt2);
    const bf16_t* Xn = more ? p.xb() + (long)mt2 * 256 * LDX : Xg; const bf16_t* Wn = more ? Wt + (long)nt2 * 256 * LDX : Wg;
    const bool vn = more ? nt2 >= 21 : nt >= 21;
    gemm_core(nt >= 21 ? Xg : Wg, LDX, nt >= 21 ? Wg : Xg, LDX, D_MODEL, gl, acc, kstep, !fake && it > 0, vn ? Xn : Wn, vn ? Wn : Xn, true);
    if (!fake) phaseA_epilogue(p, layer, mt, nt, acc, rs_s);
    else if (acc[0][0][0] == 123.456f && acc[7][3][3] == 5.f) p.dummy()[0] = 1;
    __syncthreads();
  }
}

DI void compress_partial(const Params& p, int ci, unsigned char* lds) {
  bf16_t* gl = (bf16_t*)lds;
  const int split = ci & 3, item = ci >> 2, kv = item & 1, pair = item >> 1;
  const bf16_t* src = (kv ? p.vcr() : p.kcr()) + (long)pair * 256 * 1024 + split * 512;
  const bf16_t* W1 = p.w1t() + (long)kv * 256 * 2048 + split * 512;
  f32x4 acc[8][4]; zero_acc(acc);
  gemm_core(W1, 2048, src, 1024, 512, gl, acc);
  const int tid = my_tid(), lane = tid & 63, w = tid >> 6, wa = w >> 2, wb = w & 3, qi = lane & 15, quad = lane >> 4;
  float* dst = p.hpre() + ((long)(split * 32 + item) * 256) * 256;
#pragma unroll
  for (int i = 0; i < 8; ++i)
#pragma unroll
    for (int j = 0; j < 4; ++j) *(f32x4*)(dst + (long)(wb * 64 + j * 16 + qi) * 256 + wa * 128 + i * 16 + quad * 4) = acc[i][j];
}

DI void phaseB2(const Params& p0, int layer, unsigned char* lds) {
  const Params p = relaunder(p0);
  const int tid = my_tid(), lane = tid & 63, w = tid >> 6, qi = lane & 15, quad = lane >> 4;
  float* bias_s = (float*)lds;
  {
    const float* b1 = p.b1eff() + (long)(layer * 2 + (tid >> 8)) * 16 * 256 + (tid & 255);
    float sacc = 0.f;
#pragma unroll
    for (int kq = 0; kq < 16; ++kq) sacc += b1[kq * 256];
    bias_s[tid] = sacc;
  }
  __syncthreads();
  if (w < 2)
  for (int wi = blockIdx.x * 2 + w; wi < 32 * 16; wi += gridDim.x * 2) {
    const int item = wi >> 4, r16 = wi & 15, kv = item & 1, pair = item >> 1;
    const int row = r16 * 16 + qi;
    const bf16_t* W2 = p.w2t() + (long)kv * 64 * 256;
    const float* hp = p.hpre() + ((long)item * 256 + row) * 256 + quad * 8;
    f32x4 o[4];
#pragma unroll
    for (int dt = 0; dt < 4; ++dt) o[dt] = (f32x4){0.f, 0.f, 0.f, 0.f};
#pragma unroll 1
    for (int ksx = 0; ksx < 8; ++ksx) {
      f32x4 h0 = *(const f32x4*)(bias_s + kv * 256 + ksx * 32 + quad * 8), h1 = *(const f32x4*)(bias_s + kv * 256 + ksx * 32 + quad * 8 + 4);
#pragma unroll
      for (int sp = 0; sp < 4; ++sp) { const float* q = hp + (long)sp * 32 * 256 * 256 + ksx * 32; h0 += *(const f32x4*)q; h1 += *(const f32x4*)(q + 4); }
      const bf16x8 hf = mk8((u32x4){pk2(siluf_(h0[0]), siluf_(h0[1])), pk2(siluf_(h0[2]), siluf_(h0[3])), pk2(siluf_(h1[0]), siluf_(h1[1])), pk2(siluf_(h1[2]), siluf_(h1[3]))});
#pragma unroll
      for (int dt = 0; dt < 4; ++dt) {
        const bf16x8 wf = ld8(W2 + (long)(dt * 16 + qi) * 256 + ksx * 32 + quad * 8);
        o[dt] = kv ? MFMA16(hf, wf, o[dt]) : MFMA16(wf, hf, o[dt]);
      }
    }
    const int bg = pair * 2 + (r16 >> 3);
    if (kv == 0) {
      const float* g = p.kng() + (layer * 3 + 0) * 64;
      const int b = bg >> 1, c = (r16 & 7) * 16 + qi;
      float ss = 0.f;
#pragma unroll
      for (int dt = 0; dt < 4; ++dt) ss += o[dt][0] * o[dt][0] + o[dt][1] * o[dt][1] + o[dt][2] * o[dt][2] + o[dt][3] * o[dt][3];
      ss += __shfl_xor(ss, 16); ss += __shfl_xor(ss, 32);
      const float rn = rsqrtf(ss * (1.f / 64.f) + NORM_EPS);
#pragma unroll
      for (int dt = 0; dt < 4; ++dt) { const f32x4 gg = *(const f32x4*)(g + dt * 16 + quad * 4); o[dt] = o[dt] * rn * gg; }
#pragma unroll
      for (int dt = 0; dt < 2; ++dt) {
        const long ti = ((long)b * 128 + c) * 32 + dt * 16 + quad * 4;
        const f32x4 cs = *(const f32x4*)(p.cosC() + ti), sn = *(const f32x4*)(p.sinC() + ti);
        const f32x4 x1 = o[dt], x2 = o[dt + 2];
        o[dt] = x1 * cs - x2 * sn; o[dt + 2] = x2 * cs + x1 * sn;
      }
      bf16_t* dst = p.kc() + ((long)bg * 128 + c) * 64 + quad * 4;
#pragma unroll
      for (int dt = 0; dt < 4; ++dt) {
        u32x2 ov = (u32x2){pk2(o[dt][0], o[dt][1]), pk2(o[dt][2], o[dt][3])};
        if (c >= NCMP) ov = (u32x2){0u, 0u};
        *(u32x2*)(dst + dt * 16) = ov;
      }
    } else {
#pragma unroll
      for (int dt = 0; dt < 4; ++dt) {
        const int c0 = (r16 & 7) * 16 + quad * 4;
        f32x4 v = o[dt];
        if (c0 + 3 >= NCMP) v[3] = 0.f;
        *(u32x2*)(p.vct() + ((long)bg * 64 + dt * 16 + qi) * 128 + c0) = (u32x2){pk2(v[0], v[1]), pk2(v[2], v[3])};
      }
    }
  }
  __syncthreads();
}

struct SbFrag { bf16x8 k[2][2]; bf16x8 v[4]; };
DI void sb_load(SbFrag& f, const bf16_t* __restrict__ kp0, const bf16_t* __restrict__ vp0, int kb) {
#pragma unroll
  for (int a = 0; a < 2; ++a) { f.k[a][0] = ld8(kp0 + (long)(kb + 4 * a) * 64); f.k[a][1] = ld8(kp0 + (long)(kb + 4 * a) * 64 + 32); }
#pragma unroll
  for (int dt = 0; dt < 4; ++dt) f.v[dt] = ld8(vp0 + (long)kb * 64 + dt * 16 * 32);
}
template <bool FULL>
DI void sb_chunk(const SbFrag& f, int kb, int t, int quad, const bf16x8 (&qf)[2], f32x4 (&o)[4], float& carry) {
  f32x4 s[2];
#pragma unroll
  for (int a = 0; a < 2; ++a) {
    s[a] = MFMA16(f.k[a][0], qf[0], ((f32x4){0.f, 0.f, 0.f, 0.f}));
    s[a] = MFMA16(f.k[a][1], qf[1], s[a]);
  }
  float beta[8], om[8];
  float prod = 1.f;
#pragma unroll
  for (int idx = 0; idx < 8; ++idx) {
    const float z2 = fminf(s[idx >> 2][idx & 3] * (0.125f * 1.44269504089f), 60.f);
    const float e = __builtin_amdgcn_exp2f(z2);
    const float r = __builtin_amdgcn_rcpf(1.f + e);
    const bool val = FULL ? true : (kb + 8 * quad + idx < t);
    om[idx] = val ? r : 1.f;
    beta[idx] = val ? e * r : 0.f;
    prod *= om[idx];
  }
  const float a1 = __shfl_xor(prod, 16), a2 = __shfl_xor(prod, 32), a3 = __shfl_xor(a1, 32);
  const float higher = ((quad ^ 1) > quad ? a1 : 1.f) * ((quad ^ 2) > quad ? a2 : 1.f) * ((quad ^ 3) > quad ? a3 : 1.f);
  float q = __builtin_amdgcn_exp2f(carry) * higher;
  float wv[8];
#pragma unroll
  for (int idx = 7; idx >= 0; --idx) { wv[idx] = beta[idx] * q; q *= om[idx]; }
  carry += __builtin_amdgcn_logf((prod * a1) * (a2 * a3));
  const bf16x8 pf = mk8((u32x4){pk2(wv[0], wv[1]), pk2(wv[2], wv[3]), pk2(wv[4], wv[5]), pk2(wv[6], wv[7])});
#pragma unroll
  for (int dt = 0; dt < 4; ++dt) o[dt] = MFMA16(f.v[dt], pf, o[dt]);
}

DI void sb_attn_wave(const Params& p, int b, int h, int t0, bf16_t* ybase) {
  const int lane = my_tid() & 63, qi = lane & 15, quad = lane >> 4;
  const bf16_t* Q = p.sbq() + (long)(b * 8 + h) * SEQ * 64;
  const bf16_t* K = p.sbk() + (long)(b * 8 + h) * SEQ * 64;
  const bf16_t* Vt = p.sbvt() + (long)(b * 8 + h) * 64 * SEQ;
  const int tA = t0 + qi, tB = t0 + 16 + qi;
  bf16x8 qa[2], qb[2];
  qa[0] = ld8(Q + (long)tA * 64 + quad * 8); qa[1] = ld8(Q + (long)tA * 64 + 32 + quad * 8);
  qb[0] = ld8(Q + (long)tB * 64 + quad * 8); qb[1] = ld8(Q + (long)tB * 64 + 32 + quad * 8);
  f32x4 oa[4], ob[4];
#pragma unroll
  for (int dt = 0; dt < 4; ++dt) { oa[dt] = (f32x4){0.f, 0.f, 0.f, 0.f}; ob[dt] = oa[dt]; }
  float ca = 0.f, cb = 0.f;
  const int krow = 8 * (qi >> 2) + (qi & 3);
  const bf16_t* kp0 = K + (long)krow * 64 + quad * 8;
  const bf16_t* vp0 = Vt + qi * 32 + 8 * quad;
  int kb = t0;
  SbFrag f0, f1, f2;
  sb_load(f0, kp0, vp0, kb); sb_load(f1, kp0, vp0, max(kb - 32, 0));
#define SB_STEP(F, KB) (((KB) + 32 <= t0) ? (sb_chunk<true>(F, KB, tA, quad, qa, oa, ca), sb_chunk<true>(F, KB, tB, quad, qb, ob, cb)) : (sb_chunk<false>(F, KB, tA, quad, qa, oa, ca), sb_chunk<false>(F, KB, tB, quad, qb, ob, cb)), __all(ca < -160.f && cb < -160.f))
  while (true) {
    sb_load(f2, kp0, vp0, max(kb - 64, 0));
    if (SB_STEP(f0, kb) || kb < 32) break;
    sb_load(f0, kp0, vp0, max(kb - 96, 0));
    if (SB_STEP(f1, kb - 32) || kb < 64) break;
    sb_load(f1, kp0, vp0, max(kb - 128, 0));
    if (SB_STEP(f2, kb - 64) || kb < 96) break;
    kb -= 96;
  }
#undef SB_STEP
#pragma unroll
  for (int half = 0; half < 2; ++half) {
    const long zo = ((long)b * SEQ + (half ? tB : tA)) * 512 + h * 64 + quad * 4;
    const bf16_t* zp = p.sbz() + zo; bf16_t* yp = ybase + zo;
#pragma unroll
    for (int dt = 0; dt < 4; ++dt) {
      const f32x4 o = half ? ob[dt] : oa[dt];
      const u32x2 zz = *(const u32x2*)(zp + dt * 16);
      *(u32x2*)(yp + dt * 16) = (u32x2){pk2(o[0] * bflo(zz[0]), o[1] * bfhi(zz[0])), pk2(o[2] * bflo(zz[1]), o[3] * bfhi(zz[1]))};
    }
  }
}

DI void phaseB(const Params& p0, int layer, unsigned char* lds, bool probe) {
  const int NITEM = 128 + BATCH * 8 * 8;
  for (int it = blockIdx.x; it < NITEM; it += gridDim.x) {
    const Params p = relaunder(p0);
    if (it < 128) { compress_partial(p, it, lds); continue; }
    const int i = it - 128, qt = 7 - (i >> 7), bh = i & 127;
    sb_attn_wave(p, bh >> 3, bh & 7, qt * 256 + (my_tid() >> 6) * 32, probe ? p.dummy() : p.sbz());
  }
}

constexpr int NSA_LO_BYTES = 8 * 8192;
constexpr int NSA_KROW = 144, NSA_VROW = 80;
constexpr int NSA_SLOT = 32 * NSA_KROW + 64 * NSA_VROW;
constexpr int NSA_SLOT0 = NSA_LO_BYTES, NSA_BLIST = NSA_SLOT0 + 2 * NSA_SLOT, NSA_UMW = NSA_BLIST + 64 * 4;

struct KVFrag { bf16x8 k[2][2]; bf16x8 v[4]; };
DI void nsa_ldsfrag(KVFrag& f, const unsigned char* slot, int qi, int quad) {
  const int krow = 8 * (qi >> 2) + (qi & 3);
#pragma unroll
  for (int a = 0; a < 2; ++a) { const unsigned char* kp = slot + (krow + 4 * a) * NSA_KROW + quad * 16; f.k[a][0] = mk8(*(const u32x4*)kp); f.k[a][1] = mk8(*(const u32x4*)(kp + 64)); }
#pragma unroll
  for (int dt = 0; dt < 4; ++dt) f.v[dt] = mk8(*(const u32x4*)(slot + 32 * NSA_KROW + (dt * 16 + qi) * NSA_VROW + quad * 16));
}
template <int MODE>
DI void nsa_chunk(const KVFrag& f, int kb, int t, bool selbit, const bf16x8 (&qf)[4][2], f32x4 (&O)[4][4], float (&m)[4], float (&l)[4], int quad, bool online) {
  const float SC = 0.125f * 1.44269504089f;
  bool val[8];
#pragma unroll
  for (int idx = 0; idx < 8; ++idx) {
    const int key = kb + 8 * quad + idx;
    val[idx] = MODE == 0 ? (selbit && key <= t) : (key <= t && key > t - 512);
  }
#pragma unroll
  for (int hh = 0; hh < 4; ++hh) {
    f32x4 s[2];
#pragma unroll
    for (int a = 0; a < 2; ++a) { s[a] = MFMA16(f.k[a][0], qf[hh][0], ((f32x4){0.f, 0.f, 0.f, 0.f})); s[a] = MFMA16(f.k[a][1], qf[hh][1], s[a]); }
    float mn = m[hh];
    if (online) {
      float cm = -1e30f;
#pragma unroll
      for (int idx = 0; idx < 8; ++idx) if (val[idx]) cm = fmaxf(cm, s[idx >> 2][idx & 3] * SC);
      cm = fmaxf(cm, __shfl_xor(cm, 16)); cm = fmaxf(cm, __shfl_xor(cm, 32));
      mn = fmaxf(mn, cm);
      const float alpha = __builtin_amdgcn_exp2f(m[hh] - mn);
      m[hh] = mn; l[hh] *= alpha;
#pragma unroll
      for (int dt = 0; dt < 4; ++dt) O[hh][dt] = O[hh][dt] * alpha;
    }
    float pv[8]; float ps = 0.f;
#pragma unroll
    for (int idx = 0; idx < 8; ++idx) { pv[idx] = val[idx] ? __builtin_amdgcn_exp2f(fmaf(s[idx >> 2][idx & 3], SC, -mn)) : 0.f; ps += pv[idx]; }
    l[hh] += ps;
    const bf16x8 pf = mk8((u32x4){pk2(pv[0], pv[1]), pk2(pv[2], pv[3]), pk2(pv[4], pv[5]), pk2(pv[6], pv[7])});
#pragma unroll
    for (int dt = 0; dt < 4; ++dt) O[hh][dt] = MFMA16(f.v[dt], pf, O[hh][dt]);
  }
}

template <int MODE>
DI void nsa_branch(const bf16_t* __restrict__ Kb, const bf16_t* __restrict__ Vtb, unsigned char* lds, int nb, int t, int cur, unsigned selmask, unsigned umall,
                   const bf16x8 (&qf)[4][2], f32x4 (&O)[4][4], float (&m)[4], float (&l)[4], bool online) {
  const int tid = my_tid(), lane = tid & 63, qi = lane & 15, quad = lane >> 4;
  const int* blist = (const int*)(lds + NSA_BLIST);
  const bool isv = tid >= 256;
  const int t2 = tid & 255;
  const bf16_t* gsrc = isv ? Vtb + (t2 >> 2) * 32 + (t2 & 3) * 8 : Kb + (long)(t2 >> 3) * 64 + (t2 & 7) * 8;
  const long gmul = 64;
  const int ldst = isv ? 32 * NSA_KROW + (t2 >> 2) * NSA_VROW + (t2 & 3) * 16 : (t2 >> 3) * NSA_KROW + (t2 & 7) * 16;
  unsigned char* slot0 = lds + NSA_SLOT0; unsigned char* slot1 = slot0 + NSA_SLOT;
  const int N = 2 * nb;
  auto kbof = [&](int n) { return blist[n >> 1] * 64 + (n & 1) * 32; };
  u32x4 ra = *(const u32x4*)(gsrc + (long)kbof(0) * gmul), rb = *(const u32x4*)(gsrc + (long)kbof(1) * gmul);
  *(u32x4*)(slot0 + ldst) = ra;
  __syncthreads();
#pragma unroll 1
  for (int n = 0; n < N; n += 2) {
    const int j = blist[n >> 1];
    const bool won = MODE == 0 ? ((umall >> j) & 1u) != 0 : (j >= cur - 8 && j <= cur);
    const bool bit = (selmask >> j) & 1u;
    ra = *(const u32x4*)(gsrc + (long)kbof(min(n + 2, N - 2)) * gmul);
    if (won) { KVFrag f; nsa_ldsfrag(f, slot0, qi, quad); nsa_chunk<MODE>(f, j * 64, t, bit, qf, O, m, l, quad, online); }
    *(u32x4*)(slot1 + ldst) = rb;
    __syncthreads();
    rb = *(const u32x4*)(gsrc + (long)kbof(min(n + 3, N - 1)) * gmul);
    if (won) { KVFrag f; nsa_ldsfrag(f, slot1, qi, quad); nsa_chunk<MODE>(f, j * 64 + 32, t, bit, qf, O, m, l, quad, online); }
    *(u32x4*)(slot0 + ldst) = ra;
    __syncthreads();
  }
}

template <bool LAST>
DI void nsa_finish(u32x2* lo, f32x4 (&O)[4][4], float (&m)[4], float (&l)[4], const float (&gate)[4], const bf16_t* zp, bf16_t* yp, float minit) {
#pragma unroll
  for (int hh = 0; hh < 4; ++hh) {
    float lt = l[hh]; lt += __shfl_xor(lt, 16); lt += __shfl_xor(lt, 32);
    const float f = lt > 0.f ? gate[hh] / lt : 0.f;
#pragma unroll
    for (int dt = 0; dt < 4; ++dt) {
      const u32x2 a = lo[(hh * 4 + dt) * 64];
      const f32x4 v = (f32x4){bflo(a[0]), bfhi(a[0]), bflo(a[1]), bfhi(a[1])} + O[hh][dt] * f;
      if (LAST) {
        const u32x2 zz = *(const u32x2*)(zp + hh * 64 + dt * 16);
        *(u32x2*)(yp + hh * 64 + dt * 16) = (u32x2){pk2(v[0] * bflo(zz[0]), v[1] * bfhi(zz[0])), pk2(v[2] * bflo(zz[1]), v[3] * bfhi(zz[1]))};
      } else {
        lo[(hh * 4 + dt) * 64] = (u32x2){pk2(v[0], v[1]), pk2(v[2], v[3])};
        O[hh][dt] = (f32x4){0.f, 0.f, 0.f, 0.f};
      }
    }
    m[hh] = minit; l[hh] = 0.f;
  }
}

DI void nsa_wave(const Params& p, int layer, int b, int g, int t0, unsigned char* lds, bf16_t* ybase) {
  const int lane = my_tid() & 63, qi = lane & 15, quad = lane >> 4;
  const int t = t0 + qi, cur = t0 >> 6;
  const long tok = (long)b * SEQ + t;
  const int bg = b * 2 + g;
  u32x2* lo = (u32x2*)lds + (my_tid() >> 6) * 1024 + lane;

  const float mf_c = p.mfix()[layer * 4 + 0], mf_s = p.mfix()[layer * 4 + 1], mf_w = p.mfix()[layer * 4 + 2];
  const bool on_c = mf_c > 60.f, on_s = mf_s > 60.f, on_w = mf_w > 60.f;
  const float SC = 0.125f * 1.44269504089f;
  const bf16_t* Kc = p.kc() + (long)bg * 128 * 64;
  const bf16_t* Vc = p.vct() + (long)bg * 64 * 128;
  f32x4 ph[8];
#pragma unroll
  for (int kt = 0; kt < 8; ++kt) ph[kt] = (f32x4){0.f, 0.f, 0.f, 0.f};
#pragma unroll 1
  for (int hh = 0; hh < 4; ++hh) {
    const bf16_t* qp0 = p.nq() + ((long)(b * 8 + g * 4 + hh) * SEQ + t) * 64 + quad * 8;
    const bf16x8 q0 = ld8(qp0), q1 = ld8(qp0 + 32); const float gt = p.ngate()[tok * 32 + g * 4 + hh];
    f32x4 sc[8];
    float mx = on_c ? -1e30f : mf_c;
#pragma unroll
    for (int kt = 0; kt < 8; ++kt) {
      const bf16_t* kp = Kc + (long)(kt * 16 + qi) * 64 + quad * 8;
      sc[kt] = MFMA16(ld8(kp), q0, ((f32x4){0.f, 0.f, 0.f, 0.f}));
      sc[kt] = MFMA16(ld8(kp + 32), q1, sc[kt]);
      sc[kt] = sc[kt] * SC;
    }
    if (on_c) {
#pragma unroll
      for (int kt = 0; kt < 8; ++kt)
#pragma unroll
        for (int r = 0; r < 4; ++r) { const int c = kt * 16 + quad * 4 + r; if (c < NCMP && 16 * c + 31 <= t) mx = fmaxf(mx, sc[kt][r]); }
      mx = fmaxf(mx, __shfl_xor(mx, 16)); mx = fmaxf(mx, __shfl_xor(mx, 32));
    }
    float sum = 0.f;
#pragma unroll
    for (int kt = 0; kt < 8; ++kt)
#pragma unroll
      for (int r = 0; r < 4; ++r) {
        const int c = kt * 16 + quad * 4 + r;
        const float e = (c < NCMP && 16 * c + 31 <= t) ? __builtin_amdgcn_exp2f(sc[kt][r] - mx) : 0.f;
        sc[kt][r] = e; sum += e;
      }
    sum += __shfl_xor(sum, 16); sum += __shfl_xor(sum, 32);
    const float inv = sum > 0.f ? 1.f / sum : 0.f;
#pragma unroll
    for (int kt = 0; kt < 8; ++kt) { sc[kt] = sc[kt] * inv; ph[kt] += sc[kt]; }
    f32x4 oc[4];
#pragma unroll
    for (int dt = 0; dt < 4; ++dt) oc[dt] = (f32x4){0.f, 0.f, 0.f, 0.f};
#pragma unroll
    for (int mm = 0; mm < 4; ++mm) {
      const bf16x8 pf = mk8((u32x4){pk2(sc[2 * mm][0], sc[2 * mm][1]), pk2(sc[2 * mm][2], sc[2 * mm][3]), pk2(sc[2 * mm + 1][0], sc[2 * mm + 1][1]), pk2(sc[2 * mm + 1][2], sc[2 * mm + 1][3])});
#pragma unroll
      for (int dt = 0; dt < 4; ++dt) {
        const bf16_t* vp = Vc + (long)(dt * 16 + qi) * 128 + 32 * mm + quad * 4;
        const u32x2 lo = *(const u32x2*)vp, hi = *(const u32x2*)(vp + 16);
        oc[dt] = MFMA16(mk8((u32x4){lo[0], lo[1], hi[0], hi[1]}), pf, oc[dt]);
      }
    }
#pragma unroll
    for (int dt = 0; dt < 4; ++dt) { const f32x4 v = oc[dt] * gt; lo[(hh * 4 + dt) * 64] = (u32x2){pk2(v[0], v[1]), pk2(v[2], v[3])}; }
  }
  float imp[8];
  {
    float rot[8];
#pragma unroll
    for (int kt = 0; kt < 8; ++kt) rot[kt] = __shfl(ph[kt][3], (lane + 48) & 63);
#pragma unroll
    for (int kt = 0; kt < 8; ++kt) {
      const float extra = quad > 0 ? rot[kt] : (kt > 0 ? rot[kt > 0 ? kt - 1 : 0] : 0.f);
      const float v = (ph[kt][0] + ph[kt][1]) + (ph[kt][2] + ph[kt][3]) + extra;
      const int j = 4 * kt + quad;
      const bool forced = j == 0 || j == cur || j == cur - 1;
      imp[kt] = j <= cur ? v + (forced ? 1e4f : 0.f) : -1e30f;
    }
  }
  unsigned selmask = 0;
  {
    int rank[8];
#pragma unroll
    for (int kt = 0; kt < 8; ++kt) rank[kt] = 0;
#pragma unroll 1
    for (int q2 = 0; q2 < 4; ++q2)
#pragma unroll
      for (int k2 = 0; k2 < 8; ++k2) {
        const float ov = __shfl(imp[k2], qi + 16 * q2);
#pragma unroll
        for (int kt = 0; kt < 8; ++kt) {
          const bool before = k2 < kt || (k2 == kt && q2 < quad);
          rank[kt] += (ov > imp[kt] || (ov == imp[kt] && before)) ? 1 : 0;
        }
      }
#pragma unroll
    for (int kt = 0; kt < 8; ++kt) if (rank[kt] < 8 && 4 * kt + quad <= cur) selmask |= 1u << (4 * kt + quad);
    selmask |= __shfl_xor(selmask, 16); selmask |= __shfl_xor(selmask, 32);
  }

  unsigned umall = selmask;
  umall |= __shfl_xor(umall, 1); umall |= __shfl_xor(umall, 2); umall |= __shfl_xor(umall, 4); umall |= __shfl_xor(umall, 8);
  umall = __builtin_amdgcn_readfirstlane(umall);
  const int wv = my_tid() >> 6;
  unsigned* umw = (unsigned*)(lds + NSA_UMW); int* blist = (int*)(lds + NSA_BLIST);
  if (lane == 0) umw[wv] = umall;
  bf16x8 qf[4][2];
#pragma unroll
  for (int hh = 0; hh < 4; ++hh) {
    const bf16_t* qp = p.nq() + ((long)(b * 8 + g * 4 + hh) * SEQ + t) * 64 + quad * 8;
    qf[hh][0] = ld8(qp); qf[hh][1] = ld8(qp + 32);
  }
  float gate[3][4];
#pragma unroll
  for (int br = 1; br < 3; ++br) { const f32x4 gv = *(const f32x4*)(p.ngate() + tok * 32 + br * 8 + g * 4); gate[br][0] = gv[0]; gate[br][1] = gv[1]; gate[br][2] = gv[2]; gate[br][3] = gv[3]; }
  f32x4 O[4][4]; float m[4], l[4];
#pragma unroll
  for (int hh = 0; hh < 4; ++hh) { m[hh] = on_s ? -1e30f : mf_s; l[hh] = 0.f;
#pragma unroll
    for (int dt = 0; dt < 4; ++dt) O[hh][dt] = (f32x4){0.f, 0.f, 0.f, 0.f}; }
  __syncthreads();
  int nb;
  {
    unsigned ub = 0;
#pragma unroll
    for (int i = 0; i < 8; ++i) ub |= umw[i];
    nb = __builtin_popcount(ub);
    if (my_tid() < 32) { if ((ub >> my_tid()) & 1u) blist[__builtin_popcount(ub & ((1u << my_tid()) - 1u))] = my_tid(); }
    __syncthreads();
    nsa_branch<0>(p.ks() + (long)bg * SEQ * 64, p.vst() + (long)bg * 64 * SEQ, lds, nb, t, cur, selmask, umall, qf, O, m, l, on_s);
    nsa_finish<false>(lo, O, m, l, gate[1], nullptr, nullptr, on_w ? -1e30f : mf_w);
  }
  {
    const int cur0 = (t0 >> 7) * 2, jlo = cur0 >= 8 ? cur0 - 8 : 0;
    nb = cur0 + 2 - jlo;
    if (my_tid() < nb) blist[my_tid()] = jlo + my_tid();
    __syncthreads();
    nsa_branch<1>(p.kw() + (long)bg * SEQ * 64, p.vwt() + (long)bg * 64 * SEQ, lds, nb, t, cur, selmask, umall, qf, O, m, l, on_w);
    nsa_finish<true>(lo, O, m, l, gate[2], p.nz() + tok * 512 + g * 256 + quad * 4, ybase + tok * 512 + g * 256 + quad * 4, 0.f);
  }
  __syncthreads();
}

DI void phaseC(const Params& p0, int layer, unsigned char* lds, bool probe) {
  const int NITEM = BATCH * 2 * 16;
  for (int it = blockIdx.x; it < NITEM; it += gridDim.x) {
    const Params p = relaunder(p0);
    const int qi5 = it >> 5, qt = qi5 < 8 ? 15 - qi5 : qi5 - 8, bg = it & 31;
    nsa_wave(p, layer, bg >> 1, bg & 1, qt * 128 + (my_tid() >> 6) * 16, lds, probe ? p.dummy() : p.nz());
  }
}

DI void phaseD(const Params& p0, const Slot sl, int layer, unsigned char* lds) {
  const Params p = relaunder(p0);
  bf16_t* gl = (bf16_t*)lds;
  int mt, nt;
  for (int it = 0; tile_order(sl, it, 4, mt, nt); ++it) {
#pragma unroll 1
    for (int which = 0; which < 2; ++which) {
      const bf16_t* Wg = (which ? p.wupb_t() : p.wupa_t()) + ((long)nt * 256) * 512;
      const bf16_t* Yg = (which ? p.nz() : p.sbz()) + (long)mt * 256 * 512;
      const bf16_t* Gg = which ? p.gb() : p.ga();
      int mt2 = mt, nt2 = nt; bool more = true;
      if (which) more = tile_order(sl, it + 1, 4, mt2, nt2);
      const bf16_t* Wn = more ? (which ? p.wupa_t() : p.wupb_t()) + ((long)nt2 * 256) * 512 : Wg;
      const bf16_t* Yn = more ? (which ? p.sbz() : p.nz()) + (long)mt2 * 256 * 512 : Yg;
      f32x4 acc[8][4]; zero_acc(acc);
      gemm_core(Wg, 512, Yg, 512, 512, gl, acc, 64, it > 0 || which, Wn, Yn);
      const int tid = my_tid(), lane = tid & 63, w = tid >> 6, wa = w >> 2, wb = w & 3, qi = lane & 15, quad = lane >> 4;
#pragma unroll
      for (int j = 0; j < 4; ++j) {
        const long tok = (long)mt * 256 + wb * 64 + j * 16 + qi;
#pragma unroll
        for (int i = 0; i < 8; ++i) {
          const long off = tok * 1024 + nt * 256 + wa * 128 + i * 16 + quad * 4;
          const u32x2 xg = *(const u32x2*)(Gg + off);
          const f32x4 v = acc[i][j];
          float o0 = bflo(xg[0]) * v[0], o1 = bfhi(xg[0]) * v[1], o2 = bflo(xg[1]) * v[2], o3 = bfhi(xg[1]) * v[3];
          if (which) { const u32x2 a = *(const u32x2*)(p.merged() + off); o0 += bflo(a[0]); o1 += bfhi(a[0]); o2 += bflo(a[1]); o3 += bfhi(a[1]); }
          *(u32x2*)(p.merged() + off) = (u32x2){pk2(o0, o1), pk2(o2, o3)};
          if ((i & 3) == 3) asm volatile("" ::: "memory");
        }
      }
    }
  }
}

DI void phaseE(const Params& p0, const Slot sl, int layer, unsigned char* lds, const float* xsrc) {
  const Params p = relaunder(p0);
  bf16_t* gl = (bf16_t*)lds;
  int mt, nt;
  for (int it = 0; tile_order(sl, it, 4, mt, nt); ++it) {
    f32x4 acc[8][4]; zero_acc(acc);
    int mt2, nt2;
    const bool more = tile_order(sl, it + 1, 4, mt2, nt2);
    const bf16_t* Wg = p.wout_t() + ((long)nt * 256) * 1024; const bf16_t* Mg = p.merged() + (long)mt * 256 * 1024;
    gemm_core(Wg, 1024, Mg, 1024, 1024, gl, acc, 64, it > 0, more ? p.wout_t() + ((long)nt2 * 256) * 1024 : Wg, more ? p.merged() + (long)mt2 * 256 * 1024 : Mg);
    const int tid = my_tid(), lane = tid & 63, w = tid >> 6, wa = w >> 2, wb = w & 3, qi = lane & 15, quad = lane >> 4;
#pragma unroll
    for (int j = 0; j < 4; ++j) {
      const long tok = (long)mt * 256 + wb * 64 + j * 16 + qi;
      float ss = 0.f;
#pragma unroll
      for (int i = 0; i < 8; ++i) {
        const long off = tok * 1024 + nt * 256 + wa * 128 + i * 16 + quad * 4;
        const f32x4 xo = *(const f32x4*)(xsrc + off);
        const f32x4 xn = xo + acc[i][j];
        *(f32x4*)(p.out + off) = xn;
        *(u32x2*)(p.xb() + off + tok * (LDX - D_MODEL)) = (u32x2){pk2(xn[0], xn[1]), pk2(xn[2], xn[3])};
        ss += xn[0] * xn[0] + xn[1] * xn[1] + xn[2] * xn[2] + xn[3] * xn[3];
      }
      ss += __shfl_xor(ss, 16); ss += __shfl_xor(ss, 32);
      if (quad == 0) p.part()[tok * 16 + nt * 2 + wa] = ss;
    }
  }
}

#ifndef STOP_AFTER
#define STOP_AFTER 0
#endif
constexpr int LDS_BYTES = LDS_GEMM_BYTES + 1024;

__global__ void __launch_bounds__(512) hybrid_megakernel(Params p) {
  extern __shared__ __attribute__((aligned(16))) unsigned char lds[];
  cg::grid_group grid = cg::this_grid();
  __shared__ int s_xcc, s_rank, s_ok;
  __shared__ unsigned s_bar[4];
  if (threadIdx.x == 0) { s_bar[0] = 0u; s_bar[1] = 0u; }
  __syncthreads();
  const XcdBarrier xb = xcd_barrier_post((unsigned*)(p.ws + OFF_BAR), (volatile LAS unsigned*)s_bar);
  if (threadIdx.x == 0) {
    const unsigned xcc = (unsigned)__builtin_amdgcn_s_getreg((3 << 11) | 20) & 7u;
    s_xcc = (int)xcc; s_rank = (int)atomicAdd(p.ctl() + xcc, 1u);
  }
  phase_prologue(p, lds);
  grid.sync();
  if (threadIdx.x == 0) {
    int ok = 1;
    for (int i = 0; i < 8; ++i) ok &= (__hip_atomic_load(p.ctl() + i, __ATOMIC_RELAXED, __HIP_MEMORY_SCOPE_AGENT) == (gridDim.x >> 3));
    s_ok = ok;
  }
  __syncthreads();
  const Slot sl = {s_ok ? s_xcc : (int)(blockIdx.x & 7), s_ok ? s_rank : (int)(blockIdx.x >> 3)};
  for (int layer = 0; layer < DEPTH; ++layer) {
    if (layer > 0) convert_weights(p, layer, lds, 2);
    if (STOP_AFTER != 0 && STOP_AFTER == layer * 10) return;
    phaseA(p, sl, layer, lds);
    xcd_barrier(xb);
#ifdef PROBE_A
    phaseA(p, sl, layer, lds, PROBE_A >= 2 ? PROBE_A : 0);
    xcd_barrier(xb);
#endif
    if (STOP_AFTER == layer * 10 + 1) return;
#ifdef PROBE_B
    phaseB(p, layer, lds, true);
    xcd_barrier(xb);
#endif
    phaseB(p, layer, lds, false);
    xcd_barrier(xb);
    phaseB2(p, layer, lds);
    xcd_barrier(xb);
    if (STOP_AFTER == layer * 10 + 2) return;
#ifdef PROBE_C
    phaseC(p, layer, lds, true);
    xcd_barrier(xb);
#endif
    phaseC(p, layer, lds, false);
    xcd_barrier(xb);
    if (STOP_AFTER == layer * 10 + 3) return;
    phaseD(p, sl, layer, lds);
    xcd_barrier(xb);
#ifdef PROBE_D
    phaseD(p, sl, layer, lds);
    xcd_barrier(xb);
#endif
    if (STOP_AFTER == layer * 10 + 4) return;
    if (layer == 0) phaseE(p, sl, layer, lds, p.x_in); else phaseE(p, sl, layer, lds, p.out);
    if (layer + 1 < DEPTH) convert_weights(p, layer + 1, lds, 1);
    if (layer + 1 < DEPTH) xcd_barrier(xb);
    if (STOP_AFTER == layer * 10 + 5) return;
  }
}

extern "C" void kernel_launch(void* const* d_in, const int* in_sizes, int n_in, void* d_out, int out_size,
                              void* d_ws, size_t ws_size, hipStream_t stream) {
  static int grid_blocks = 0;
  if (!grid_blocks) {
    int dev = 0, cus = 0, per_cu = 0;
    (void)hipGetDevice(&dev);
    (void)hipDeviceGetAttribute(&cus, hipDeviceAttributeMultiprocessorCount, dev);
    if (hipFuncSetAttribute((const void*)hybrid_megakernel, hipFuncAttributeMaxDynamicSharedMemorySize, LDS_BYTES) != hipSuccess) fprintf(stderr, "hipFuncSetAttribute(max dynamic LDS) failed\n");
    (void)hipOccupancyMaxActiveBlocksPerMultiprocessor(&per_cu, hybrid_megakernel, NTHR, LDS_BYTES);
    (void)hipGetLastError();
    if (per_cu > 1) per_cu = 1;
    if (per_cu < 1) per_cu = 1;
    grid_blocks = (cus * per_cu) & ~7;
  }
  Params a{};
  a.x_in = (const float*)d_in[0]; a.pos = (const int*)d_in[1]; a.norm_g = (const float*)d_in[2]; a.w_in = (const float*)d_in[3];
  a.q_norm_g = (const float*)d_in[4]; a.k_norm_g = (const float*)d_in[5]; a.cmp_pe = (const float*)d_in[6]; a.cmp_w1 = (const float*)d_in[7];
  a.cmp_b1 = (const float*)d_in[8]; a.cmp_w2 = (const float*)d_in[9]; a.w_up_a = (const float*)d_in[10]; a.w_up_b = (const float*)d_in[11];
  a.w_out = (const float*)d_in[12];
  a.out = (float*)d_out; a.ws = (unsigned char*)d_ws;
  if (WS_NEED > ws_size) { fprintf(stderr, "workspace too small: need %zu have %zu\n", (size_t)WS_NEED, ws_size); return; }
  (void)hipMemsetAsync((unsigned char*)d_ws + OFF_CTL, 0, 256, stream);
  (void)hipMemsetAsync((unsigned char*)d_ws + OFF_BAR, 0, 3456 * 4, stream);
  void* args[] = {&a};
  hipError_t e = hipLaunchCooperativeKernel((void*)hybrid_megakernel, dim3(grid_blocks), dim3(NTHR), args, LDS_BYTES, stream);
  if (e != hipSuccess) fprintf(stderr, "cooperative launch failed: %s (grid %d)\n", hipGetErrorString(e), grid_blocks);
}
```

```cpp
#include <hip/hip_runtime.h>
#include <hip/hip_cooperative_groups.h>
#include <cstdio>
#include <cstdint>
namespace cg = cooperative_groups;

typedef unsigned short bf16_t;
typedef short bf16x8 __attribute__((ext_vector_type(8)));
typedef float f32x4 __attribute__((ext_vector_type(4)));
typedef float f32x2 __attribute__((ext_vector_type(2)));
typedef unsigned u32x4 __attribute__((ext_vector_type(4)));
typedef unsigned u32x2 __attribute__((ext_vector_type(2)));
typedef __bf16 bf16x2_t __attribute__((ext_vector_type(2)));

#define DI __device__ __forceinline__
#define MFMA16(a, b, c) __builtin_amdgcn_mfma_f32_16x16x32_bf16((a), (b), (c), 0, 0, 0)

constexpr int D_MODEL = 1024, BATCH = 16, SEQ = 2048, DEPTH = 4, NTOK = BATCH * SEQ;
constexpr int N_IN = 5912, NP = 6144, NT_IN = 24;
constexpr int NTHR = 512;
constexpr int LDX = D_MODEL + 64;
constexpr int NCMP = 127;
constexpr float NORM_EPS = 1e-6f;

DI unsigned pk2(float lo, float hi) { f32x2 v = {lo, hi}; bf16x2_t b = __builtin_convertvector(v, bf16x2_t); return __builtin_bit_cast(unsigned, b); }
DI float bflo(unsigned u) { return __uint_as_float(u << 16); }
DI float bfhi(unsigned u) { return __uint_as_float(u & 0xffff0000u); }
DI float sigmoidf_(float x) { return __builtin_amdgcn_rcpf(1.f + __builtin_amdgcn_exp2f(-1.44269504089f * x)); }
DI float siluf_(float x) { return x * __builtin_amdgcn_rcpf(1.f + __builtin_amdgcn_exp2f(-1.44269504089f * x)); }
DI bf16x8 mk8(u32x4 v) { return __builtin_bit_cast(bf16x8, v); }
DI bf16x8 ld8(const bf16_t* p) { return __builtin_bit_cast(bf16x8, *(const u32x4*)p); }


DI void sincos_acc(float angf, float& sn, float& cs) {
  const double a = (double)angf;
  const double k = rint(a * 0.63661977236758134308);
  const double y = (a - k * 1.57079632679489655800) - k * 6.12323399573676603587e-17;
  const double y2 = y * y;
  const double sp = y * (1.0 + y2 * (-1.0 / 6 + y2 * (1.0 / 120 + y2 * (-1.0 / 5040 + y2 * (1.0 / 362880 + y2 * (-1.0 / 39916800 + y2 * (1.0 / 6227020800.0)))))));
  const double cp = 1.0 + y2 * (-0.5 + y2 * (1.0 / 24 + y2 * (-1.0 / 720 + y2 * (1.0 / 40320 + y2 * (-1.0 / 3628800 + y2 * (1.0 / 479001600.0))))));
  const int q = ((int)k) & 3;
  const double s_ = (q & 1) ? cp : sp, c_ = (q & 1) ? sp : cp;
  sn = (float)((q & 2) ? -s_ : s_);
  cs = (float)(((q + 1) & 2) ? -c_ : c_);
}
DI float inv_freq(int f) { return (float)exp(-(double)f * (9.21034037197618273607 / 32.0)); }

constexpr size_t al256(size_t x) { return (x + 255) & ~(size_t)255; }
constexpr size_t OFF_WT_IN = 0;
constexpr size_t OFF_W1T = OFF_WT_IN + al256((size_t)NP * LDX * 2);
constexpr size_t OFF_W2T = OFF_W1T + al256((size_t)2 * 256 * 2048 * 2);
constexpr size_t OFF_WUPA = OFF_W2T + al256((size_t)2 * 64 * 256 * 2);
constexpr size_t OFF_WUPB = OFF_WUPA + al256((size_t)1024 * 512 * 2);
constexpr size_t OFF_WOUT = OFF_WUPB + al256((size_t)1024 * 512 * 2);
constexpr size_t OFF_B1EFF = OFF_WOUT + al256((size_t)1024 * 1024 * 2);
constexpr size_t OFF_COST = OFF_B1EFF + al256((size_t)DEPTH * 2 * 16 * 256 * 4);
constexpr size_t OFF_SINT = OFF_COST + al256((size_t)NTOK * 32 * 4);
constexpr size_t OFF_COSC = OFF_SINT + al256((size_t)NTOK * 32 * 4);
constexpr size_t OFF_SINC = OFF_COSC + al256((size_t)BATCH * 128 * 32 * 4);
constexpr size_t OFF_XB = OFF_SINC + al256((size_t)BATCH * 128 * 32 * 4);
constexpr size_t OFF_PART = OFF_XB + al256((size_t)NTOK * LDX * 2);
constexpr size_t OFF_SBQ = OFF_PART + al256((size_t)NTOK * 16 * 4);
constexpr size_t OFF_SBK = OFF_SBQ + al256((size_t)NTOK * 512 * 2);
constexpr size_t OFF_SBVT = OFF_SBK + al256((size_t)NTOK * 512 * 2);
constexpr size_t OFF_SBZ = OFF_SBVT + al256((size_t)NTOK * 512 * 2);
constexpr size_t OFF_NQ = OFF_SBZ + al256((size_t)NTOK * 512 * 2);
constexpr size_t OFF_KCR = OFF_NQ + al256((size_t)NTOK * 512 * 2);
constexpr size_t OFF_VCR = OFF_KCR + al256((size_t)NTOK * 128 * 2);
constexpr size_t OFF_KS = OFF_VCR + al256((size_t)NTOK * 128 * 2);
constexpr size_t OFF_VST = OFF_KS + al256((size_t)NTOK * 128 * 2);
constexpr size_t OFF_KW = OFF_VST + al256((size_t)NTOK * 128 * 2);
constexpr size_t OFF_VWT = OFF_KW + al256((size_t)NTOK * 128 * 2);
constexpr size_t OFF_NGATE = OFF_VWT + al256((size_t)NTOK * 128 * 2);
constexpr size_t OFF_NZ = OFF_NGATE + al256((size_t)NTOK * 32 * 4);
constexpr size_t OFF_GA = OFF_NZ + al256((size_t)NTOK * 512 * 2);
constexpr size_t OFF_GB = OFF_GA + al256((size_t)NTOK * 1024 * 2);
constexpr size_t OFF_HID = OFF_GB + al256((size_t)NTOK * 1024 * 2);
constexpr size_t OFF_KC = OFF_HID + al256((size_t)4 * 32 * 256 * 256 * 4);
constexpr size_t OFF_VCT = OFF_KC + al256((size_t)BATCH * 2 * 128 * 64 * 2);
constexpr size_t OFF_QNG = OFF_VCT + al256((size_t)BATCH * 2 * 64 * 128 * 2);
constexpr size_t OFF_KNG = OFF_QNG + al256((size_t)DEPTH * 64 * 4);
constexpr size_t OFF_CTL = OFF_KNG + al256((size_t)DEPTH * 3 * 64 * 4);
constexpr size_t OFF_MFIX_BASE = OFF_CTL + 256;
constexpr size_t OFF_MFIX_OLD = OFF_KNG + al256((size_t)DEPTH * 3 * 64 * 4);
constexpr size_t OFF_MFIX = OFF_MFIX_BASE;
constexpr size_t OFF_DUMMY = OFF_MFIX + 256;
constexpr size_t OFF_BAR = OFF_DUMMY + 256;
constexpr size_t WS_NEED = OFF_BAR + 3456 * 4;

struct Params {
  const float* x_in; const int* pos; const float* norm_g; const float* w_in; const float* q_norm_g; const float* k_norm_g;
  const float* cmp_pe; const float* cmp_w1; const float* cmp_b1; const float* cmp_w2; const float* w_up_a; const float* w_up_b; const float* w_out;
  float* out; unsigned char* ws;
#define WSBUF(T, name, OFF) DI T* name() const { return (T*)(ws + (OFF)); }
  WSBUF(bf16_t, wt_in, OFF_WT_IN) WSBUF(bf16_t, w1t, OFF_W1T) WSBUF(bf16_t, w2t, OFF_W2T) WSBUF(bf16_t, wupa_t, OFF_WUPA) WSBUF(bf16_t, wupb_t, OFF_WUPB) WSBUF(bf16_t, wout_t, OFF_WOUT)
  WSBUF(float, b1eff, OFF_B1EFF) WSBUF(float, cosT, OFF_COST) WSBUF(float, sinT, OFF_SINT) WSBUF(float, cosC, OFF_COSC) WSBUF(float, sinC, OFF_SINC)
  WSBUF(bf16_t, xb, OFF_XB) WSBUF(float, part, OFF_PART) WSBUF(bf16_t, sbq, OFF_SBQ) WSBUF(bf16_t, sbk, OFF_SBK) WSBUF(bf16_t, sbvt, OFF_SBVT) WSBUF(bf16_t, sbz, OFF_SBZ)
  WSBUF(bf16_t, nq, OFF_NQ) WSBUF(bf16_t, kcr, OFF_KCR) WSBUF(bf16_t, vcr, OFF_VCR) WSBUF(bf16_t, ks, OFF_KS) WSBUF(bf16_t, vst, OFF_VST) WSBUF(bf16_t, kw, OFF_KW) WSBUF(bf16_t, vwt, OFF_VWT)
  WSBUF(float, ngate, OFF_NGATE) WSBUF(bf16_t, nz, OFF_NZ) WSBUF(bf16_t, ga, OFF_GA) WSBUF(bf16_t, gb, OFF_GB) WSBUF(float, hpre, OFF_HID) WSBUF(bf16_t, kc, OFF_KC) WSBUF(bf16_t, vct, OFF_VCT)
  WSBUF(bf16_t, merged, OFF_SBK)
  WSBUF(bf16_t, dummy, OFF_XB)     WSBUF(float, mfix, OFF_MFIX) WSBUF(unsigned, ctl, OFF_CTL)
  WSBUF(float, qng, OFF_QNG) WSBUF(float, kng, OFF_KNG)
};

DI int my_tid() { int t = threadIdx.x; asm volatile("" : "+v"(t)); return t; }
DI Params relaunder(const Params& p0) { Params p = p0; size_t z = 0; asm volatile("" : "+s"(z)); p.ws = p0.ws + z; return p; }

constexpr int TILE_B = 32 * 1024;
constexpr int STAGE_B = 2 * TILE_B;
constexpr int LDS_GEMM_BYTES = 2 * STAGE_B;
typedef __attribute__((address_space(3))) unsigned lds_u32;

DI void g_dma(const bf16_t* __restrict__ base, const unsigned (&off)[8], int ko, unsigned char* stage, int w) {
#pragma unroll
  for (int u = 0; u < 8; ++u)
    __builtin_amdgcn_global_load_lds((const unsigned*)(base + (off[u] + ko)), (lds_u32*)(stage + (w * 8 + u) * 1024), 16, 0, 0);
}
#define G_LDA(dst, ih, ks) _Pragma("unroll") for (int i = 0; i < 4; ++i) dst[i] = mk8(*(const u32x4*)(stage + ra + (((ih) * 4 + i) * 2 + (ks)) * 1024))
#define G_LDB(dst, ks) _Pragma("unroll") for (int j = 0; j < 4; ++j) dst[j] = mk8(*(const u32x4*)(stage + TILE_B + rb + (j * 2 + (ks)) * 1024))
#define G_MMA(ih, A, B) do { _Pragma("unroll") for (int i = 0; i < 4; ++i) _Pragma("unroll") for (int j = 0; j < 4; ++j) acc[(ih) * 4 + i][j] = MFMA16(A[i], B[j], acc[(ih) * 4 + i][j]); } while (0)
DI void g_compute(const unsigned char* stage, int ra, int rb, f32x4 (&acc)[8][4]) {
  bf16x8 b0[4], b1[4], a0[4], a1[4];
  G_LDB(b0, 0); G_LDA(a0, 0, 0);
  __builtin_amdgcn_sched_barrier(0);
  G_LDA(a1, 1, 0);
  G_MMA(0, a0, b0);
  __builtin_amdgcn_sched_barrier(0);
  G_LDB(b1, 1); G_LDA(a0, 0, 1);
  G_MMA(1, a1, b0);
  __builtin_amdgcn_sched_barrier(0);
  G_LDA(a1, 1, 1);
  G_MMA(0, a0, b1);
  __builtin_amdgcn_sched_barrier(0);
  G_MMA(1, a1, b1);
  __builtin_amdgcn_sched_barrier(0);
}

DI void gemm_core(const bf16_t* __restrict__ Ag, long lda, const bf16_t* __restrict__ Bg, long ldb, int K,
                  bf16_t* ldsb, f32x4 (&acc)[8][4], int kstep = 64, bool pre = false, const bf16_t* nAg = nullptr, const bf16_t* nBg = nullptr, bool perm = false) {
  unsigned char* lds = (unsigned char*)ldsb;
  const int tid = my_tid(), lane = tid & 63, w = __builtin_amdgcn_readfirstlane(tid >> 6), wa = w >> 2, wb = w & 3, qi = lane & 15, quad = lane >> 4;
  const bf16_t* base = w >= 4 ? Bg : Ag; const int ld = (int)(w >= 4 ? ldb : lda);
  const bf16_t* nbase = nAg ? (w >= 4 ? nBg : nAg) : base;
  unsigned off[8];
#pragma unroll
  for (int u = 0; u < 8; ++u) {
    const int blk = (w & 3) * 8 + u, rg = blk >> 1, kh = blk & 1;
    int R = rg * 16 + (lane >> 2);
    if (perm) { const int rho = R & 31; R = (R & ~31) + ((rho >> 2) & 3) * 8 + (rho >> 4) * 4 + (rho & 3); }
    off[u] = (unsigned)(R * ld + kh * 32 + (lane & 3) * 8);
  }
  const int ra = (wa * 8) * 2 * 1024 + (qi * 4 + quad) * 16, rb = (wb * 4) * 2 * 1024 + (qi * 4 + quad) * 16;
  unsigned char* buf0 = lds; unsigned char* buf1 = lds + STAGE_B;
  const int KT = K >> 6;
  if (!pre) {
    g_dma(base, off, 0, buf0, w);
    asm volatile("s_waitcnt vmcnt(0)" ::: "memory");
    __syncthreads();
  }
  for (int kt = 0; kt < KT; kt += 2) {
    g_dma(base, off, (kt + 1) * kstep, buf1, w);
    g_compute(buf0, ra, rb, acc);
    asm volatile("s_waitcnt vmcnt(0)" ::: "memory");
    __syncthreads();
    const bool last = kt + 2 >= KT;
    g_dma(last ? nbase : base, off, last ? 0 : (kt + 2) * kstep, buf0, w);
    g_compute(buf1, ra, rb, acc);
    asm volatile("s_waitcnt vmcnt(0)" ::: "memory");
    __syncthreads();
  }
}

DI void zero_acc(f32x4 (&acc)[8][4]) {
#pragma unroll
  for (int i = 0; i < 8; ++i)
#pragma unroll
    for (int j = 0; j < 4; ++j) acc[i][j] = (f32x4){0.f, 0.f, 0.f, 0.f};
}

struct Slot { int xcd, slot; };
DI bool tile_order(const Slot sl, int it, int nN, int& mt, int& nt) {
  const int xcd = sl.xcd, slot = sl.slot, SL = gridDim.x >> 3;
  const int q = slot + it * SL, per = 8 * nN;
  if (q >= 2 * per) return false;
  const int mg = q / per, e = q - mg * per;
  nt = e >> 3; mt = xcd * 16 + mg * 8 + (e & 7);
  return true;
}


#define XB_TMO      128
#define XB_XCNT(j)  (256  + 64 * (j))
#define XB_XSUB(j)  (1280 + 64 * (j))
#define XB_XGEN(j)  (2304 + 64 * (j))
#define XB_TOP      3328
#define XB_TOPGEN   3392
#define XCD_BAR_WORDS 3456
#define XB_SPIN_CAP (1u << 21)
#define LAS __attribute__((address_space(3)))
DI unsigned xb_ld(unsigned* p)              { return __hip_atomic_load(p, __ATOMIC_RELAXED, __HIP_MEMORY_SCOPE_AGENT); }
DI unsigned xb_add(unsigned* p, unsigned v) { return __hip_atomic_fetch_add(p, v, __ATOMIC_RELAXED, __HIP_MEMORY_SCOPE_AGENT); }
DI unsigned xb_xcc_id() { return (unsigned)__builtin_amdgcn_s_getreg((3 << 11) | 20) & 0xFu; }
#define XB_SPIN(cond, bar) do { unsigned _sp = 0; while (cond) { __builtin_amdgcn_s_sleep(1); \
    if ((++_sp & 255u) == 0u) { if (xb_ld(&(bar)[XB_TMO])) break; if (_sp > XB_SPIN_CAP) { atomicAdd(&(bar)[XB_TMO], 1u); break; } } } } while (0)
struct XcdBarrier { unsigned* bar; unsigned x; volatile LAS unsigned* st; };
DI XcdBarrier xcd_barrier_post(unsigned* bar, volatile LAS unsigned* st) {
  XcdBarrier b; b.bar = bar; b.x = xb_xcc_id(); b.st = st;
  if (threadIdx.x == 0) (void)xb_add(&bar[XB_XCNT(b.x)], 1u);
  return b;
}
DI void xcd_barrier_complete(unsigned* bar, unsigned x, unsigned& nloc, unsigned& nx) {
  const unsigned G = gridDim.x * gridDim.y * gridDim.z;
  unsigned sum, cnt, mine, sp = 0u;
  for (;;) {
    sum = 0u; cnt = 0u; mine = 0u;
#pragma unroll
    for (unsigned j = 0; j < 16; ++j) { const unsigned c = xb_ld(&bar[XB_XCNT(j)]); sum += c; cnt += (c > 0u) ? 1u : 0u; mine = (j == x) ? c : mine; }
    if (sum == G) break;
    __builtin_amdgcn_s_sleep(1);
    if ((++sp & 255u) == 0u) { if (xb_ld(&bar[XB_TMO])) break; if (sp > XB_SPIN_CAP) { atomicAdd(&bar[XB_TMO], 1u); break; } }
  }
  nloc = mine > 0u ? mine : 1u; nx = cnt > 0u ? cnt : 1u;
}
DI void xcd_barrier(const XcdBarrier& b) {
  asm volatile("s_waitcnt vmcnt(0)" ::: "memory");
  __syncthreads();
  if (threadIdx.x == 0) {
    unsigned* bar = b.bar;
    __builtin_amdgcn_s_waitcnt(0);
    unsigned nloc = b.st[0], nx = b.st[1];
    if (nloc == 0u) { xcd_barrier_complete(bar, b.x, nloc, nx); b.st[0] = nloc; b.st[1] = nx; }
    const unsigned old = xb_add(&bar[XB_XSUB(b.x)], 1u);
    const unsigned gen = old / nloc;
    if (old + 1u == (gen + 1u) * nloc) {
      __builtin_amdgcn_fence(__ATOMIC_RELEASE, "agent");
      asm volatile("s_waitcnt vmcnt(0)" ::: "memory");
      const unsigned og = xb_add(&bar[XB_TOP], 1u);
      const unsigned tg = og / nx;
      if (og + 1u == (tg + 1u) * nx) xb_add(&bar[XB_TOPGEN], 1u);
      else XB_SPIN(xb_ld(&bar[XB_TOPGEN]) == tg, bar);
      __builtin_amdgcn_fence(__ATOMIC_ACQUIRE, "agent");
      xb_add(&bar[XB_XGEN(b.x)], 1u);
      asm volatile("s_waitcnt vmcnt(0)" ::: "memory");
    } else {
      XB_SPIN(xb_ld(&bar[XB_XGEN(b.x)]) == gen, bar);
      __builtin_amdgcn_fence(__ATOMIC_ACQUIRE, "agent");
      asm volatile("s_waitcnt vmcnt(0)" ::: "memory");
    }
  }
  __syncthreads();
}

DI int inmap(int c) {
  if (c < 1024) return c;
  if (c < 1536) return c + 512;
  if (c < 2048) return c + 512;
  if (c < 2304) return c + 512;
  if (c < 2432) return c + 512;
  if (c < 2560) return c + 640;
  if (c < 3072) return c + 792;
  if (c < 4096) return c + 792;
  if (c < 5120) return c + 792;
  if (c < 5376) return c < 5144 ? c - 1792 : -1;
  if (c < 5888) return c - 4352;
  if (c < 6016) return c - 2944;
  return c - 2816;
}

DI void tr_tile(const float* __restrict__ src, int ld, int K, int k0, int n0, bool use_map, const float* __restrict__ scale, bf16_t* __restrict__ dst, int ldd, float* tile) {
  const int tid = my_tid();
  {
    const int nl = tid & 63, kk = tid >> 6;
    int n = n0 + nl; asm volatile("" : "+v"(n));
    const int sc = use_map ? inmap(n) : n;
#pragma unroll
    for (int r = 0; r < 8; ++r) {
      const int k = k0 + r * 8 + kk;
      float v = 0.f;
      if (sc >= 0) { v = src[(long)k * ld + sc]; if (scale) v *= scale[k]; }
      tile[(r * 8 + kk) * 65 + nl] = v;
    }
  }
  __syncthreads();
  {
    const int nl = tid >> 3, ks = tid & 7;
    unsigned o[4];
#pragma unroll
    for (int e = 0; e < 4; ++e) o[e] = pk2(tile[(ks * 8 + 2 * e) * 65 + nl], tile[(ks * 8 + 2 * e + 1) * 65 + nl]);
    *(u32x4*)(dst + (long)(n0 + nl) * ldd + k0 + ks * 8) = (u32x4){o[0], o[1], o[2], o[3]};
  }
  __syncthreads();
}

DI void tr_job(const float* src, int ld, int K, int N, bool use_map, const float* scale, bf16_t* dst, int ldd, float* tile) {
  const int nk = K >> 6, nn = N >> 6;
  for (int t = blockIdx.x; t < nk * nn; t += gridDim.x) tr_tile(src, ld, K, (t % nk) * 64, (t / nk) * 64, use_map, scale, dst, ldd, tile);
}

DI void convert_weights(const Params& p0, int l, unsigned char* lds, int which) {
  const Params p = relaunder(p0);
  float* tile = (float*)lds;
  if (which & 1) {
    tr_job(p.w_in + (long)l * D_MODEL * N_IN, N_IN, D_MODEL, NP, true, p.norm_g + l * D_MODEL, p.wt_in(), LDX, tile);
    for (int kv = 0; kv < 2; ++kv) {
      tr_job(p.cmp_w1 + (long)(l * 2 + kv) * 2048 * 256, 256, 2048, 256, false, nullptr, p.w1t() + (long)kv * 256 * 2048, 2048, tile);
      tr_job(p.cmp_w2 + (long)(l * 2 + kv) * 256 * 64, 64, 256, 64, false, nullptr, p.w2t() + (long)kv * 64 * 256, 256, tile);
    }
    tr_job(p.w_up_a + (long)l * 512 * 1024, 1024, 512, 1024, false, nullptr, p.wupa_t(), 512, tile);
    tr_job(p.w_up_b + (long)l * 512 * 1024, 1024, 512, 1024, false, nullptr, p.wupb_t(), 512, tile);
  }
  if (which & 2) tr_job(p.w_out + (long)l * 1024 * 1024, 1024, 1024, 1024, false, nullptr, p.wout_t(), 1024, tile);
}

DI void phase_prologue(const Params& p, unsigned char* lds) {
  const int tid = my_tid();
  convert_weights(p, 0, lds, 3);
  {
    const int lane = tid & 63;
    for (int wi = blockIdx.x * 8 + (tid >> 6); wi < DEPTH * 2 * 16 * 4; wi += gridDim.x * 8) {
      const int jq = wi & 3, kq = (wi >> 2) & 15, it = wi >> 6;
      const float* w1 = p.cmp_w1 + (long)it * 2048 * 256 + (long)kq * 128 * 256 + jq * 64 + lane; const float* pe = p.cmp_pe + (long)it * 2048 + kq * 128;
      float s0 = kq == 0 ? p.cmp_b1[it * 256 + jq * 64 + lane] : 0.f, s1 = 0.f, s2 = 0.f, s3 = 0.f;
#pragma unroll 4
      for (int k = 0; k < 128; k += 4) {
        s0 += pe[k] * w1[(long)k * 256]; s1 += pe[k + 1] * w1[(long)(k + 1) * 256]; s2 += pe[k + 2] * w1[(long)(k + 2) * 256]; s3 += pe[k + 3] * w1[(long)(k + 3) * 256];
      }
      p.b1eff()[(it * 16 + kq) * 256 + jq * 64 + lane] = (s0 + s1) + (s2 + s3);
    }
  }
  if (blockIdx.x == 1 && tid < DEPTH * 3) {
    const int l = tid / 3, br = tid % 3;
    float mq = 0.f, mk = 0.f;
    for (int d = 0; d < 64; ++d) { mq = fmaxf(mq, fabsf(p.q_norm_g[l * 64 + d])); mk = fmaxf(mk, fabsf(p.k_norm_g[(l * 3 + br) * 64 + d])); }
    p.mfix()[l * 4 + br] = 8.f * 1.44269504089f * mq * mk * 1.02f + 0.25f;
  }
  if (blockIdx.x == 0) { for (int i = tid; i < DEPTH * 64; i += NTHR) p.qng()[i] = p.q_norm_g[i]; for (int i = tid; i < DEPTH * 192; i += NTHR) p.kng()[i] = p.k_norm_g[i]; }
  const long gtid = (long)blockIdx.x * NTHR + tid, gn = (long)gridDim.x * NTHR;
  for (long i = gtid; i < (long)NTOK * 32; i += gn) {
    const int f = (int)(i & 31); const long tok = i >> 5;
    const float ang = (float)p.pos[tok] * inv_freq(f);
    float sn, cs; sincos_acc(ang, sn, cs);
    p.cosT()[i] = cs; p.sinT()[i] = sn;
  }
  for (long i = gtid; i < (long)BATCH * 128 * 32; i += gn) {
    const int f = (int)(i & 31); const int c = (int)((i >> 5) & 127); const int b = (int)(i >> 12);
    float cs = 1.f, sn = 0.f;
    if (c < NCMP) {
      float sum = 0.f;
      for (int k = 0; k < 32; ++k) sum += (float)p.pos[b * SEQ + c * 16 + k];
      const float ang = (sum * (1.f / 32.f)) * inv_freq(f);
      sincos_acc(ang, sn, cs);
    }
    p.cosC()[i] = cs; p.sinC()[i] = sn;
  }
  const int lane = tid & 63;
  for (long row = (long)blockIdx.x * 8 + (tid >> 6); row < NTOK; row += (long)gridDim.x * 8) {
    const float* xr = p.x_in + row * D_MODEL; bf16_t* xo = p.xb() + row * LDX;
    float ss = 0.f;
#pragma unroll
    for (int u = 0; u < 4; ++u) {
      const f32x4 v = *(const f32x4*)(xr + u * 256 + lane * 4);
      ss += v[0] * v[0] + v[1] * v[1] + v[2] * v[2] + v[3] * v[3];
      *(u32x2*)(xo + u * 256 + lane * 4) = (u32x2){pk2(v[0], v[1]), pk2(v[2], v[3])};
    }
#pragma unroll
    for (int o = 32; o >= 1; o >>= 1) ss += __shfl_xor(ss, o);
    if (lane < 8) p.part()[row * 16 + lane] = lane == 0 ? ss : 0.f;
  }
}

DI void phaseA_epilogue(const Params& p, int layer, int mt, int nt, const f32x4 (&acc)[8][4], const float* rs_s) {
  const int tid = my_tid(), lane = tid & 63, w = tid >> 6, wa = w >> 2, wb = w & 3, qi = lane & 15, quad = lane >> 4;
  if (nt >= 21) {
    bf16_t* dstb; int nh, head;
    if (nt < 23) { dstb = p.sbvt(); nh = 8; head = (nt - 21) * 4 + wb; } else if (wb < 2) { dstb = p.vst(); nh = 2; head = wb; } else { dstb = p.vwt(); nh = 2; head = wb - 2; }
    const int tok0 = mt * 256, b = tok0 >> 11;
#pragma unroll
    for (int ip = 0; ip < 4; ++ip) {
      const int tl = wa * 128 + ip * 32 + quad * 8;
      const f32x4 ra = *(const f32x4*)(rs_s + tl), rb2 = *(const f32x4*)(rs_s + tl + 4);
      const int sq = (tok0 & 2047) + tl;
#pragma unroll
      for (int j = 0; j < 4; ++j) {
        const int d = (j >> 1) * 32 + (qi >> 2) * 8 + (j & 1) * 4 + (qi & 3);
        const f32x4 v0 = acc[2 * ip][j] * ra, v1 = acc[2 * ip + 1][j] * rb2;
        bf16_t* dst = dstb + (long)(b * nh + head) * 64 * SEQ + (long)(sq >> 5) * 2048 + d * 32 + (sq & 31);
        *(u32x4*)dst = (u32x4){pk2(v0[0], v0[1]), pk2(v0[2], v0[3]), pk2(v1[0], v1[1]), pk2(v1[2], v1[3])};
      }
    }
    return;
  }
  const bool headtype = nt < 4 || (nt >= 6 && nt < 10);
#pragma unroll
  for (int j = 0; j < 4; ++j) {
    const int tl = wb * 64 + (j >> 1) * 32 + (qi >> 2) * 8 + (j & 1) * 4 + (qi & 3); const long tok = (long)mt * 256 + tl; const int b = (int)(tok >> 11), sq = (int)(tok & 2047);
    const float rs = rs_s[tl];
    if (headtype) {
#pragma unroll
      for (int ih = 0; ih < 2; ++ih) {
        const int hit = wa * 2 + ih;
        f32x4 v[4];
#pragma unroll
        for (int i = 0; i < 4; ++i) v[i] = acc[ih * 4 + i][j] * rs;
        bf16_t* dstb; int nh, head; const float* g = nullptr;
        if (nt < 2) { dstb = p.sbq(); nh = 8; head = nt * 4 + hit; }
        else if (nt < 4) { dstb = p.sbk(); nh = 8; head = (nt - 2) * 4 + hit; }
        else if (nt < 8) { dstb = p.nq(); nh = 8; head = (nt - 6) * 4 + hit; g = p.qng() + layer * 64; }
        else if (nt == 8) { dstb = hit < 2 ? p.kcr() : p.vcr(); nh = 2; head = hit & 1; }
        else { dstb = hit < 2 ? p.ks() : p.kw(); nh = 2; head = hit & 1; g = p.kng() + (layer * 3 + (hit < 2 ? 1 : 2)) * 64; }
        if (g) {
          float ss = 0.f;
#pragma unroll
          for (int i = 0; i < 4; ++i) ss += v[i][0] * v[i][0] + v[i][1] * v[i][1] + v[i][2] * v[i][2] + v[i][3] * v[i][3];
          ss += __shfl_xor(ss, 16); ss += __shfl_xor(ss, 32);
          const float rn = rsqrtf(ss * (1.f / 64.f) + NORM_EPS);
#pragma unroll
          for (int i = 0; i < 4; ++i) { const f32x4 gg = *(const f32x4*)(g + (i >> 1) * 32 + quad * 8 + (i & 1) * 4); v[i] = v[i] * rn * gg; }
#pragma unroll
          for (int i = 0; i < 2; ++i) {
            const f32x4 cs = *(const f32x4*)(p.cosT() + tok * 32 + quad * 8 + i * 4), sn = *(const f32x4*)(p.sinT() + tok * 32 + quad * 8 + i * 4);
            const f32x4 x1 = v[i], x2 = v[i + 2];
            v[i] = x1 * cs - x2 * sn; v[i + 2] = x2 * cs + x1 * sn;
          }
        }
        bf16_t* dst = dstb + ((long)(b * nh + head) * SEQ + sq) * 64 + quad * 8;
#pragma unroll
        for (int ip = 0; ip < 2; ++ip)
          *(u32x4*)(dst + ip * 32) = (u32x4){pk2(v[2 * ip][0], v[2 * ip][1]), pk2(v[2 * ip][2], v[2 * ip][3]), pk2(v[2 * ip + 1][0], v[2 * ip + 1][1]), pk2(v[2 * ip + 1][2], v[2 * ip + 1][3])};
        asm volatile("" ::: "memory");
      }
    } else if (nt == 20) {
      if (wa == 0 && quad < 3) {
#pragma unroll
        for (int i = 0; i < 2; ++i) {
          const f32x4 v = acc[i][j] * rs;
          const f32x4 o = {sigmoidf_(v[0]), sigmoidf_(v[1]), sigmoidf_(v[2]), sigmoidf_(v[3])};
          *(f32x4*)(p.ngate() + tok * 32 + quad * 8 + i * 4) = o;
        }
      }
    } else {
      bf16_t* dstb; int ldd, c0; bool sil;
      if (nt < 6) { dstb = p.sbz(); ldd = 512; c0 = (nt - 4) * 256; sil = true; }
      else if (nt < 12) { dstb = p.nz(); ldd = 512; c0 = (nt - 10) * 256; sil = true; }
      else if (nt < 16) { dstb = p.ga(); ldd = 1024; c0 = (nt - 12) * 256; sil = false; }
      else { dstb = p.gb(); ldd = 1024; c0 = (nt - 16) * 256; sil = false; }
      bf16_t* dst = dstb + tok * ldd + c0 + wa * 128 + quad * 8;
#pragma unroll
      for (int ip = 0; ip < 4; ++ip) {
        const f32x4 v0 = acc[2 * ip][j] * rs, v1 = acc[2 * ip + 1][j] * rs;
        f32x4 o0, o1;
#pragma unroll
        for (int r = 0; r < 4; ++r) { o0[r] = sil ? siluf_(v0[r]) : sigmoidf_(v0[r]); o1[r] = sil ? siluf_(v1[r]) : sigmoidf_(v1[r]); }
        *(u32x4*)(dst + ip * 32) = (u32x4){pk2(o0[0], o0[1]), pk2(o0[2], o0[3]), pk2(o1[0], o1[1]), pk2(o1[2], o1[3])};
      }
    }
    asm volatile("" ::: "memory");
  }
}

DI void phaseA(const Params& p0, const Slot sl, int layer, unsigned char* lds, int fake = 0) {
  const Params p = relaunder(p0);
  bf16_t* gl = (bf16_t*)lds; float* rs_s = (float*)(lds + LDS_GEMM_BYTES);
  const bf16_t* Wt = p.wt_in();
  int mt, nt;
  for (int it = 0; tile_order(sl, it, NT_IN, mt, nt); ++it) {
    if (my_tid() < 256) {
      const float* pp = p.part() + ((long)mt * 256 + my_tid()) * 16;
      const f32x4 v0 = *(const f32x4*)pp, v1 = *(const f32x4*)(pp + 4);
      const float s = ((v0[0] + v0[1]) + (v0[2] + v0[3])) + ((v1[0] + v1[1]) + (v1[2] + v1[3]));
      rs_s[my_tid()] = rsqrtf(s * (1.f / 1024.f) + NORM_EPS);
    }
    const int mtl = fake == 3 ? 0 : (fake == 4 ? sl.xcd * 16 + (sl.slot & 7) : mt), ntl = fake == 3 ? 0 : (fake == 4 ? (sl.slot >> 3) : nt);
    const bf16_t* Xg = p.xb() + (long)mtl * 256 * LDX; const bf16_t* Wg = Wt + (long)ntl * 256 * LDX;
    f32x4 acc[8][4]; zero_acc(acc);
    const int kstep = (fake == 1 || fake == 2) ? 0 : 64;
    int mt2, nt2;
    const bool more = !fake && tile_order(sl, it + 1, NT_IN, mt2, nt2);
    const bf16_t* Xn = more ? p.xb() + (long)mt2 * 256 * LDX : Xg; const bf16_t* Wn = more ? Wt + (long)nt2 * 256 * LDX : Wg;
    const bool vn = more ? nt2 >= 21 : nt >= 21;
    gemm_core(nt >= 21 ? Xg : Wg, LDX, nt >= 21 ? Wg : Xg, LDX, D_MODEL, gl, acc, kstep, !fake && it > 0, vn ? Xn : Wn, vn ? Wn : Xn, true);
    if (!fake) phaseA_epilogue(p, layer, mt, nt, acc, rs_s);
    else if (acc[0][0][0] == 123.456f && acc[7][3][3] == 5.f) p.dummy()[0] = 1;
    __syncthreads();
  }
}

DI void compress_partial(const Params& p, int ci, unsigned char* lds) {
  bf16_t* gl = (bf16_t*)lds;
  const int split = ci & 3, item = ci >> 2, kv = item & 1, pair = item >> 1;
  const bf16_t* src = (kv ? p.vcr() : p.kcr()) + (long)pair * 256 * 1024 + split * 512;
  const bf16_t* W1 = p.w1t() + (long)kv * 256 * 2048 + split * 512;
  f32x4 acc[8][4]; zero_acc(acc);
  gemm_core(W1, 2048, src, 1024, 512, gl, acc);
  const int tid = my_tid(), lane = tid & 63, w = tid >> 6, wa = w >> 2, wb = w & 3, qi = lane & 15, quad = lane >> 4;
  float* dst = p.hpre() + ((long)(split * 32 + item) * 256) * 256;
#pragma unroll
  for (int i = 0; i < 8; ++i)
#pragma unroll
    for (int j = 0; j < 4; ++j) *(f32x4*)(dst + (long)(wb * 64 + j * 16 + qi) * 256 + wa * 128 + i * 16 + quad * 4) = acc[i][j];
}

DI void phaseB2(const Params& p0, int layer, unsigned char* lds) {
  const Params p = relaunder(p0);
  const int tid = my_tid(), lane = tid & 63, w = tid >> 6, qi = lane & 15, quad = lane >> 4;
  float* bias_s = (float*)lds;
  {
    const float* b1 = p.b1eff() + (long)(layer * 2 + (tid >> 8)) * 16 * 256 + (tid & 255);
    float sacc = 0.f;
#pragma unroll
    for (int kq = 0; kq < 16; ++kq) sacc += b1[kq * 256];
    bias_s[tid] = sacc;
  }
  __syncthreads();
  if (w < 2)
  for (int wi = blockIdx.x * 2 + w; wi < 32 * 16; wi += gridDim.x * 2) {
    const int item = wi >> 4, r16 = wi & 15, kv = item & 1, pair = item >> 1;
    const int row = r16 * 16 + qi;
    const bf16_t* W2 = p.w2t() + (long)kv * 64 * 256;
    const float* hp = p.hpre() + ((long)item * 256 + row) * 256 + quad * 8;
    f32x4 o[4];
#pragma unroll
    for (int dt = 0; dt < 4; ++dt) o[dt] = (f32x4){0.f, 0.f, 0.f, 0.f};
#pragma unroll 1
    for (int ksx = 0; ksx < 8; ++ksx) {
      f32x4 h0 = *(const f32x4*)(bias_s + kv * 256 + ksx * 32 + quad * 8), h1 = *(const f32x4*)(bias_s + kv * 256 + ksx * 32 + quad * 8 + 4);
#pragma unroll
      for (int sp = 0; sp < 4; ++sp) { const float* q = hp + (long)sp * 32 * 256 * 256 + ksx * 32; h0 += *(const f32x4*)q; h1 += *(const f32x4*)(q + 4); }
      const bf16x8 hf = mk8((u32x4){pk2(siluf_(h0[0]), siluf_(h0[1])), pk2(siluf_(h0[2]), siluf_(h0[3])), pk2(siluf_(h1[0]), siluf_(h1[1])), pk2(siluf_(h1[2]), siluf_(h1[3]))});
#pragma unroll
      for (int dt = 0; dt < 4; ++dt) {
        const bf16x8 wf = ld8(W2 + (long)(dt * 16 + qi) * 256 + ksx * 32 + quad * 8);
        o[dt] = kv ? MFMA16(hf, wf, o[dt]) : MFMA16(wf, hf, o[dt]);
      }
    }
    const int bg = pair * 2 + (r16 >> 3);
    if (kv == 0) {
      const float* g = p.kng() + (layer * 3 + 0) * 64;
      const int b = bg >> 1, c = (r16 & 7) * 16 + qi;
      float ss = 0.f;
#pragma unroll
      for (int dt = 0; dt < 4; ++dt) ss += o[dt][0] * o[dt][0] + o[dt][1] * o[dt][1] + o[dt][2] * o[dt][2] + o[dt][3] * o[dt][3];
      ss += __shfl_xor(ss, 16); ss += __shfl_xor(ss, 32);
      const float rn = rsqrtf(ss * (1.f / 64.f) + NORM_EPS);
#pragma unroll
      for (int dt = 0; dt < 4; ++dt) { const f32x4 gg = *(const f32x4*)(g + dt * 16 + quad * 4); o[dt] = o[dt] * rn * gg; }
#pragma unroll
      for (int dt = 0; dt < 2; ++dt) {
        const long ti = ((long)b * 128 + c) * 32 + dt * 16 + quad * 4;
        const f32x4 cs = *(const f32x4*)(p.cosC() + ti), sn = *(const f32x4*)(p.sinC() + ti);
        const f32x4 x1 = o[dt], x2 = o[dt + 2];
        o[dt] = x1 * cs - x2 * sn; o[dt + 2] = x2 * cs + x1 * sn;
      }
      bf16_t* dst = p.kc() + ((long)bg * 128 + c) * 64 + quad * 4;
#pragma unroll
      for (int dt = 0; dt < 4; ++dt) {
        u32x2 ov = (u32x2){pk2(o[dt][0], o[dt][1]), pk2(o[dt][2], o[dt][3])};
        if (c >= NCMP) ov = (u32x2){0u, 0u};
        *(u32x2*)(dst + dt * 16) = ov;
      }
    } else {
#pragma unroll
      for (int dt = 0; dt < 4; ++dt) {
        const int c0 = (r16 & 7) * 16 + quad * 4;
        f32x4 v = o[dt];
        if (c0 + 3 >= NCMP) v[3] = 0.f;
        *(u32x2*)(p.vct() + ((long)bg * 64 + dt * 16 + qi) * 128 + c0) = (u32x2){pk2(v[0], v[1]), pk2(v[2], v[3])};
      }
    }
  }
  __syncthreads();
}

struct SbFrag { bf16x8 k[2][2]; bf16x8 v[4]; };
DI void sb_load(SbFrag& f, const bf16_t* __restrict__ kp0, const bf16_t* __restrict__ vp0, int kb) {
#pragma unroll
  for (int a = 0; a < 2; ++a) { f.k[a][0] = ld8(kp0 + (long)(kb + 4 * a) * 64); f.k[a][1] = ld8(kp0 + (long)(kb + 4 * a) * 64 + 32); }
#pragma unroll
  for (int dt = 0; dt < 4; ++dt) f.v[dt] = ld8(vp0 + (long)kb * 64 + dt * 16 * 32);
}
template <bool FULL>
DI void sb_chunk(const SbFrag& f, int kb, int t, int quad, const bf16x8 (&qf)[2], f32x4 (&o)[4], float& carry) {
  f32x4 s[2];
#pragma unroll
  for (int a = 0; a < 2; ++a) {
    s[a] = MFMA16(f.k[a][0], qf[0], ((f32x4){0.f, 0.f, 0.f, 0.f}));
    s[a] = MFMA16(f.k[a][1], qf[1], s[a]);
  }
  float beta[8], om[8];
  float prod = 1.f;
#pragma unroll
  for (int idx = 0; idx < 8; ++idx) {
    const float z2 = fminf(s[idx >> 2][idx & 3] * (0.125f * 1.44269504089f), 60.f);
    const float e = __builtin_amdgcn_exp2f(z2);
    const float r = __builtin_amdgcn_rcpf(1.f + e);
    const bool val = FULL ? true : (kb + 8 * quad + idx < t);
    om[idx] = val ? r : 1.f;
    beta[idx] = val ? e * r : 0.f;
    prod *= om[idx];
  }
  const float a1 = __shfl_xor(prod, 16), a2 = __shfl_xor(prod, 32), a3 = __shfl_xor(a1, 32);
  const float higher = ((quad ^ 1) > quad ? a1 : 1.f) * ((quad ^ 2) > quad ? a2 : 1.f) * ((quad ^ 3) > quad ? a3 : 1.f);
  float q = __builtin_amdgcn_exp2f(carry) * higher;
  float wv[8];
#pragma unroll
  for (int idx = 7; idx >= 0; --idx) { wv[idx] = beta[idx] * q; q *= om[idx]; }
  carry += __builtin_amdgcn_logf((prod * a1) * (a2 * a3));
  const bf16x8 pf = mk8((u32x4){pk2(wv[0], wv[1]), pk2(wv[2], wv[3]), pk2(wv[4], wv[5]), pk2(wv[6], wv[7])});
#pragma unroll
  for (int dt = 0; dt < 4; ++dt) o[dt] = MFMA16(f.v[dt], pf, o[dt]);
}

DI void sb_attn_wave(const Params& p, int b, int h, int t0, bf16_t* ybase) {
  const int lane = my_tid() & 63, qi = lane & 15, quad = lane >> 4;
  const bf16_t* Q = p.sbq() + (long)(b * 8 + h) * SEQ * 64;
  const bf16_t* K = p.sbk() + (long)(b * 8 + h) * SEQ * 64;
  const bf16_t* Vt = p.sbvt() + (long)(b * 8 + h) * 64 * SEQ;
  const int tA = t0 + qi, tB = t0 + 16 + qi;
  bf16x8 qa[2], qb[2];
  qa[0] = ld8(Q + (long)tA * 64 + quad * 8); qa[1] = ld8(Q + (long)tA * 64 + 32 + quad * 8);
  qb[0] = ld8(Q + (long)tB * 64 + quad * 8); qb[1] = ld8(Q + (long)tB * 64 + 32 + quad * 8);
  f32x4 oa[4], ob[4];
#pragma unroll
  for (int dt = 0; dt < 4; ++dt) { oa[dt] = (f32x4){0.f, 0.f, 0.f, 0.f}; ob[dt] = oa[dt]; }
  float ca = 0.f, cb = 0.f;
  const int krow = 8 * (qi >> 2) + (qi & 3);
  const bf16_t* kp0 = K + (long)krow * 64 + quad * 8;
  const bf16_t* vp0 = Vt + qi * 32 + 8 * quad;
  int kb = t0;
  SbFrag f0, f1, f2;
  sb_load(f0, kp0, vp0, kb); sb_load(f1, kp0, vp0, max(kb - 32, 0));
#define SB_STEP(F, KB) (((KB) + 32 <= t0) ? (sb_chunk<true>(F, KB, tA, quad, qa, oa, ca), sb_chunk<true>(F, KB, tB, quad, qb, ob, cb)) : (sb_chunk<false>(F, KB, tA, quad, qa, oa, ca), sb_chunk<false>(F, KB, tB, quad, qb, ob, cb)), __all(ca < -160.f && cb < -160.f))
  while (true) {
    sb_load(f2, kp0, vp0, max(kb - 64, 0));
    if (SB_STEP(f0, kb) || kb < 32) break;
    sb_load(f0, kp0, vp0, max(kb - 96, 0));
    if (SB_STEP(f1, kb - 32) || kb < 64) break;
    sb_load(f1, kp0, vp0, max(kb - 128, 0));
    if (SB_STEP(f2, kb - 64) || kb < 96) break;
    kb -= 96;
  }
#undef SB_STEP
#pragma unroll
  for (int half = 0; half < 2; ++half) {
    const long zo = ((long)b * SEQ + (half ? tB : tA)) * 512 + h * 64 + quad * 4;
    const bf16_t* zp = p.sbz() + zo; bf16_t* yp = ybase + zo;
#pragma unroll
    for (int dt = 0; dt < 4; ++dt) {
      const f32x4 o = half ? ob[dt] : oa[dt];
      const u32x2 zz = *(const u32x2*)(zp + dt * 16);
      *(u32x2*)(yp + dt * 16) = (u32x2){pk2(o[0] * bflo(zz[0]), o[1] * bfhi(zz[0])), pk2(o[2] * bflo(zz[1]), o[3] * bfhi(zz[1]))};
    }
  }
}

DI void phaseB(const Params& p0, int layer, unsigned char* lds, bool probe) {
  const int NITEM = 128 + BATCH * 8 * 8;
  for (int it = blockIdx.x; it < NITEM; it += gridDim.x) {
    const Params p = relaunder(p0);
    if (it < 128) { compress_partial(p, it, lds); continue; }
    const int i = it - 128, qt = 7 - (i >> 7), bh = i & 127;
    sb_attn_wave(p, bh >> 3, bh & 7, qt * 256 + (my_tid() >> 6) * 32, probe ? p.dummy() : p.sbz());
  }
}

constexpr int NSA_LO_BYTES = 8 * 8192;
constexpr int NSA_KROW = 144, NSA_VROW = 80;
constexpr int NSA_SLOT = 32 * NSA_KROW + 64 * NSA_VROW;
constexpr int NSA_SLOT0 = NSA_LO_BYTES, NSA_BLIST = NSA_SLOT0 + 2 * NSA_SLOT, NSA_UMW = NSA_BLIST + 64 * 4;

struct KVFrag { bf16x8 k[2][2]; bf16x8 v[4]; };
DI void nsa_ldsfrag(KVFrag& f, const unsigned char* slot, int qi, int quad) {
  const int krow = 8 * (qi >> 2) + (qi & 3);
#pragma unroll
  for (int a = 0; a < 2; ++a) { const unsigned char* kp = slot + (krow + 4 * a) * NSA_KROW + quad * 16; f.k[a][0] = mk8(*(const u32x4*)kp); f.k[a][1] = mk8(*(const u32x4*)(kp + 64)); }
#pragma unroll
  for (int dt = 0; dt < 4; ++dt) f.v[dt] = mk8(*(const u32x4*)(slot + 32 * NSA_KROW + (dt * 16 + qi) * NSA_VROW + quad * 16));
}
template <int MODE>
DI void nsa_chunk(const KVFrag& f, int kb, int t, bool selbit, const bf16x8 (&qf)[4][2], f32x4 (&O)[4][4], float (&m)[4], float (&l)[4], int quad, bool online) {
  const float SC = 0.125f * 1.44269504089f;
  bool val[8];
#pragma unroll
  for (int idx = 0; idx < 8; ++idx) {
    const int key = kb + 8 * quad + idx;
    val[idx] = MODE == 0 ? (selbit && key <= t) : (key <= t && key > t - 512);
  }
#pragma unroll
  for (int hh = 0; hh < 4; ++hh) {
    f32x4 s[2];
#pragma unroll
    for (int a = 0; a < 2; ++a) { s[a] = MFMA16(f.k[a][0], qf[hh][0], ((f32x4){0.f, 0.f, 0.f, 0.f})); s[a] = MFMA16(f.k[a][1], qf[hh][1], s[a]); }
    float mn = m[hh];
    if (online) {
      float cm = -1e30f;
#pragma unroll
      for (int idx = 0; idx < 8; ++idx) if (val[idx]) cm = fmaxf(cm, s[idx >> 2][idx & 3] * SC);
      cm = fmaxf(cm, __shfl_xor(cm, 16)); cm = fmaxf(cm, __shfl_xor(cm, 32));
      mn = fmaxf(mn, cm);
      const float alpha = __builtin_amdgcn_exp2f(m[hh] - mn);
      m[hh] = mn; l[hh] *= alpha;
#pragma unroll
      for (int dt = 0; dt < 4; ++dt) O[hh][dt] = O[hh][dt] * alpha;
    }
    float pv[8]; float ps = 0.f;
#pragma unroll
    for (int idx = 0; idx < 8; ++idx) { pv[idx] = val[idx] ? __builtin_amdgcn_exp2f(fmaf(s[idx >> 2][idx & 3], SC, -mn)) : 0.f; ps += pv[idx]; }
    l[hh] += ps;
    const bf16x8 pf = mk8((u32x4){pk2(pv[0], pv[1]), pk2(pv[2], pv[3]), pk2(pv[4], pv[5]), pk2(pv[6], pv[7])});
#pragma unroll
    for (int dt = 0; dt < 4; ++dt) O[hh][dt] = MFMA16(f.v[dt], pf, O[hh][dt]);
  }
}

template <int MODE>
DI void nsa_branch(const bf16_t* __restrict__ Kb, const bf16_t* __restrict__ Vtb, unsigned char* lds, int nb, int t, int cur, unsigned selmask, unsigned umall,
                   const bf16x8 (&qf)[4][2], f32x4 (&O)[4][4], float (&m)[4], float (&l)[4], bool online) {
  const int tid = my_tid(), lane = tid & 63, qi = lane & 15, quad = lane >> 4;
  const int* blist = (const int*)(lds + NSA_BLIST);
  const bool isv = tid >= 256;
  const int t2 = tid & 255;
  const bf16_t* gsrc = isv ? Vtb + (t2 >> 2) * 32 + (t2 & 3) * 8 : Kb + (long)(t2 >> 3) * 64 + (t2 & 7) * 8;
  const long gmul = 64;
  const int ldst = isv ? 32 * NSA_KROW + (t2 >> 2) * NSA_VROW + (t2 & 3) * 16 : (t2 >> 3) * NSA_KROW + (t2 & 7) * 16;
  unsigned char* slot0 = lds + NSA_SLOT0; unsigned char* slot1 = slot0 + NSA_SLOT;
  const int N = 2 * nb;
  auto kbof = [&](int n) { return blist[n >> 1] * 64 + (n & 1) * 32; };
  u32x4 ra = *(const u32x4*)(gsrc + (long)kbof(0) * gmul), rb = *(const u32x4*)(gsrc + (long)kbof(1) * gmul);
  *(u32x4*)(slot0 + ldst) = ra;
  __syncthreads();
#pragma unroll 1
  for (int n = 0; n < N; n += 2) {
    const int j = blist[n >> 1];
    const bool won = MODE == 0 ? ((umall >> j) & 1u) != 0 : (j >= cur - 8 && j <= cur);
    const bool bit = (selmask >> j) & 1u;
    ra = *(const u32x4*)(gsrc + (long)kbof(min(n + 2, N - 2)) * gmul);
    if (won) { KVFrag f; nsa_ldsfrag(f, slot0, qi, quad); nsa_chunk<MODE>(f, j * 64, t, bit, qf, O, m, l, quad, online); }
    *(u32x4*)(slot1 + ldst) = rb;
    __syncthreads();
    rb = *(const u32x4*)(gsrc + (long)kbof(min(n + 3, N - 1)) * gmul);
    if (won) { KVFrag f; nsa_ldsfrag(f, slot1, qi, quad); nsa_chunk<MODE>(f, j * 64 + 32, t, bit, qf, O, m, l, quad, online); }
    *(u32x4*)(slot0 + ldst) = ra;
    __syncthreads();
  }
}

template <bool LAST>
DI void nsa_finish(u32x2* lo, f32x4 (&O)[4][4], float (&m)[4], float (&l)[4], const float (&gate)[4], const bf16_t* zp, bf16_t* yp, float minit) {
#pragma unroll
  for (int hh = 0; hh < 4; ++hh) {
    float lt = l[hh]; lt += __shfl_xor(lt, 16); lt += __shfl_xor(lt, 32);
    const float f = lt > 0.f ? gate[hh] / lt : 0.f;
#pragma unroll
    for (int dt = 0; dt < 4; ++dt) {
      const u32x2 a = lo[(hh * 4 + dt) * 64];
      const f32x4 v = (f32x4){bflo(a[0]), bfhi(a[0]), bflo(a[1]), bfhi(a[1])} + O[hh][dt] * f;
      if (LAST) {
        const u32x2 zz = *(const u32x2*)(zp + hh * 64 + dt * 16);
        *(u32x2*)(yp + hh * 64 + dt * 16) = (u32x2){pk2(v[0] * bflo(zz[0]), v[1] * bfhi(zz[0])), pk2(v[2] * bflo(zz[1]), v[3] * bfhi(zz[1]))};
      } else {
        lo[(hh * 4 + dt) * 64] = (u32x2){pk2(v[0], v[1]), pk2(v[2], v[3])};
        O[hh][dt] = (f32x4){0.f, 0.f, 0.f, 0.f};
      }
    }
    m[hh] = minit; l[hh] = 0.f;
  }
}

DI void nsa_wave(const Params& p, int layer, int b, int g, int t0, unsigned char* lds, bf16_t* ybase) {
  const int lane = my_tid() & 63, qi = lane & 15, quad = lane >> 4;
  const int t = t0 + qi, cur = t0 >> 6;
  const long tok = (long)b * SEQ + t;
  const int bg = b * 2 + g;
  u32x2* lo = (u32x2*)lds + (my_tid() >> 6) * 1024 + lane;

  const float mf_c = p.mfix()[layer * 4 + 0], mf_s = p.mfix()[layer * 4 + 1], mf_w = p.mfix()[layer * 4 + 2];
  const bool on_c = mf_c > 60.f, on_s = mf_s > 60.f, on_w = mf_w > 60.f;
  const float SC = 0.125f * 1.44269504089f;
  const bf16_t* Kc = p.kc() + (long)bg * 128 * 64;
  const bf16_t* Vc = p.vct() + (long)bg * 64 * 128;
  f32x4 ph[8];
#pragma unroll
  for (int kt = 0; kt < 8; ++kt) ph[kt] = (f32x4){0.f, 0.f, 0.f, 0.f};
#pragma unroll 1
  for (int hh = 0; hh < 4; ++hh) {
    const bf16_t* qp0 = p.nq() + ((long)(b * 8 + g * 4 + hh) * SEQ + t) * 64 + quad * 8;
    const bf16x8 q0 = ld8(qp0), q1 = ld8(qp0 + 32); const float gt = p.ngate()[tok * 32 + g * 4 + hh];
    f32x4 sc[8];
    float mx = on_c ? -1e30f : mf_c;
#pragma unroll
    for (int kt = 0; kt < 8; ++kt) {
      const bf16_t* kp = Kc + (long)(kt * 16 + qi) * 64 + quad * 8;
      sc[kt] = MFMA16(ld8(kp), q0, ((f32x4){0.f, 0.f, 0.f, 0.f}));
      sc[kt] = MFMA16(ld8(kp + 32), q1, sc[kt]);
      sc[kt] = sc[kt] * SC;
    }
    if (on_c) {
#pragma unroll
      for (int kt = 0; kt < 8; ++kt)
#pragma unroll
        for (int r = 0; r < 4; ++r) { const int c = kt * 16 + quad * 4 + r; if (c < NCMP && 16 * c + 31 <= t) mx = fmaxf(mx, sc[kt][r]); }
      mx = fmaxf(mx, __shfl_xor(mx, 16)); mx = fmaxf(mx, __shfl_xor(mx, 32));
    }
    float sum = 0.f;
#pragma unroll
    for (int kt = 0; kt < 8; ++kt)
#pragma unroll
      for (int r = 0; r < 4; ++r) {
        const int c = kt * 16 + quad * 4 + r;
        const float e = (c < NCMP && 16 * c + 31 <= t) ? __builtin_amdgcn_exp2f(sc[kt][r] - mx) : 0.f;
        sc[kt][r] = e; sum += e;
      }
    sum += __shfl_xor(sum, 16); sum += __shfl_xor(sum, 32);
    const float inv = sum > 0.f ? 1.f / sum : 0.f;
#pragma unroll
    for (int kt = 0; kt < 8; ++kt) { sc[kt] = sc[kt] * inv; ph[kt] += sc[kt]; }
    f32x4 oc[4];
#pragma unroll
    for (int dt = 0; dt < 4; ++dt) oc[dt] = (f32x4){0.f, 0.f, 0.f, 0.f};
#pragma unroll
    for (int mm = 0; mm < 4; ++mm) {
      const bf16x8 pf = mk8((u32x4){pk2(sc[2 * mm][0], sc[2 * mm][1]), pk2(sc[2 * mm][2], sc[2 * mm][3]), pk2(sc[2 * mm + 1][0], sc[2 * mm + 1][1]), pk2(sc[2 * mm + 1][2], sc[2 * mm + 1][3])});
#pragma unroll
      for (int dt = 0; dt < 4; ++dt) {
        const bf16_t* vp = Vc + (long)(dt * 16 + qi) * 128 + 32 * mm + quad * 4;
        const u32x2 lo = *(const u32x2*)vp, hi = *(const u32x2*)(vp + 16);
        oc[dt] = MFMA16(mk8((u32x4){lo[0], lo[1], hi[0], hi[1]}), pf, oc[dt]);
      }
    }
#pragma unroll
    for (int dt = 0; dt < 4; ++dt) { const f32x4 v = oc[dt] * gt; lo[(hh * 4 + dt) * 64] = (u32x2){pk2(v[0], v[1]), pk2(v[2], v[3])}; }
  }
  float imp[8];
  {
    float rot[8];
#pragma unroll
    for (int kt = 0; kt < 8; ++kt) rot[kt] = __shfl(ph[kt][3], (lane + 48) & 63);
#pragma unroll
    for (int kt = 0; kt < 8; ++kt) {
      const float extra = quad > 0 ? rot[kt] : (kt > 0 ? rot[kt > 0 ? kt - 1 : 0] : 0.f);
      const float v = (ph[kt][0] + ph[kt][1]) + (ph[kt][2] + ph[kt][3]) + extra;
      const int j = 4 * kt + quad;
      const bool forced = j == 0 || j == cur || j == cur - 1;
      imp[kt] = j <= cur ? v + (forced ? 1e4f : 0.f) : -1e30f;
    }
  }
  unsigned selmask = 0;
  {
    int rank[8];
#pragma unroll
    for (int kt = 0; kt < 8; ++kt) rank[kt] = 0;
#pragma unroll 1
    for (int q2 = 0; q2 < 4; ++q2)
#pragma unroll
      for (int k2 = 0; k2 < 8; ++k2) {
        const float ov = __shfl(imp[k2], qi + 16 * q2);
#pragma unroll
        for (int kt = 0; kt < 8; ++kt) {
          const bool before = k2 < kt || (k2 == kt && q2 < quad);
          rank[kt] += (ov > imp[kt] || (ov == imp[kt] && before)) ? 1 : 0;
        }
      }
#pragma unroll
    for (int kt = 0; kt < 8; ++kt) if (rank[kt] < 8 && 4 * kt + quad <= cur) selmask |= 1u << (4 * kt + quad);
    selmask |= __shfl_xor(selmask, 16); selmask |= __shfl_xor(selmask, 32);
  }

  unsigned umall = selmask;
  umall |= __shfl_xor(umall, 1); umall |= __shfl_xor(umall, 2); umall |= __shfl_xor(umall, 4); umall |= __shfl_xor(umall, 8);
  umall = __builtin_amdgcn_readfirstlane(umall);
  const int wv = my_tid() >> 6;
  unsigned* umw = (unsigned*)(lds + NSA_UMW); int* blist = (int*)(lds + NSA_BLIST);
  if (lane == 0) umw[wv] = umall;
  bf16x8 qf[4][2];
#pragma unroll
  for (int hh = 0; hh < 4; ++hh) {
    const bf16_t* qp = p.nq() + ((long)(b * 8 + g * 4 + hh) * SEQ + t) * 64 + quad * 8;
    qf[hh][0] = ld8(qp); qf[hh][1] = ld8(qp + 32);
  }
  float gate[3][4];
#pragma unroll
  for (int br = 1; br < 3; ++br) { const f32x4 gv = *(const f32x4*)(p.ngate() + tok * 32 + br * 8 + g * 4); gate[br][0] = gv[0]; gate[br][1] = gv[1]; gate[br][2] = gv[2]; gate[br][3] = gv[3]; }
  f32x4 O[4][4]; float m[4], l[4];
#pragma unroll
  for (int hh = 0; hh < 4; ++hh) { m[hh] = on_s ? -1e30f : mf_s; l[hh] = 0.f;
#pragma unroll
    for (int dt = 0; dt < 4; ++dt) O[hh][dt] = (f32x4){0.f, 0.f, 0.f, 0.f}; }
  __syncthreads();
  int nb;
  {
    unsigned ub = 0;
#pragma unroll
    for (int i = 0; i < 8; ++i) ub |= umw[i];
    nb = __builtin_popcount(ub);
    if (my_tid() < 32) { if ((ub >> my_tid()) & 1u) blist[__builtin_popcount(ub & ((1u << my_tid()) - 1u))] = my_tid(); }
    __syncthreads();
    nsa_branch<0>(p.ks() + (long)bg * SEQ * 64, p.vst() + (long)bg * 64 * SEQ, lds, nb, t, cur, selmask, umall, qf, O, m, l, on_s);
    nsa_finish<false>(lo, O, m, l, gate[1], nullptr, nullptr, on_w ? -1e30f : mf_w);
  }
  {
    const int cur0 = (t0 >> 7) * 2, jlo = cur0 >= 8 ? cur0 - 8 : 0;
    nb = cur0 + 2 - jlo;
    if (my_tid() < nb) blist[my_tid()] = jlo + my_tid();
    __syncthreads();
    nsa_branch<1>(p.kw() + (long)bg * SEQ * 64, p.vwt() + (long)bg * 64 * SEQ, lds, nb, t, cur, selmask, umall, qf, O, m, l, on_w);
    nsa_finish<true>(lo, O, m, l, gate[2], p.nz() + tok * 512 + g * 256 + quad * 4, ybase + tok * 512 + g * 256 + quad * 4, 0.f);
  }
  __syncthreads();
}

DI void phaseC(const Params& p0, int layer, unsigned char* lds, bool probe) {
  const int NITEM = BATCH * 2 * 16;
  for (int it = blockIdx.x; it < NITEM; it += gridDim.x) {
    const Params p = relaunder(p0);
    const int qi5 = it >> 5, qt = qi5 < 8 ? 15 - qi5 : qi5 - 8, bg = it & 31;
    nsa_wave(p, layer, bg >> 1, bg & 1, qt * 128 + (my_tid() >> 6) * 16, lds, probe ? p.dummy() : p.nz());
  }
}

DI void phaseD(const Params& p0, const Slot sl, int layer, unsigned char* lds) {
  const Params p = relaunder(p0);
  bf16_t* gl = (bf16_t*)lds;
  int mt, nt;
  for (int it = 0; tile_order(sl, it, 4, mt, nt); ++it) {
#pragma unroll 1
    for (int which = 0; which < 2; ++which) {
      const bf16_t* Wg = (which ? p.wupb_t() : p.wupa_t()) + ((long)nt * 256) * 512;
      const bf16_t* Yg = (which ? p.nz() : p.sbz()) + (long)mt * 256 * 512;
      const bf16_t* Gg = which ? p.gb() : p.ga();
      int mt2 = mt, nt2 = nt; bool more = true;
      if (which) more = tile_order(sl, it + 1, 4, mt2, nt2);
      const bf16_t* Wn = more ? (which ? p.wupa_t() : p.wupb_t()) + ((long)nt2 * 256) * 512 : Wg;
      const bf16_t* Yn = more ? (which ? p.sbz() : p.nz()) + (long)mt2 * 256 * 512 : Yg;
      f32x4 acc[8][4]; zero_acc(acc);
      gemm_core(Wg, 512, Yg, 512, 512, gl, acc, 64, it > 0 || which, Wn, Yn);
      const int tid = my_tid(), lane = tid & 63, w = tid >> 6, wa = w >> 2, wb = w & 3, qi = lane & 15, quad = lane >> 4;
#pragma unroll
      for (int j = 0; j < 4; ++j) {
        const long tok = (long)mt * 256 + wb * 64 + j * 16 + qi;
#pragma unroll
        for (int i = 0; i < 8; ++i) {
          const long off = tok * 1024 + nt * 256 + wa * 128 + i * 16 + quad * 4;
          const u32x2 xg = *(const u32x2*)(Gg + off);
          const f32x4 v = acc[i][j];
          float o0 = bflo(xg[0]) * v[0], o1 = bfhi(xg[0]) * v[1], o2 = bflo(xg[1]) * v[2], o3 = bfhi(xg[1]) * v[3];
          if (which) { const u32x2 a = *(const u32x2*)(p.merged() + off); o0 += bflo(a[0]); o1 += bfhi(a[0]); o2 += bflo(a[1]); o3 += bfhi(a[1]); }
          *(u32x2*)(p.merged() + off) = (u32x2){pk2(o0, o1), pk2(o2, o3)};
          if ((i & 3) == 3) asm volatile("" ::: "memory");
        }
      }
    }
  }
}

DI void phaseE(const Params& p0, const Slot sl, int layer, unsigned char* lds, const float* xsrc) {
  const Params p = relaunder(p0);
  bf16_t* gl = (bf16_t*)lds;
  int mt, nt;
  for (int it = 0; tile_order(sl, it, 4, mt, nt); ++it) {
    f32x4 acc[8][4]; zero_acc(acc);
    int mt2, nt2;
    const bool more = tile_order(sl, it + 1, 4, mt2, nt2);
    const bf16_t* Wg = p.wout_t() + ((long)nt * 256) * 1024; const bf16_t* Mg = p.merged() + (long)mt * 256 * 1024;
    gemm_core(Wg, 1024, Mg, 1024, 1024, gl, acc, 64, it > 0, more ? p.wout_t() + ((long)nt2 * 256) * 1024 : Wg, more ? p.merged() + (long)mt2 * 256 * 1024 : Mg);
    const int tid = my_tid(), lane = tid & 63, w = tid >> 6, wa = w >> 2, wb = w & 3, qi = lane & 15, quad = lane >> 4;
#pragma unroll
    for (int j = 0; j < 4; ++j) {
      const long tok = (long)mt * 256 + wb * 64 + j * 16 + qi;
      float ss = 0.f;
#pragma unroll
      for (int i = 0; i < 8; ++i) {
        const long off = tok * 1024 + nt * 256 + wa * 128 + i * 16 + quad * 4;
        const f32x4 xo = *(const f32x4*)(xsrc + off);
        const f32x4 xn = xo + acc[i][j];
        *(f32x4*)(p.out + off) = xn;
        *(u32x2*)(p.xb() + off + tok * (LDX - D_MODEL)) = (u32x2){pk2(xn[0], xn[1]), pk2(xn[2], xn[3])};
        ss += xn[0] * xn[0] + xn[1] * xn[1] + xn[2] * xn[2] + xn[3] * xn[3];
      }
      ss += __shfl_xor(ss, 16); ss += __shfl_xor(ss, 32);
      if (quad == 0) p.part()[tok * 16 + nt * 2 + wa] = ss;
    }
  }
}

#ifndef STOP_AFTER
#define STOP_AFTER 0
#endif
constexpr int LDS_BYTES = LDS_GEMM_BYTES + 1024;

__global__ void __launch_bounds__(512) hybrid_megakernel(Params p) {
  extern __shared__ __attribute__((aligned(16))) unsigned char lds[];
  cg::grid_group grid = cg::this_grid();
  __shared__ int s_xcc, s_rank, s_ok;
  __shared__ unsigned s_bar[4];
  if (threadIdx.x == 0) { s_bar[0] = 0u; s_bar[1] = 0u; }
  __syncthreads();
  const XcdBarrier xb = xcd_barrier_post((unsigned*)(p.ws + OFF_BAR), (volatile LAS unsigned*)s_bar);
  if (threadIdx.x == 0) {
    const unsigned xcc = (unsigned)__builtin_amdgcn_s_getreg((3 << 11) | 20) & 7u;
    s_xcc = (int)xcc; s_rank = (int)atomicAdd(p.ctl() + xcc, 1u);
  }
  phase_prologue(p, lds);
  xcd_barrier(xb);
  if (p.ws == nullptr) grid.sync();
  if (threadIdx.x == 0) {
    int ok = 1;
    for (int i = 0; i < 8; ++i) ok &= (__hip_atomic_load(p.ctl() + i, __ATOMIC_RELAXED, __HIP_MEMORY_SCOPE_AGENT) == (gridDim.x >> 3));
    s_ok = ok;
  }
  __syncthreads();
  const Slot sl = {s_ok ? s_xcc : (int)(blockIdx.x & 7), s_ok ? s_rank : (int)(blockIdx.x >> 3)};
  for (int layer = 0; layer < DEPTH; ++layer) {
    if (layer > 0) convert_weights(p, layer, lds, 2);
    if (STOP_AFTER != 0 && STOP_AFTER == layer * 10) return;
    phaseA(p, sl, layer, lds);
    xcd_barrier(xb);
#ifdef PROBE_A
    phaseA(p, sl, layer, lds, PROBE_A >= 2 ? PROBE_A : 0);
    xcd_barrier(xb);
#endif
    if (STOP_AFTER == layer * 10 + 1) return;
#ifdef PROBE_B
    phaseB(p, layer, lds, true);
    xcd_barrier(xb);
#endif
    phaseB(p, layer, lds, false);
    xcd_barrier(xb);
    phaseB2(p, layer, lds);
    xcd_barrier(xb);
    if (STOP_AFTER == layer * 10 + 2) return;
#ifdef PROBE_C
    phaseC(p, layer, lds, true);
    xcd_barrier(xb);
#endif
    phaseC(p, layer, lds, false);
    xcd_barrier(xb);
    if (STOP_AFTER == layer * 10 + 3) return;
    phaseD(p, sl, layer, lds);
    xcd_barrier(xb);
#ifdef PROBE_D
    phaseD(p, sl, layer, lds);
    xcd_barrier(xb);
#endif
    if (STOP_AFTER == layer * 10 + 4) return;
    if (layer == 0) phaseE(p, sl, layer, lds, p.x_in); else phaseE(p, sl, layer, lds, p.out);
    if (layer + 1 < DEPTH) convert_weights(p, layer + 1, lds, 1);
    if (layer + 1 < DEPTH) xcd_barrier(xb);
    if (STOP_AFTER == layer * 10 + 5) return;
  }
}

extern "C" void kernel_launch(void* const* d_in, const int* in_sizes, int n_in, void* d_out, int out_size,
                              void* d_ws, size_t ws_size, hipStream_t stream) {
  static int grid_blocks = 0;
  if (!grid_blocks) {
    int dev = 0, cus = 0, per_cu = 0;
    (void)hipGetDevice(&dev);
    (void)hipDeviceGetAttribute(&cus, hipDeviceAttributeMultiprocessorCount, dev);
    if (hipFuncSetAttribute((const void*)hybrid_megakernel, hipFuncAttributeMaxDynamicSharedMemorySize, LDS_BYTES) != hipSuccess) fprintf(stderr, "hipFuncSetAttribute(max dynamic LDS) failed\n");
    (void)hipOccupancyMaxActiveBlocksPerMultiprocessor(&per_cu, hybrid_megakernel, NTHR, LDS_BYTES);
    (void)hipGetLastError();
    if (per_cu > 1) per_cu = 1;
    if (per_cu < 1) per_cu = 1;
    grid_blocks = (cus * per_cu) & ~7;
  }
  Params a{};
  a.x_in = (const float*)d_in[0]; a.pos = (const int*)d_in[1]; a.norm_g = (const float*)d_in[2]; a.w_in = (const float*)d_in[3];
  a.q_norm_g = (const float*)d_in[4]; a.k_norm_g = (const float*)d_in[5]; a.cmp_pe = (const float*)d_in[6]; a.cmp_w1 = (const float*)d_in[7];
  a.cmp_b1 = (const float*)d_in[8]; a.cmp_w2 = (const float*)d_in[9]; a.w_up_a = (const float*)d_in[10]; a.w_up_b = (const float*)d_in[11];
  a.w_out = (const float*)d_in[12];
  a.out = (float*)d_out; a.ws = (unsigned char*)d_ws;
  if (WS_NEED > ws_size) { fprintf(stderr, "workspace too small: need %zu have %zu\n", (size_t)WS_NEED, ws_size); return; }
  (void)hipMemsetAsync((unsigned char*)d_ws + OFF_CTL, 0, 256, stream);
  (void)hipMemsetAsync((unsigned char*)d_ws + OFF_BAR, 0, 3456 * 4, stream);
  void* args[] = {&a};
  hipError_t e = hipLaunchCooperativeKernel((void*)hybrid_megakernel, dim3(grid_blocks), dim3(NTHR), args, LDS_BYTES, stream);
  if (e != hipSuccess) fprintf(stderr, "cooperative launch failed: %s (grid %d)\n", hipGetErrorString(e), grid_blocks);
}
```

```cpp
#include <hip/hip_runtime.h>
#include <hip/hip_cooperative_groups.h>
#include <cstdio>
#include <cstdint>
namespace cg = cooperative_groups;

typedef unsigned short bf16_t;
typedef short bf16x8 __attribute__((ext_vector_type(8)));
typedef float f32x4 __attribute__((ext_vector_type(4)));
typedef float f32x2 __attribute__((ext_vector_type(2)));
typedef unsigned u32x4 __attribute__((ext_vector_type(4)));
typedef unsigned u32x2 __attribute__((ext_vector_type(2)));
typedef __bf16 bf16x2_t __attribute__((ext_vector_type(2)));

#define DI __device__ __forceinline__
#define MFMA16(a, b, c) __builtin_amdgcn_mfma_f32_16x16x32_bf16((a), (b), (c), 0, 0, 0)

constexpr int D_MODEL = 1024, BATCH = 16, SEQ = 2048, DEPTH = 4, NTOK = BATCH * SEQ;
constexpr int N_IN = 5912, NP = 6144, NT_IN = 24;
constexpr int NTHR = 512;
constexpr int LDX = D_MODEL + 64;
constexpr int NCMP = 127;
constexpr float NORM_EPS = 1e-6f;

DI unsigned pk2(float lo, float hi) { f32x2 v = {lo, hi}; bf16x2_t b = __builtin_convertvector(v, bf16x2_t); return __builtin_bit_cast(unsigned, b); }
DI float bflo(unsigned u) { return __uint_as_float(u << 16); }
DI float bfhi(unsigned u) { return __uint_as_float(u & 0xffff0000u); }
DI float sigmoidf_(float x) { return __builtin_amdgcn_rcpf(1.f + __builtin_amdgcn_exp2f(-1.44269504089f * x)); }
DI float siluf_(float x) { return x * __builtin_amdgcn_rcpf(1.f + __builtin_amdgcn_exp2f(-1.44269504089f * x)); }
DI bf16x8 mk8(u32x4 v) { return __builtin_bit_cast(bf16x8, v); }
DI bf16x8 ld8(const bf16_t* p) { return __builtin_bit_cast(bf16x8, *(const u32x4*)p); }


DI void sincos_acc(float angf, float& sn, float& cs) {
  const double a = (double)angf;
  const double k = rint(a * 0.63661977236758134308);
  const double y = (a - k * 1.57079632679489655800) - k * 6.12323399573676603587e-17;
  const double y2 = y * y;
  const double sp = y * (1.0 + y2 * (-1.0 / 6 + y2 * (1.0 / 120 + y2 * (-1.0 / 5040 + y2 * (1.0 / 362880 + y2 * (-1.0 / 39916800 + y2 * (1.0 / 6227020800.0)))))));
  const double cp = 1.0 + y2 * (-0.5 + y2 * (1.0 / 24 + y2 * (-1.0 / 720 + y2 * (1.0 / 40320 + y2 * (-1.0 / 3628800 + y2 * (1.0 / 479001600.0))))));
  const int q = ((int)k) & 3;
  const double s_ = (q & 1) ? cp : sp, c_ = (q & 1) ? sp : cp;
  sn = (float)((q & 2) ? -s_ : s_);
  cs = (float)(((q + 1) & 2) ? -c_ : c_);
}
DI float inv_freq(int f) { return (float)exp(-(double)f * (9.21034037197618273607 / 32.0)); }

constexpr size_t al256(size_t x) { return (x + 255) & ~(size_t)255; }
constexpr size_t OFF_WT_IN = 0;
constexpr size_t OFF_W1T = OFF_WT_IN + al256((size_t)NP * LDX * 2);
constexpr size_t OFF_W2T = OFF_W1T + al256((size_t)2 * 256 * 2048 * 2);
constexpr size_t OFF_WUPA = OFF_W2T + al256((size_t)2 * 64 * 256 * 2);
constexpr size_t OFF_WUPB = OFF_WUPA + al256((size_t)1024 * 512 * 2);
constexpr size_t OFF_WOUT = OFF_WUPB + al256((size_t)1024 * 512 * 2);
constexpr size_t OFF_B1EFF = OFF_WOUT + al256((size_t)1024 * 1024 * 2);
constexpr size_t OFF_COST = OFF_B1EFF + al256((size_t)DEPTH * 2 * 16 * 256 * 4);
constexpr size_t OFF_SINT = OFF_COST + al256((size_t)NTOK * 32 * 4);
constexpr size_t OFF_COSC = OFF_SINT + al256((size_t)NTOK * 32 * 4);
constexpr size_t OFF_SINC = OFF_COSC + al256((size_t)BATCH * 128 * 32 * 4);
constexpr size_t OFF_XB = OFF_SINC + al256((size_t)BATCH * 128 * 32 * 4);
constexpr size_t OFF_PART = OFF_XB + al256((size_t)NTOK * LDX * 2);
constexpr size_t OFF_SBQ = OFF_PART + al256((size_t)NTOK * 16 * 4);
constexpr size_t OFF_SBK = OFF_SBQ + al256((size_t)NTOK * 512 * 2);
constexpr size_t OFF_SBVT = OFF_SBK + al256((size_t)NTOK * 512 * 2);
constexpr size_t OFF_SBZ = OFF_SBVT + al256((size_t)NTOK * 512 * 2);
constexpr size_t OFF_NQ = OFF_SBZ + al256((size_t)NTOK * 512 * 2);
constexpr size_t OFF_KCR = OFF_NQ + al256((size_t)NTOK * 512 * 2);
constexpr size_t OFF_VCR = OFF_KCR + al256((size_t)NTOK * 128 * 2);
constexpr size_t OFF_KS = OFF_VCR + al256((size_t)NTOK * 128 * 2);
constexpr size_t OFF_VST = OFF_KS + al256((size_t)NTOK * 128 * 2);
constexpr size_t OFF_KW = OFF_VST + al256((size_t)NTOK * 128 * 2);
constexpr size_t OFF_VWT = OFF_KW + al256((size_t)NTOK * 128 * 2);
constexpr size_t OFF_NGATE = OFF_VWT + al256((size_t)NTOK * 128 * 2);
constexpr size_t OFF_NZ = OFF_NGATE + al256((size_t)NTOK * 32 * 4);
constexpr size_t OFF_GA = OFF_NZ + al256((size_t)NTOK * 512 * 2);
constexpr size_t OFF_GB = OFF_GA + al256((size_t)NTOK * 1024 * 2);
constexpr size_t OFF_HID = OFF_GB + al256((size_t)NTOK * 1024 * 2);
constexpr size_t OFF_KC = OFF_HID + al256((size_t)4 * 32 * 256 * 256 * 4);
constexpr size_t OFF_VCT = OFF_KC + al256((size_t)BATCH * 2 * 128 * 64 * 2);
constexpr size_t OFF_QNG = OFF_VCT + al256((size_t)BATCH * 2 * 64 * 128 * 2);
constexpr size_t OFF_KNG = OFF_QNG + al256((size_t)DEPTH * 64 * 4);
constexpr size_t OFF_CTL = OFF_KNG + al256((size_t)DEPTH * 3 * 64 * 4);
constexpr size_t OFF_MFIX_BASE = OFF_CTL + 256;
constexpr size_t OFF_MFIX_OLD = OFF_KNG + al256((size_t)DEPTH * 3 * 64 * 4);
constexpr size_t OFF_MFIX = OFF_MFIX_BASE;
constexpr size_t OFF_DUMMY = OFF_MFIX + 256;
constexpr size_t OFF_BAR = OFF_DUMMY + 256;
constexpr size_t WS_NEED = OFF_BAR + 3456 * 4;

struct Params {
  const float* x_in; const int* pos; const float* norm_g; const float* w_in; const float* q_norm_g; const float* k_norm_g;
  const float* cmp_pe; const float* cmp_w1; const float* cmp_b1; const float* cmp_w2; const float* w_up_a; const float* w_up_b; const float* w_out;
  float* out; unsigned char* ws;
#define WSBUF(T, name, OFF) DI T* name() const { return (T*)(ws + (OFF)); }
  WSBUF(bf16_t, wt_in, OFF_WT_IN) WSBUF(bf16_t, w1t, OFF_W1T) WSBUF(bf16_t, w2t, OFF_W2T) WSBUF(bf16_t, wupa_t, OFF_WUPA) WSBUF(bf16_t, wupb_t, OFF_WUPB) WSBUF(bf16_t, wout_t, OFF_WOUT)
  WSBUF(float, b1eff, OFF_B1EFF) WSBUF(float, cosT, OFF_COST) WSBUF(float, sinT, OFF_SINT) WSBUF(float, cosC, OFF_COSC) WSBUF(float, sinC, OFF_SINC)
  WSBUF(bf16_t, xb, OFF_XB) WSBUF(float, part, OFF_PART) WSBUF(bf16_t, sbq, OFF_SBQ) WSBUF(bf16_t, sbk, OFF_SBK) WSBUF(bf16_t, sbvt, OFF_SBVT) WSBUF(bf16_t, sbz, OFF_SBZ)
  WSBUF(bf16_t, nq, OFF_NQ) WSBUF(bf16_t, kcr, OFF_KCR) WSBUF(bf16_t, vcr, OFF_VCR) WSBUF(bf16_t, ks, OFF_KS) WSBUF(bf16_t, vst, OFF_VST) WSBUF(bf16_t, kw, OFF_KW) WSBUF(bf16_t, vwt, OFF_VWT)
  WSBUF(float, ngate, OFF_NGATE) WSBUF(bf16_t, nz, OFF_NZ) WSBUF(bf16_t, ga, OFF_GA) WSBUF(bf16_t, gb, OFF_GB) WSBUF(float, hpre, OFF_HID) WSBUF(bf16_t, kc, OFF_KC) WSBUF(bf16_t, vct, OFF_VCT)
  WSBUF(bf16_t, merged, OFF_SBK)
  WSBUF(bf16_t, dummy, OFF_XB)     WSBUF(float, mfix, OFF_MFIX) WSBUF(unsigned, ctl, OFF_CTL)
  WSBUF(float, qng, OFF_QNG) WSBUF(float, kng, OFF_KNG)
};

DI int my_tid() { int t = threadIdx.x; asm volatile("" : "+v"(t)); return t; }
DI Params relaunder(const Params& p0) { Params p = p0; size_t z = 0; asm volatile("" : "+s"(z)); p.ws = p0.ws + z; return p; }

constexpr int TILE_B = 32 * 1024;
constexpr int STAGE_B = 2 * TILE_B;
constexpr int LDS_GEMM_BYTES = 2 * STAGE_B;
typedef __attribute__((address_space(3))) unsigned lds_u32;

DI void g_dma(const bf16_t* __restrict__ base, const unsigned (&off)[8], int ko, unsigned char* stage, int w) {
#pragma unroll
  for (int u = 0; u < 8; ++u)
    __builtin_amdgcn_global_load_lds((const unsigned*)(base + (off[u] + ko)), (lds_u32*)(stage + (w * 8 + u) * 1024), 16, 0, 0);
}
#define G_LDA(dst, ih, ks) _Pragma("unroll") for (int i = 0; i < 4; ++i) dst[i] = mk8(*(const u32x4*)(stage + ra + (((ih) * 4 + i) * 2 + (ks)) * 1024))
#define G_LDB(dst, ks) _Pragma("unroll") for (int j = 0; j < 4; ++j) dst[j] = mk8(*(const u32x4*)(stage + TILE_B + rb + (j * 2 + (ks)) * 1024))
#define G_MMA(ih, A, B) do { _Pragma("unroll") for (int i = 0; i < 4; ++i) _Pragma("unroll") for (int j = 0; j < 4; ++j) acc[(ih) * 4 + i][j] = MFMA16(A[i], B[j], acc[(ih) * 4 + i][j]); } while (0)
DI void g_compute(const unsigned char* stage, int ra, int rb, f32x4 (&acc)[8][4]) {
  bf16x8 b0[4], b1[4], a0[4], a1[4];
  G_LDB(b0, 0); G_LDA(a0, 0, 0);
  __builtin_amdgcn_sched_barrier(0);
  G_LDA(a1, 1, 0);
  G_MMA(0, a0, b0);
  __builtin_amdgcn_sched_barrier(0);
  G_LDB(b1, 1); G_LDA(a0, 0, 1);
  G_MMA(1, a1, b0);
  __builtin_amdgcn_sched_barrier(0);
  G_LDA(a1, 1, 1);
  G_MMA(0, a0, b1);
  __builtin_amdgcn_sched_barrier(0);
  G_MMA(1, a1, b1);
  __builtin_amdgcn_sched_barrier(0);
}

DI void gemm_core(const bf16_t* __restrict__ Ag, long lda, const bf16_t* __restrict__ Bg, long ldb, int K,
                  bf16_t* ldsb, f32x4 (&acc)[8][4], int kstep = 64, bool pre = false, const bf16_t* nAg = nullptr, const bf16_t* nBg = nullptr, bool perm = false) {
  unsigned char* lds = (unsigned char*)ldsb;
  const int tid = my_tid(), lane = tid & 63, w = __builtin_amdgcn_readfirstlane(tid >> 6), wa = w >> 2, wb = w & 3, qi = lane & 15, quad = lane >> 4;
  const bf16_t* base = w >= 4 ? Bg : Ag; const int ld = (int)(w >= 4 ? ldb : lda);
  const bf16_t* nbase = nAg ? (w >= 4 ? nBg : nAg) : base;
  unsigned off[8];
#pragma unroll
  for (int u = 0; u < 8; ++u) {
    const int blk = (w & 3) * 8 + u, rg = blk >> 1, kh = blk & 1;
    int R = rg * 16 + (lane >> 2);
    if (perm) { const int rho = R & 31; R = (R & ~31) + ((rho >> 2) & 3) * 8 + (rho >> 4) * 4 + (rho & 3); }
    off[u] = (unsigned)(R * ld + kh * 32 + (lane & 3) * 8);
  }
  const int ra = (wa * 8) * 2 * 1024 + (qi * 4 + quad) * 16, rb = (wb * 4) * 2 * 1024 + (qi * 4 + quad) * 16;
  unsigned char* buf0 = lds; unsigned char* buf1 = lds + STAGE_B;
  const int KT = K >> 6;
  if (!pre) {
    g_dma(base, off, 0, buf0, w);
    asm volatile("s_waitcnt vmcnt(0)" ::: "memory");
    __syncthreads();
  }
  for (int kt = 0; kt < KT; kt += 2) {
    g_dma(base, off, (kt + 1) * kstep, buf1, w);
    g_compute(buf0, ra, rb, acc);
    asm volatile("s_waitcnt vmcnt(0)" ::: "memory");
    __syncthreads();
    const bool last = kt + 2 >= KT;
    g_dma(last ? nbase : base, off, last ? 0 : (kt + 2) * kstep, buf0, w);
    g_compute(buf1, ra, rb, acc);
    asm volatile("s_waitcnt vmcnt(0)" ::: "memory");
    __syncthreads();
  }
}

DI void zero_acc(f32x4 (&acc)[8][4]) {
#pragma unroll
  for (int i = 0; i < 8; ++i)
#pragma unroll
    for (int j = 0; j < 4; ++j) acc[i][j] = (f32x4){0.f, 0.f, 0.f, 0.f};
}

struct Slot { int xcd, slot; };
DI bool tile_order(const Slot sl, int it, int nN, int& mt, int& nt) {
  const int xcd = sl.xcd, slot = sl.slot, SL = gridDim.x >> 3;
  const int q = slot + it * SL, per = 8 * nN;
  if (q >= 2 * per) return false;
  const int mg = q / per, e = q - mg * per;
  nt = e >> 3; mt = xcd * 16 + mg * 8 + (e & 7);
  return true;
}


#define XB_TMO      128
#define XB_XCNT(j)  (256  + 64 * (j))
#define XB_XSUB(j)  (1280 + 64 * (j))
#define XB_XGEN(j)  (2304 + 64 * (j))
#define XB_TOP      3328
#define XB_TOPGEN   3392
#define XCD_BAR_WORDS 3456
#define XB_SPIN_CAP (1u << 21)
#define LAS __attribute__((address_space(3)))
DI unsigned xb_ld(unsigned* p)              { return __hip_atomic_load(p, __ATOMIC_RELAXED, __HIP_MEMORY_SCOPE_AGENT); }
DI unsigned xb_add(unsigned* p, unsigned v) { return __hip_atomic_fetch_add(p, v, __ATOMIC_RELAXED, __HIP_MEMORY_SCOPE_AGENT); }
DI unsigned xb_xcc_id() { return (unsigned)__builtin_amdgcn_s_getreg((3 << 11) | 20) & 0xFu; }
#define XB_SPIN(cond, bar) do { unsigned _sp = 0; while (cond) { __builtin_amdgcn_s_sleep(1); \
    if ((++_sp & 255u) == 0u) { if (xb_ld(&(bar)[XB_TMO])) break; if (_sp > XB_SPIN_CAP) { atomicAdd(&(bar)[XB_TMO], 1u); break; } } } } while (0)
struct XcdBarrier { unsigned* bar; unsigned x; volatile LAS unsigned* st; };
DI XcdBarrier xcd_barrier_post(unsigned* bar, volatile LAS unsigned* st) {
  XcdBarrier b; b.bar = bar; b.x = xb_xcc_id(); b.st = st;
  if (threadIdx.x == 0) (void)xb_add(&bar[XB_XCNT(b.x)], 1u);
  return b;
}
DI void xcd_barrier_complete(unsigned* bar, unsigned x, unsigned& nloc, unsigned& nx) {
  const unsigned G = gridDim.x * gridDim.y * gridDim.z;
  unsigned sum, cnt, mine, sp = 0u;
  for (;;) {
    sum = 0u; cnt = 0u; mine = 0u;
#pragma unroll
    for (unsigned j = 0; j < 16; ++j) { const unsigned c = xb_ld(&bar[XB_XCNT(j)]); sum += c; cnt += (c > 0u) ? 1u : 0u; mine = (j == x) ? c : mine; }
    if (sum == G) break;
    __builtin_amdgcn_s_sleep(1);
    if ((++sp & 255u) == 0u) { if (xb_ld(&bar[XB_TMO])) break; if (sp > XB_SPIN_CAP) { atomicAdd(&bar[XB_TMO], 1u); break; } }
  }
  nloc = mine > 0u ? mine : 1u; nx = cnt > 0u ? cnt : 1u;
}
DI void xcd_barrier(const XcdBarrier& b) {
  asm volatile("s_waitcnt vmcnt(0)" ::: "memory");
  __syncthreads();
  if (threadIdx.x == 0) {
    unsigned* bar = b.bar;
    __builtin_amdgcn_s_waitcnt(0);
    unsigned nloc = b.st[0], nx = b.st[1];
    if (nloc == 0u) { xcd_barrier_complete(bar, b.x, nloc, nx); b.st[0] = nloc; b.st[1] = nx; }
    const unsigned old = xb_add(&bar[XB_XSUB(b.x)], 1u);
    const unsigned gen = old / nloc;
    if (old + 1u == (gen + 1u) * nloc) {
      __builtin_amdgcn_fence(__ATOMIC_RELEASE, "agent");
      asm volatile("s_waitcnt vmcnt(0)" ::: "memory");
      const unsigned og = xb_add(&bar[XB_TOP], 1u);
      const unsigned tg = og / nx;
      if (og + 1u == (tg + 1u) * nx) xb_add(&bar[XB_TOPGEN], 1u);
      else XB_SPIN(xb_ld(&bar[XB_TOPGEN]) == tg, bar);
      __builtin_amdgcn_fence(__ATOMIC_ACQUIRE, "agent");
      xb_add(&bar[XB_XGEN(b.x)], 1u);
      asm volatile("s_waitcnt vmcnt(0)" ::: "memory");
    } else {
      XB_SPIN(xb_ld(&bar[XB_XGEN(b.x)]) == gen, bar);
      __builtin_amdgcn_fence(__ATOMIC_ACQUIRE, "agent");
      asm volatile("s_waitcnt vmcnt(0)" ::: "memory");
    }
  }
  __syncthreads();
}

DI int inmap(int c) {
  if (c < 1024) return c;
  if (c < 1536) return c + 512;
  if (c < 2048) return c + 512;
  if (c < 2304) return c + 512;
  if (c < 2432) return c + 512;
  if (c < 2560) return c + 640;
  if (c < 3072) return c + 792;
  if (c < 4096) return c + 792;
  if (c < 5120) return c + 792;
  if (c < 5376) return c < 5144 ? c - 1792 : -1;
  if (c < 5888) return c - 4352;
  if (c < 6016) return c - 2944;
  return c - 2816;
}

DI void tr_tile(const float* __restrict__ src, int ld, int K, int k0, int n0, bool use_map, const float* __restrict__ scale, bf16_t* __restrict__ dst, int ldd, float* tile) {
  const int tid = my_tid();
  {
    const int nl = tid & 63, kk = tid >> 6;
    int n = n0 + nl; asm volatile("" : "+v"(n));
    const int sc = use_map ? inmap(n) : n;
#pragma unroll
    for (int r = 0; r < 8; ++r) {
      const int k = k0 + r * 8 + kk;
      float v = 0.f;
      if (sc >= 0) { v = src[(long)k * ld + sc]; if (scale) v *= scale[k]; }
      tile[(r * 8 + kk) * 65 + nl] = v;
    }
  }
  __syncthreads();
  {
    const int nl = tid >> 3, ks = tid & 7;
    unsigned o[4];
#pragma unroll
    for (int e = 0; e < 4; ++e) o[e] = pk2(tile[(ks * 8 + 2 * e) * 65 + nl], tile[(ks * 8 + 2 * e + 1) * 65 + nl]);
    *(u32x4*)(dst + (long)(n0 + nl) * ldd + k0 + ks * 8) = (u32x4){o[0], o[1], o[2], o[3]};
  }
  __syncthreads();
}

DI void tr_job(const float* src, int ld, int K, int N, bool use_map, const float* scale, bf16_t* dst, int ldd, float* tile) {
  const int nk = K >> 6, nn = N >> 6;
  for (int t = blockIdx.x; t < nk * nn; t += gridDim.x) tr_tile(src, ld, K, (t % nk) * 64, (t / nk) * 64, use_map, scale, dst, ldd, tile);
}

DI void convert_weights(const Params& p0, int l, unsigned char* lds, int which) {
  const Params p = relaunder(p0);
  float* tile = (float*)lds;
  if (which & 1) {
    tr_job(p.w_in + (long)l * D_MODEL * N_IN, N_IN, D_MODEL, NP, true, p.norm_g + l * D_MODEL, p.wt_in(), LDX, tile);
    for (int kv = 0; kv < 2; ++kv) {
      tr_job(p.cmp_w1 + (long)(l * 2 + kv) * 2048 * 256, 256, 2048, 256, false, nullptr, p.w1t() + (long)kv * 256 * 2048, 2048, tile);
      tr_job(p.cmp_w2 + (long)(l * 2 + kv) * 256 * 64, 64, 256, 64, false, nullptr, p.w2t() + (long)kv * 64 * 256, 256, tile);
    }
    tr_job(p.w_up_a + (long)l * 512 * 1024, 1024, 512, 1024, false, nullptr, p.wupa_t(), 512, tile);
    tr_job(p.w_up_b + (long)l * 512 * 1024, 1024, 512, 1024, false, nullptr, p.wupb_t(), 512, tile);
  }
  if (which & 2) tr_job(p.w_out + (long)l * 1024 * 1024, 1024, 1024, 1024, false, nullptr, p.wout_t(), 1024, tile);
}

DI void phase_prologue(const Params& p, unsigned char* lds) {
  const int tid = my_tid();
  convert_weights(p, 0, lds, 3);
  {
    const int lane = tid & 63;
    for (int wi = blockIdx.x * 8 + (tid >> 6); wi < DEPTH * 2 * 16 * 4; wi += gridDim.x * 8) {
      const int jq = wi & 3, kq = (wi >> 2) & 15, it = wi >> 6;
      const float* w1 = p.cmp_w1 + (long)it * 2048 * 256 + (long)kq * 128 * 256 + jq * 64 + lane; const float* pe = p.cmp_pe + (long)it * 2048 + kq * 128;
      float s0 = kq == 0 ? p.cmp_b1[it * 256 + jq * 64 + lane] : 0.f, s1 = 0.f, s2 = 0.f, s3 = 0.f;
#pragma unroll 4
      for (int k = 0; k < 128; k += 4) {
        s0 += pe[k] * w1[(long)k * 256]; s1 += pe[k + 1] * w1[(long)(k + 1) * 256]; s2 += pe[k + 2] * w1[(long)(k + 2) * 256]; s3 += pe[k + 3] * w1[(long)(k + 3) * 256];
      }
      p.b1eff()[(it * 16 + kq) * 256 + jq * 64 + lane] = (s0 + s1) + (s2 + s3);
    }
  }
  if (blockIdx.x == 1 && tid < DEPTH * 3) {
    const int l = tid / 3, br = tid % 3;
    float mq = 0.f, mk = 0.f;
    for (int d = 0; d < 64; ++d) { mq = fmaxf(mq, fabsf(p.q_norm_g[l * 64 + d])); mk = fmaxf(mk, fabsf(p.k_norm_g[(l * 3 + br) * 64 + d])); }
    p.mfix()[l * 4 + br] = 8.f * 1.44269504089f * mq * mk * 1.02f + 0.25f;
  }
  if (blockIdx.x == 0) { for (int i = tid; i < DEPTH * 64; i += NTHR) p.qng()[i] = p.q_norm_g[i]; for (int i = tid; i < DEPTH * 192; i += NTHR) p.kng()[i] = p.k_norm_g[i]; }
  const long gtid = (long)blockIdx.x * NTHR + tid, gn = (long)gridDim.x * NTHR;
  for (long i = gtid; i < (long)NTOK * 32; i += gn) {
    const int f = (int)(i & 31); const long tok = i >> 5;
    const float ang = (float)p.pos[tok] * inv_freq(f);
    float sn, cs; sincos_acc(ang, sn, cs);
    p.cosT()[i] = cs; p.sinT()[i] = sn;
  }
  for (long i = gtid; i < (long)BATCH * 128 * 32; i += gn) {
    const int f = (int)(i & 31); const int c = (int)((i >> 5) & 127); const int b = (int)(i >> 12);
    float cs = 1.f, sn = 0.f;
    if (c < NCMP) {
      float sum = 0.f;
      for (int k = 0; k < 32; ++k) sum += (float)p.pos[b * SEQ + c * 16 + k];
      const float ang = (sum * (1.f / 32.f)) * inv_freq(f);
      sincos_acc(ang, sn, cs);
    }
    p.cosC()[i] = cs; p.sinC()[i] = sn;
  }
  const int lane = tid & 63;
  for (long row = (long)blockIdx.x * 8 + (tid >> 6); row < NTOK; row += (long)gridDim.x * 8) {
    const float* xr = p.x_in + row * D_MODEL; bf16_t* xo = p.xb() + row * LDX;
    float ss = 0.f;
#pragma unroll
    for (int u = 0; u < 4; ++u) {
      const f32x4 v = *(const f32x4*)(xr + u * 256 + lane * 4);
      ss += v[0] * v[0] + v[1] * v[1] + v[2] * v[2] + v[3] * v[3];
      *(u32x2*)(xo + u * 256 + lane * 4) = (u32x2){pk2(v[0], v[1]), pk2(v[2], v[3])};
    }
#pragma unroll
    for (int o = 32; o >= 1; o >>= 1) ss += __shfl_xor(ss, o);
    if (lane < 8) p.part()[row * 16 + lane] = lane == 0 ? ss : 0.f;
  }
}

DI void phaseA_epilogue(const Params& p, int layer, int mt, int nt, const f32x4 (&acc)[8][4], const float* rs_s) {
  const int tid = my_tid(), lane = tid & 63, w = tid >> 6, wa = w >> 2, wb = w & 3, qi = lane & 15, quad = lane >> 4;
  if (nt >= 21) {
    bf16_t* dstb; int nh, head;
    if (nt < 23) { dstb = p.sbvt(); nh = 8; head = (nt - 21) * 4 + wb; } else if (wb < 2) { dstb = p.vst(); nh = 2; head = wb; } else { dstb = p.vwt(); nh = 2; head = wb - 2; }
    const int tok0 = mt * 256, b = tok0 >> 11;
#pragma unroll
    for (int ip = 0; ip < 4; ++ip) {
      const int tl = wa * 128 + ip * 32 + quad * 8;
      const f32x4 ra = *(const f32x4*)(rs_s + tl), rb2 = *(const f32x4*)(rs_s + tl + 4);
      const int sq = (tok0 & 2047) + tl;
#pragma unroll
      for (int j = 0; j < 4; ++j) {
        const int d = (j >> 1) * 32 + (qi >> 2) * 8 + (j & 1) * 4 + (qi & 3);
        const f32x4 v0 = acc[2 * ip][j] * ra, v1 = acc[2 * ip + 1][j] * rb2;
        bf16_t* dst = dstb + (long)(b * nh + head) * 64 * SEQ + (long)(sq >> 5) * 2048 + d * 32 + (sq & 31);
        *(u32x4*)dst = (u32x4){pk2(v0[0], v0[1]), pk2(v0[2], v0[3]), pk2(v1[0], v1[1]), pk2(v1[2], v1[3])};
      }
    }
    return;
  }
  const bool headtype = nt < 4 || (nt >= 6 && nt < 10);
#pragma unroll
  for (int j = 0; j < 4; ++j) {
    const int tl = wb * 64 + (j >> 1) * 32 + (qi >> 2) * 8 + (j & 1) * 4 + (qi & 3); const long tok = (long)mt * 256 + tl; const int b = (int)(tok >> 11), sq = (int)(tok & 2047);
    const float rs = rs_s[tl];
    if (headtype) {
#pragma unroll
      for (int ih = 0; ih < 2; ++ih) {
        const int hit = wa * 2 + ih;
        f32x4 v[4];
#pragma unroll
        for (int i = 0; i < 4; ++i) v[i] = acc[ih * 4 + i][j] * rs;
        bf16_t* dstb; int nh, head; const float* g = nullptr;
        if (nt < 2) { dstb = p.sbq(); nh = 8; head = nt * 4 + hit; }
        else if (nt < 4) { dstb = p.sbk(); nh = 8; head = (nt - 2) * 4 + hit; }
        else if (nt < 8) { dstb = p.nq(); nh = 8; head = (nt - 6) * 4 + hit; g = p.qng() + layer * 64; }
        else if (nt == 8) { dstb = hit < 2 ? p.kcr() : p.vcr(); nh = 2; head = hit & 1; }
        else { dstb = hit < 2 ? p.ks() : p.kw(); nh = 2; head = hit & 1; g = p.kng() + (layer * 3 + (hit < 2 ? 1 : 2)) * 64; }
        if (g) {
          float ss = 0.f;
#pragma unroll
          for (int i = 0; i < 4; ++i) ss += v[i][0] * v[i][0] + v[i][1] * v[i][1] + v[i][2] * v[i][2] + v[i][3] * v[i][3];
          ss += __shfl_xor(ss, 16); ss += __shfl_xor(ss, 32);
          const float rn = rsqrtf(ss * (1.f / 64.f) + NORM_EPS);
#pragma unroll
          for (int i = 0; i < 4; ++i) { const f32x4 gg = *(const f32x4*)(g + (i >> 1) * 32 + quad * 8 + (i & 1) * 4); v[i] = v[i] * rn * gg; }
#pragma unroll
          for (int i = 0; i < 2; ++i) {
            const f32x4 cs = *(const f32x4*)(p.cosT() + tok * 32 + quad * 8 + i * 4), sn = *(const f32x4*)(p.sinT() + tok * 32 + quad * 8 + i * 4);
            const f32x4 x1 = v[i], x2 = v[i + 2];
            v[i] = x1 * cs - x2 * sn; v[i + 2] = x2 * cs + x1 * sn;
          }
        }
        bf16_t* dst = dstb + ((long)(b * nh + head) * SEQ + sq) * 64 + quad * 8;
#pragma unroll
        for (int ip = 0; ip < 2; ++ip)
          *(u32x4*)(dst + ip * 32) = (u32x4){pk2(v[2 * ip][0], v[2 * ip][1]), pk2(v[2 * ip][2], v[2 * ip][3]), pk2(v[2 * ip + 1][0], v[2 * ip + 1][1]), pk2(v[2 * ip + 1][2], v[2 * ip + 1][3])};
        asm volatile("" ::: "memory");
      }
    } else if (nt == 20) {
      if (wa == 0 && quad < 3) {
#pragma unroll
        for (int i = 0; i < 2; ++i) {
          const f32x4 v = acc[i][j] * rs;
          const f32x4 o = {sigmoidf_(v[0]), sigmoidf_(v[1]), sigmoidf_(v[2]), sigmoidf_(v[3])};
          *(f32x4*)(p.ngate() + tok * 32 + quad * 8 + i * 4) = o;
        }
      }
    } else {
      bf16_t* dstb; int ldd, c0; bool sil;
      if (nt < 6) { dstb = p.sbz(); ldd = 512; c0 = (nt - 4) * 256; sil = true; }
      else if (nt < 12) { dstb = p.nz(); ldd = 512; c0 = (nt - 10) * 256; sil = true; }
      else if (nt < 16) { dstb = p.ga(); ldd = 1024; c0 = (nt - 12) * 256; sil = false; }
      else { dstb = p.gb(); ldd = 1024; c0 = (nt - 16) * 256; sil = false; }
      bf16_t* dst = dstb + tok * ldd + c0 + wa * 128 + quad * 8;
#pragma unroll
      for (int ip = 0; ip < 4; ++ip) {
        const f32x4 v0 = acc[2 * ip][j] * rs, v1 = acc[2 * ip + 1][j] * rs;
        f32x4 o0, o1;
#pragma unroll
        for (int r = 0; r < 4; ++r) { o0[r] = sil ? siluf_(v0[r]) : sigmoidf_(v0[r]); o1[r] = sil ? siluf_(v1[r]) : sigmoidf_(v1[r]); }
        *(u32x4*)(dst + ip * 32) = (u32x4){pk2(o0[0], o0[1]), pk2(o0[2], o0[3]), pk2(o1[0], o1[1]), pk2(o1[2], o1[3])};
      }
    }
    asm volatile("" ::: "memory");
  }
}

DI void phaseA(const Params& p0, const Slot sl, int layer, unsigned char* lds, int fake = 0) {
  const Params p = relaunder(p0);
  bf16_t* gl = (bf16_t*)lds; float* rs_s = (float*)(lds + LDS_GEMM_BYTES);
  const bf16_t* Wt = p.wt_in();
  int mt, nt;
  for (int it = 0; tile_order(sl, it, NT_IN, mt, nt); ++it) {
    if (my_tid() < 256) {
      const float* pp = p.part() + ((long)mt * 256 + my_tid()) * 16;
      const f32x4 v0 = *(const f32x4*)pp, v1 = *(const f32x4*)(pp + 4);
      const float s = ((v0[0] + v0[1]) + (v0[2] + v0[3])) + ((v1[0] + v1[1]) + (v1[2] + v1[3]));
      rs_s[my_tid()] = rsqrtf(s * (1.f / 1024.f) + NORM_EPS);
    }
    const int mtl = fake == 3 ? 0 : (fake == 4 ? sl.xcd * 16 + (sl.slot & 7) : mt), ntl = fake == 3 ? 0 : (fake == 4 ? (sl.slot >> 3) : nt);
    const bf16_t* Xg = p.xb() + (long)mtl * 256 * LDX; const bf16_t* Wg = Wt + (long)ntl * 256 * LDX;
    f32x4 acc[8][4]; zero_acc(acc);
    const int kstep = (fake == 1 || fake == 2) ? 0 : 64;
    int mt2, nt2;
    const bool more = !fake && tile_order(sl, it + 1, NT_IN, mt2, nt2);
    const bf16_t* Xn = more ? p.xb() + (long)mt2 * 256 * LDX : Xg; const bf16_t* Wn = more ? Wt + (long)nt2 * 256 * LDX : Wg;
    const bool vn = more ? nt2 >= 21 : nt >= 21;
    gemm_core(nt >= 21 ? Xg : Wg, LDX, nt >= 21 ? Wg : Xg, LDX, D_MODEL, gl, acc, kstep, !fake && it > 0, vn ? Xn : Wn, vn ? Wn : Xn, true);
    if (!fake) phaseA_epilogue(p, layer, mt, nt, acc, rs_s);
    else if (acc[0][0][0] == 123.456f && acc[7][3][3] == 5.f) p.dummy()[0] = 1;
    __syncthreads();
  }
}

DI void compress_partial(const Params& p, int ci, unsigned char* lds) {
  bf16_t* gl = (bf16_t*)lds;
  const int split = ci & 3, item = ci >> 2, kv = item & 1, pair = item >> 1;
  const bf16_t* src = (kv ? p.vcr() : p.kcr()) + (long)pair * 256 * 1024 + split * 512;
  const bf16_t* W1 = p.w1t() + (long)kv * 256 * 2048 + split * 512;
  f32x4 acc[8][4]; zero_acc(acc);
  gemm_core(W1, 2048, src, 1024, 512, gl, acc);
  const int tid = my_tid(), lane = tid & 63, w = tid >> 6, wa = w >> 2, wb = w & 3, qi = lane & 15, quad = lane >> 4;
  float* dst = p.hpre() + ((long)(split * 32 + item) * 256) * 256;
#pragma unroll
  for (int i = 0; i < 8; ++i)
#pragma unroll
    for (int j = 0; j < 4; ++j) *(f32x4*)(dst + (long)(wb * 64 + j * 16 + qi) * 256 + wa * 128 + i * 16 + quad * 4) = acc[i][j];
}

DI void phaseB2(const Params& p0, int layer, unsigned char* lds) {
  const Params p = relaunder(p0);
  const int tid = my_tid(), lane = tid & 63, w = tid >> 6, qi = lane & 15, quad = lane >> 4;
  float* bias_s = (float*)lds;
  {
    const float* b1 = p.b1eff() + (long)(layer * 2 + (tid >> 8)) * 16 * 256 + (tid & 255);
    float sacc = 0.f;
#pragma unroll
    for (int kq = 0; kq < 16; ++kq) sacc += b1[kq * 256];
    bias_s[tid] = sacc;
  }
  __syncthreads();
  if (w < 2)
  for (int wi = blockIdx.x * 2 + w; wi < 32 * 16; wi += gridDim.x * 2) {
    const int item = wi >> 4, r16 = wi & 15, kv = item & 1, pair = item >> 1;
    const int row = r16 * 16 + qi;
    const bf16_t* W2 = p.w2t() + (long)kv * 64 * 256;
    const float* hp = p.hpre() + ((long)item * 256 + row) * 256 + quad * 8;
    f32x4 o[4];
#pragma unroll
    for (int dt = 0; dt < 4; ++dt) o[dt] = (f32x4){0.f, 0.f, 0.f, 0.f};
#pragma unroll 2
    for (int ksx = 0; ksx < 8; ++ksx) {
      f32x4 h0 = *(const f32x4*)(bias_s + kv * 256 + ksx * 32 + quad * 8), h1 = *(const f32x4*)(bias_s + kv * 256 + ksx * 32 + quad * 8 + 4);
#pragma unroll
      for (int sp = 0; sp < 4; ++sp) { const float* q = hp + (long)sp * 32 * 256 * 256 + ksx * 32; h0 += *(const f32x4*)q; h1 += *(const f32x4*)(q + 4); }
      const bf16x8 hf = mk8((u32x4){pk2(siluf_(h0[0]), siluf_(h0[1])), pk2(siluf_(h0[2]), siluf_(h0[3])), pk2(siluf_(h1[0]), siluf_(h1[1])), pk2(siluf_(h1[2]), siluf_(h1[3]))});
#pragma unroll
      for (int dt = 0; dt < 4; ++dt) {
        const bf16x8 wf = ld8(W2 + (long)(dt * 16 + qi) * 256 + ksx * 32 + quad * 8);
        o[dt] = kv ? MFMA16(hf, wf, o[dt]) : MFMA16(wf, hf, o[dt]);
      }
    }
    const int bg = pair * 2 + (r16 >> 3);
    if (kv == 0) {
      const float* g = p.kng() + (layer * 3 + 0) * 64;
      const int b = bg >> 1, c = (r16 & 7) * 16 + qi;
      float ss = 0.f;
#pragma unroll
      for (int dt = 0; dt < 4; ++dt) ss += o[dt][0] * o[dt][0] + o[dt][1] * o[dt][1] + o[dt][2] * o[dt][2] + o[dt][3] * o[dt][3];
      ss += __shfl_xor(ss, 16); ss += __shfl_xor(ss, 32);
      const float rn = rsqrtf(ss * (1.f / 64.f) + NORM_EPS);
#pragma unroll
      for (int dt = 0; dt < 4; ++dt) { const f32x4 gg = *(const f32x4*)(g + dt * 16 + quad * 4); o[dt] = o[dt] * rn * gg; }
#pragma unroll
      for (int dt = 0; dt < 2; ++dt) {
        const long ti = ((long)b * 128 + c) * 32 + dt * 16 + quad * 4;
        const f32x4 cs = *(const f32x4*)(p.cosC() + ti), sn = *(const f32x4*)(p.sinC() + ti);
        const f32x4 x1 = o[dt], x2 = o[dt + 2];
        o[dt] = x1 * cs - x2 * sn; o[dt + 2] = x2 * cs + x1 * sn;
      }
      bf16_t* dst = p.kc() + ((long)bg * 128 + c) * 64 + quad * 4;
#pragma unroll
      for (int dt = 0; dt < 4; ++dt) {
        u32x2 ov = (u32x2){pk2(o[dt][0], o[dt][1]), pk2(o[dt][2], o[dt][3])};
        if (c >= NCMP) ov = (u32x2){0u, 0u};
        *(u32x2*)(dst + dt * 16) = ov;
      }
    } else {
#pragma unroll
      for (int dt = 0; dt < 4; ++dt) {
        const int c0 = (r16 & 7) * 16 + quad * 4;
        f32x4 v = o[dt];
        if (c0 + 3 >= NCMP) v[3] = 0.f;
        *(u32x2*)(p.vct() + ((long)bg * 64 + dt * 16 + qi) * 128 + c0) = (u32x2){pk2(v[0], v[1]), pk2(v[2], v[3])};
      }
    }
  }
  __syncthreads();
}

struct SbFrag { bf16x8 k[2][2]; bf16x8 v[4]; };
DI void sb_load(SbFrag& f, const bf16_t* __restrict__ kp0, const bf16_t* __restrict__ vp0, int kb) {
#pragma unroll
  for (int a = 0; a < 2; ++a) { f.k[a][0] = ld8(kp0 + (long)(kb + 4 * a) * 64); f.k[a][1] = ld8(kp0 + (long)(kb + 4 * a) * 64 + 32); }
#pragma unroll
  for (int dt = 0; dt < 4; ++dt) f.v[dt] = ld8(vp0 + (long)kb * 64 + dt * 16 * 32);
}
template <bool FULL>
DI void sb_chunk(const SbFrag& f, int kb, int t, int quad, const bf16x8 (&qf)[2], f32x4 (&o)[4], float& carry) {
  f32x4 s[2];
#pragma unroll
  for (int a = 0; a < 2; ++a) {
    s[a] = MFMA16(f.k[a][0], qf[0], ((f32x4){0.f, 0.f, 0.f, 0.f}));
    s[a] = MFMA16(f.k[a][1], qf[1], s[a]);
  }
  float beta[8], om[8];
  float prod = 1.f;
#pragma unroll
  for (int idx = 0; idx < 8; ++idx) {
    const float z2 = fminf(s[idx >> 2][idx & 3] * (0.125f * 1.44269504089f), 60.f);
    const float e = __builtin_amdgcn_exp2f(z2);
    const float r = __builtin_amdgcn_rcpf(1.f + e);
    const bool val = FULL ? true : (kb + 8 * quad + idx < t);
    om[idx] = val ? r : 1.f;
    beta[idx] = val ? e * r : 0.f;
    prod *= om[idx];
  }
  const float a1 = __shfl_xor(prod, 16), a2 = __shfl_xor(prod, 32), a3 = __shfl_xor(a1, 32);
  const float higher = ((quad ^ 1) > quad ? a1 : 1.f) * ((quad ^ 2) > quad ? a2 : 1.f) * ((quad ^ 3) > quad ? a3 : 1.f);
  float q = __builtin_amdgcn_exp2f(carry) * higher;
  float wv[8];
#pragma unroll
  for (int idx = 7; idx >= 0; --idx) { wv[idx] = beta[idx] * q; q *= om[idx]; }
  carry += __builtin_amdgcn_logf((prod * a1) * (a2 * a3));
  const bf16x8 pf = mk8((u32x4){pk2(wv[0], wv[1]), pk2(wv[2], wv[3]), pk2(wv[4], wv[5]), pk2(wv[6], wv[7])});
#pragma unroll
  for (int dt = 0; dt < 4; ++dt) o[dt] = MFMA16(f.v[dt], pf, o[dt]);
}

DI void sb_attn_wave(const Params& p, int b, int h, int t0, bf16_t* ybase) {
  const int lane = my_tid() & 63, qi = lane & 15, quad = lane >> 4;
  const bf16_t* Q = p.sbq() + (long)(b * 8 + h) * SEQ * 64;
  const bf16_t* K = p.sbk() + (long)(b * 8 + h) * SEQ * 64;
  const bf16_t* Vt = p.sbvt() + (long)(b * 8 + h) * 64 * SEQ;
  const int tA = t0 + qi, tB = t0 + 16 + qi;
  bf16x8 qa[2], qb[2];
  qa[0] = ld8(Q + (long)tA * 64 + quad * 8); qa[1] = ld8(Q + (long)tA * 64 + 32 + quad * 8);
  qb[0] = ld8(Q + (long)tB * 64 + quad * 8); qb[1] = ld8(Q + (long)tB * 64 + 32 + quad * 8);
  f32x4 oa[4], ob[4];
#pragma unroll
  for (int dt = 0; dt < 4; ++dt) { oa[dt] = (f32x4){0.f, 0.f, 0.f, 0.f}; ob[dt] = oa[dt]; }
  float ca = 0.f, cb = 0.f;
  const int krow = 8 * (qi >> 2) + (qi & 3);
  const bf16_t* kp0 = K + (long)krow * 64 + quad * 8;
  const bf16_t* vp0 = Vt + qi * 32 + 8 * quad;
  int kb = t0;
  SbFrag f0, f1, f2;
  sb_load(f0, kp0, vp0, kb); sb_load(f1, kp0, vp0, max(kb - 32, 0));
#define SB_STEP(F, KB) (((KB) + 32 <= t0) ? (sb_chunk<true>(F, KB, tA, quad, qa, oa, ca), sb_chunk<true>(F, KB, tB, quad, qb, ob, cb)) : (sb_chunk<false>(F, KB, tA, quad, qa, oa, ca), sb_chunk<false>(F, KB, tB, quad, qb, ob, cb)), __all(ca < -160.f && cb < -160.f))
  while (true) {
    sb_load(f2, kp0, vp0, max(kb - 64, 0));
    if (SB_STEP(f0, kb) || kb < 32) break;
    sb_load(f0, kp0, vp0, max(kb - 96, 0));
    if (SB_STEP(f1, kb - 32) || kb < 64) break;
    sb_load(f1, kp0, vp0, max(kb - 128, 0));
    if (SB_STEP(f2, kb - 64) || kb < 96) break;
    kb -= 96;
  }
#undef SB_STEP
#pragma unroll
  for (int half = 0; half < 2; ++half) {
    const long zo = ((long)b * SEQ + (half ? tB : tA)) * 512 + h * 64 + quad * 4;
    const bf16_t* zp = p.sbz() + zo; bf16_t* yp = ybase + zo;
#pragma unroll
    for (int dt = 0; dt < 4; ++dt) {
      const f32x4 o = half ? ob[dt] : oa[dt];
      const u32x2 zz = *(const u32x2*)(zp + dt * 16);
      *(u32x2*)(yp + dt * 16) = (u32x2){pk2(o[0] * bflo(zz[0]), o[1] * bfhi(zz[0])), pk2(o[2] * bflo(zz[1]), o[3] * bfhi(zz[1]))};
    }
  }
}

DI void phaseB(const Params& p0, int layer, unsigned char* lds, bool probe) {
  const int NITEM = 128 + BATCH * 8 * 8;
  for (int it = blockIdx.x; it < NITEM; it += gridDim.x) {
    const Params p = relaunder(p0);
    if (it < 128) { compress_partial(p, it, lds); continue; }
    const int i = it - 128, qt = 7 - (i >> 7), bh = i & 127;
    sb_attn_wave(p, bh >> 3, bh & 7, qt * 256 + (my_tid() >> 6) * 32, probe ? p.dummy() : p.sbz());
  }
}

constexpr int NSA_LO_BYTES = 8 * 8192;
constexpr int NSA_KROW = 144, NSA_VROW = 80;
constexpr int NSA_SLOT = 32 * NSA_KROW + 64 * NSA_VROW;
constexpr int NSA_SLOT0 = NSA_LO_BYTES, NSA_BLIST = NSA_SLOT0 + 2 * NSA_SLOT, NSA_UMW = NSA_BLIST + 64 * 4;

struct KVFrag { bf16x8 k[2][2]; bf16x8 v[4]; };
DI void nsa_ldsfrag(KVFrag& f, const unsigned char* slot, int qi, int quad) {
  const int krow = 8 * (qi >> 2) + (qi & 3);
#pragma unroll
  for (int a = 0; a < 2; ++a) { const unsigned char* kp = slot + (krow + 4 * a) * NSA_KROW + quad * 16; f.k[a][0] = mk8(*(const u32x4*)kp); f.k[a][1] = mk8(*(const u32x4*)(kp + 64)); }
#pragma unroll
  for (int dt = 0; dt < 4; ++dt) f.v[dt] = mk8(*(const u32x4*)(slot + 32 * NSA_KROW + (dt * 16 + qi) * NSA_VROW + quad * 16));
}
template <int MODE>
DI void nsa_chunk(const KVFrag& f, int kb, int t, bool selbit, const bf16x8 (&qf)[4][2], f32x4 (&O)[4][4], float (&m)[4], float (&l)[4], int quad, bool online) {
  const float SC = 0.125f * 1.44269504089f;
  bool val[8];
#pragma unroll
  for (int idx = 0; idx < 8; ++idx) {
    const int key = kb + 8 * quad + idx;
    val[idx] = MODE == 0 ? (selbit && key <= t) : (key <= t && key > t - 512);
  }
#pragma unroll
  for (int hh = 0; hh < 4; ++hh) {
    f32x4 s[2];
#pragma unroll
    for (int a = 0; a < 2; ++a) { s[a] = MFMA16(f.k[a][0], qf[hh][0], ((f32x4){0.f, 0.f, 0.f, 0.f})); s[a] = MFMA16(f.k[a][1], qf[hh][1], s[a]); }
    float mn = m[hh];
    if (online) {
      float cm = -1e30f;
#pragma unroll
      for (int idx = 0; idx < 8; ++idx) if (val[idx]) cm = fmaxf(cm, s[idx >> 2][idx & 3] * SC);
      cm = fmaxf(cm, __shfl_xor(cm, 16)); cm = fmaxf(cm, __shfl_xor(cm, 32));
      mn = fmaxf(mn, cm);
      const float alpha = __builtin_amdgcn_exp2f(m[hh] - mn);
      m[hh] = mn; l[hh] *= alpha;
#pragma unroll
      for (int dt = 0; dt < 4; ++dt) O[hh][dt] = O[hh][dt] * alpha;
    }
    float pv[8]; float ps = 0.f;
#pragma unroll
    for (int idx = 0; idx < 8; ++idx) { pv[idx] = val[idx] ? __builtin_amdgcn_exp2f(fmaf(s[idx >> 2][idx & 3], SC, -mn)) : 0.f; ps += pv[idx]; }
    l[hh] += ps;
    const bf16x8 pf = mk8((u32x4){pk2(pv[0], pv[1]), pk2(pv[2], pv[3]), pk2(pv[4], pv[5]), pk2(pv[6], pv[7])});
#pragma unroll
    for (int dt = 0; dt < 4; ++dt) O[hh][dt] = MFMA16(f.v[dt], pf, O[hh][dt]);
  }
}

template <int MODE>
DI void nsa_branch(const bf16_t* __restrict__ Kb, const bf16_t* __restrict__ Vtb, unsigned char* lds, int nb, int t, int cur, unsigned selmask, unsigned umall,
                   const bf16x8 (&qf)[4][2], f32x4 (&O)[4][4], float (&m)[4], float (&l)[4], bool online) {
  const int tid = my_tid(), lane = tid & 63, qi = lane & 15, quad = lane >> 4;
  const int* blist = (const int*)(lds + NSA_BLIST);
  const bool isv = tid >= 256;
  const int t2 = tid & 255;
  const bf16_t* gsrc = isv ? Vtb + (t2 >> 2) * 32 + (t2 & 3) * 8 : Kb + (long)(t2 >> 3) * 64 + (t2 & 7) * 8;
  const long gmul = 64;
  const int ldst = isv ? 32 * NSA_KROW + (t2 >> 2) * NSA_VROW + (t2 & 3) * 16 : (t2 >> 3) * NSA_KROW + (t2 & 7) * 16;
  unsigned char* slot0 = lds + NSA_SLOT0; unsigned char* slot1 = slot0 + NSA_SLOT;
  const int N = 2 * nb;
  auto kbof = [&](int n) { return blist[n >> 1] * 64 + (n & 1) * 32; };
  u32x4 ra = *(const u32x4*)(gsrc + (long)kbof(0) * gmul), rb = *(const u32x4*)(gsrc + (long)kbof(1) * gmul);
  *(u32x4*)(slot0 + ldst) = ra;
  __syncthreads();
#pragma unroll 1
  for (int n = 0; n < N; n += 2) {
    const int j = blist[n >> 1];
    const bool won = MODE == 0 ? ((umall >> j) & 1u) != 0 : (j >= cur - 8 && j <= cur);
    const bool bit = (selmask >> j) & 1u;
    ra = *(const u32x4*)(gsrc + (long)kbof(min(n + 2, N - 2)) * gmul);
    if (won) { KVFrag f; nsa_ldsfrag(f, slot0, qi, quad); nsa_chunk<MODE>(f, j * 64, t, bit, qf, O, m, l, quad, online); }
    *(u32x4*)(slot1 + ldst) = rb;
    __syncthreads();
    rb = *(const u32x4*)(gsrc + (long)kbof(min(n + 3, N - 1)) * gmul);
    if (won) { KVFrag f; nsa_ldsfrag(f, slot1, qi, quad); nsa_chunk<MODE>(f, j * 64 + 32, t, bit, qf, O, m, l, quad, online); }
    *(u32x4*)(slot0 + ldst) = ra;
    __syncthreads();
  }
}

template <bool LAST>
DI void nsa_finish(u32x2* lo, f32x4 (&O)[4][4], float (&m)[4], float (&l)[4], const float (&gate)[4], const bf16_t* zp, bf16_t* yp, float minit) {
#pragma unroll
  for (int hh = 0; hh < 4; ++hh) {
    float lt = l[hh]; lt += __shfl_xor(lt, 16); lt += __shfl_xor(lt, 32);
    const float f = lt > 0.f ? gate[hh] / lt : 0.f;
#pragma unroll
    for (int dt = 0; dt < 4; ++dt) {
      const u32x2 a = lo[(hh * 4 + dt) * 64];
      const f32x4 v = (f32x4){bflo(a[0]), bfhi(a[0]), bflo(a[1]), bfhi(a[1])} + O[hh][dt] * f;
      if (LAST) {
        const u32x2 zz = *(const u32x2*)(zp + hh * 64 + dt * 16);
        *(u32x2*)(yp + hh * 64 + dt * 16) = (u32x2){pk2(v[0] * bflo(zz[0]), v[1] * bfhi(zz[0])), pk2(v[2] * bflo(zz[1]), v[3] * bfhi(zz[1]))};
      } else {
        lo[(hh * 4 + dt) * 64] = (u32x2){pk2(v[0], v[1]), pk2(v[2], v[3])};
        O[hh][dt] = (f32x4){0.f, 0.f, 0.f, 0.f};
      }
    }
    m[hh] = minit; l[hh] = 0.f;
  }
}

DI void nsa_wave(const Params& p, int layer, int b, int g, int t0, unsigned char* lds, bf16_t* ybase) {
  const int lane = my_tid() & 63, qi = lane & 15, quad = lane >> 4;
  const int t = t0 + qi, cur = t0 >> 6;
  const long tok = (long)b * SEQ + t;
  const int bg = b * 2 + g;
  u32x2* lo = (u32x2*)lds + (my_tid() >> 6) * 1024 + lane;

  const float mf_c = p.mfix()[layer * 4 + 0], mf_s = p.mfix()[layer * 4 + 1], mf_w = p.mfix()[layer * 4 + 2];
  const bool on_c = mf_c > 60.f, on_s = mf_s > 60.f, on_w = mf_w > 60.f;
  const float SC = 0.125f * 1.44269504089f;
  const bf16_t* Kc = p.kc() + (long)bg * 128 * 64;
  const bf16_t* Vc = p.vct() + (long)bg * 64 * 128;
  f32x4 ph[8];
#pragma unroll
  for (int kt = 0; kt < 8; ++kt) ph[kt] = (f32x4){0.f, 0.f, 0.f, 0.f};
#pragma unroll 1
  for (int hh = 0; hh < 4; ++hh) {
    const bf16_t* qp0 = p.nq() + ((long)(b * 8 + g * 4 + hh) * SEQ + t) * 64 + quad * 8;
    const bf16x8 q0 = ld8(qp0), q1 = ld8(qp0 + 32); const float gt = p.ngate()[tok * 32 + g * 4 + hh];
    f32x4 sc[8];
    float mx = on_c ? -1e30f : mf_c;
#pragma unroll
    for (int kt = 0; kt < 8; ++kt) {
      const bf16_t* kp = Kc + (long)(kt * 16 + qi) * 64 + quad * 8;
      sc[kt] = MFMA16(ld8(kp), q0, ((f32x4){0.f, 0.f, 0.f, 0.f}));
      sc[kt] = MFMA16(ld8(kp + 32), q1, sc[kt]);
      sc[kt] = sc[kt] * SC;
    }
    if (on_c) {
#pragma unroll
      for (int kt = 0; kt < 8; ++kt)
#pragma unroll
        for (int r = 0; r < 4; ++r) { const int c = kt * 16 + quad * 4 + r; if (c < NCMP && 16 * c + 31 <= t) mx = fmaxf(mx, sc[kt][r]); }
      mx = fmaxf(mx, __shfl_xor(mx, 16)); mx = fmaxf(mx, __shfl_xor(mx, 32));
    }
    float sum = 0.f;
#pragma unroll
    for (int kt = 0; kt < 8; ++kt)
#pragma unroll
      for (int r = 0; r < 4; ++r) {
        const int c = kt * 16 + quad * 4 + r;
        const float e = (c < NCMP && 16 * c + 31 <= t) ? __builtin_amdgcn_exp2f(sc[kt][r] - mx) : 0.f;
        sc[kt][r] = e; sum += e;
      }
    sum += __shfl_xor(sum, 16); sum += __shfl_xor(sum, 32);
    const float inv = sum > 0.f ? 1.f / sum : 0.f;
#pragma unroll
    for (int kt = 0; kt < 8; ++kt) { sc[kt] = sc[kt] * inv; ph[kt] += sc[kt]; }
    f32x4 oc[4];
#pragma unroll
    for (int dt = 0; dt < 4; ++dt) oc[dt] = (f32x4){0.f, 0.f, 0.f, 0.f};
#pragma unroll
    for (int mm = 0; mm < 4; ++mm) {
      const bf16x8 pf = mk8((u32x4){pk2(sc[2 * mm][0], sc[2 * mm][1]), pk2(sc[2 * mm][2], sc[2 * mm][3]), pk2(sc[2 * mm + 1][0], sc[2 * mm + 1][1]), pk2(sc[2 * mm + 1][2], sc[2 * mm + 1][3])});
#pragma unroll
      for (int dt = 0; dt < 4; ++dt) {
        const bf16_t* vp = Vc + (long)(dt * 16 + qi) * 128 + 32 * mm + quad * 4;
        const u32x2 lo = *(const u32x2*)vp, hi = *(const u32x2*)(vp + 16);
        oc[dt] = MFMA16(mk8((u32x4){lo[0], lo[1], hi[0], hi[1]}), pf, oc[dt]);
      }
    }
#pragma unroll
    for (int dt = 0; dt < 4; ++dt) { const f32x4 v = oc[dt] * gt; lo[(hh * 4 + dt) * 64] = (u32x2){pk2(v[0], v[1]), pk2(v[2], v[3])}; }
  }
  float imp[8];
  {
    float rot[8];
#pragma unroll
    for (int kt = 0; kt < 8; ++kt) rot[kt] = __shfl(ph[kt][3], (lane + 48) & 63);
#pragma unroll
    for (int kt = 0; kt < 8; ++kt) {
      const float extra = quad > 0 ? rot[kt] : (kt > 0 ? rot[kt > 0 ? kt - 1 : 0] : 0.f);
      const float v = (ph[kt][0] + ph[kt][1]) + (ph[kt][2] + ph[kt][3]) + extra;
      const int j = 4 * kt + quad;
      const bool forced = j == 0 || j == cur || j == cur - 1;
      imp[kt] = j <= cur ? v + (forced ? 1e4f : 0.f) : -1e30f;
    }
  }
  unsigned selmask = 0;
  {
    int rank[8];
#pragma unroll
    for (int kt = 0; kt < 8; ++kt) rank[kt] = 0;
#pragma unroll 1
    for (int q2 = 0; q2 < 4; ++q2)
#pragma unroll
      for (int k2 = 0; k2 < 8; ++k2) {
        const float ov = __shfl(imp[k2], qi + 16 * q2);
#pragma unroll
        for (int kt = 0; kt < 8; ++kt) {
          const bool before = k2 < kt || (k2 == kt && q2 < quad);
          rank[kt] += (ov > imp[kt] || (ov == imp[kt] && before)) ? 1 : 0;
        }
      }
#pragma unroll
    for (int kt = 0; kt < 8; ++kt) if (rank[kt] < 8 && 4 * kt + quad <= cur) selmask |= 1u << (4 * kt + quad);
    selmask |= __shfl_xor(selmask, 16); selmask |= __shfl_xor(selmask, 32);
  }

  unsigned umall = selmask;
  umall |= __shfl_xor(umall, 1); umall |= __shfl_xor(umall, 2); umall |= __shfl_xor(umall, 4); umall |= __shfl_xor(umall, 8);
  umall = __builtin_amdgcn_readfirstlane(umall);
  const int wv = my_tid() >> 6;
  unsigned* umw = (unsigned*)(lds + NSA_UMW); int* blist = (int*)(lds + NSA_BLIST);
  if (lane == 0) umw[wv] = umall;
  bf16x8 qf[4][2];
#pragma unroll
  for (int hh = 0; hh < 4; ++hh) {
    const bf16_t* qp = p.nq() + ((long)(b * 8 + g * 4 + hh) * SEQ + t) * 64 + quad * 8;
    qf[hh][0] = ld8(qp); qf[hh][1] = ld8(qp + 32);
  }
  float gate[3][4];
#pragma unroll
  for (int br = 1; br < 3; ++br) { const f32x4 gv = *(const f32x4*)(p.ngate() + tok * 32 + br * 8 + g * 4); gate[br][0] = gv[0]; gate[br][1] = gv[1]; gate[br][2] = gv[2]; gate[br][3] = gv[3]; }
  f32x4 O[4][4]; float m[4], l[4];
#pragma unroll
  for (int hh = 0; hh < 4; ++hh) { m[hh] = on_s ? -1e30f : mf_s; l[hh] = 0.f;
#pragma unroll
    for (int dt = 0; dt < 4; ++dt) O[hh][dt] = (f32x4){0.f, 0.f, 0.f, 0.f}; }
  __syncthreads();
  int nb;
  {
    unsigned ub = 0;
#pragma unroll
    for (int i = 0; i < 8; ++i) ub |= umw[i];
    nb = __builtin_popcount(ub);
    if (my_tid() < 32) { if ((ub >> my_tid()) & 1u) blist[__builtin_popcount(ub & ((1u << my_tid()) - 1u))] = my_tid(); }
    __syncthreads();
    nsa_branch<0>(p.ks() + (long)bg * SEQ * 64, p.vst() + (long)bg * 64 * SEQ, lds, nb, t, cur, selmask, umall, qf, O, m, l, on_s);
    nsa_finish<false>(lo, O, m, l, gate[1], nullptr, nullptr, on_w ? -1e30f : mf_w);
  }
  {
    const int cur0 = (t0 >> 7) * 2, jlo = cur0 >= 8 ? cur0 - 8 : 0;
    nb = cur0 + 2 - jlo;
    if (my_tid() < nb) blist[my_tid()] = jlo + my_tid();
    __syncthreads();
    nsa_branch<1>(p.kw() + (long)bg * SEQ * 64, p.vwt() + (long)bg * 64 * SEQ, lds, nb, t, cur, selmask, umall, qf, O, m, l, on_w);
    nsa_finish<true>(lo, O, m, l, gate[2], p.nz() + tok * 512 + g * 256 + quad * 4, ybase + tok * 512 + g * 256 + quad * 4, 0.f);
  }
  __syncthreads();
}

DI void phaseC(const Params& p0, int layer, unsigned char* lds, bool probe) {
  const int NITEM = BATCH * 2 * 16;
  for (int it = blockIdx.x; it < NITEM; it += gridDim.x) {
    const Params p = relaunder(p0);
    const int qi5 = it >> 5, qt = qi5 < 8 ? 15 - qi5 : qi5 - 8, bg = it & 31;
    nsa_wave(p, layer, bg >> 1, bg & 1, qt * 128 + (my_tid() >> 6) * 16, lds, probe ? p.dummy() : p.nz());
  }
}

DI void phaseD(const Params& p0, const Slot sl, int layer, unsigned char* lds) {
  const Params p = relaunder(p0);
  bf16_t* gl = (bf16_t*)lds;
  int mt, nt;
  for (int it = 0; tile_order(sl, it, 4, mt, nt); ++it) {
#pragma unroll 1
    for (int which = 0; which < 2; ++which) {
      const bf16_t* Wg = (which ? p.wupb_t() : p.wupa_t()) + ((long)nt * 256) * 512;
      const bf16_t* Yg = (which ? p.nz() : p.sbz()) + (long)mt * 256 * 512;
      const bf16_t* Gg = which ? p.gb() : p.ga();
      int mt2 = mt, nt2 = nt; bool more = true;
      if (which) more = tile_order(sl, it + 1, 4, mt2, nt2);
      const bf16_t* Wn = more ? (which ? p.wupa_t() : p.wupb_t()) + ((long)nt2 * 256) * 512 : Wg;
      const bf16_t* Yn = more ? (which ? p.sbz() : p.nz()) + (long)mt2 * 256 * 512 : Yg;
      f32x4 acc[8][4]; zero_acc(acc);
      gemm_core(Wg, 512, Yg, 512, 512, gl, acc, 64, it > 0 || which, Wn, Yn);
      const int tid = my_tid(), lane = tid & 63, w = tid >> 6, wa = w >> 2, wb = w & 3, qi = lane & 15, quad = lane >> 4;
#pragma unroll
      for (int j = 0; j < 4; ++j) {
        const long tok = (long)mt * 256 + wb * 64 + j * 16 + qi;
#pragma unroll
        for (int i = 0; i < 8; ++i) {
          const long off = tok * 1024 + nt * 256 + wa * 128 + i * 16 + quad * 4;
          const u32x2 xg = *(const u32x2*)(Gg + off);
          const f32x4 v = acc[i][j];
          float o0 = bflo(xg[0]) * v[0], o1 = bfhi(xg[0]) * v[1], o2 = bflo(xg[1]) * v[2], o3 = bfhi(xg[1]) * v[3];
          if (which) { const u32x2 a = *(const u32x2*)(p.merged() + off); o0 += bflo(a[0]); o1 += bfhi(a[0]); o2 += bflo(a[1]); o3 += bfhi(a[1]); }
          *(u32x2*)(p.merged() + off) = (u32x2){pk2(o0, o1), pk2(o2, o3)};
          if ((i & 3) == 3) asm volatile("" ::: "memory");
        }
      }
    }
  }
}

DI void phaseE(const Params& p0, const Slot sl, int layer, unsigned char* lds, const float* xsrc) {
  const Params p = relaunder(p0);
  bf16_t* gl = (bf16_t*)lds;
  int mt, nt;
  for (int it = 0; tile_order(sl, it, 4, mt, nt); ++it) {
    f32x4 acc[8][4]; zero_acc(acc);
    int mt2, nt2;
    const bool more = tile_order(sl, it + 1, 4, mt2, nt2);
    const bf16_t* Wg = p.wout_t() + ((long)nt * 256) * 1024; const bf16_t* Mg = p.merged() + (long)mt * 256 * 1024;
    gemm_core(Wg, 1024, Mg, 1024, 1024, gl, acc, 64, it > 0, more ? p.wout_t() + ((long)nt2 * 256) * 1024 : Wg, more ? p.merged() + (long)mt2 * 256 * 1024 : Mg);
    const int tid = my_tid(), lane = tid & 63, w = tid >> 6, wa = w >> 2, wb = w & 3, qi = lane & 15, quad = lane >> 4;
#pragma unroll
    for (int j = 0; j < 4; ++j) {
      const long tok = (long)mt * 256 + wb * 64 + j * 16 + qi;
      float ss = 0.f;
#pragma unroll
      for (int i = 0; i < 8; ++i) {
        const long off = tok * 1024 + nt * 256 + wa * 128 + i * 16 + quad * 4;
        const f32x4 xo = *(const f32x4*)(xsrc + off);
        const f32x4 xn = xo + acc[i][j];
        *(f32x4*)(p.out + off) = xn;
        *(u32x2*)(p.xb() + off + tok * (LDX - D_MODEL)) = (u32x2){pk2(xn[0], xn[1]), pk2(xn[2], xn[3])};
        ss += xn[0] * xn[0] + xn[1] * xn[1] + xn[2] * xn[2] + xn[3] * xn[3];
      }
      ss += __shfl_xor(ss, 16); ss += __shfl_xor(ss, 32);
      if (quad == 0) p.part()[tok * 16 + nt * 2 + wa] = ss;
    }
  }
}

#ifndef STOP_AFTER
#define STOP_AFTER 0
#endif
constexpr int LDS_BYTES = LDS_GEMM_BYTES + 1024;

__global__ void __launch_bounds__(512) hybrid_megakernel(Params p) {
  extern __shared__ __attribute__((aligned(16))) unsigned char lds[];
  cg::grid_group grid = cg::this_grid();
  __shared__ int s_xcc, s_rank, s_ok;
  __shared__ unsigned s_bar[4];
  if (threadIdx.x == 0) { s_bar[0] = 0u; s_bar[1] = 0u; }
  __syncthreads();
  const XcdBarrier xb = xcd_barrier_post((unsigned*)(p.ws + OFF_BAR), (volatile LAS unsigned*)s_bar);
  if (threadIdx.x == 0) {
    const unsigned xcc = (unsigned)__builtin_amdgcn_s_getreg((3 << 11) | 20) & 7u;
    s_xcc = (int)xcc; s_rank = (int)atomicAdd(p.ctl() + xcc, 1u);
  }
  phase_prologue(p, lds);
  xcd_barrier(xb);
  if (p.ws == nullptr) grid.sync();
  if (threadIdx.x == 0) {
    int ok = 1;
    for (int i = 0; i < 8; ++i) ok &= (__hip_atomic_load(p.ctl() + i, __ATOMIC_RELAXED, __HIP_MEMORY_SCOPE_AGENT) == (gridDim.x >> 3));
    s_ok = ok;
  }
  __syncthreads();
  const Slot sl = {s_ok ? s_xcc : (int)(blockIdx.x & 7), s_ok ? s_rank : (int)(blockIdx.x >> 3)};
  for (int layer = 0; layer < DEPTH; ++layer) {
    if (layer > 0) convert_weights(p, layer, lds, 2);
    if (STOP_AFTER != 0 && STOP_AFTER == layer * 10) return;
    phaseA(p, sl, layer, lds);
    xcd_barrier(xb);
#ifdef PROBE_A
    phaseA(p, sl, layer, lds, PROBE_A >= 2 ? PROBE_A : 0);
    xcd_barrier(xb);
#endif
    if (STOP_AFTER == layer * 10 + 1) return;
#ifdef PROBE_B
    phaseB(p, layer, lds, true);
    xcd_barrier(xb);
#endif
    phaseB(p, layer, lds, false);
    xcd_barrier(xb);
    phaseB2(p, layer, lds);
    xcd_barrier(xb);
    if (STOP_AFTER == layer * 10 + 2) return;
#ifdef PROBE_C
    phaseC(p, layer, lds, true);
    xcd_barrier(xb);
#endif
    phaseC(p, layer, lds, false);
    xcd_barrier(xb);
    if (STOP_AFTER == layer * 10 + 3) return;
    phaseD(p, sl, layer, lds);
    xcd_barrier(xb);
#ifdef PROBE_D
    phaseD(p, sl, layer, lds);
    xcd_barrier(xb);
#endif
    if (STOP_AFTER == layer * 10 + 4) return;
    if (layer == 0) phaseE(p, sl, layer, lds, p.x_in); else phaseE(p, sl, layer, lds, p.out);
    if (layer + 1 < DEPTH) convert_weights(p, layer + 1, lds, 1);
    if (layer + 1 < DEPTH) xcd_barrier(xb);
    if (STOP_AFTER == layer * 10 + 5) return;
  }
}

extern "C" void kernel_launch(void* const* d_in, const int* in_sizes, int n_in, void* d_out, int out_size,
                              void* d_ws, size_t ws_size, hipStream_t stream) {
  static int grid_blocks = 0;
  if (!grid_blocks) {
    int dev = 0, cus = 0, per_cu = 0;
    (void)hipGetDevice(&dev);
    (void)hipDeviceGetAttribute(&cus, hipDeviceAttributeMultiprocessorCount, dev);
    if (hipFuncSetAttribute((const void*)hybrid_megakernel, hipFuncAttributeMaxDynamicSharedMemorySize, LDS_BYTES) != hipSuccess) fprintf(stderr, "hipFuncSetAttribute(max dynamic LDS) failed\n");
    (void)hipOccupancyMaxActiveBlocksPerMultiprocessor(&per_cu, hybrid_megakernel, NTHR, LDS_BYTES);
    (void)hipGetLastError();
    if (per_cu > 1) per_cu = 1;
    if (per_cu < 1) per_cu = 1;
    grid_blocks = (cus * per_cu) & ~7;
  }
  Params a{};
  a.x_in = (const float*)d_in[0]; a.pos = (const int*)d_in[1]; a.norm_g = (const float*)d_in[2]; a.w_in = (const float*)d_in[3];
  a.q_norm_g = (const float*)d_in[4]; a.k_norm_g = (const float*)d_in[5]; a.cmp_pe = (const float*)d_in[6]; a.cmp_w1 = (const float*)d_in[7];
  a.cmp_b1 = (const float*)d_in[8]; a.cmp_w2 = (const float*)d_in[9]; a.w_up_a = (const float*)d_in[10]; a.w_up_b = (const float*)d_in[11];
  a.w_out = (const float*)d_in[12];
  a.out = (float*)d_out; a.ws = (unsigned char*)d_ws;
  if (WS_NEED > ws_size) { fprintf(stderr, "workspace too small: need %zu have %zu\n", (size_t)WS_NEED, ws_size); return; }
  (void)hipMemsetAsync((unsigned char*)d_ws + OFF_CTL, 0, 256, stream);
  (void)hipMemsetAsync((unsigned char*)d_ws + OFF_BAR, 0, 3456 * 4, stream);
  void* args[] = {&a};
  hipError_t e = hipLaunchCooperativeKernel((void*)hybrid_megakernel, dim3(grid_blocks), dim3(NTHR), args, LDS_BYTES, stream);
  if (e != hipSuccess) fprintf(stderr, "cooperative launch failed: %s (grid %d)\n", hipGetErrorString(e), grid_blocks);
}
```
